# Optimizing an MI355X kernel written in HIP

```python
import math
import jax
import jax.numpy as jnp
from jax import lax
import numpy as np

D_MODEL = 1024
BATCH = 4
SEQ = 8192
DEPTH = 2

GRID_W = 64
CTX_LEN = 256
EPS = 1e-6

DN_HEADS = 8
DN_HEAD_DIM = 64
DN_DIM = DN_HEADS * DN_HEAD_DIM
DN_CONV_W = 5
DN_CHUNK = 64

AT_Q_HEADS = 8
AT_KV_HEADS = 2
AT_GROUP = AT_Q_HEADS // AT_KV_HEADS
AT_HEAD_DIM = 64
AT_Q_DIM = AT_Q_HEADS * AT_HEAD_DIM
AT_KV_DIM = AT_KV_HEADS * AT_HEAD_DIM
Q_BLOCK = 128
ROPE_THETA = 10000.0
ROPE_AXIS_DIM = AT_HEAD_DIM // 2

FFN_DIM = 2816
N_EXPERTS = 8
TOP_K = 2
EXPERT_DIM = 3584
MOE_BLOCK = 256
N_DENSE = (DEPTH + 1) // 2
N_MOE = DEPTH // 2

OFF_DN_Z = 3 * DN_DIM
OFF_DN_A = OFF_DN_Z + DN_DIM
OFF_DN_B = OFF_DN_A + 2 * DN_HEADS
OFF_AT_Q = OFF_DN_B + 2 * DN_HEADS
OFF_AT_K = OFF_AT_Q + AT_Q_DIM
OFF_AT_V = OFF_AT_K + AT_KV_DIM
IN_DIM = OFF_AT_V + AT_KV_DIM
MIX_DIM = DN_DIM + AT_Q_DIM

kernel_name = 'hybrid_deltanet_axial_gqa_moe_prefix_dit'


def _rmsnorm(x, w):
    x32 = x.astype(jnp.float32)
    y = x32 * lax.rsqrt(jnp.mean(x32 * x32, axis=-1, keepdims=True) + EPS)
    return (y * w.astype(jnp.float32)).astype(x.dtype)


def _modulate(h, shift, scale):
    return h * (1.0 + scale) + shift


def _l2norm(x):
    return x * lax.rsqrt(jnp.sum(x * x, axis=-1, keepdims=True) + EPS)


def _centred_dwconv(x, w):
    pad = (w.shape[0] - 1) // 2
    return lax.conv_general_dilated(
        x, w[:, None, :], window_strides=(1,), padding=[(pad, pad)],
        dimension_numbers=('NWC', 'WIO', 'NWC'), feature_group_count=x.shape[-1])


def _axial_rope_tables(t):
    rows = t // GRID_W
    row_pos = jnp.repeat(jnp.arange(rows, dtype=jnp.float32), GRID_W, total_repeat_length=t)
    col_pos = jnp.tile(jnp.arange(GRID_W, dtype=jnp.float32), rows)
    n_freq = ROPE_AXIS_DIM // 2
    freqs = ROPE_THETA ** (-jnp.arange(n_freq, dtype=jnp.float32) / n_freq)
    ang = jnp.concatenate([row_pos[:, None] * freqs, col_pos[:, None] * freqs], axis=-1)
    return jnp.cos(ang), jnp.sin(ang)


def _apply_rope(x, cos, sin):
    half = x.shape[-1] // 2
    x32 = x.astype(jnp.float32)
    x1, x2 = x32[..., :half], x32[..., half:]
    cos, sin = cos[None, :, None, :], sin[None, :, None, :]
    return jnp.concatenate([x1 * cos - x2 * sin, x2 * cos + x1 * sin], axis=-1).astype(x.dtype)


def _gated_delta_chunked(q, k, v, g, beta, s0):
    b, h, t, dk = q.shape
    dv = v.shape[-1]
    n = t // DN_CHUNK
    chunk = lambda z: z.reshape((b, h, n, DN_CHUNK) + z.shape[3:])
    q, k, v, g, beta = chunk(q), chunk(k), chunk(v), chunk(g), chunk(beta)
    g = jnp.cumsum(g, axis=-1)
    incl = jnp.tril(jnp.ones((DN_CHUNK, DN_CHUNK), dtype=bool))
    strict = jnp.tril(jnp.ones((DN_CHUNK, DN_CHUNK), dtype=bool), -1)
    diff = g[..., :, None] - g[..., None, :]
    decay = jnp.where(incl, jnp.exp(jnp.where(incl, diff, 0.0)), 0.0)
    k_beta = k * beta[..., None]
    a_low = jnp.where(strict, jnp.einsum('bhncd,bhnsd->bhncs', k_beta, k) * decay, 0.0)
    rhs = jnp.concatenate([v * beta[..., None], k_beta * jnp.exp(g)[..., None]], axis=-1)
    eye = jnp.eye(DN_CHUNK, dtype=q.dtype)
    sol = lax.linalg.triangular_solve(a_low + eye, rhs, left_side=True, lower=True, unit_diagonal=True)
    u, w = sol[..., :dv], sol[..., dv:]
    attn = jnp.where(incl, jnp.einsum('bhncd,bhnsd->bhncs', q, k) * decay, 0.0)
    q_dec = q * jnp.exp(g)[..., None]
    k_dec = k * jnp.exp(g[..., -1:] - g)[..., None]
    g_last = jnp.exp(g[..., -1])

    def step(s, xs):
        u_c, w_c, attn_c, q_c, k_c, gl_c = xs
        v_new = u_c - jnp.einsum('bhcd,bhde->bhce', w_c, s)
        o_c = jnp.einsum('bhcd,bhde->bhce', q_c, s) + jnp.einsum('bhcs,bhse->bhce', attn_c, v_new)
        s = s * gl_c[..., None, None] + jnp.einsum('bhcd,bhce->bhde', k_c, v_new)
        return s, o_c

    xs = tuple(jnp.moveaxis(z, 2, 0) for z in (u, w, attn, q_dec, k_dec, g_last))
    s_final, o = lax.scan(step, s0, xs)
    o = jnp.moveaxis(o, 0, 2).reshape(b, h, t, dv)
    return o, s_final


def _dn_streams(p, conv_w, a_log, dt_bias):
    b, t, _ = p.shape
    p = p.astype(jnp.float32)
    qkv = jax.nn.silu(_centred_dwconv(p[..., :3 * DN_DIM], conv_w.astype(jnp.float32)))
    q, k, v = jnp.split(qkv, 3, axis=-1)
    heads = lambda z: z.reshape(b, t, DN_HEADS, DN_HEAD_DIM).transpose(0, 2, 1, 3)
    q = _l2norm(heads(q)) * (DN_HEAD_DIM ** -0.5)
    k = _l2norm(heads(k))
    v = heads(v)
    a = p[..., OFF_DN_A:OFF_DN_A + 2 * DN_HEADS].reshape(b, t, 2, DN_HEADS)
    bb = p[..., OFF_DN_B:OFF_DN_B + 2 * DN_HEADS].reshape(b, t, 2, DN_HEADS)
    g = -jnp.exp(a_log.astype(jnp.float32)) * jax.nn.softplus(a + dt_bias.astype(jnp.float32))
    beta = jax.nn.sigmoid(bb)
    return q, k, v, g.transpose(2, 0, 3, 1), beta.transpose(2, 0, 3, 1)


def _bidir_delta(q, k, v, g, beta, s0_f, s0_b):
    flip = lambda z: jnp.flip(z, axis=2)
    o_f, s_f = _gated_delta_chunked(q, k, v, g[0], beta[0], s0_f)
    o_b, s_b = _gated_delta_chunked(flip(q), flip(k), flip(v), flip(g[1]), flip(beta[1]), s0_b)
    return o_f + flip(o_b), s_f, s_b


def _dn_output(o, p, norm_w):
    b, h, t, dv = o.shape
    o = o.transpose(0, 2, 1, 3)
    o = o * lax.rsqrt(jnp.mean(o * o, axis=-1, keepdims=True) + EPS) * norm_w.astype(jnp.float32)
    z = p[..., OFF_DN_Z:OFF_DN_Z + DN_DIM].astype(jnp.float32).reshape(b, t, h, dv)
    return (o * jax.nn.silu(z)).reshape(b, t, DN_DIM).astype(p.dtype)


def _gated_deltanet(p_lat, p_ctx, conv_w, a_log, dt_bias, norm_w, need_ctx_out):
    b = p_lat.shape[0]
    zero = jnp.zeros((b, DN_HEADS, DN_HEAD_DIM, DN_HEAD_DIM), jnp.float32)
    qc, kc, vc, gc, bc = _dn_streams(p_ctx, conv_w, a_log, dt_bias)
    o_c, s_f, s_b = _bidir_delta(qc, kc, vc, gc, bc, zero, zero)
    q, k, v, g, be = _dn_streams(p_lat, conv_w, a_log, dt_bias)
    o, _, _ = _bidir_delta(q, k, v, g, be, s_f, s_b)
    lat = _dn_output(o, p_lat, norm_w)
    ctx = _dn_output(o_c, p_ctx, norm_w) if need_ctx_out else None
    return lat, ctx


def _attend(qb, kk, vv):
    s = jnp.einsum('bqkgd,bskd->bkgqs', qb, kk).astype(jnp.float32) * (AT_HEAD_DIM ** -0.5)
    pr = jax.nn.softmax(s, axis=-1).astype(vv.dtype)
    return jnp.einsum('bkgqs,bskd->bqkgd', pr, vv)


def _axial_gqa(p_lat, p_ctx, qn_w, kn_w, need_ctx_out):
    b, t, _ = p_lat.shape
    lc = p_ctx.shape[1]
    q_of = lambda p: _rmsnorm(p[..., OFF_AT_Q:OFF_AT_Q + AT_Q_DIM].reshape(p.shape[0], p.shape[1], AT_Q_HEADS, AT_HEAD_DIM), qn_w)
    k_of = lambda p: _rmsnorm(p[..., OFF_AT_K:OFF_AT_K + AT_KV_DIM].reshape(p.shape[0], p.shape[1], AT_KV_HEADS, AT_HEAD_DIM), kn_w)
    v_of = lambda p: p[..., OFF_AT_V:OFF_AT_V + AT_KV_DIM].reshape(p.shape[0], p.shape[1], AT_KV_HEADS, AT_HEAD_DIM)
    cos, sin = _axial_rope_tables(t)
    q = _apply_rope(q_of(p_lat), cos, sin)
    k = _apply_rope(k_of(p_lat), cos, sin)
    kc, vc = k_of(p_ctx), v_of(p_ctx)
    k_all = jnp.concatenate([k, kc], axis=1)
    v_all = jnp.concatenate([v_of(p_lat), vc], axis=1)
    nb = t // Q_BLOCK
    qb = q.reshape(b, nb, Q_BLOCK, AT_KV_HEADS, AT_GROUP, AT_HEAD_DIM).transpose(1, 0, 2, 3, 4, 5)
    o = lax.map(lambda blk: _attend(blk, k_all, v_all), qb)
    lat = o.transpose(1, 0, 2, 3, 4, 5).reshape(b, t, AT_Q_DIM)
    ctx = None
    if need_ctx_out:
        qc = q_of(p_ctx).reshape(b, lc, AT_KV_HEADS, AT_GROUP, AT_HEAD_DIM)
        ctx = _attend(qc, kc, vc).reshape(b, lc, AT_Q_DIM)
    return lat, ctx


def _swiglu(h, w_gate, w_up, w_down):
    return (jax.nn.silu(h @ w_gate) * (h @ w_up)) @ w_down


def _moe_swiglu(h, router_w, router_b, w_gate, w_up, w_down):
    b, l, d = h.shape
    hf = h.reshape(-1, d)
    n = hf.shape[0]
    logits = (hf @ router_w).astype(jnp.float32) + router_b.astype(jnp.float32)
    top_val, top_e = lax.top_k(logits, TOP_K)
    top_w = jax.nn.softmax(top_val, axis=-1)
    m = n * TOP_K
    flat_e = top_e.reshape(m)
    flat_tok = jnp.repeat(jnp.arange(n, dtype=jnp.int32), TOP_K)
    flat_w = top_w.reshape(m)
    order = jnp.argsort(flat_e, stable=True)
    sorted_e = flat_e[order]
    counts = jnp.bincount(flat_e, length=N_EXPERTS)
    padded = (counts + MOE_BLOCK - 1) // MOE_BLOCK * MOE_BLOCK
    start = jnp.cumsum(counts) - counts
    pad_end = jnp.cumsum(padded)
    pad_start = pad_end - padded
    dest = pad_start[sorted_e] + jnp.arange(m, dtype=jnp.int32) - start[sorted_e]
    p_rows = ((m + MOE_BLOCK - 1) // MOE_BLOCK + N_EXPERTS) * MOE_BLOCK
    row_tok = jnp.full((p_rows,), n, jnp.int32).at[dest].set(flat_tok[order])
    row_w = jnp.zeros((p_rows,), jnp.float32).at[dest].set(flat_w[order])
    nblk = p_rows // MOE_BLOCK
    blk_e = jnp.minimum(jnp.searchsorted(pad_end, jnp.arange(nblk, dtype=pad_end.dtype) * MOE_BLOCK, side='right'), N_EXPERTS - 1)
    xs = jnp.concatenate([hf, jnp.zeros((1, d), hf.dtype)], axis=0)[row_tok].reshape(nblk, MOE_BLOCK, d)

    def expert_block(args):
        xb, e = args
        return _swiglu(xb, w_gate[e], w_up[e], w_down[e])

    ys = lax.map(expert_block, (xs, blk_e)).reshape(p_rows, d)
    out = jnp.zeros((n + 1, d), ys.dtype).at[row_tok].add(ys * row_w[:, None].astype(ys.dtype))
    return out[:n].reshape(b, l, d)


def setup_inputs(seed: int = 0) -> dict:
    key = jax.random.key(seed)
    ks = jax.random.split(key, 32)
    f32 = jnp.float32
    D, L = D_MODEL, DEPTH
    nrm = lambda k, shape, s: jax.random.normal(k, shape, f32) * s
    dt = jnp.exp(jax.random.uniform(ks[10], (L, 2, DN_HEADS), f32, math.log(1e-3), math.log(1e-1)))
    return {
        'x': nrm(ks[0], (BATCH, SEQ, D), 1.0),
        'c': nrm(ks[1], (BATCH, D), 1.0),
        'ctx': nrm(ks[2], (BATCH, CTX_LEN, D), 1.0),
        'c_ctx': nrm(ks[3], (D,), 1.0),
        'w_mod': nrm(ks[4], (L, D, 6 * D), 0.5 * D ** -0.5),
        'b_mod': nrm(ks[5], (L, 6 * D), 0.02),
        'norm1_w': 1.0 + nrm(ks[6], (L, D), 0.02),
        'norm2_w': 1.0 + nrm(ks[7], (L, D), 0.02),
        'w_in': nrm(ks[8], (L, D, IN_DIM), D ** -0.5),
        'dn_conv_w': nrm(ks[9], (L, DN_CONV_W, 3 * DN_DIM), DN_CONV_W ** -0.5),
        'dn_a_log': jnp.log(jax.random.uniform(ks[11], (L, 2, DN_HEADS), f32, 1.0, 16.0)),
        'dn_dt_bias': dt + jnp.log(-jnp.expm1(-dt)),
        'dn_norm_w': 1.0 + nrm(ks[12], (L, DN_HEAD_DIM), 0.02),
        'at_qnorm_w': 1.0 + nrm(ks[13], (L, AT_HEAD_DIM), 0.02),
        'at_knorm_w': 1.0 + nrm(ks[14], (L, AT_HEAD_DIM), 0.02),
        'w_out': nrm(ks[15], (L, MIX_DIM, D), MIX_DIM ** -0.5),
        'ffn_w_gate': nrm(ks[16], (N_DENSE, D, FFN_DIM), D ** -0.5),
        'ffn_w_up': nrm(ks[17], (N_DENSE, D, FFN_DIM), D ** -0.5),
        'ffn_w_down': nrm(ks[18], (N_DENSE, FFN_DIM, D), FFN_DIM ** -0.5),
        'moe_router_w': nrm(ks[19], (N_MOE, D, N_EXPERTS), D ** -0.5),
        'moe_router_b': nrm(ks[20], (N_MOE, N_EXPERTS), 0.01),
        'moe_w_gate': nrm(ks[21], (N_MOE, N_EXPERTS, D, EXPERT_DIM), D ** -0.5),
        'moe_w_up': nrm(ks[22], (N_MOE, N_EXPERTS, D, EXPERT_DIM), D ** -0.5),
        'moe_w_down': nrm(ks[23], (N_MOE, N_EXPERTS, EXPERT_DIM, D), EXPERT_DIM ** -0.5),
        'final_norm_w': 1.0 + nrm(ks[24], (D,), 0.02),
    }


def reference(x, c, ctx, c_ctx, w_mod, b_mod, norm1_w, norm2_w, w_in, dn_conv_w, dn_a_log,
              dn_dt_bias, dn_norm_w, at_qnorm_w, at_knorm_w, w_out, ffn_w_gate, ffn_w_up,
              ffn_w_down, moe_router_w, moe_router_b, moe_w_gate, moe_w_up, moe_w_down,
              final_norm_w):
    xc = ctx
    sc = jax.nn.silu(c)
    scc = jax.nn.silu(c_ctx)
    for layer in range(DEPTH):
        last = layer == DEPTH - 1
        mod = (sc @ w_mod[layer] + b_mod[layer])[:, None, :]
        mod_c = scc @ w_mod[layer] + b_mod[layer]
        sh1, sc1, g1, sh2, sc2, g2 = jnp.split(mod, 6, axis=-1)
        sh1c, sc1c, g1c, sh2c, sc2c, g2c = jnp.split(mod_c, 6, axis=-1)
        p = _modulate(_rmsnorm(x, norm1_w[layer]), sh1, sc1) @ w_in[layer]
        pc = _modulate(_rmsnorm(xc, norm1_w[layer]), sh1c, sc1c) @ w_in[layer]
        dn, dn_c = _gated_deltanet(p, pc, dn_conv_w[layer], dn_a_log[layer], dn_dt_bias[layer],
                                   dn_norm_w[layer], not last)
        at, at_c = _axial_gqa(p, pc, at_qnorm_w[layer], at_knorm_w[layer], not last)
        x = x + g1 * (jnp.concatenate([dn, at], axis=-1) @ w_out[layer])
        if layer % 2 == 0:
            i = layer // 2
            ffn = lambda t: _swiglu(t, ffn_w_gate[i], ffn_w_up[i], ffn_w_down[i])
        else:
            j = layer // 2
            ffn = lambda t: _moe_swiglu(t, moe_router_w[j], moe_router_b[j], moe_w_gate[j],
                                        moe_w_up[j], moe_w_down[j])
        x = x + g2 * ffn(_modulate(_rmsnorm(x, norm2_w[layer]), sh2, sc2))
        if not last:
            xc = xc + g1c * (jnp.concatenate([dn_c, at_c], axis=-1) @ w_out[layer])
            xc = xc + g2c * ffn(_modulate(_rmsnorm(xc, norm2_w[layer]), sh2c, sc2c))
    return _rmsnorm(x, final_norm_w)
```

```cpp
#include <hip/hip_runtime.h>
#include <hip/hip_bf16.h>
#include <cstdio>
#include <cstdint>
#include <cmath>
namespace pg8 {
#define PG8_LAS __attribute__((address_space(3)))
typedef unsigned short bf16_t;
typedef short bf16x8 __attribute__((ext_vector_type(8)));
typedef float f32x4 __attribute__((ext_vector_type(4)));
typedef unsigned u32x4 __attribute__((ext_vector_type(4)));
constexpr int BM = 256, BK = 64, HALF = 128, HTB = HALF * BK * 2  , STAGE_BYTES = 8 * HTB, NXCD = 8, WGM = 8;

__host__ __device__ __forceinline__ int lds_byte(int r, int c) { const int st = (r >> 4) * 2 + (c >> 5), rr = r & 15, cc = c & 31, ob = rr * 64 + cc * 2; return st * 1024 + (ob ^ (((ob >> 9) & 1) << 5)); }
__host__ __device__ __forceinline__ void stage_rc(int b, int& R, int& C) { const int st = b / 1024, sb = b % 1024, swz = sb ^ (((sb >> 9) & 1) << 5); R = (st >> 1) * 16 + swz / 64; C = (st & 1) * 32 + (swz % 64) / 2; }
__host__ __device__ __forceinline__ int perm32(int rho) { const int n = rho >> 4, i = rho & 15; return 8 * (i >> 2) + 4 * n + (i & 3); }

struct Unit { int pm, pn; };
struct Gemm { const bf16_t* A; const bf16_t* Bt; int M, N, K; };

struct StaticOrder {
    int nM, nN, nwg, G, c;
    __host__ __device__ void init(int M, int N, int G_, int c_) { nM = M / BM; nN = N / BM; nwg = nM * nN; G = G_; c = c_; }
    __host__ __device__ bool next(int i, Unit& u) const {
        const long L = (long)i * G + c; if (L >= nwg) return false;
        int wgid = (int)L; { const int q = nwg / NXCD, r = nwg % NXCD, xcd = wgid % NXCD, off = wgid / NXCD; wgid = (xcd < r ? xcd * (q + 1) : r * (q + 1) + (xcd - r) * q) + off; }
        const int nig = WGM * nN, gid = wgid / nig, fm = gid * WGM, gsz = (nM - fm) < WGM ? (nM - fm) : WGM;
        u.pm = fm + ((wgid % nig) % gsz); u.pn = (wgid % nig) / gsz; return true;
    }
    __device__ __forceinline__ void a_ready(const Unit&) const {}
    __device__ __forceinline__ void done(const Unit&) const {}
};

__device__ __forceinline__ unsigned cvt_pk_bf16(float lo, float hi) { unsigned r; asm volatile("v_cvt_pk_bf16_f32 %0, %1, %2" : "=v"(r) : "v"(lo), "v"(hi)); return r; }
typedef float f32x2 __attribute__((ext_vector_type(2)));
__device__ __forceinline__ f32x2 gelu_pk(f32x2 v) {
    const f32x2 av = __builtin_elementwise_abs(v), d = av * 0.2316418882f + 1.0f;
    f32x2 t; t.x = __builtin_amdgcn_rcpf(d.x); t.y = __builtin_amdgcn_rcpf(d.y);
    f32x2 q = t * 0.5307027145f + (-0.7265760135f); q = q * t + 0.7107068705f; q = q * t + (-0.142248368f); q = q * t + 0.127414796f; q = q * t;
    const f32x2 s = (v * v) * (-0.72134752044f);
    f32x2 e; e.x = __builtin_amdgcn_exp2f(s.x); e.y = __builtin_amdgcn_exp2f(s.y);
    const f32x2 m = v * (q * e), r = v - m;
    f32x2 o; o.x = v.x < 0.f ? m.x : r.x; o.y = v.y < 0.f ? m.y : r.y; return o;
}

template <int ACT  > struct EpiBf16 {
    static constexpr bool PERM = true, AFTER_DRAIN = false; static_assert(ACT == 0 || ACT == 1, "EpiBf16: ACT is 0 (none) or 1 (gelu_pk)");
    bf16_t* O; int ldc; const float* bias; int split_cols; size_t split_stride; float scale0;
    __device__ __forceinline__ void operator()(const f32x4 (&acc)[2][2][4][2], const Unit& u, int wr, int wc, int fr, int fq) const {
        const int row0 = u.pm * BM + wr * 64 + fr; int colt = u.pn * BM; bf16_t* base = O;
        float sc = 1.f; if (split_cols) { const int t = colt / split_cols; base += (size_t)t * split_stride; colt -= t * split_cols; if (t == 0) sc = scale0; }
        const int col0 = colt + wc * 32 + 8 * fq, bcol0 = u.pn * BM + wc * 32 + 8 * fq;
        f32x4 bv[2][2];
#pragma unroll
        for (int bj = 0; bj < 2; ++bj)
#pragma unroll
            for (int n = 0; n < 2; ++n) bv[bj][n] = bias ? *(const f32x4*)(bias + bcol0 + bj * HALF + 4 * n) : (f32x4){0.f, 0.f, 0.f, 0.f};
#pragma unroll
        for (int ai = 0; ai < 2; ++ai)
#pragma unroll
            for (int m = 0; m < 4; ++m) { bf16_t* rowp = base + (size_t)(row0 + ai * HALF + m * 16) * ldc + col0;
#pragma unroll
                for (int bj = 0; bj < 2; ++bj) { f32x4 v0 = acc[ai][bj][m][0] + bv[bj][0], v1 = acc[ai][bj][m][1] + bv[bj][1];
                    if (ACT == 1) { f32x2 a = gelu_pk((f32x2){v0[0], v0[1]}), b = gelu_pk((f32x2){v0[2], v0[3]}), c = gelu_pk((f32x2){v1[0], v1[1]}), d = gelu_pk((f32x2){v1[2], v1[3]});
                        v0 = (f32x4){a.x, a.y, b.x, b.y}; v1 = (f32x4){c.x, c.y, d.x, d.y}; }
                    v0 = v0 * sc; v1 = v1 * sc; u32x4 w; w.x = cvt_pk_bf16(v0[0], v0[1]); w.y = cvt_pk_bf16(v0[2], v0[3]); w.z = cvt_pk_bf16(v1[0], v1[1]); w.w = cvt_pk_bf16(v1[2], v1[3]);
                    *(u32x4*)(rowp + bj * HALF) = w; } }
    }
};

template <class Epi, class Sched, bool ALIGN_EPI = false, bool SP2 = false>
__device__ __forceinline__ void gemm_phase(PG8_LAS unsigned char* lds, const Gemm g, const Sched& S, const Epi& E) {
    int tid_ = threadIdx.x; asm volatile("" : "+v"(tid_));
    const int tid = tid_, wid = __builtin_amdgcn_readfirstlane(tid >> 6), lane = tid & 63, wr = wid >> 2, wc = wid & 3, fr = lane & 15, fq = lane >> 4;
    const int K = g.K, nt = K / BK;
    unsigned voffA[2], voffB[2];
#pragma unroll
    for (int i = 0; i < 2; ++i) { int R, C; stage_rc(tid * 16 + i * 8192, R, C); const int Rb = Epi::PERM ? ((R & ~31) + perm32(R & 31)) : R;
        voffA[i] = (unsigned)(R * K + C) * 2u; voffB[i] = (unsigned)(Rb * K + C) * 2u; }
    const size_t kstep = (size_t)(BK * 2);
    const size_t hstep = (size_t)HALF * K * 2;
    const size_t tstep = 2 * hstep;
    const unsigned ldsw = (unsigned)wid * 1024u;
    const int aoff = lds_byte(wr * 64 + fr, fq * 8), boff = lds_byte(wc * 32 + fr, fq * 8);
#define PG8_SA(b, h) (((b) * 2 + (h)) * HTB)
#define PG8_SB(b, h) ((4 + (b) * 2 + (h)) * HTB)
#define PG8_STAGE(bufoff, gbase, voff) do { _Pragma("unroll") for (int _i = 0; _i < 2; ++_i) \
        __builtin_amdgcn_global_load_lds((const unsigned*)((const char*)(gbase) + (voff)[_i]), (PG8_LAS unsigned*)(lds + (bufoff) + ldsw + _i * 8192), 16, 0, 0); } while (0)
#define PG8_LDA(dst, b, h) do { _Pragma("unroll") for (int m = 0; m < 4; ++m) _Pragma("unroll") for (int k = 0; k < 2; ++k) dst[m][k] = *(const PG8_LAS bf16x8*)(lds + PG8_SA(b, h) + aoff + m * 2048 + k * 1024); } while (0)
#define PG8_LDB(dst, b, h) do { _Pragma("unroll") for (int n = 0; n < 2; ++n) _Pragma("unroll") for (int k = 0; k < 2; ++k) dst[n][k] = *(const PG8_LAS bf16x8*)(lds + PG8_SB(b, h) + boff + n * 2048 + k * 1024); } while (0)
#define PG8_MMA(ai, bj, At, Bt) do { __builtin_amdgcn_s_setprio(1); _Pragma("unroll") for (int m = 0; m < 4; ++m) _Pragma("unroll") for (int n = 0; n < 2; ++n) _Pragma("unroll") for (int k = 0; k < 2; ++k) \
        acc[ai][bj][m][n] = __builtin_amdgcn_mfma_f32_16x16x32_bf16(Bt[n][k], At[m][k], acc[ai][bj][m][n], 0, 0, 0); __builtin_amdgcn_s_setprio(0); } while (0)
#define PG8_WAIT_V(n) asm volatile("s_waitcnt vmcnt(" #n ")" ::: "memory")
#define PG8_WAIT_L(n) asm volatile("s_waitcnt lgkmcnt(" #n ")" ::: "memory")
#define PG8_BAR __builtin_amdgcn_s_barrier()
#define PG8_SCHED __builtin_amdgcn_sched_barrier(0)
    Unit cur, nxt; int ui = 0;
    if (!S.next(0, cur)) return;
    f32x4 acc[2][2][4][2];
#pragma unroll
    for (int a = 0; a < 2; ++a)
#pragma unroll
        for (int b = 0; b < 2; ++b)
#pragma unroll
            for (int m = 0; m < 4; ++m)
#pragma unroll
                for (int n = 0; n < 2; ++n) acc[a][b][m][n] = (f32x4){0.f, 0.f, 0.f, 0.f};
    bf16x8 At[4][2], B0[2][2], B1[2][2];
    const char* cA = (const char*)g.A + (size_t)cur.pm * tstep; const char* cB = (const char*)g.Bt + (size_t)cur.pn * tstep;
    S.a_ready(cur);
    if constexpr (SP2) {
        PG8_STAGE(PG8_SB(0, 0), cB, voffB); PG8_STAGE(PG8_SB(0, 1), cB + hstep, voffB); PG8_STAGE(PG8_SA(0, 0), cA, voffA); PG8_STAGE(PG8_SA(0, 1), cA + hstep, voffA);
        if (wr == 1) PG8_BAR;
        PG8_WAIT_V(2); PG8_BAR;
        PG8_STAGE(PG8_SB(1, 0), cB + kstep, voffB); PG8_STAGE(PG8_SA(1, 0), cA + kstep, voffA); PG8_STAGE(PG8_SB(1, 1), cB + hstep + kstep, voffB);
        PG8_WAIT_V(6); PG8_BAR;
    } else {
        PG8_STAGE(PG8_SB(0, 0), cB, voffB); PG8_STAGE(PG8_SA(0, 0), cA, voffA); PG8_STAGE(PG8_SB(0, 1), cB + hstep, voffB); PG8_STAGE(PG8_SA(0, 1), cA + hstep, voffA);
        if (wr == 1) PG8_BAR;
        PG8_WAIT_V(4); PG8_BAR;
        PG8_STAGE(PG8_SB(1, 0), cB + kstep, voffB); PG8_STAGE(PG8_SA(1, 0), cA + kstep, voffA); PG8_STAGE(PG8_SB(1, 1), cB + hstep + kstep, voffB);
        PG8_WAIT_V(6); PG8_BAR;
    }
    for (;;) {
        const bool has_next = S.next(ui + 1, nxt);
        const char* nA = has_next ? (const char*)g.A + (size_t)nxt.pm * tstep : cA; const char* nB = has_next ? (const char*)g.Bt + (size_t)nxt.pn * tstep : cB;
        for (int t = 0; t < nt; t += 2) {
            const bool last = (t == nt - 2);
            const char* a1 = cA + (size_t)(t + 1) * kstep;
            const char* a2 = last ? nA : cA + (size_t)(t + 2) * kstep; const char* b2 = last ? nB : cB + (size_t)(t + 2) * kstep;
            const char* a3 = a2 + kstep; const char* b3 = b2 + kstep;
            if (last && has_next) S.a_ready(nxt);
            if constexpr (SP2) {
            PG8_LDB(B0, 0, 0); PG8_LDB(B1, 0, 1); PG8_SCHED; PG8_LDA(At, 0, 0); PG8_STAGE(PG8_SA(1, 1), a1 + hstep, voffA);
            PG8_WAIT_V(8); PG8_WAIT_L(0); PG8_BAR; PG8_MMA(0, 0, At, B0); PG8_MMA(0, 1, At, B1); PG8_BAR; PG8_SCHED;
            PG8_LDA(At, 0, 1); PG8_STAGE(PG8_SB(0, 0), b2, voffB); PG8_STAGE(PG8_SB(0, 1), b2 + hstep, voffB); PG8_STAGE(PG8_SA(0, 0), a2, voffA);
            PG8_WAIT_V(8); PG8_WAIT_L(0); PG8_BAR; PG8_MMA(1, 0, At, B0); PG8_MMA(1, 1, At, B1); PG8_BAR; PG8_SCHED;
            PG8_LDB(B0, 1, 0); PG8_LDB(B1, 1, 1); PG8_SCHED; PG8_LDA(At, 1, 0); PG8_STAGE(PG8_SA(0, 1), a2 + hstep, voffA);
            PG8_WAIT_V(8); PG8_WAIT_L(0); PG8_BAR; PG8_MMA(0, 0, At, B0); PG8_MMA(0, 1, At, B1); PG8_BAR; PG8_SCHED;
            PG8_LDA(At, 1, 1); PG8_STAGE(PG8_SB(1, 0), b3, voffB); PG8_STAGE(PG8_SB(1, 1), b3 + hstep, voffB); PG8_STAGE(PG8_SA(1, 0), a3, voffA);
            PG8_WAIT_V(8); PG8_WAIT_L(0); PG8_BAR; PG8_MMA(1, 0, At, B0); PG8_MMA(1, 1, At, B1); PG8_BAR; PG8_SCHED;
            } else {
            PG8_LDB(B0, 0, 0); PG8_SCHED; PG8_LDA(At, 0, 0); PG8_STAGE(PG8_SA(1, 1), a1 + hstep, voffA);
            PG8_WAIT_L(8); PG8_BAR; PG8_WAIT_L(0); PG8_MMA(0, 0, At, B0); PG8_BAR; PG8_SCHED;
            PG8_LDB(B1, 0, 1); PG8_STAGE(PG8_SB(0, 0), b2, voffB);
            PG8_BAR; PG8_WAIT_L(0); PG8_MMA(0, 1, At, B1); PG8_BAR;
            PG8_LDA(At, 0, 1); PG8_STAGE(PG8_SA(0, 0), a2, voffA);
            PG8_BAR; PG8_WAIT_L(0); PG8_MMA(1, 0, At, B0); PG8_BAR; PG8_SCHED;
            PG8_STAGE(PG8_SB(0, 1), b2 + hstep, voffB);
            PG8_WAIT_V(6); PG8_BAR; PG8_MMA(1, 1, At, B1); PG8_BAR;
            PG8_LDB(B0, 1, 0); PG8_SCHED; PG8_LDA(At, 1, 0); PG8_STAGE(PG8_SA(0, 1), a2 + hstep, voffA);
            PG8_WAIT_L(8); PG8_BAR; PG8_WAIT_L(0); PG8_MMA(0, 0, At, B0); PG8_BAR; PG8_SCHED;
            PG8_LDB(B1, 1, 1); PG8_STAGE(PG8_SB(1, 0), b3, voffB);
            PG8_BAR; PG8_WAIT_L(0); PG8_MMA(0, 1, At, B1); PG8_BAR;
            PG8_LDA(At, 1, 1); PG8_STAGE(PG8_SA(1, 0), a3, voffA);
            PG8_BAR; PG8_WAIT_L(0); PG8_MMA(1, 0, At, B0); PG8_BAR; PG8_SCHED;
            PG8_STAGE(PG8_SB(1, 1), b3 + hstep, voffB);
            PG8_WAIT_V(6); PG8_BAR; PG8_MMA(1, 1, At, B1); PG8_BAR;
            }
        }
        if constexpr (ALIGN_EPI) { if (wr == 0) PG8_BAR; }
        if constexpr (!Epi::AFTER_DRAIN) { E(acc, cur, wr, wc, fr, fq); S.done(cur); }
        if (!has_next) break;
#pragma unroll
        for (int a = 0; a < 2; ++a)
#pragma unroll
            for (int b = 0; b < 2; ++b)
#pragma unroll
                for (int m = 0; m < 4; ++m)
#pragma unroll
                    for (int n = 0; n < 2; ++n) acc[a][b][m][n] = (f32x4){0.f, 0.f, 0.f, 0.f};
        cur = nxt; cA = nA; cB = nB; ++ui;
        if constexpr (ALIGN_EPI) { if (wr == 1) PG8_BAR; }
    }
    PG8_WAIT_V(0);
    if constexpr (!ALIGN_EPI) { if (wr == 0) PG8_BAR; }
    PG8_BAR;
    if constexpr (Epi::AFTER_DRAIN) { E.fused(acc, cur, wr, wc, fr, fq, lds, wid, lane); S.done(cur); }
#undef PG8_SA
#undef PG8_SB
#undef PG8_STAGE
#undef PG8_LDA
#undef PG8_LDB
#undef PG8_MMA
#undef PG8_WAIT_V
#undef PG8_WAIT_L
#undef PG8_BAR
#undef PG8_SCHED
}
}
#define GAS __attribute__((address_space(1)))
#define LAS __attribute__((address_space(3)))
typedef unsigned short bf16;
typedef unsigned v4u __attribute__((ext_vector_type(4)));
typedef float f32x4 __attribute__((ext_vector_type(4)));
typedef short bf16x8 __attribute__((ext_vector_type(8)));
typedef GAS unsigned gu32;
typedef GAS unsigned long long gu64;
#define RLX_AGENT __ATOMIC_RELAXED, __HIP_MEMORY_SCOPE_AGENT
#define LDS_WAIT() asm volatile("s_waitcnt lgkmcnt(0)" ::: "memory")
#define VM_WAIT() asm volatile("s_waitcnt vmcnt(0)" ::: "memory")
__device__ __forceinline__ unsigned long long rt() { return __builtin_amdgcn_s_memrealtime(); }
__device__ __forceinline__ unsigned f2bf(float f) { unsigned u = __builtin_bit_cast(unsigned, f); return (u + 0x7fffu + ((u >> 16) & 1u)) >> 16; }
__device__ __forceinline__ unsigned pk2(float lo, float hi) { return f2bf(lo) | (f2bf(hi) << 16); }
#define XB_TMO      128
#define XB_XCNT(j)  (256  + 64 * (j))
#define XB_XSUB(j)  (1280 + 64 * (j))
#define XB_XGEN(j)  (2304 + 64 * (j))
#define XB_TOP      3328
#define XB_TOPGEN   3392
#define XCD_BAR_WORDS 3456
#define XB_SPIN_CAP (1u << 18)

__device__ __forceinline__ unsigned xb_ld(unsigned* p)              { return __hip_atomic_load(p, __ATOMIC_RELAXED, __HIP_MEMORY_SCOPE_AGENT); }
__device__ __forceinline__ unsigned xb_add(unsigned* p, unsigned v) { return __hip_atomic_fetch_add(p, v, __ATOMIC_RELAXED, __HIP_MEMORY_SCOPE_AGENT); }
__device__ __forceinline__ unsigned xb_xcc_id() { return (unsigned)__builtin_amdgcn_s_getreg((3 << 11) | 20) & 0xFu; }
#define XB_SPIN(cond, bar) do { unsigned _sp = 0; while (cond) { __builtin_amdgcn_s_sleep(1); \
    if ((++_sp & 255u) == 0u) { if (xb_ld(&(bar)[XB_TMO])) break; if (_sp > XB_SPIN_CAP) { atomicAdd(&(bar)[XB_TMO], 1u); break; } } } } while (0)

struct XcdBarrier {
    unsigned* bar; unsigned x;
    volatile LAS unsigned* st;
};

__device__ __forceinline__ XcdBarrier xcd_barrier_post(unsigned* bar, volatile LAS unsigned* st) {
    XcdBarrier b; b.bar = bar; b.x = xb_xcc_id(); b.st = st;
    if (threadIdx.x == 0) (void)xb_add(&bar[XB_XCNT(b.x)], 1u);
    return b;
}
__device__ __forceinline__ void xcd_barrier_complete(unsigned* bar, unsigned x, unsigned& nloc, unsigned& nx) {
    const unsigned G = gridDim.x * gridDim.y * gridDim.z;
    unsigned sum, cnt, mine, sp = 0u;
    for (;;) {
        sum = 0u; cnt = 0u; mine = 0u;
#pragma unroll
        for (unsigned j = 0; j < 16; ++j) { const unsigned c = xb_ld(&bar[XB_XCNT(j)]); sum += c; cnt += (c > 0u) ? 1u : 0u; mine = (j == x) ? c : mine; }
        if (sum == G) break;
        __builtin_amdgcn_s_sleep(1);
        if ((++sp & 255u) == 0u) { if (xb_ld(&bar[XB_TMO])) break; if (sp > XB_SPIN_CAP) { atomicAdd(&bar[XB_TMO], 1u); break; } }
    }
    nloc = mine > 0u ? mine : 1u; nx = cnt > 0u ? cnt : 1u;
}

__device__ __forceinline__ void xcd_barrier(const XcdBarrier& b) {
    asm volatile("s_waitcnt vmcnt(0)" ::: "memory");
    __syncthreads();
    if (threadIdx.x == 0) {
        unsigned* bar = b.bar;
        __builtin_amdgcn_s_waitcnt(0);
        unsigned nloc = b.st[0], nx = b.st[1];
        if (nloc == 0u) { xcd_barrier_complete(bar, b.x, nloc, nx); b.st[0] = nloc; b.st[1] = nx; }
        const unsigned old = xb_add(&bar[XB_XSUB(b.x)], 1u);
        const unsigned gen = old / nloc;
        if (old + 1u == (gen + 1u) * nloc) {
            __builtin_amdgcn_fence(__ATOMIC_RELEASE, "agent");
            asm volatile("s_waitcnt vmcnt(0)" ::: "memory");
            const unsigned og = xb_add(&bar[XB_TOP], 1u);
            const unsigned tg = og / nx;
            if (og + 1u == (tg + 1u) * nx) xb_add(&bar[XB_TOPGEN], 1u);
            else XB_SPIN(xb_ld(&bar[XB_TOPGEN]) == tg, bar);
            __builtin_amdgcn_fence(__ATOMIC_ACQUIRE, "agent");
            xb_add(&bar[XB_XGEN(b.x)], 1u);
            asm volatile("s_waitcnt vmcnt(0)" ::: "memory");
        } else {
            XB_SPIN(xb_ld(&bar[XB_XGEN(b.x)]) == gen, bar);
            __builtin_amdgcn_fence(__ATOMIC_ACQUIRE, "agent");
            asm volatile("s_waitcnt vmcnt(0)" ::: "memory");
        }
    }
    __syncthreads();
}
constexpr int NB = 4, T = 8192, LC = 256, D = 1024, NLAYER = 2;
constexpr int ML = NB * T, MC = NB * LC, MT = ML + MC;
constexpr int NIN = 2848, NINP = 3072;
constexpr int FF = 2816, EF = 3584, NE = 8;
constexpr int TK = T + LC;
constexpr int NCH = TK / 64;
constexpr float EPS = 1e-6f;
constexpr float QSCALE = 0.125f * 1.4426950408889634f;

constexpr int NWAVES = 8;
constexpr int LDS_BYTES = 147456;
constexpr int RING_BYTES = 131072, LDSCTL_OFF = RING_BYTES, MISC_OFF = LDSCTL_OFF + 320;

constexpr size_t MiB = 1u << 20;
constexpr size_t CTL_ZERO_BYTES = 1 * MiB;
constexpr int CW_BAR = 4096;
constexpr int CW_CNT = 16384;
constexpr size_t WS_MODS = 1 * MiB;
constexpr size_t WS_ROUTE = 1 * MiB + 512 * 1024;
constexpr size_t WS_RW = WS_ROUTE + (size_t)ML * 16;
constexpr size_t WS_POS = WS_RW + (size_t)ML * 8;
constexpr size_t WS_XC = 3 * MiB;
constexpr size_t WS_ROPE = 7 * MiB;
constexpr size_t WS_WIN = 9 * MiB;
constexpr size_t WS_WOUT = 21 * MiB;
constexpr size_t WS_WGU = 25 * MiB;
constexpr size_t WS_WD = 36 * MiB;
constexpr size_t WS_G = 42 * MiB;
constexpr size_t WS_BETA = WS_G + (size_t)2 * MT * 8 * 4;
constexpr size_t WS_AB = 47 * MiB;
constexpr size_t WS_KALL = 52 * MiB;
constexpr size_t WS_VALL = 61 * MiB;
constexpr size_t WS_DYN = 70 * MiB;
constexpr size_t WS_XN = WS_DYN;
constexpr size_t WS_OF = WS_XN, WS_OB = WS_XN + 33 * MiB;
constexpr size_t WS_DNRAW = WS_XN + 66 * MiB;
constexpr size_t WS_QRAW = WS_DNRAW + 99 * MiB;
constexpr size_t WS_KVRAW = WS_QRAW + 33 * MiB;
constexpr size_t WS_U = WS_DNRAW, WS_W = WS_DNRAW + 66 * MiB;
constexpr size_t WS_ZB = WS_KVRAW + 17 * MiB;
constexpr size_t WS_QKVDN = WS_ZB + 33 * MiB;
constexpr size_t WS_MIX = WS_QKVDN + 99 * MiB;
constexpr size_t WS_MIX_END = WS_MIX + 66 * MiB;
constexpr size_t WS_H = WS_DNRAW;
constexpr size_t WS_MGU = WS_DYN;
constexpr size_t WS_MD = WS_MGU + 112 * MiB;
constexpr size_t WS_XS = WS_MD + 56 * MiB;
constexpr int SS_PANELS = 53, NSS = 5;
constexpr size_t WS_HM = WS_XS + 132 * MiB;
constexpr size_t WS_END = WS_HM + 93 * MiB;
static_assert(WS_W + 66 * MiB <= WS_ZB && WS_H + (size_t)MT * FF * 2 <= WS_MIX && WS_MIX_END <= 560 * MiB && WS_POS + (size_t)ML * 8 <= WS_XC, "ws map");

typedef unsigned short bf16;
__device__ __forceinline__ float bf2f(unsigned short h) { return __uint_as_float(((unsigned)h) << 16); }
__device__ __forceinline__ float bflo(unsigned w) { return __uint_as_float(w << 16); }
__device__ __forceinline__ float bfhi(unsigned w) { return __uint_as_float(w & 0xffff0000u); }
__device__ __forceinline__ float wave_sum(float v) {
#pragma unroll
    for (int o = 1; o < 64; o <<= 1) v += __shfl_xor(v, o);
    return v;
}
__device__ __forceinline__ float silu_f(float x) { return x / (1.0f + __expf(-x)); }
namespace pg8 {
struct EpiIn {
    static constexpr bool PERM = true, AFTER_DRAIN = false;
    bf16_t* dnraw; bf16_t* zb; bf16_t* qraw; bf16_t* kvraw; float* ab;
    __device__ __forceinline__ void operator()(const f32x4 (&acc)[2][2][4][2], const Unit& u, int wr, int wc, int fr, int fq) const {
        const int row0 = u.pm * BM + wr * 64 + fr; const int pn = u.pn;
        if (pn < 11) {
            bf16_t* base; int ldc, coff;
            if (pn < 6) { base = dnraw; ldc = 1536; coff = pn * 256; } else if (pn < 8) { base = zb; ldc = 512; coff = (pn - 6) * 256; }
            else if (pn < 10) { base = qraw; ldc = 512; coff = (pn - 8) * 256; } else { base = kvraw; ldc = 256; coff = 0; }
            const int col0 = coff + wc * 32 + 8 * fq;
#pragma unroll
            for (int ai = 0; ai < 2; ++ai)
#pragma unroll
                for (int m = 0; m < 4; ++m) { bf16_t* rowp = base + (size_t)(row0 + ai * HALF + m * 16) * ldc + col0;
#pragma unroll
                    for (int bj = 0; bj < 2; ++bj) { const f32x4 v0 = acc[ai][bj][m][0], v1 = acc[ai][bj][m][1];
                        u32x4 w; w.x = cvt_pk_bf16(v0[0], v0[1]); w.y = cvt_pk_bf16(v0[2], v0[3]); w.z = cvt_pk_bf16(v1[0], v1[1]); w.w = cvt_pk_bf16(v1[2], v1[3]);
                        *(u32x4*)(rowp + bj * HALF) = w; } }
        } else if (wc == 0) {
#pragma unroll
            for (int ai = 0; ai < 2; ++ai)
#pragma unroll
                for (int m = 0; m < 4; ++m) { float* rowp = ab + (size_t)(row0 + ai * HALF + m * 16) * 32 + 8 * fq;
                    *(f32x4*)(rowp) = acc[ai][0][m][0]; *(f32x4*)(rowp + 4) = acc[ai][0][m][1]; }
        }
    }
};
struct EpiRes {
    static constexpr bool PERM = false, AFTER_DRAIN = false;
    const float* xin_l; float* out_l; const float* xin_c; float* out_c; const float* gate; int gstride;
    __device__ __forceinline__ void operator()(const f32x4 (&acc)[2][2][4][2], const Unit& u, int wr, int wc, int fr, int fq) const {
        const int pm = u.pm; const bool isc = pm >= 128; const int bidx = isc ? 4 : (pm >> 5);
        const float* xin = isc ? xin_c : xin_l; float* out = isc ? out_c : out_l; const int prow = isc ? pm - 128 : pm;
        const int row0 = prow * BM + wr * 64 + fr; const int col0 = u.pn * BM + wc * 32 + 4 * fq; const float* gp = gate + (size_t)bidx * gstride + col0;
        f32x4 gv[2][2];
#pragma unroll
        for (int bj = 0; bj < 2; ++bj)
#pragma unroll
            for (int n = 0; n < 2; ++n) gv[bj][n] = *(const f32x4*)(gp + bj * HALF + n * 16);
#pragma unroll
        for (int ai = 0; ai < 2; ++ai)
#pragma unroll
            for (int m = 0; m < 4; ++m) { const size_t off = (size_t)(row0 + ai * HALF + m * 16) * 1024 + col0;
#pragma unroll
                for (int bj = 0; bj < 2; ++bj)
#pragma unroll
                    for (int n = 0; n < 2; ++n) { const f32x4 xv = *(const f32x4*)(xin + off + bj * HALF + n * 16);
                        *(f32x4*)(out + off + bj * HALF + n * 16) = xv + gv[bj][n] * acc[ai][bj][m][n]; } }
    }
};
struct EpiSwiGLU {
    static constexpr bool PERM = true, AFTER_DRAIN = false;
    bf16_t* H; int ldh; int nloc; int pm0;
    __device__ __forceinline__ void operator()(const f32x4 (&acc)[2][2][4][2], const Unit& u, int wr, int wc, int fr, int fq) const {
        const int row0 = (u.pm - pm0) * BM + wr * 64 + fr; const int col0 = (u.pn % nloc) * 128 + wc * 32 + 8 * fq;
#pragma unroll
        for (int ai = 0; ai < 2; ++ai)
#pragma unroll
            for (int m = 0; m < 4; ++m) { bf16_t* rowp = H + (size_t)(row0 + ai * HALF + m * 16) * ldh + col0;
                float r[8];
#pragma unroll
                for (int n = 0; n < 2; ++n)
#pragma unroll
                    for (int j = 0; j < 4; ++j) { const float g = acc[ai][0][m][n][j], up = acc[ai][1][m][n][j]; r[n * 4 + j] = g / (1.0f + __expf(-g)) * up; }
                u32x4 w; w.x = cvt_pk_bf16(r[0], r[1]); w.y = cvt_pk_bf16(r[2], r[3]); w.z = cvt_pk_bf16(r[4], r[5]); w.w = cvt_pk_bf16(r[6], r[7]);
                *(u32x4*)(rowp) = w; }
    }
};
struct EpiBfPlain {
    static constexpr bool PERM = true, AFTER_DRAIN = false;
    bf16_t* O; int ldc; int nloc;
    __device__ __forceinline__ void operator()(const f32x4 (&acc)[2][2][4][2], const Unit& u, int wr, int wc, int fr, int fq) const {
        const int row0 = u.pm * BM + wr * 64 + fr; const int col0 = (u.pn % nloc) * BM + wc * 32 + 8 * fq;
#pragma unroll
        for (int ai = 0; ai < 2; ++ai)
#pragma unroll
            for (int m = 0; m < 4; ++m) { bf16_t* rowp = O + (size_t)(row0 + ai * HALF + m * 16) * ldc + col0;
#pragma unroll
                for (int bj = 0; bj < 2; ++bj) { const f32x4 v0 = acc[ai][bj][m][0], v1 = acc[ai][bj][m][1];
                    u32x4 w; w.x = cvt_pk_bf16(v0[0], v0[1]); w.y = cvt_pk_bf16(v0[2], v0[3]); w.z = cvt_pk_bf16(v1[0], v1[1]); w.w = cvt_pk_bf16(v1[2], v1[3]);
                    *(u32x4*)(rowp + bj * HALF) = w; } }
    }
};
struct MoeOrder {
    int ps[9]; int p0, p1, nloc, G, c; int a_off;
    __device__ __forceinline__ bool next(int i, Unit& u) const {
        const int L = i * G + c; const int np = p1 - p0; if (L >= np * nloc) return false;
        const int p = p0 + L / nloc, pl = L % nloc; int e = 0;
#pragma unroll
        for (int k = 1; k < 8; ++k) e += (p >= ps[k]) ? 1 : 0;
        u.pm = p + a_off; u.pn = e * nloc + pl; return true;
    }
    __device__ __forceinline__ void a_ready(const Unit&) const {}
    __device__ __forceinline__ void done(const Unit&) const {}
};
}
struct Ctx {
    LAS unsigned char* lds; gu32* ctl; int tid, lane, wave, G, gw, NGW;
    const float* const __attribute__((address_space(4)))* in; float* out; unsigned char* ws;
};
#define WSP(T, off) ((T*)(C.ws + (off)))

template <class MapF>
__device__ __forceinline__ void transpose_item(const float* W, int K, int N, bf16* WT, MapF map, LAS float* scr, int item, int lane) {
    const int nblk = N / 32, kb = item / nblk, nb = item % nblk, k0 = 64 * kb, n0 = 32 * nb;
#pragma unroll 8
    for (int i = 0; i < 32; ++i) { const int kk = 2 * i + (lane >> 5); scr[kk * 33 + (lane & 31)] = W[(size_t)(k0 + kk) * N + n0 + (lane & 31)]; }
    LDS_WAIT(); asm volatile("" ::: "memory");
    const int c = lane & 7; const int r0 = map(n0);
#pragma unroll
    for (int j = 0; j < 4; ++j) { const int n = (lane >> 3) + 8 * j; const LAS float* s = scr + (8 * c) * 33 + n;
        v4u o; o.x = pk2(s[0 * 33], s[1 * 33]); o.y = pk2(s[2 * 33], s[3 * 33]); o.z = pk2(s[4 * 33], s[5 * 33]); o.w = pk2(s[6 * 33], s[7 * 33]);
        *(GAS v4u*)(WT + (size_t)(r0 + n) * K + k0 + 8 * c) = o; }
    LDS_WAIT(); asm volatile("" ::: "memory");
}
struct MapId { __device__ __forceinline__ int operator()(int n0) const { return n0; } };
struct MapWin { __device__ __forceinline__ int operator()(int n0) const { return n0 < 2048 ? n0 : (n0 < 2080 ? n0 + 768 : n0 - 32); } };
struct MapGU { int up; __device__ __forceinline__ int operator()(int n0) const { return (n0 >> 7) * 256 + (n0 & 127) + up * 128; } };

__device__ __forceinline__ void p0_weights(Ctx& C) {
    LAS float* scr = (LAS float*)(C.lds + C.wave * 16384);
    constexpr int I_IN = (D / 64) * (NIN / 32), I_OUT = (D / 64) * (D / 32), I_G = (D / 64) * (FF / 32), I_D = (FF / 64) * (D / 32);
    constexpr int NITEMS = 2 * I_IN + 2 * I_OUT + 2 * I_G + I_D;
    for (int it = C.gw; it < NITEMS; it += C.NGW) {
        int r = it;
        if (r < 2 * I_IN) { const int l = r / I_IN; transpose_item(C.in[8] + (size_t)l * D * NIN, D, NIN, WSP(bf16, WS_WIN) + (size_t)l * NINP * D, MapWin(), scr, r % I_IN, C.lane); continue; } r -= 2 * I_IN;
        if (r < 2 * I_OUT) { const int l = r / I_OUT; transpose_item(C.in[15] + (size_t)l * D * D, D, D, WSP(bf16, WS_WOUT) + (size_t)l * D * D, MapId(), scr, r % I_OUT, C.lane); continue; } r -= 2 * I_OUT;
        if (r < I_G) { transpose_item(C.in[16], D, FF, WSP(bf16, WS_WGU), MapGU{0}, scr, r, C.lane); continue; } r -= I_G;
        if (r < I_G) { transpose_item(C.in[17], D, FF, WSP(bf16, WS_WGU), MapGU{1}, scr, r, C.lane); continue; } r -= I_G;
        transpose_item(C.in[18], FF, D, WSP(bf16, WS_WD), MapId(), scr, r, C.lane);
    }
    for (int i = C.gw * 64 + C.lane; i < 2 * 28672; i += C.NGW * 64) { const int l = i / 28672, j = i % 28672;
        *(GAS v4u*)(WSP(bf16, WS_WIN) + (size_t)l * NINP * D + (size_t)NIN * D + (size_t)j * 8) = (v4u){0u, 0u, 0u, 0u}; }
    for (int i = C.gw * 64 + C.lane; i < T * 32; i += C.NGW * 64) { const int t = i >> 5, a = i & 31;
        const float pos = (float)((a < 16) ? (t >> 6) : (t & 63)); const float fr = powf(10000.0f, -(float)(a & 15) / 16.0f);
        float sn, cs; sincosf(pos * fr, &sn, &cs);
        WSP(float, WS_ROPE)[i] = cs; WSP(float, WS_ROPE)[T * 32 + i] = sn; }
}
__device__ __forceinline__ void p0_mods(Ctx& C) {
    LAS float* sc = (LAS float*)C.lds;
    LAS float* part = (LAS float*)(C.lds + 32768);
    const int nblk = 2 * 6144 / 64;
    bool staged = false;
    for (int cb = blockIdx.x; cb < nblk; cb += C.G) {
        if (!staged) { for (int i = C.tid; i < 5 * 1024; i += 512) { const float v = (i < 4096) ? C.in[1][i] : C.in[3][i - 4096]; sc[i] = silu_f(v); } staged = true; }
        __syncthreads();
        const int l = cb / 96, j = (cb % 96) * 64 + C.lane;
        const float* wm = C.in[4] + (size_t)l * D * 6144 + j;
        float a0 = 0.f, a1 = 0.f, a2 = 0.f, a3 = 0.f, a4 = 0.f;
        const int kb = C.wave * 128;
#pragma unroll 8
        for (int k = 0; k < 128; ++k) { const float w = wm[(size_t)(kb + k) * 6144];
            a0 += sc[kb + k] * w; a1 += sc[1024 + kb + k] * w; a2 += sc[2048 + kb + k] * w; a3 += sc[3072 + kb + k] * w; a4 += sc[4096 + kb + k] * w; }
        part[(C.wave * 5 + 0) * 64 + C.lane] = a0; part[(C.wave * 5 + 1) * 64 + C.lane] = a1; part[(C.wave * 5 + 2) * 64 + C.lane] = a2;
        part[(C.wave * 5 + 3) * 64 + C.lane] = a3; part[(C.wave * 5 + 4) * 64 + C.lane] = a4;
        __syncthreads();
        if (C.tid < 320) { const int i = C.tid / 64, ln = C.tid % 64; const int jj = (cb % 96) * 64 + ln;
            float s = 0.f;
#pragma unroll
            for (int w = 0; w < 8; ++w) s += part[(w * 5 + i) * 64 + ln];
            s += C.in[5][l * 6144 + jj];
            const int chunk = jj >> 10, col = jj & 1023;
            if (chunk == 1) s = C.in[6][l * 1024 + col] * (1.0f + s);
            if (chunk == 4) s = C.in[7][l * 1024 + col] * (1.0f + s);
            WSP(float, WS_MODS)[((size_t)(l * 5 + i) * 6 + chunk) * 1024 + col] = s; }
        __syncthreads();
    }
}
__device__ __forceinline__ const float* mods_ptr(Ctx& C, int l, int i, int chunk) { return WSP(float, WS_MODS) + ((size_t)(l * 5 + i) * 6 + chunk) * 1024; }

template <bool ROUTE>
__device__ __forceinline__ void norm_mod(Ctx& C, const float* xl, const float* xc, int nrows, int l, int chA, int chS, bf16* dst) {
    float rw[ROUTE ? 16 : 1][8];
    if (ROUTE) {
#pragma unroll
        for (int j = 0; j < 4; ++j)
#pragma unroll
            for (int q = 0; q < 4; ++q) { const f32x4 a = *(const f32x4*)(C.in[19] + (size_t)(4 * C.lane + 256 * j + q) * 8), b = *(const f32x4*)(C.in[19] + (size_t)(4 * C.lane + 256 * j + q) * 8 + 4);
                rw[j * 4 + q][0] = a.x; rw[j * 4 + q][1] = a.y; rw[j * 4 + q][2] = a.z; rw[j * 4 + q][3] = a.w; rw[j * 4 + q][4] = b.x; rw[j * 4 + q][5] = b.y; rw[j * 4 + q][6] = b.z; rw[j * 4 + q][7] = b.w; }
    }
    for (int m = C.gw; m < nrows; m += C.NGW) {
        const bool isc = m >= ML; const int bidx = isc ? 4 : (m >> 13);
        const float* xrow = isc ? xc + (size_t)(m - ML) * D : xl + (size_t)m * D;
        const GAS f32x4* xr = (const GAS f32x4*)xrow + C.lane;
        const GAS f32x4* Ap = (const GAS f32x4*)mods_ptr(C, l, bidx, chA) + C.lane; const GAS f32x4* Sp = (const GAS f32x4*)mods_ptr(C, l, bidx, chS) + C.lane;
        f32x4 v[4]; float s2 = 0.f;
#pragma unroll
        for (int j = 0; j < 4; ++j) { v[j] = xr[64 * j]; s2 += (v[j].x * v[j].x + v[j].y * v[j].y) + (v[j].z * v[j].z + v[j].w * v[j].w); }
        const float rstd = 1.0f / sqrtf(wave_sum(s2) * (1.f / D) + EPS);
#pragma unroll
        for (int j = 0; j < 4; ++j) v[j] = v[j] * rstd * Ap[64 * j] + Sp[64 * j];
        GAS unsigned long long* o8 = (GAS unsigned long long*)(dst + (size_t)m * D) + C.lane;
#pragma unroll
        for (int j = 0; j < 4; ++j) o8[64 * j] = (unsigned long long)pk2(v[j].x, v[j].y) | ((unsigned long long)pk2(v[j].z, v[j].w) << 32);
        if (ROUTE) {
            float lg[8];
#pragma unroll
            for (int e = 0; e < 8; ++e) { float s = 0.f;
#pragma unroll
                for (int j = 0; j < 4; ++j) s += (v[j].x * rw[j * 4 + 0][e] + v[j].y * rw[j * 4 + 1][e]) + (v[j].z * rw[j * 4 + 2][e] + v[j].w * rw[j * 4 + 3][e]);
                lg[e] = wave_sum(s) + C.in[20][e]; }
            if (C.lane == 0) {
                int e0 = 0; float v0 = lg[0];
#pragma unroll
                for (int e = 1; e < 8; ++e) if (lg[e] > v0) { v0 = lg[e]; e0 = e; }
                int e1 = -1; float v1 = -INFINITY;
#pragma unroll
                for (int e = 0; e < 8; ++e) if (e != e0 && lg[e] > v1) { v1 = lg[e]; e1 = e; }
                const float w0 = 1.0f / (1.0f + expf(v1 - v0)), w1 = 1.0f - w0;
                const int s0 = (int)__hip_atomic_fetch_add(C.ctl + CW_CNT + 64 * e0, 1u, RLX_AGENT), s1 = (int)__hip_atomic_fetch_add(C.ctl + CW_CNT + 64 * e1, 1u, RLX_AGENT);
                WSP(int, WS_ROUTE)[m * 4 + 0] = e0; WSP(int, WS_ROUTE)[m * 4 + 1] = s0; WSP(int, WS_ROUTE)[m * 4 + 2] = e1; WSP(int, WS_ROUTE)[m * 4 + 3] = s1;
                WSP(float, WS_RW)[m * 2 + 0] = w0; WSP(float, WS_RW)[m * 2 + 1] = w1;
            }
        }
    }
}
__device__ __forceinline__ void load8(const bf16* p, float (&f)[8]) { const v4u w = *(const GAS v4u*)p; f[0] = bflo(w.x); f[1] = bfhi(w.x); f[2] = bflo(w.y); f[3] = bfhi(w.y); f[4] = bflo(w.z); f[5] = bfhi(w.z); f[6] = bflo(w.w); f[7] = bfhi(w.w); }
__device__ __forceinline__ void store8(bf16* p, const float (&f)[8]) { v4u w; w.x = pk2(f[0], f[1]); w.y = pk2(f[2], f[3]); w.z = pk2(f[4], f[5]); w.w = pk2(f[6], f[7]); *(GAS v4u*)p = w; }
__device__ __forceinline__ float sum8(float v) { v += __shfl_xor(v, 1); v += __shfl_xor(v, 2); v += __shfl_xor(v, 4); return v; }

__device__ __forceinline__ void p3_prep(Ctx& C, int l) {
    const int lane = C.lane;
    const bf16* qraw = WSP(bf16, WS_QRAW); const bf16* kvraw = WSP(bf16, WS_KVRAW); const bf16* dnraw = WSP(bf16, WS_DNRAW); const float* ab = WSP(float, WS_AB);
    bf16* mix = WSP(bf16, WS_MIX); bf16* kall = WSP(bf16, WS_KALL); bf16* vall = WSP(bf16, WS_VALL); bf16* qkv = WSP(bf16, WS_QKVDN);
    const float* ropec = WSP(float, WS_ROPE); const float* ropes = ropec + T * 32;
    const int jj = (lane & 7) * 8;
    float qw[8], kw[8];
#pragma unroll
    for (int i = 0; i < 8; ++i) { qw[i] = C.in[13][l * 64 + jj + i]; kw[i] = C.in[14][l * 64 + jj + i]; }
    float cw[3][5][8];
#pragma unroll
    for (int sg = 0; sg < 3; ++sg)
#pragma unroll
        for (int tp = 0; tp < 5; ++tp)
#pragma unroll
            for (int i = 0; i < 8; ++i) cw[sg][tp][i] = C.in[9][(size_t)(l * 5 + tp) * 1536 + sg * 512 + lane * 8 + i];
    const int gd = (lane >> 3) & 1, gh = lane & 7;
    const float neg_a = -expf(C.in[10][l * 16 + gd * 8 + gh]), dtb = C.in[11][l * 16 + gd * 8 + gh];
    for (int m = C.gw; m < MT; m += C.NGW) {
        const bool isc = m >= ML; const int b = isc ? (m - ML) >> 8 : m >> 13; const int t = isc ? (m - ML) & 255 : m & 8191; const int tlen = isc ? LC : T;
        {
            float f[8]; load8(qraw + (size_t)m * 512 + lane * 8, f);
            float ss = 0.f;
#pragma unroll
            for (int i = 0; i < 8; ++i) ss += f[i] * f[i];
            const float r = 1.0f / sqrtf(sum8(ss) * (1.f / 64.f) + EPS);
#pragma unroll
            for (int i = 0; i < 8; ++i) f[i] = f[i] * r * qw[i];
            if (!isc) {
                float o[8];
#pragma unroll
                for (int i = 0; i < 8; ++i) o[i] = __shfl_xor(f[i], 4);
                const int a0 = jj & 31; const bool first = jj < 32;
#pragma unroll
                for (int i = 0; i < 8; ++i) { const float cs = ropec[t * 32 + a0 + i], sn = ropes[t * 32 + a0 + i]; f[i] = first ? (f[i] * cs - o[i] * sn) : (f[i] * cs + o[i] * sn); }
            }
#pragma unroll
            for (int i = 0; i < 8; ++i) f[i] *= QSCALE;
            store8(mix + (size_t)m * 1024 + 512 + lane * 8, f);
        }
        {
            const size_t krow = (size_t)b * TK + (isc ? T + t : t);
            if (lane < 32) {
                float f[8]; load8(kvraw + (size_t)m * 256 + lane * 8, f);
                if (lane < 16) {
                    float ss = 0.f;
#pragma unroll
                    for (int i = 0; i < 8; ++i) ss += f[i] * f[i];
                    const float r = 1.0f / sqrtf(sum8(ss) * (1.f / 64.f) + EPS);
#pragma unroll
                    for (int i = 0; i < 8; ++i) f[i] = f[i] * r * kw[i];
                    float o[8];
#pragma unroll
                    for (int i = 0; i < 8; ++i) o[i] = __shfl_xor(f[i], 4);
                    if (!isc) { const int a0 = jj & 31; const bool first = jj < 32;
#pragma unroll
                        for (int i = 0; i < 8; ++i) { const float cs = ropec[t * 32 + a0 + i], sn = ropes[t * 32 + a0 + i]; f[i] = first ? (f[i] * cs - o[i] * sn) : (f[i] * cs + o[i] * sn); } }
                    store8(kall + krow * 128 + lane * 8, f);
                } else {
                    float o[8];
#pragma unroll
                    for (int i = 0; i < 8; ++i) o[i] = __shfl_xor(f[i], 4);
                    (void)o; store8(vall + krow * 128 + (lane - 16) * 8, f);
                }
            }
        }
#pragma unroll
        for (int sg = 0; sg < 3; ++sg) {
            float y[8];
#pragma unroll
            for (int i = 0; i < 8; ++i) y[i] = 0.f;
#pragma unroll
            for (int tp = 0; tp < 5; ++tp) { const int tt = t + tp - 2;
                if (tt >= 0 && tt < tlen) { float f[8]; load8(dnraw + (size_t)(m + tp - 2) * 1536 + sg * 512 + lane * 8, f);
#pragma unroll
                    for (int i = 0; i < 8; ++i) y[i] += f[i] * cw[sg][tp][i]; } }
#pragma unroll
            for (int i = 0; i < 8; ++i) y[i] = silu_f(y[i]);
            if (sg < 2) { float ss = 0.f;
#pragma unroll
                for (int i = 0; i < 8; ++i) ss += y[i] * y[i];
                const float r = (1.0f / sqrtf(sum8(ss) + EPS)) * (sg == 0 ? 0.125f : 1.0f);
#pragma unroll
                for (int i = 0; i < 8; ++i) y[i] *= r; }
            store8(qkv + (size_t)m * 1536 + sg * 512 + lane * 8, y);
        }
        if (lane < 16) {
            const float a = ab[(size_t)m * 32 + lane], bb = ab[(size_t)m * 32 + 16 + lane];
            const float xx = a + dtb; const float sp = xx > 20.f ? xx : log1pf(expf(xx));
            WSP(float, WS_G)[((size_t)gd * MT + m) * 8 + gh] = neg_a * sp;
            WSP(float, WS_BETA)[((size_t)gd * MT + m) * 8 + gh] = 1.0f / (1.0f + expf(-bb));
        }
    }
}
__device__ __forceinline__ void attn_naive_unit(Ctx& C, int b, int kvh, int qrow0  , int key0  , int nkeys) {
    LAS float* Ks = (LAS float*)C.lds; LAS float* Vs = Ks + 32 * 64;
    bf16* mix = WSP(bf16, WS_MIX); const bf16* kall = WSP(bf16, WS_KALL); const bf16* vall = WSP(bf16, WS_VALL);
    const int r = C.tid & 127, g = C.tid >> 7, h = kvh * 4 + g;
    bf16* qp = mix + (size_t)(qrow0 + r) * 1024 + 512 + h * 64;
    float q[64], o[64];
#pragma unroll
    for (int i = 0; i < 8; ++i) { float f[8]; load8(qp + i * 8, f);
#pragma unroll
        for (int j = 0; j < 8; ++j) { q[i * 8 + j] = f[j]; o[i * 8 + j] = 0.f; } }
    float mx = -INFINITY, lsum = 0.f;
    for (int k0 = 0; k0 < nkeys; k0 += 32) {
        __syncthreads();
        { const int kr = C.tid >> 4, c4 = (C.tid & 15) * 4;
            const bf16* kp = kall + (size_t)(key0 + k0 + kr) * 128 + kvh * 64 + c4; const bf16* vp = vall + (size_t)(key0 + k0 + kr) * 128 + kvh * 64 + c4;
            const unsigned long long kw = *(const GAS unsigned long long*)kp, vw = *(const GAS unsigned long long*)vp;
            f32x4 kf = {bflo((unsigned)kw), bfhi((unsigned)kw), bflo((unsigned)(kw >> 32)), bfhi((unsigned)(kw >> 32))};
            f32x4 vf = {bflo((unsigned)vw), bfhi((unsigned)vw), bflo((unsigned)(vw >> 32)), bfhi((unsigned)(vw >> 32))};
            *(LAS f32x4*)(Ks + kr * 64 + c4) = kf; *(LAS f32x4*)(Vs + kr * 64 + c4) = vf; }
        __syncthreads();
#pragma unroll 2
        for (int j = 0; j < 32; ++j) { float a = 0.f;
#pragma unroll
            for (int d = 0; d < 64; d += 4) { const f32x4 kv = *(const LAS f32x4*)(Ks + j * 64 + d); a += (q[d] * kv.x + q[d + 1] * kv.y) + (q[d + 2] * kv.z + q[d + 3] * kv.w); }
            if (a > mx) { const float sc = exp2f(mx - a); mx = a; lsum *= sc;
#pragma unroll
                for (int d = 0; d < 64; ++d) o[d] *= sc; }
            const float p = exp2f(a - mx); lsum += p;
#pragma unroll
            for (int d = 0; d < 64; d += 4) { const f32x4 vv = *(const LAS f32x4*)(Vs + j * 64 + d); o[d] += p * vv.x; o[d + 1] += p * vv.y; o[d + 2] += p * vv.z; o[d + 3] += p * vv.w; } }
    }
    const float inv = 1.0f / lsum;
#pragma unroll
    for (int i = 0; i < 8; ++i) { float f[8];
#pragma unroll
        for (int j = 0; j < 8; ++j) f[j] = o[i * 8 + j] * inv;
        store8(qp + i * 8, f); }
}
__device__ __forceinline__ void p4_attn_naive(Ctx& C, int l) {
    const int nlat = NB * 2 * (T / 128);
    const int nctx = (l == 0) ? NB * 2 * 2 : 0;
    for (int u = blockIdx.x; u < nlat + nctx; u += C.G) {
        if (u < nlat) { const int b = u / 128, rem = u % 128, kvh = rem / 64, qb = rem % 64; attn_naive_unit(C, b, kvh, b * T + qb * 128, b * TK, TK); }
        else { const int v = u - nlat; const int b = v / 4, kvh = (v / 2) & 1, qb = v & 1; attn_naive_unit(C, b, kvh, ML + b * LC + qb * 128, b * TK + T, LC); }
    }
    __syncthreads();
}

__device__ __forceinline__ int chunk_row(int b, int cc, int dir, int i) { const int ii = dir ? 63 - i : i; return cc < 4 ? ML + b * LC + cc * 64 + ii : b * T + (cc - 4) * 64 + ii; }
__device__ __forceinline__ void p5_dn1_naive(Ctx& C) {
    LAS float* Ks = (LAS float*)C.lds;
    LAS float* As = Ks + 64 * 65;
    LAS float* R = As + 64 * 65;
    LAS float* gc = R + 64 * 129;
    LAS float* bt = gc + 64;
    const bf16* qkv = WSP(bf16, WS_QKVDN); const float* G = WSP(float, WS_G); const float* BT = WSP(float, WS_BETA);
    bf16* U = WSP(bf16, WS_U); bf16* W = WSP(bf16, WS_W);
    const int nunits = NB * 8 * 2 * NCH;
    for (int u = blockIdx.x; u < nunits; u += C.G) {
        const int cc = u % NCH, dir = (u / NCH) & 1, h = (u / (2 * NCH)) & 7, b = u / (16 * NCH);
        __syncthreads();
        if (C.tid < 64) { const int row = chunk_row(b, cc, dir, C.tid); float g = G[((size_t)dir * MT + row) * 8 + h];
#pragma unroll
            for (int o = 1; o < 64; o <<= 1) { const float n = __shfl_up(g, o); if (C.lane >= o) g += n; }
            gc[C.tid] = g; bt[C.tid] = BT[((size_t)dir * MT + row) * 8 + h]; }
        __syncthreads();
        { const int i = C.tid >> 3, c8 = (C.tid & 7) * 8; const int row = chunk_row(b, cc, dir, i); const float be = bt[i], eg = __expf(gc[i]);
            float kf[8], vf[8]; load8(qkv + (size_t)row * 1536 + 512 + h * 64 + c8, kf); load8(qkv + (size_t)row * 1536 + 1024 + h * 64 + c8, vf);
#pragma unroll
            for (int j = 0; j < 8; ++j) { Ks[i * 65 + c8 + j] = kf[j]; R[i * 129 + c8 + j] = vf[j] * be; R[i * 129 + 64 + c8 + j] = kf[j] * be * eg; } }
        __syncthreads();
#pragma unroll
        for (int e = 0; e < 8; ++e) { const int idx = C.tid * 8 + e, i = idx >> 6, j = idx & 63; float a = 0.f;
            if (i > j) {
#pragma unroll 16
                for (int d = 0; d < 64; ++d) a += Ks[i * 65 + d] * Ks[j * 65 + d];
                a *= bt[i] * __expf(gc[i] - gc[j]); }
            As[i * 65 + j] = a; }
        __syncthreads();
        if (C.tid < 128) { const int c = C.tid;
            for (int i = 1; i < 64; ++i) { float x = R[i * 129 + c];
                for (int j = 0; j < i; ++j) x -= As[i * 65 + j] * R[j * 129 + c];
                R[i * 129 + c] = x; }
            bf16* dst = (c < 64 ? U : W) + (size_t)u * 4096 + (c & 63);
            for (int i = 0; i < 64; ++i) dst[i * 64] = (bf16)f2bf(R[i * 129 + c]); }
    }
    __syncthreads();
}
__device__ __forceinline__ void p6_dn2_naive(Ctx& C) {
    LAS float* Qs = (LAS float*)C.lds;
    LAS float* Ks = Qs + 64 * 65;
    LAS float* Ws = Ks + 64 * 65;
    LAS float* At = Ws + 64 * 65;
    LAS float* Us = At + 64 * 65;
    LAS float* Vn = Us + 64 * 17;
    LAS float* S = Vn + 64 * 17;
    LAS float* gc = S + 64 * 17;
    const bf16* qkv = WSP(bf16, WS_QKVDN); const float* G = WSP(float, WS_G);
    const bf16* U = WSP(bf16, WS_U); const bf16* W = WSP(bf16, WS_W);
    for (int ch = blockIdx.x; ch < NB * 8 * 2 * 4; ch += C.G) {
        const int dvq = ch & 3, dir = (ch >> 2) & 1, h = (ch >> 3) & 7, b = ch >> 6;
        bf16* O = dir ? WSP(bf16, WS_OB) : WSP(bf16, WS_OF);
        __syncthreads();
        for (int i = C.tid; i < 64 * 17; i += 512) S[i] = 0.f;
        for (int st = 0; st < NCH; ++st) {
            const int cc = dir == 0 ? st : (st < 4 ? 3 - st : NCH + 3 - st);
            const size_t unit = ((size_t)((b * 8 + h) * 2 + dir)) * NCH + cc;
            __syncthreads();
            if (C.tid < 64) { const int row = chunk_row(b, cc, dir, C.tid); float g = G[((size_t)dir * MT + row) * 8 + h];
#pragma unroll
                for (int o = 1; o < 64; o <<= 1) { const float n = __shfl_up(g, o); if (C.lane >= o) g += n; }
                gc[C.tid] = g; }
            { const int i = C.tid >> 3, c8 = (C.tid & 7) * 8; const int row = chunk_row(b, cc, dir, i);
                float qf[8], kf[8], wf[8]; load8(qkv + (size_t)row * 1536 + h * 64 + c8, qf); load8(qkv + (size_t)row * 1536 + 512 + h * 64 + c8, kf); load8(W + unit * 4096 + i * 64 + c8, wf);
#pragma unroll
                for (int j = 0; j < 8; ++j) { Qs[i * 65 + c8 + j] = qf[j]; Ks[i * 65 + c8 + j] = kf[j]; Ws[i * 65 + c8 + j] = wf[j]; }
                if ((C.tid & 7) < 2) { float uf[8]; load8(U + unit * 4096 + i * 64 + dvq * 16 + (C.tid & 7) * 8, uf);
#pragma unroll
                    for (int j = 0; j < 8; ++j) Us[i * 17 + (C.tid & 7) * 8 + j] = uf[j]; } }
            __syncthreads();
#pragma unroll
            for (int e = 0; e < 8; ++e) { const int idx = C.tid * 8 + e, i = idx >> 6, j = idx & 63; float a = 0.f;
                if (i >= j) {
#pragma unroll 16
                    for (int d = 0; d < 64; ++d) a += Qs[i * 65 + d] * Ks[j * 65 + d];
                    a *= __expf(gc[i] - gc[j]); }
                At[i * 65 + j] = a; }
#pragma unroll
            for (int e = 0; e < 2; ++e) { const int idx = C.tid * 2 + e, c = idx >> 4, ee = idx & 15; float a = Us[c * 17 + ee];
#pragma unroll 16
                for (int d = 0; d < 64; ++d) a -= Ws[c * 65 + d] * S[d * 17 + ee];
                Vn[c * 17 + ee] = a; }
            __syncthreads();
            float sn[2];
#pragma unroll
            for (int e = 0; e < 2; ++e) { const int idx = C.tid * 2 + e, c = idx >> 4, ee = idx & 15;
                float a = 0.f;
#pragma unroll 16
                for (int d = 0; d < 64; ++d) a += Qs[c * 65 + d] * S[d * 17 + ee];
                a *= __expf(gc[c]);
                for (int s = 0; s <= c; ++s) a += At[c * 65 + s] * Vn[s * 17 + ee];
                O[(size_t)chunk_row(b, cc, dir, c) * 512 + h * 64 + dvq * 16 + ee] = (bf16)f2bf(a);
                const int d = c; const float gl = gc[63]; float sv = S[d * 17 + ee] * __expf(gl);
#pragma unroll 16
                for (int cr = 0; cr < 64; ++cr) sv += Ks[cr * 65 + d] * __expf(gl - gc[cr]) * Vn[cr * 17 + ee];
                sn[e] = sv; }
            __syncthreads();
#pragma unroll
            for (int e = 0; e < 2; ++e) { const int idx = C.tid * 2 + e; S[(idx >> 4) * 17 + (idx & 15)] = sn[e]; }
        }
    }
    __syncthreads();
}
__device__ __forceinline__ void p7_dn3(Ctx& C, int l, int nrows) {
    const bf16* of = WSP(bf16, WS_OF); const bf16* ob = WSP(bf16, WS_OB); const bf16* zb = WSP(bf16, WS_ZB); bf16* mix = WSP(bf16, WS_MIX);
    float nw[8];
#pragma unroll
    for (int i = 0; i < 8; ++i) nw[i] = C.in[12][l * 64 + (C.lane & 7) * 8 + i];
    for (int m = C.gw; m < nrows; m += C.NGW) {
        float a[8], bb[8], z[8]; load8(of + (size_t)m * 512 + C.lane * 8, a); load8(ob + (size_t)m * 512 + C.lane * 8, bb); load8(zb + (size_t)m * 512 + C.lane * 8, z);
        float ss = 0.f;
#pragma unroll
        for (int i = 0; i < 8; ++i) { a[i] += bb[i]; ss += a[i] * a[i]; }
        const float r = 1.0f / sqrtf(sum8(ss) * (1.f / 64.f) + EPS);
#pragma unroll
        for (int i = 0; i < 8; ++i) a[i] = a[i] * r * nw[i] * silu_f(z[i]);
        store8(mix + (size_t)m * 1024 + C.lane * 8, a);
    }
}
struct MapGUE { int off; __device__ __forceinline__ int operator()(int n0) const { return off + (n0 >> 7) * 256 + (n0 & 127); } };
__device__ __forceinline__ void moe_weights(Ctx& C) {
    LAS float* scr = (LAS float*)(C.lds + C.wave * 16384);
    constexpr int I_G = (D / 64) * (EF / 32), I_D = (EF / 64) * (D / 32);
    constexpr int NITEMS = NE * (2 * I_G + I_D);
    for (int it = C.gw; it < NITEMS; it += C.NGW) {
        const int e = it / (2 * I_G + I_D); int r = it % (2 * I_G + I_D);
        if (r < I_G) { transpose_item(C.in[21] + (size_t)e * D * EF, D, EF, WSP(bf16, WS_MGU), MapGUE{e * 7168}, scr, r, C.lane); continue; } r -= I_G;
        if (r < I_G) { transpose_item(C.in[22] + (size_t)e * D * EF, D, EF, WSP(bf16, WS_MGU), MapGUE{e * 7168 + 128}, scr, r, C.lane); continue; } r -= I_G;
        transpose_item(C.in[23] + (size_t)e * EF * D, EF, D, WSP(bf16, WS_MD) + (size_t)e * D * EF, MapId(), scr, r, C.lane);
    }
}
__device__ __forceinline__ void moe_panel_starts(Ctx& C, int (&ps)[9], int (&cnt)[8]) {
    int acc = 0;
#pragma unroll
    for (int e = 0; e < 8; ++e) { cnt[e] = (int)__hip_atomic_load(C.ctl + CW_CNT + 64 * e, RLX_AGENT); ps[e] = acc; acc += (cnt[e] + 255) >> 8; }
    ps[8] = acc;
}
__device__ __forceinline__ void moe_scatter(Ctx& C, const bf16* xn2) {
    int ps[9], cnt[8]; moe_panel_starts(C, ps, cnt);
    bf16* xs = WSP(bf16, WS_XS); const int* route = WSP(int, WS_ROUTE); int* pos = WSP(int, WS_POS);
    for (int m = C.gw; m < ML; m += C.NGW) {
        const int e0 = route[m * 4 + 0], s0 = route[m * 4 + 1], e1 = route[m * 4 + 2], s1 = route[m * 4 + 3];
        int p0 = 0, p1 = 0;
#pragma unroll
        for (int e = 0; e < 8; ++e) { p0 = (e == e0) ? ps[e] : p0; p1 = (e == e1) ? ps[e] : p1; }
        const int r0 = p0 * 256 + s0, r1 = p1 * 256 + s1;
        const GAS v4u* src = (const GAS v4u*)(xn2 + (size_t)m * D) + C.lane; GAS v4u* d0 = (GAS v4u*)(xs + (size_t)r0 * D) + C.lane; GAS v4u* d1 = (GAS v4u*)(xs + (size_t)r1 * D) + C.lane;
        const v4u a = src[0], b = src[64]; d0[0] = a; d0[64] = b; d1[0] = a; d1[64] = b;

        if (C.lane == 0) { pos[m * 2 + 0] = r0; pos[m * 2 + 1] = r1; }
    }
#pragma unroll
    for (int e = 0; e < 8; ++e) { const int nb = ps[e + 1] * 256 - (ps[e] * 256 + cnt[e]); const int rb = ps[e] * 256 + cnt[e];
        for (int r = C.gw; r < nb; r += C.NGW) { GAS v4u* d = (GAS v4u*)(xs + (size_t)(rb + r) * D) + C.lane; d[0] = (v4u){0u, 0u, 0u, 0u}; d[64] = (v4u){0u, 0u, 0u, 0u}; } }
}
__device__ __forceinline__ void moe_final(Ctx& C, int l) {
    const bf16* ys = WSP(bf16, WS_XS); const int* route = WSP(int, WS_POS); const float* rwt = WSP(float, WS_RW);
    for (int m = C.gw; m < ML; m += C.NGW) {
        const int r0 = route[m * 2 + 0], r1 = route[m * 2 + 1]; const float w0 = rwt[m * 2], w1 = rwt[m * 2 + 1];
        const int bidx = m >> 13; const float* g2 = mods_ptr(C, l, bidx, 5);
        float x[16]; float ss = 0.f;
#pragma unroll
        for (int j = 0; j < 2; ++j) { const int c0 = j * 512 + C.lane * 8; float a[8], bb[8]; load8(ys + (size_t)r0 * D + c0, a); load8(ys + (size_t)r1 * D + c0, bb);
            const f32x4 xa = *(const GAS f32x4*)(C.out + (size_t)m * D + c0), xb = *(const GAS f32x4*)(C.out + (size_t)m * D + c0 + 4);
            const f32x4 ga = *(const GAS f32x4*)(g2 + c0), gb = *(const GAS f32x4*)(g2 + c0 + 4);
            const float xv[8] = {xa.x, xa.y, xa.z, xa.w, xb.x, xb.y, xb.z, xb.w}, gv[8] = {ga.x, ga.y, ga.z, ga.w, gb.x, gb.y, gb.z, gb.w};
#pragma unroll
            for (int i = 0; i < 8; ++i) { const float v = xv[i] + gv[i] * (w0 * a[i] + w1 * bb[i]); x[j * 8 + i] = v; ss += v * v; } }
        const float rstd = 1.0f / sqrtf(wave_sum(ss) * (1.f / D) + EPS);
#pragma unroll
        for (int j = 0; j < 2; ++j) { const int c0 = j * 512 + C.lane * 8;
            const f32x4 fa = *(const GAS f32x4*)(C.in[24] + c0), fb = *(const GAS f32x4*)(C.in[24] + c0 + 4);
            f32x4 oa = {x[j * 8 + 0] * rstd * fa.x, x[j * 8 + 1] * rstd * fa.y, x[j * 8 + 2] * rstd * fa.z, x[j * 8 + 3] * rstd * fa.w};
            f32x4 ob = {x[j * 8 + 4] * rstd * fb.x, x[j * 8 + 5] * rstd * fb.y, x[j * 8 + 6] * rstd * fb.z, x[j * 8 + 7] * rstd * fb.w};
            *(GAS f32x4*)(C.out + (size_t)m * D + c0) = oa; *(GAS f32x4*)(C.out + (size_t)m * D + c0 + 4) = ob; }
    }
}
struct Args { const float* in[25]; float* out; unsigned char* ws; };
__global__ void __launch_bounds__(NWAVES * 64, 2) mk_fwd(Args args) {
    extern __shared__ __attribute__((aligned(16))) unsigned char lds[];
    Ctx C;
    C.lds = (LAS unsigned char*)lds; C.tid = threadIdx.x; C.lane = C.tid & 63; C.wave = __builtin_amdgcn_readfirstlane(C.tid >> 6);
    C.G = gridDim.x; C.gw = blockIdx.x * NWAVES + C.wave; C.NGW = C.G * NWAVES;
    C.in = (const float* const __attribute__((address_space(4)))*)__builtin_amdgcn_kernarg_segment_ptr();
    C.out = args.out; C.ws = args.ws; C.ctl = (gu32*)args.ws;
    volatile LAS unsigned* MISC = (volatile LAS unsigned*)(C.lds + MISC_OFF);
    for (int u = C.tid; u < (LDS_BYTES - LDSCTL_OFF) / 4; u += NWAVES * 64) ((LAS unsigned*)(C.lds + LDSCTL_OFF))[u] = 0u;
    __syncthreads();
    XcdBarrier bar = xcd_barrier_post((unsigned*)(C.ctl + CW_BAR), MISC + 8);
#define RELOAD() do { int t_ = threadIdx.x; asm volatile("" : "+v"(t_)); C.tid = t_; C.lane = t_ & 63; C.wave = __builtin_amdgcn_readfirstlane(t_ >> 6); C.gw = blockIdx.x * NWAVES + C.wave; } while (0)
#define GRID_BAR() do { xcd_barrier(bar); RELOAD(); } while (0)

    p0_weights(C); __syncthreads(); RELOAD(); p0_mods(C);
    GRID_BAR();
    for (int l = 0; l < NLAYER; ++l) {
        const float* xl = (l == 0) ? C.in[0] : C.out; const float* xc = (l == 0) ? C.in[2] : WSP(float, WS_XC);
        norm_mod<false>(C, xl, xc, MT, l, 1, 0, WSP(bf16, WS_XN));
        GRID_BAR();
        {   pg8::Gemm g{WSP(bf16, WS_XN), WSP(bf16, WS_WIN) + (size_t)l * NINP * D, MT, NINP, D}; pg8::StaticOrder S; S.init(MT, NINP, C.G, (int)blockIdx.x);
            pg8::EpiIn E{WSP(bf16, WS_DNRAW), WSP(bf16, WS_ZB), WSP(bf16, WS_QRAW), WSP(bf16, WS_KVRAW), WSP(float, WS_AB)};
            pg8::gemm_phase<pg8::EpiIn, pg8::StaticOrder, true, true>(C.lds, g, S, E); }
        GRID_BAR();
        p3_prep(C, l);
        GRID_BAR();
        p4_attn_naive(C, l);
        RELOAD();
        p5_dn1_naive(C);
        GRID_BAR();
        p6_dn2_naive(C);
        GRID_BAR();
        p7_dn3(C, l, l == 0 ? MT : ML);
        GRID_BAR();
        {   const int Mo = (l == 0) ? MT : ML;
            pg8::Gemm g{WSP(bf16, WS_MIX), WSP(bf16, WS_WOUT) + (size_t)l * D * D, Mo, D, D}; pg8::StaticOrder S; S.init(Mo, D, C.G, (int)blockIdx.x);
            pg8::EpiRes E{xl, C.out, xc, WSP(float, WS_XC), mods_ptr(C, l, 0, 2), 6 * 1024};
            pg8::gemm_phase<pg8::EpiRes, pg8::StaticOrder, true, true>(C.lds, g, S, E); }
        GRID_BAR();
        if (l == 0) {
            norm_mod<false>(C, C.out, WSP(float, WS_XC), MT, l, 4, 3, WSP(bf16, WS_XN));
            GRID_BAR();
            {   pg8::Gemm g{WSP(bf16, WS_XN), WSP(bf16, WS_WGU), MT, 2 * FF, D}; pg8::StaticOrder S; S.init(MT, 2 * FF, C.G, (int)blockIdx.x);
                pg8::EpiSwiGLU E{WSP(bf16, WS_H), FF, 22, 0};
                pg8::gemm_phase<pg8::EpiSwiGLU, pg8::StaticOrder, true, true>(C.lds, g, S, E); }
            GRID_BAR();
            {   pg8::Gemm g{WSP(bf16, WS_H), WSP(bf16, WS_WD), MT, D, FF}; pg8::StaticOrder S; S.init(MT, D, C.G, (int)blockIdx.x);
                pg8::EpiRes E{C.out, C.out, WSP(float, WS_XC), WSP(float, WS_XC), mods_ptr(C, l, 0, 5), 6 * 1024};
                pg8::gemm_phase<pg8::EpiRes, pg8::StaticOrder, true, true>(C.lds, g, S, E); }
            GRID_BAR();
        } else {
            norm_mod<true>(C, C.out, WSP(float, WS_XC), ML, l, 4, 3, WSP(bf16, WS_HM));
            RELOAD();
            moe_weights(C);
            GRID_BAR();
            moe_scatter(C, WSP(bf16, WS_HM));
            GRID_BAR();
            int ps[9], cnt[8]; moe_panel_starts(C, ps, cnt);
            const int per = (ps[8] + NSS - 1) / NSS;
            for (int ss = 0; ss < NSS; ++ss) {
                const int p0 = ss * per, p1 = (p0 + per < ps[8]) ? p0 + per : ps[8];
                if (p0 < p1) {
                    pg8::MoeOrder S;
#pragma unroll
                    for (int k = 0; k < 9; ++k) S.ps[k] = ps[k];
                    S.p0 = p0; S.p1 = p1; S.nloc = 28; S.G = C.G; S.c = (int)blockIdx.x; S.a_off = 0;
                    pg8::Gemm g{WSP(bf16, WS_XS), WSP(bf16, WS_MGU), 0, 0, D};
                    pg8::EpiSwiGLU E{WSP(bf16, WS_HM), EF, 28, p0};
                    pg8::gemm_phase<pg8::EpiSwiGLU, pg8::MoeOrder, true, true>(C.lds, g, S, E);
                }
                GRID_BAR();
                if (p0 < p1) {
                    pg8::MoeOrder S;
#pragma unroll
                    for (int k = 0; k < 9; ++k) S.ps[k] = ps[k];
                    S.p0 = p0; S.p1 = p1; S.nloc = 4; S.G = C.G; S.c = (int)blockIdx.x; S.a_off = -p0;
                    pg8::Gemm g{WSP(bf16, WS_HM), WSP(bf16, WS_MD), 0, 0, EF};
                    pg8::EpiBfPlain E{WSP(bf16, WS_XS) + (size_t)p0 * 256 * D, D, 4};
                    pg8::gemm_phase<pg8::EpiBfPlain, pg8::MoeOrder, true, true>(C.lds, g, S, E);
                }
                GRID_BAR();
            }
            moe_final(C, l);
        }
    }
}

extern "C" void kernel_launch(void* const* d_in, const int* in_sizes, int n_in, void* d_out, int out_size, void* d_ws, size_t ws_size, hipStream_t stream) {
    static int grid = 0;
    if (grid == 0) {
        int dev = 0, cus = 0;
        if (n_in != 25 || out_size != ML * D || ws_size < (size_t)560 * MiB) { fprintf(stderr, "kernel_launch: unexpected problem (n_in %d out %d ws %zu)\n", n_in, out_size, ws_size); grid = -1; return; }
        if (hipGetDevice(&dev) != hipSuccess || hipDeviceGetAttribute(&cus, hipDeviceAttributeMultiprocessorCount, dev) != hipSuccess) { grid = -1; return; }
        if (hipFuncSetAttribute((const void*)mk_fwd, hipFuncAttributeMaxDynamicSharedMemorySize, LDS_BYTES) != hipSuccess) { grid = -1; return; }
        (void)hipGetLastError();
        grid = cus;
    }
    if (grid < 0) return;
    (void)hipMemsetAsync((char*)d_ws, 0, CTL_ZERO_BYTES, stream);
    Args a{};
    for (int i = 0; i < 25; ++i) a.in[i] = (const float*)d_in[i];
    a.out = (float*)d_out; a.ws = (unsigned char*)d_ws;
    hipLaunchKernelGGL(mk_fwd, dim3(grid), dim3(NWAVES * 64), LDS_BYTES, stream, a);
}
```

```cpp
#include <hip/hip_runtime.h>
#include <hip/hip_bf16.h>
#include <cstdio>
#include <cstdint>
#include <cmath>
namespace pg8 {
#define PG8_LAS __attribute__((address_space(3)))
typedef unsigned short bf16_t;
typedef short bf16x8 __attribute__((ext_vector_type(8)));
typedef float f32x4 __attribute__((ext_vector_type(4)));
typedef unsigned u32x4 __attribute__((ext_vector_type(4)));
constexpr int BM = 256, BK = 64, HALF = 128, HTB = HALF * BK * 2  , STAGE_BYTES = 8 * HTB, NXCD = 8, WGM = 8;

__host__ __device__ __forceinline__ int lds_byte(int r, int c) { const int st = (r >> 4) * 2 + (c >> 5), rr = r & 15, cc = c & 31, ob = rr * 64 + cc * 2; return st * 1024 + (ob ^ (((ob >> 9) & 1) << 5)); }
__host__ __device__ __forceinline__ void stage_rc(int b, int& R, int& C) { const int st = b / 1024, sb = b % 1024, swz = sb ^ (((sb >> 9) & 1) << 5); R = (st >> 1) * 16 + swz / 64; C = (st & 1) * 32 + (swz % 64) / 2; }
__host__ __device__ __forceinline__ int perm32(int rho) { const int n = rho >> 4, i = rho & 15; return 8 * (i >> 2) + 4 * n + (i & 3); }

struct Unit { int pm, pn; };
struct Gemm { const bf16_t* A; const bf16_t* Bt; int M, N, K; };

struct StaticOrder {
    int nM, nN, nwg, G, c;
    __host__ __device__ void init(int M, int N, int G_, int c_) { nM = M / BM; nN = N / BM; nwg = nM * nN; G = G_; c = c_; }
    __host__ __device__ bool next(int i, Unit& u) const {
        const long L = (long)i * G + c; if (L >= nwg) return false;
        int wgid = (int)L; { const int q = nwg / NXCD, r = nwg % NXCD, xcd = wgid % NXCD, off = wgid / NXCD; wgid = (xcd < r ? xcd * (q + 1) : r * (q + 1) + (xcd - r) * q) + off; }
        const int nig = WGM * nN, gid = wgid / nig, fm = gid * WGM, gsz = (nM - fm) < WGM ? (nM - fm) : WGM;
        u.pm = fm + ((wgid % nig) % gsz); u.pn = (wgid % nig) / gsz; return true;
    }
    __device__ __forceinline__ void a_ready(const Unit&) const {}
    __device__ __forceinline__ void done(const Unit&) const {}
};

__device__ __forceinline__ unsigned cvt_pk_bf16(float lo, float hi) { unsigned r; asm volatile("v_cvt_pk_bf16_f32 %0, %1, %2" : "=v"(r) : "v"(lo), "v"(hi)); return r; }
typedef float f32x2 __attribute__((ext_vector_type(2)));
__device__ __forceinline__ f32x2 gelu_pk(f32x2 v) {
    const f32x2 av = __builtin_elementwise_abs(v), d = av * 0.2316418882f + 1.0f;
    f32x2 t; t.x = __builtin_amdgcn_rcpf(d.x); t.y = __builtin_amdgcn_rcpf(d.y);
    f32x2 q = t * 0.5307027145f + (-0.7265760135f); q = q * t + 0.7107068705f; q = q * t + (-0.142248368f); q = q * t + 0.127414796f; q = q * t;
    const f32x2 s = (v * v) * (-0.72134752044f);
    f32x2 e; e.x = __builtin_amdgcn_exp2f(s.x); e.y = __builtin_amdgcn_exp2f(s.y);
    const f32x2 m = v * (q * e), r = v - m;
    f32x2 o; o.x = v.x < 0.f ? m.x : r.x; o.y = v.y < 0.f ? m.y : r.y; return o;
}

template <int ACT  > struct EpiBf16 {
    static constexpr bool PERM = true, AFTER_DRAIN = false; static_assert(ACT == 0 || ACT == 1, "EpiBf16: ACT is 0 (none) or 1 (gelu_pk)");
    bf16_t* O; int ldc; const float* bias; int split_cols; size_t split_stride; float scale0;
    __device__ __forceinline__ void operator()(const f32x4 (&acc)[2][2][4][2], const Unit& u, int wr, int wc, int fr, int fq) const {
        const int row0 = u.pm * BM + wr * 64 + fr; int colt = u.pn * BM; bf16_t* base = O;
        float sc = 1.f; if (split_cols) { const int t = colt / split_cols; base += (size_t)t * split_stride; colt -= t * split_cols; if (t == 0) sc = scale0; }
        const int col0 = colt + wc * 32 + 8 * fq, bcol0 = u.pn * BM + wc * 32 + 8 * fq;
        f32x4 bv[2][2];
#pragma unroll
        for (int bj = 0; bj < 2; ++bj)
#pragma unroll
            for (int n = 0; n < 2; ++n) bv[bj][n] = bias ? *(const f32x4*)(bias + bcol0 + bj * HALF + 4 * n) : (f32x4){0.f, 0.f, 0.f, 0.f};
#pragma unroll
        for (int ai = 0; ai < 2; ++ai)
#pragma unroll
            for (int m = 0; m < 4; ++m) { bf16_t* rowp = base + (size_t)(row0 + ai * HALF + m * 16) * ldc + col0;
#pragma unroll
                for (int bj = 0; bj < 2; ++bj) { f32x4 v0 = acc[ai][bj][m][0] + bv[bj][0], v1 = acc[ai][bj][m][1] + bv[bj][1];
                    if (ACT == 1) { f32x2 a = gelu_pk((f32x2){v0[0], v0[1]}), b = gelu_pk((f32x2){v0[2], v0[3]}), c = gelu_pk((f32x2){v1[0], v1[1]}), d = gelu_pk((f32x2){v1[2], v1[3]});
                        v0 = (f32x4){a.x, a.y, b.x, b.y}; v1 = (f32x4){c.x, c.y, d.x, d.y}; }
                    v0 = v0 * sc; v1 = v1 * sc; u32x4 w; w.x = cvt_pk_bf16(v0[0], v0[1]); w.y = cvt_pk_bf16(v0[2], v0[3]); w.z = cvt_pk_bf16(v1[0], v1[1]); w.w = cvt_pk_bf16(v1[2], v1[3]);
                    *(u32x4*)(rowp + bj * HALF) = w; } }
    }
};

template <class Epi, class Sched, bool ALIGN_EPI = false, bool SP2 = false>
__device__ __forceinline__ void gemm_phase(PG8_LAS unsigned char* lds, const Gemm g, const Sched& S, const Epi& E) {
    int tid_ = threadIdx.x; asm volatile("" : "+v"(tid_));
    const int tid = tid_, wid = __builtin_amdgcn_readfirstlane(tid >> 6), lane = tid & 63, wr = wid >> 2, wc = wid & 3, fr = lane & 15, fq = lane >> 4;
    const int K = g.K, nt = K / BK;
    unsigned voffA[2], voffB[2];
#pragma unroll
    for (int i = 0; i < 2; ++i) { int R, C; stage_rc(tid * 16 + i * 8192, R, C); const int Rb = Epi::PERM ? ((R & ~31) + perm32(R & 31)) : R;
        voffA[i] = (unsigned)(R * K + C) * 2u; voffB[i] = (unsigned)(Rb * K + C) * 2u; }
    const size_t kstep = (size_t)(BK * 2);
    const size_t hstep = (size_t)HALF * K * 2;
    const size_t tstep = 2 * hstep;
    const unsigned ldsw = (unsigned)wid * 1024u;
    const int aoff = lds_byte(wr * 64 + fr, fq * 8), boff = lds_byte(wc * 32 + fr, fq * 8);
#define PG8_SA(b, h) (((b) * 2 + (h)) * HTB)
#define PG8_SB(b, h) ((4 + (b) * 2 + (h)) * HTB)
#define PG8_STAGE(bufoff, gbase, voff) do { _Pragma("unroll") for (int _i = 0; _i < 2; ++_i) \
        __builtin_amdgcn_global_load_lds((const unsigned*)((const char*)(gbase) + (voff)[_i]), (PG8_LAS unsigned*)(lds + (bufoff) + ldsw + _i * 8192), 16, 0, 0); } while (0)
#define PG8_LDA(dst, b, h) do { _Pragma("unroll") for (int m = 0; m < 4; ++m) _Pragma("unroll") for (int k = 0; k < 2; ++k) dst[m][k] = *(const PG8_LAS bf16x8*)(lds + PG8_SA(b, h) + aoff + m * 2048 + k * 1024); } while (0)
#define PG8_LDB(dst, b, h) do { _Pragma("unroll") for (int n = 0; n < 2; ++n) _Pragma("unroll") for (int k = 0; k < 2; ++k) dst[n][k] = *(const PG8_LAS bf16x8*)(lds + PG8_SB(b, h) + boff + n * 2048 + k * 1024); } while (0)
#define PG8_MMA(ai, bj, At, Bt) do { __builtin_amdgcn_s_setprio(1); _Pragma("unroll") for (int m = 0; m < 4; ++m) _Pragma("unroll") for (int n = 0; n < 2; ++n) _Pragma("unroll") for (int k = 0; k < 2; ++k) \
        acc[ai][bj][m][n] = __builtin_amdgcn_mfma_f32_16x16x32_bf16(Bt[n][k], At[m][k], acc[ai][bj][m][n], 0, 0, 0); __builtin_amdgcn_s_setprio(0); } while (0)
#define PG8_WAIT_V(n) asm volatile("s_waitcnt vmcnt(" #n ")" ::: "memory")
#define PG8_WAIT_L(n) asm volatile("s_waitcnt lgkmcnt(" #n ")" ::: "memory")
#define PG8_BAR __builtin_amdgcn_s_barrier()
#define PG8_SCHED __builtin_amdgcn_sched_barrier(0)
    Unit cur, nxt; int ui = 0;
    if (!S.next(0, cur)) return;
    f32x4 acc[2][2][4][2];
#pragma unroll
    for (int a = 0; a < 2; ++a)
#pragma unroll
        for (int b = 0; b < 2; ++b)
#pragma unroll
            for (int m = 0; m < 4; ++m)
#pragma unroll
                for (int n = 0; n < 2; ++n) acc[a][b][m][n] = (f32x4){0.f, 0.f, 0.f, 0.f};
    bf16x8 At[4][2], B0[2][2], B1[2][2];
    const char* cA = (const char*)g.A + (size_t)cur.pm * tstep; const char* cB = (const char*)g.Bt + (size_t)cur.pn * tstep;
    S.a_ready(cur);
    if constexpr (SP2) {
        PG8_STAGE(PG8_SB(0, 0), cB, voffB); PG8_STAGE(PG8_SB(0, 1), cB + hstep, voffB); PG8_STAGE(PG8_SA(0, 0), cA, voffA); PG8_STAGE(PG8_SA(0, 1), cA + hstep, voffA);
        if (wr == 1) PG8_BAR;
        PG8_WAIT_V(2); PG8_BAR;
        PG8_STAGE(PG8_SB(1, 0), cB + kstep, voffB); PG8_STAGE(PG8_SA(1, 0), cA + kstep, voffA); PG8_STAGE(PG8_SB(1, 1), cB + hstep + kstep, voffB);
        PG8_WAIT_V(6); PG8_BAR;
    } else {
        PG8_STAGE(PG8_SB(0, 0), cB, voffB); PG8_STAGE(PG8_SA(0, 0), cA, voffA); PG8_STAGE(PG8_SB(0, 1), cB + hstep, voffB); PG8_STAGE(PG8_SA(0, 1), cA + hstep, voffA);
        if (wr == 1) PG8_BAR;
        PG8_WAIT_V(4); PG8_BAR;
        PG8_STAGE(PG8_SB(1, 0), cB + kstep, voffB); PG8_STAGE(PG8_SA(1, 0), cA + kstep, voffA); PG8_STAGE(PG8_SB(1, 1), cB + hstep + kstep, voffB);
        PG8_WAIT_V(6); PG8_BAR;
    }
    for (;;) {
        const bool has_next = S.next(ui + 1, nxt);
        const char* nA = has_next ? (const char*)g.A + (size_t)nxt.pm * tstep : cA; const char* nB = has_next ? (const char*)g.Bt + (size_t)nxt.pn * tstep : cB;
        for (int t = 0; t < nt; t += 2) {
            const bool last = (t == nt - 2);
            const char* a1 = cA + (size_t)(t + 1) * kstep;
            const char* a2 = last ? nA : cA + (size_t)(t + 2) * kstep; const char* b2 = last ? nB : cB + (size_t)(t + 2) * kstep;
            const char* a3 = a2 + kstep; const char* b3 = b2 + kstep;
            if (last && has_next) S.a_ready(nxt);
            if constexpr (SP2) {
            PG8_LDB(B0, 0, 0); PG8_LDB(B1, 0, 1); PG8_SCHED; PG8_LDA(At, 0, 0); PG8_STAGE(PG8_SA(1, 1), a1 + hstep, voffA);
            PG8_WAIT_V(8); PG8_WAIT_L(0); PG8_BAR; PG8_MMA(0, 0, At, B0); PG8_MMA(0, 1, At, B1); PG8_BAR; PG8_SCHED;
            PG8_LDA(At, 0, 1); PG8_STAGE(PG8_SB(0, 0), b2, voffB); PG8_STAGE(PG8_SB(0, 1), b2 + hstep, voffB); PG8_STAGE(PG8_SA(0, 0), a2, voffA);
            PG8_WAIT_V(8); PG8_WAIT_L(0); PG8_BAR; PG8_MMA(1, 0, At, B0); PG8_MMA(1, 1, At, B1); PG8_BAR; PG8_SCHED;
            PG8_LDB(B0, 1, 0); PG8_LDB(B1, 1, 1); PG8_SCHED; PG8_LDA(At, 1, 0); PG8_STAGE(PG8_SA(0, 1), a2 + hstep, voffA);
            PG8_WAIT_V(8); PG8_WAIT_L(0); PG8_BAR; PG8_MMA(0, 0, At, B0); PG8_MMA(0, 1, At, B1); PG8_BAR; PG8_SCHED;
            PG8_LDA(At, 1, 1); PG8_STAGE(PG8_SB(1, 0), b3, voffB); PG8_STAGE(PG8_SB(1, 1), b3 + hstep, voffB); PG8_STAGE(PG8_SA(1, 0), a3, voffA);
            PG8_WAIT_V(8); PG8_WAIT_L(0); PG8_BAR; PG8_MMA(1, 0, At, B0); PG8_MMA(1, 1, At, B1); PG8_BAR; PG8_SCHED;
            } else {
            PG8_LDB(B0, 0, 0); PG8_SCHED; PG8_LDA(At, 0, 0); PG8_STAGE(PG8_SA(1, 1), a1 + hstep, voffA);
            PG8_WAIT_L(8); PG8_BAR; PG8_WAIT_L(0); PG8_MMA(0, 0, At, B0); PG8_BAR; PG8_SCHED;
            PG8_LDB(B1, 0, 1); PG8_STAGE(PG8_SB(0, 0), b2, voffB);
            PG8_BAR; PG8_WAIT_L(0); PG8_MMA(0, 1, At, B1); PG8_BAR;
            PG8_LDA(At, 0, 1); PG8_STAGE(PG8_SA(0, 0), a2, voffA);
            PG8_BAR; PG8_WAIT_L(0); PG8_MMA(1, 0, At, B0); PG8_BAR; PG8_SCHED;
            PG8_STAGE(PG8_SB(0, 1), b2 + hstep, voffB);
            PG8_WAIT_V(6); PG8_BAR; PG8_MMA(1, 1, At, B1); PG8_BAR;
            PG8_LDB(B0, 1, 0); PG8_SCHED; PG8_LDA(At, 1, 0); PG8_STAGE(PG8_SA(0, 1), a2 + hstep, voffA);
            PG8_WAIT_L(8); PG8_BAR; PG8_WAIT_L(0); PG8_MMA(0, 0, At, B0); PG8_BAR; PG8_SCHED;
            PG8_LDB(B1, 1, 1); PG8_STAGE(PG8_SB(1, 0), b3, voffB);
            PG8_BAR; PG8_WAIT_L(0); PG8_MMA(0, 1, At, B1); PG8_BAR;
            PG8_LDA(At, 1, 1); PG8_STAGE(PG8_SA(1, 0), a3, voffA);
            PG8_BAR; PG8_WAIT_L(0); PG8_MMA(1, 0, At, B0); PG8_BAR; PG8_SCHED;
            PG8_STAGE(PG8_SB(1, 1), b3 + hstep, voffB);
            PG8_WAIT_V(6); PG8_BAR; PG8_MMA(1, 1, At, B1); PG8_BAR;
            }
        }
        if constexpr (ALIGN_EPI) { if (wr == 0) PG8_BAR; }
        if constexpr (!Epi::AFTER_DRAIN) { E(acc, cur, wr, wc, fr, fq); S.done(cur); }
        if (!has_next) break;
#pragma unroll
        for (int a = 0; a < 2; ++a)
#pragma unroll
            for (int b = 0; b < 2; ++b)
#pragma unroll
                for (int m = 0; m < 4; ++m)
#pragma unroll
                    for (int n = 0; n < 2; ++n) acc[a][b][m][n] = (f32x4){0.f, 0.f, 0.f, 0.f};
        cur = nxt; cA = nA; cB = nB; ++ui;
        if constexpr (ALIGN_EPI) { if (wr == 1) PG8_BAR; }
    }
    PG8_WAIT_V(0);
    if constexpr (!ALIGN_EPI) { if (wr == 0) PG8_BAR; }
    PG8_BAR;
    if constexpr (Epi::AFTER_DRAIN) { E.fused(acc, cur, wr, wc, fr, fq, lds, wid, lane); S.done(cur); }
#undef PG8_SA
#undef PG8_SB
#undef PG8_STAGE
#undef PG8_LDA
#undef PG8_LDB
#undef PG8_MMA
#undef PG8_WAIT_V
#undef PG8_WAIT_L
#undef PG8_BAR
#undef PG8_SCHED
}
}
namespace attn64 {
using bf16=__hip_bfloat16;
using bf16x8=__attribute__((ext_vector_type(8)))short;
using s16x4=__attribute__((ext_vector_type(4)))short;
using f32x16=__attribute__((ext_vector_type(16)))float;
using u32x4=__attribute__((ext_vector_type(4)))unsigned;
constexpr int D=64,QP=1024,KP=128;
constexpr int NW=8,QBLK=32,QB=QBLK*NW,KVBLK=64;
__device__ __forceinline__ int crow(int r,int hi){return (r&3)+8*(r>>2)+4*hi;}
#define SBAR() __builtin_amdgcn_sched_barrier(0)
constexpr int NSLOT=3, SLOTB=8192;
constexpr int LDS_K=0, LDS_V=NSLOT*SLOTB, LDS_WS=2*NSLOT*SLOTB, LDS_OST=LDS_WS+NW*64*4, LDS_BYTES=LDS_OST+NW*4096;
constexpr float C2=0.125f*1.4426950408889634f;
__device__ __forceinline__ void glds16(const void*gsrc,unsigned lds_dst){unsigned keep;
  asm volatile("s_mov_b32 %0, m0\n\ts_mov_b32 m0, %2\n\ts_nop 0\n\tglobal_load_lds_dwordx4 %1, off\n\ts_mov_b32 m0, %0":"=&s"(keep):"v"(gsrc),"s"(lds_dst):"memory");}
__device__ __forceinline__ float max3f(float a,float b,float c){float r;asm("v_max3_f32 %0, %1, %2, %3":"=v"(r):"v"(a),"v"(b),"v"(c));return r;}
__device__ __forceinline__ float max2f(float a,float b){float r;asm("v_max_f32_e32 %0, %1, %2":"=v"(r):"v"(a),"v"(b));return r;}
__device__ __forceinline__ float fadd_s(float a,float b){float r;asm("v_add_f32_e32 %0, %1, %2":"=v"(r):"v"(a),"v"(b));return r;}
__device__ __forceinline__ float fsub_s(float a,float b){float r;asm("v_sub_f32_e32 %0, %1, %2":"=v"(r):"v"(a),"v"(b));return r;}
typedef float f32x2_t __attribute__((ext_vector_type(2))); typedef __bf16 bf16x2_t __attribute__((ext_vector_type(2)));
__device__ __forceinline__ unsigned cvtpk_s(float lo,float hi){f32x2_t v={lo,hi};bf16x2_t b=__builtin_convertvector(v,bf16x2_t);return __builtin_bit_cast(unsigned,b);}
#define WAIT_BAR(N) asm volatile("s_waitcnt vmcnt(" #N ") lgkmcnt(0)\n\ts_barrier":::"memory")

__device__ __forceinline__ void qkt(f32x16&p0,f32x16&p1,const char*Kslot,const bf16x8*qr,const f32x16&negm,int r32,int hi){
  const char*kb=Kslot+hi*1024+r32*16;
  #pragma unroll
  for(int d0=0;d0<4;++d0){
    const bf16x8 b0=*reinterpret_cast<const bf16x8*>(kb+d0*2048);
    const bf16x8 b1=*reinterpret_cast<const bf16x8*>(kb+d0*2048+512);
    if(d0==0){p0=__builtin_amdgcn_mfma_f32_32x32x16_bf16(b0,qr[0],negm,0,0,0);p1=__builtin_amdgcn_mfma_f32_32x32x16_bf16(b1,qr[0],negm,0,0,0);}
    else{p0=__builtin_amdgcn_mfma_f32_32x32x16_bf16(b0,qr[d0],p0,0,0,0);p1=__builtin_amdgcn_mfma_f32_32x32x16_bf16(b1,qr[d0],p1,0,0,0);}}
}
typedef __attribute__((address_space(3))) const char* lds_cptr;
typedef short v4i16_t __attribute__((ext_vector_type(4)));
__device__ __forceinline__ void kload8(bf16x8*kf,lds_cptr kp){
  kf[0]=*(const __attribute__((address_space(3))) bf16x8*)(kp);      kf[1]=*(const __attribute__((address_space(3))) bf16x8*)(kp+512);
  kf[2]=*(const __attribute__((address_space(3))) bf16x8*)(kp+2048); kf[3]=*(const __attribute__((address_space(3))) bf16x8*)(kp+2560);
  kf[4]=*(const __attribute__((address_space(3))) bf16x8*)(kp+4096); kf[5]=*(const __attribute__((address_space(3))) bf16x8*)(kp+4608);
  kf[6]=*(const __attribute__((address_space(3))) bf16x8*)(kp+6144); kf[7]=*(const __attribute__((address_space(3))) bf16x8*)(kp+6656);
}
__device__ __forceinline__ void kload2(bf16x8*kf,lds_cptr kp,int j){ kf[2*j]=*(const __attribute__((address_space(3))) bf16x8*)(kp+j*2048); kf[2*j+1]=*(const __attribute__((address_space(3))) bf16x8*)(kp+j*2048+512); }
__device__ __forceinline__ s16x4 vtr(lds_cptr p){ return __builtin_bit_cast(s16x4,__builtin_amdgcn_ds_read_tr16_b64_v4i16((__attribute__((address_space(3))) v4i16_t*)p)); }
__device__ __forceinline__ float rowmax(const f32x16&p0,const f32x16&p1){
  float a=max3f(p0[0],p0[1],p1[0]),b=max3f(p0[2],p0[3],p1[1]);a=max3f(a,p1[2],p1[3]);
  #pragma unroll
  for(int r=4;r<16;r+=4){a=max3f(a,p0[r],p0[r+1]);b=max3f(b,p0[r+2],p0[r+3]);a=max3f(a,p1[r],p1[r+1]);b=max3f(b,p1[r+2],p1[r+3]);}
  const float m=max2f(a,b);
  auto rr=__builtin_amdgcn_permlane32_swap(__float_as_uint(m),__float_as_uint(m),false,false);
  return max2f(__uint_as_float(rr[0]),__uint_as_float(rr[1]));
}
__device__ __forceinline__ void pv(f32x16*o,int vb,bf16x8 pa0,bf16x8 pa1,bf16x8 pa2,bf16x8 pa3){
  #pragma unroll
  for(int d0=0;d0<2;++d0){s16x4 lo[4],hi[4];
    #pragma unroll
    for(int ks=0;ks<4;++ks){
      asm volatile("ds_read_b64_tr_b16 %0,%1 offset:%c2":"=&v"(lo[ks]):"v"(vb),"i"(d0*4096+ks*1024):"memory");
      asm volatile("ds_read_b64_tr_b16 %0,%1 offset:%c2":"=&v"(hi[ks]):"v"(vb),"i"(d0*4096+ks*1024+512):"memory");}
    asm volatile("s_waitcnt lgkmcnt(0)":::"memory");SBAR();
    #define PK(k) (bf16x8){lo[k][0],lo[k][1],lo[k][2],lo[k][3],hi[k][0],hi[k][1],hi[k][2],hi[k][3]}
    o[d0]=__builtin_amdgcn_mfma_f32_32x32x16_bf16(pa0,PK(0),o[d0],0,0,0);
    o[d0]=__builtin_amdgcn_mfma_f32_32x32x16_bf16(pa1,PK(1),o[d0],0,0,0);
    o[d0]=__builtin_amdgcn_mfma_f32_32x32x16_bf16(pa2,PK(2),o[d0],0,0,0);
    o[d0]=__builtin_amdgcn_mfma_f32_32x32x16_bf16(pa3,PK(3),o[d0],0,0,0);
    #undef PK
  }
}

#ifndef ATTN_STORE16
#define ATTN_STORE16(p,v) (*(u32x4*)(p)=(v))
#endif
template<int THRL> __device__ __forceinline__ void attn_unit(const bf16*Q0,bf16*O0,const bf16*__restrict__ Kh,const bf16*__restrict__ Vh,const int NT,char*shm,const float mref){
  int tid_=threadIdx.x; asm volatile("":"+v"(tid_)); const int tid=tid_,lane=tid&63,r32=lane&31,hi=lane>>5; const int wid=__builtin_amdgcn_readfirstlane(tid>>6);
  const bf16*Qw=Q0+(long)(wid*QBLK)*QP;
  const unsigned lds0=(unsigned)(uintptr_t)shm;
  float*wsf=(float*)(shm+LDS_WS)+wid*64;
  const bf16*ksrc=Kh+(long)lane*KP+wid*8;
  const bf16*vsrc=Vh+(long)(16*(wid&3)+(lane>>2))*KP+(wid>>2)*32+(lane&3)*8;
  const unsigned kdst=lds0+LDS_K+wid*1024, vdst=lds0+LDS_V+wid*1024;
  #define DMA_K(t,slot) glds16(ksrc+(long)(t)*KVBLK*KP,(unsigned)__builtin_amdgcn_readfirstlane(kdst+(slot)))
  #define DMA_V(t,slot) glds16(vsrc+(long)(t)*KVBLK*KP,(unsigned)__builtin_amdgcn_readfirstlane(vdst+(slot)))
  const int vb0=(int)(lds0+LDS_V)+((lane>>4)&1)*32+(lane&3)*8+(4*hi+((lane&15)>>2))*64;
  const char*Kbase=shm+LDS_K; bf16x8 kf[8];
  const lds_cptr shm3=(lds_cptr)shm; const lds_cptr kp0=shm3+LDS_K+hi*1024+r32*16; const lds_cptr vp0=shm3+LDS_V+((lane>>4)&1)*32+(lane&3)*8+(4*hi+((lane&15)>>2))*64;
  DMA_K(0,0);DMA_V(0,0);DMA_K(1,SLOTB);
  bf16x8 qr[4];
  #pragma unroll
  for(int d0=0;d0<4;++d0)qr[d0]=*reinterpret_cast<const bf16x8*>(&Qw[(long)r32*QP+d0*16+hi*8]);
  float l_reg=0.f;f32x16 o[2];o[0]=f32x16{};o[1]=f32x16{};f32x16 negm;
  _Pragma("unroll") for(int r=0;r<16;++r)negm[r]=-mref;
  asm volatile("":"+v"(negm));
  #define CMASK(P0,P1,t) do{}while(0)
  #define START(P0,P1) do{ _Pragma("unroll") for(int r=0;r<16;++r)P0[r]=__builtin_amdgcn_exp2f(P0[r]); }while(0)
  #define RESC() do{}while(0)
  f32x16 pA0,pA1,pB0,pB1;
  int sl_prev=0,sl_cur=0,sl_next=SLOTB;
  #define ROT() do{sl_prev=sl_cur;sl_cur=sl_next;sl_next=(sl_next==(NSLOT-1)*SLOTB)?0:sl_next+SLOTB;}while(0)
  DMA_K(2,2*SLOTB);
  WAIT_BAR(3);
  qkt(pA0,pA1,Kbase,qr,negm,r32,hi);asm volatile("s_nop 15\n\ts_nop 7":"+v"(pA0),"+v"(pA1));CMASK(pA0,pA1,0);
  START(pA0,pA1);
  _Pragma("unroll") for(int r=0;r<16;++r)pA1[r]=__builtin_amdgcn_exp2f(pA1[r]);
  WAIT_BAR(0);
  DMA_K(3,0);DMA_V(1,SLOTB);
  ROT();
  kload8(kf,kp0+sl_cur);
  WAIT_BAR(2);
  s16x4 vlo[8],vhi[8]; u32x4 pw0,pw1,pw2,pw3;
  #define PKW(P,B) cvtpk_s(P[B],P[B+1])
  #define PAF(k) __builtin_bit_cast(bf16x8,pw##k)
  #define VFR(i) (bf16x8){vlo[i][0],vlo[i][1],vlo[i][2],vlo[i][3],vhi[i][0],vhi[i][1],vhi[i][2],vhi[i][3]}
  #define PIN(x) asm volatile("":"+v"(x))
  #define MX3(a,b,c) __builtin_fmaxf(__builtin_fmaxf((a),(b)),(c))
  #define GAPA(MF,A0,A1,A2,A3,W0,W1,PW) do{ MF; sacc+=A0; sacc+=A1; sacc+=A2; sacc+=A3; PIN(sacc); W0; W1; PIN(PW); SBAR(); }while(0)
  #define EX(v) __builtin_amdgcn_exp2f(v)
  #define GAPB(MF,X,B) do{ MF; X[B]=EX(X[B]); X[B+1]=EX(X[B+1]); X[B+2]=EX(X[B+2]); X[B+3]=EX(X[B+3]); PIN(X); SBAR(); }while(0)
  #define VRD(i) do{ vlo[i]=vtr(vp_+(((i)>>2)*4096+((i)&3)*1024)); vhi[i]=vtr(vp_+(((i)>>2)*4096+((i)&3)*1024+512)); }while(0)
  #define KRD(G,j) do{ if(G){ kload2(kf,kp0+sl_next,j); SBAR(); } }while(0)
  #define STEP(C0,C1,P0,P1,t,GK,GV,GL) do{ SBAR(); \
    const lds_cptr vp_=vp0+sl_prev; \
    VRD(0); SBAR(); float sacc=(P0[0]+P0[1]); \
    GAPA(C0=__builtin_amdgcn_mfma_f32_32x32x16_bf16(kf[0],qr[0],negm,0,0,0), P0[2],P0[3],P0[4],P0[5],     pw0[0]=PKW(P0,0), pw0[1]=PKW(P0,2), pw0); \
    VRD(4); SBAR(); GAPA(C1=__builtin_amdgcn_mfma_f32_32x32x16_bf16(kf[1],qr[0],negm,0,0,0), P0[6],P0[7],P0[8],P0[9],     pw0[2]=PKW(P0,4), pw0[3]=PKW(P0,6), pw0); \
    VRD(1); SBAR(); GAPA(C0=__builtin_amdgcn_mfma_f32_32x32x16_bf16(kf[2],qr[1],C0,0,0,0),   P0[10],P0[11],P0[12],P0[13], pw1[0]=PKW(P0,8), pw1[1]=PKW(P0,10), pw1); \
    VRD(5); SBAR(); GAPA(C1=__builtin_amdgcn_mfma_f32_32x32x16_bf16(kf[3],qr[1],C1,0,0,0),   P0[14],P0[15],P1[0],P1[1],   pw1[2]=PKW(P0,12),pw1[3]=PKW(P0,14), pw1); \
    VRD(2); SBAR(); GAPA(C0=__builtin_amdgcn_mfma_f32_32x32x16_bf16(kf[4],qr[2],C0,0,0,0),   P1[2],P1[3],P1[4],P1[5],     pw2[0]=PKW(P1,0), pw2[1]=PKW(P1,2), pw2); \
    VRD(6); SBAR(); GAPA(C1=__builtin_amdgcn_mfma_f32_32x32x16_bf16(kf[5],qr[2],C1,0,0,0),   P1[6],P1[7],P1[8],P1[9],     pw2[2]=PKW(P1,4), pw2[3]=PKW(P1,6), pw2); \
    VRD(3); SBAR(); GAPA(C0=__builtin_amdgcn_mfma_f32_32x32x16_bf16(kf[6],qr[3],C0,0,0,0),   P1[10],P1[11],P1[12],P1[13], pw3[0]=PKW(P1,8), pw3[1]=PKW(P1,10), pw3); \
    VRD(7); SBAR(); GAPA(C1=__builtin_amdgcn_mfma_f32_32x32x16_bf16(kf[7],qr[3],C1,0,0,0),   P1[14],P1[15],0.f,0.f,       pw3[2]=PKW(P1,12),pw3[3]=PKW(P1,14), pw3); \
    l_reg+=sacc; \
    if(GK){DMA_K((t)+3,sl_cur);} if(GV){DMA_V((t)+1,sl_next);} \
    CMASK(C0,C1,t); \
    SBAR(); \
    GAPB(o[0]=__builtin_amdgcn_mfma_f32_32x32x16_bf16(PAF(0),VFR(0),o[0],0,0,0), C0,0); \
    GAPB(o[1]=__builtin_amdgcn_mfma_f32_32x32x16_bf16(PAF(0),VFR(4),o[1],0,0,0), C0,4); \
    KRD(GL,0); GAPB(o[0]=__builtin_amdgcn_mfma_f32_32x32x16_bf16(PAF(1),VFR(1),o[0],0,0,0), C0,8); \
    KRD(GL,1); GAPB(o[1]=__builtin_amdgcn_mfma_f32_32x32x16_bf16(PAF(1),VFR(5),o[1],0,0,0), C0,12); \
    KRD(GL,2); GAPB(o[0]=__builtin_amdgcn_mfma_f32_32x32x16_bf16(PAF(2),VFR(2),o[0],0,0,0), C1,0); \
    KRD(GL,3); GAPB(o[1]=__builtin_amdgcn_mfma_f32_32x32x16_bf16(PAF(2),VFR(6),o[1],0,0,0), C1,4); \
    GAPB(o[0]=__builtin_amdgcn_mfma_f32_32x32x16_bf16(PAF(3),VFR(3),o[0],0,0,0), C1,8); \
    GAPB(o[1]=__builtin_amdgcn_mfma_f32_32x32x16_bf16(PAF(3),VFR(7),o[1],0,0,0), C1,12); \
    }while(0)
  int t=1;
  for(;t+5<NT;t+=2){
    STEP(pB0,pB1,pA0,pA1,t,true,true,true);     WAIT_BAR(2); RESC(); ROT();
    STEP(pA0,pA1,pB0,pB1,t+1,true,true,true);   WAIT_BAR(2); RESC(); ROT();
  }
  #define ENDW(tt) do{ if((tt)+3<NT){WAIT_BAR(2);} else if((tt)+2<NT){WAIT_BAR(1);} else {WAIT_BAR(0);} }while(0)
  for(;t+1<NT;t+=2){
    STEP(pB0,pB1,pA0,pA1,t,(t+3<NT),(t+1<NT),(t+1<NT));       ENDW(t);   RESC(); ROT();
    STEP(pA0,pA1,pB0,pB1,t+1,(t+4<NT),(t+2<NT),(t+2<NT));     ENDW(t+1); RESC(); ROT();
  }
  STEP(pB0,pB1,pA0,pA1,NT-1,false,false,false); RESC();
  { float sacc=pB0[0]+pB0[1]; _Pragma("unroll") for(int r=2;r<16;++r)sacc+=pB0[r]; _Pragma("unroll") for(int r=0;r<16;++r)sacc+=pB1[r]; l_reg+=sacc;
    pw0=(u32x4){PKW(pB0,0),PKW(pB0,2),PKW(pB0,4),PKW(pB0,6)};pw1=(u32x4){PKW(pB0,8),PKW(pB0,10),PKW(pB0,12),PKW(pB0,14)};pw2=(u32x4){PKW(pB1,0),PKW(pB1,2),PKW(pB1,4),PKW(pB1,6)};pw3=(u32x4){PKW(pB1,8),PKW(pB1,10),PKW(pB1,12),PKW(pB1,14)};
    SBAR(); pv(o,vb0+sl_cur,PAF(0),PAF(1),PAF(2),PAF(3)); }
  #undef PKW
  #undef PAF
  #undef VFR
  #undef PIN
  #undef MX3
  #undef GAPA
  #undef GAPB
  #undef EX
  #undef VRD
  #undef KRD
  #undef STEP
  #undef ENDW
  {auto rr=__builtin_amdgcn_permlane32_swap(__float_as_uint(l_reg),__float_as_uint(l_reg),false,false);l_reg=__uint_as_float(rr[0])+__uint_as_float(rr[1]);}
  if(hi==0)wsf[32+r32]=l_reg;asm volatile("s_waitcnt lgkmcnt(0)":::"memory");
  float rli[16];
  #pragma unroll
  for(int r=0;r<16;++r)rli[r]=__builtin_amdgcn_rcpf(wsf[32+crow(r,hi)]);
  bf16*Ow=O0+(long)(wid*QBLK)*QP;
  { bf16*stg=(bf16*)(shm+LDS_OST)+wid*2048;
    #pragma unroll
    for(int r=0;r<16;++r){const int orow=crow(r,hi);
      #pragma unroll
      for(int d0=0;d0<2;++d0)stg[orow*64+d0*32+r32]=__float2bfloat16(o[d0][r]*rli[r]);}
    asm volatile("s_waitcnt lgkmcnt(0)":::"memory");
    #pragma unroll
    for(int i=0;i<4;++i){const int row=i*8+(lane>>3),ch=lane&7; const u32x4 v=*(const u32x4*)(stg+row*64+ch*8); ATTN_STORE16(Ow+(long)row*QP+ch*8,v);} }
  asm volatile("s_waitcnt lgkmcnt(0)\n\ts_barrier":::"memory");
  #undef DMA_K
  #undef DMA_V
  #undef CMASK
  #undef START
  #undef RESC
  #undef ROT
}
constexpr int ATTN_LDS_BYTES=LDS_BYTES;
#undef SBAR
#undef WAIT_BAR
}
#define GAS __attribute__((address_space(1)))
#define LAS __attribute__((address_space(3)))
typedef unsigned short bf16;
typedef unsigned v4u __attribute__((ext_vector_type(4)));
typedef float f32x4 __attribute__((ext_vector_type(4)));
typedef short bf16x8 __attribute__((ext_vector_type(8)));
typedef GAS unsigned gu32;
typedef GAS unsigned long long gu64;
#define RLX_AGENT __ATOMIC_RELAXED, __HIP_MEMORY_SCOPE_AGENT
#define LDS_WAIT() asm volatile("s_waitcnt lgkmcnt(0)" ::: "memory")
#define VM_WAIT() asm volatile("s_waitcnt vmcnt(0)" ::: "memory")
__device__ __forceinline__ unsigned long long rt() { return __builtin_amdgcn_s_memrealtime(); }
__device__ __forceinline__ unsigned f2bf(float f) { unsigned u = __builtin_bit_cast(unsigned, f); return (u + 0x7fffu + ((u >> 16) & 1u)) >> 16; }
typedef float pk_f32x2_t __attribute__((ext_vector_type(2))); typedef __bf16 pk_bf16x2_t __attribute__((ext_vector_type(2)));
__device__ __forceinline__ unsigned pk2(float lo, float hi) { pk_f32x2_t v = {lo, hi}; pk_bf16x2_t b = __builtin_convertvector(v, pk_bf16x2_t); return __builtin_bit_cast(unsigned, b); }
#define XB_TMO      128
#define XB_XCNT(j)  (256  + 64 * (j))
#define XB_XSUB(j)  (1280 + 64 * (j))
#define XB_XGEN(j)  (2304 + 64 * (j))
#define XB_TOP      3328
#define XB_TOPGEN   3392
#define XCD_BAR_WORDS 3456
#define XB_SPIN_CAP (1u << 18)

__device__ __forceinline__ unsigned xb_ld(unsigned* p)              { return __hip_atomic_load(p, __ATOMIC_RELAXED, __HIP_MEMORY_SCOPE_AGENT); }
__device__ __forceinline__ unsigned xb_add(unsigned* p, unsigned v) { return __hip_atomic_fetch_add(p, v, __ATOMIC_RELAXED, __HIP_MEMORY_SCOPE_AGENT); }
__device__ __forceinline__ unsigned xb_xcc_id() { return (unsigned)__builtin_amdgcn_s_getreg((3 << 11) | 20) & 0xFu; }
#define XB_SPIN(cond, bar) do { unsigned _sp = 0; while (cond) { __builtin_amdgcn_s_sleep(1); \
    if ((++_sp & 255u) == 0u) { if (xb_ld(&(bar)[XB_TMO])) break; if (_sp > XB_SPIN_CAP) { atomicAdd(&(bar)[XB_TMO], 1u); break; } } } } while (0)

struct XcdBarrier {
    unsigned* bar; unsigned x;
    volatile LAS unsigned* st;
};

__device__ __forceinline__ XcdBarrier xcd_barrier_post(unsigned* bar, volatile LAS unsigned* st) {
    XcdBarrier b; b.bar = bar; b.x = xb_xcc_id(); b.st = st;
    if (threadIdx.x == 0) (void)xb_add(&bar[XB_XCNT(b.x)], 1u);
    return b;
}
__device__ __forceinline__ void xcd_barrier_complete(unsigned* bar, unsigned x, unsigned& nloc, unsigned& nx) {
    const unsigned G = gridDim.x * gridDim.y * gridDim.z;
    unsigned sum, cnt, mine, sp = 0u;
    for (;;) {
        sum = 0u; cnt = 0u; mine = 0u;
#pragma unroll
        for (unsigned j = 0; j < 16; ++j) { const unsigned c = xb_ld(&bar[XB_XCNT(j)]); sum += c; cnt += (c > 0u) ? 1u : 0u; mine = (j == x) ? c : mine; }
        if (sum == G) break;
        __builtin_amdgcn_s_sleep(1);
        if ((++sp & 255u) == 0u) { if (xb_ld(&bar[XB_TMO])) break; if (sp > XB_SPIN_CAP) { atomicAdd(&bar[XB_TMO], 1u); break; } }
    }
    nloc = mine > 0u ? mine : 1u; nx = cnt > 0u ? cnt : 1u;
}

__device__ __forceinline__ void xcd_barrier(const XcdBarrier& b) {
    asm volatile("s_waitcnt vmcnt(0)" ::: "memory");
    __syncthreads();
    if (threadIdx.x == 0) {
        unsigned* bar = b.bar;
        __builtin_amdgcn_s_waitcnt(0);
        unsigned nloc = b.st[0], nx = b.st[1];
        if (nloc == 0u) { xcd_barrier_complete(bar, b.x, nloc, nx); b.st[0] = nloc; b.st[1] = nx; }
        const unsigned old = xb_add(&bar[XB_XSUB(b.x)], 1u);
        const unsigned gen = old / nloc;
        if (old + 1u == (gen + 1u) * nloc) {
            __builtin_amdgcn_fence(__ATOMIC_RELEASE, "agent");
            asm volatile("s_waitcnt vmcnt(0)" ::: "memory");
            const unsigned og = xb_add(&bar[XB_TOP], 1u);
            const unsigned tg = og / nx;
            if (og + 1u == (tg + 1u) * nx) xb_add(&bar[XB_TOPGEN], 1u);
            else XB_SPIN(xb_ld(&bar[XB_TOPGEN]) == tg, bar);
            __builtin_amdgcn_fence(__ATOMIC_ACQUIRE, "agent");
            xb_add(&bar[XB_XGEN(b.x)], 1u);
            asm volatile("s_waitcnt vmcnt(0)" ::: "memory");
        } else {
            XB_SPIN(xb_ld(&bar[XB_XGEN(b.x)]) == gen, bar);
            __builtin_amdgcn_fence(__ATOMIC_ACQUIRE, "agent");
            asm volatile("s_waitcnt vmcnt(0)" ::: "memory");
        }
    }
    __syncthreads();
}
constexpr int NB = 4, T = 8192, LC = 256, D = 1024, NLAYER = 2;
constexpr int ML = NB * T, MC = NB * LC, MT = ML + MC;
constexpr int NIN = 2848, NINP = 3072;
constexpr int FF = 2816, EF = 3584, NE = 8;
constexpr int TK = T + LC;
constexpr int NCH = TK / 64;
constexpr float EPS = 1e-6f;
constexpr float QSCALE = 0.125f * 1.4426950408889634f;

constexpr int NWAVES = 8;
constexpr int LDS_BYTES = 147456;
constexpr int RING_BYTES = 131072, LDSCTL_OFF = RING_BYTES, MISC_OFF = LDSCTL_OFF + 320;

constexpr size_t MiB = 1u << 20;
constexpr size_t CTL_ZERO_BYTES = 1 * MiB;
constexpr int CW_BAR = 4096;
constexpr int CW_CNT = 16384;
constexpr int CW_Q = 17408;
constexpr size_t WS_MODS = 1 * MiB;
constexpr size_t WS_ROUTE = 1 * MiB + 512 * 1024;
constexpr size_t WS_RW = WS_ROUTE + (size_t)ML * 16;
constexpr size_t WS_POS = WS_RW + (size_t)ML * 8;
constexpr size_t WS_XC = 3 * MiB;
constexpr size_t WS_ROPE = 7 * MiB;
constexpr size_t WS_WIN = 9 * MiB;
constexpr size_t WS_WOUT = 21 * MiB;
constexpr size_t WS_WGU = 25 * MiB;
constexpr size_t WS_WD = 36 * MiB;
constexpr size_t WS_G = 42 * MiB;
constexpr size_t WS_BETA = WS_G + (size_t)2 * MT * 8 * 4;
constexpr size_t WS_AB = 47 * MiB;
constexpr size_t WS_KALL = 52 * MiB;
constexpr size_t WS_VALL = 61 * MiB;
constexpr size_t WS_DYN = 70 * MiB;
constexpr size_t WS_XN = WS_DYN;
constexpr size_t WS_OF = WS_XN, WS_OB = WS_XN + 33 * MiB;
constexpr size_t WS_DNRAW = WS_XN + 66 * MiB;
constexpr size_t WS_QRAW = WS_DNRAW + 99 * MiB;
constexpr size_t WS_KVRAW = WS_QRAW + 33 * MiB;
constexpr size_t WS_U = WS_DNRAW, WS_W = WS_DNRAW + 66 * MiB;
constexpr size_t WS_ZB = WS_KVRAW + 17 * MiB;
constexpr size_t WS_QDN = WS_ZB + 33 * MiB;
constexpr size_t WS_KDN = WS_QDN + 33 * MiB;
constexpr size_t WS_KT = WS_KDN + 33 * MiB;
constexpr size_t WS_VT = WS_KT + 33 * MiB;
constexpr size_t WS_MIX = WS_VT + 33 * MiB;
constexpr size_t WS_MIX_END = WS_MIX + 66 * MiB;
constexpr size_t WS_GCB = WS_MIX_END + 1 * MiB;
constexpr size_t WS_H = WS_DNRAW;
constexpr size_t WS_XB2 = WS_DYN;
constexpr size_t WS_MGU = WS_DYN + 64 * MiB;
constexpr size_t WS_MD = WS_MGU + 112 * MiB;
constexpr size_t WS_XS = WS_MD + 56 * MiB;
constexpr int SS_PANELS = 64, NSS = 5;
constexpr size_t WS_HM = WS_XS + 132 * MiB;
constexpr size_t WS_END = WS_HM + 112 * MiB;
static_assert(WS_END <= 560 * MiB, "ws map (MoE)");
static_assert(WS_W + 66 * MiB <= WS_ZB && WS_H + (size_t)MT * FF * 2 <= WS_MIX && WS_MIX_END <= 560 * MiB && WS_POS + (size_t)ML * 8 <= WS_XC, "ws map");

typedef unsigned short bf16;
__device__ __forceinline__ float bf2f(unsigned short h) { return __uint_as_float(((unsigned)h) << 16); }
__device__ __forceinline__ float bflo(unsigned w) { return __uint_as_float(w << 16); }
__device__ __forceinline__ float bfhi(unsigned w) { return __uint_as_float(w & 0xffff0000u); }
__device__ __forceinline__ float wave_sum(float v) {
#pragma unroll
    for (int o = 1; o < 64; o <<= 1) v += __shfl_xor(v, o);
    return v;
}
__device__ __forceinline__ float silu_f(float x) { return x * __builtin_amdgcn_rcpf(1.0f + __expf(-x)); }
namespace pg8 {
struct EpiIn {
    static constexpr bool PERM = true, AFTER_DRAIN = false;
    bf16_t* dnraw; bf16_t* zb; bf16_t* qraw; bf16_t* kvraw; float* ab;
    __device__ __forceinline__ void operator()(const f32x4 (&acc)[2][2][4][2], const Unit& u, int wr, int wc, int fr, int fq) const {
        const int row0 = u.pm * BM + wr * 64 + fr; const int pn = u.pn;
        if (pn < 11) {
            bf16_t* base; int ldc, coff;
            if (pn < 6) { base = dnraw; ldc = 1536; coff = pn * 256; } else if (pn < 8) { base = zb; ldc = 512; coff = (pn - 6) * 256; }
            else if (pn < 10) { base = qraw; ldc = 512; coff = (pn - 8) * 256; } else { base = kvraw; ldc = 256; coff = 0; }
            const int col0 = coff + wc * 32 + 8 * fq;
#pragma unroll
            for (int ai = 0; ai < 2; ++ai)
#pragma unroll
                for (int m = 0; m < 4; ++m) { bf16_t* rowp = base + (size_t)(row0 + ai * HALF + m * 16) * ldc + col0;
#pragma unroll
                    for (int bj = 0; bj < 2; ++bj) { const f32x4 v0 = acc[ai][bj][m][0], v1 = acc[ai][bj][m][1];
                        u32x4 w; w.x = cvt_pk_bf16(v0[0], v0[1]); w.y = cvt_pk_bf16(v0[2], v0[3]); w.z = cvt_pk_bf16(v1[0], v1[1]); w.w = cvt_pk_bf16(v1[2], v1[3]);
                        *(u32x4*)(rowp + bj * HALF) = w; } }
        } else if (wc == 0) {
#pragma unroll
            for (int ai = 0; ai < 2; ++ai)
#pragma unroll
                for (int m = 0; m < 4; ++m) { float* rowp = ab + (size_t)(row0 + ai * HALF + m * 16) * 32 + 8 * fq;
                    *(f32x4*)(rowp) = acc[ai][0][m][0]; *(f32x4*)(rowp + 4) = acc[ai][0][m][1]; }
        }
    }
};
template <bool XF32> struct EpiRes {
    static constexpr bool PERM = true, AFTER_DRAIN = false;
    const void* xin_l; bf16_t* out_l; const void* xin_c; bf16_t* out_c; const float* gate; int gstride;
    __device__ __forceinline__ void operator()(const f32x4 (&acc)[2][2][4][2], const Unit& u, int wr, int wc, int fr, int fq) const {
        const int pm = u.pm; const bool isc = pm >= 128; const int bidx = isc ? 4 : (pm >> 5);
        const void* xin = isc ? xin_c : xin_l; bf16_t* out = isc ? out_c : out_l; const int prow = isc ? pm - 128 : pm;
        const int row0 = prow * BM + wr * 64 + fr; const int col0 = u.pn * BM + wc * 32 + 8 * fq; const float* gp = gate + (size_t)bidx * gstride + col0;
        f32x4 gv[2][2];
#pragma unroll
        for (int bj = 0; bj < 2; ++bj)
#pragma unroll
            for (int n = 0; n < 2; ++n) gv[bj][n] = *(const f32x4*)(gp + bj * HALF + 4 * n);
#pragma unroll
        for (int ai = 0; ai < 2; ++ai)
#pragma unroll
            for (int m = 0; m < 4; ++m) { const size_t off = (size_t)(row0 + ai * HALF + m * 16) * 1024 + col0;
#pragma unroll
                for (int bj = 0; bj < 2; ++bj) { f32x4 x0, x1;
                    if (XF32) { x0 = *(const f32x4*)((const float*)xin + off + bj * HALF); x1 = *(const f32x4*)((const float*)xin + off + bj * HALF + 4); }
                    else { const u32x4 w = *(const u32x4*)((const bf16_t*)xin + off + bj * HALF);
                        x0 = (f32x4){__uint_as_float(w.x << 16), __uint_as_float(w.x & 0xffff0000u), __uint_as_float(w.y << 16), __uint_as_float(w.y & 0xffff0000u)};
                        x1 = (f32x4){__uint_as_float(w.z << 16), __uint_as_float(w.z & 0xffff0000u), __uint_as_float(w.w << 16), __uint_as_float(w.w & 0xffff0000u)}; }
                    const f32x4 v0 = x0 + gv[bj][0] * acc[ai][bj][m][0], v1 = x1 + gv[bj][1] * acc[ai][bj][m][1];
                    u32x4 o; o.x = cvt_pk_bf16(v0[0], v0[1]); o.y = cvt_pk_bf16(v0[2], v0[3]); o.z = cvt_pk_bf16(v1[0], v1[1]); o.w = cvt_pk_bf16(v1[2], v1[3]);
                    *(u32x4*)(out + off + bj * HALF) = o; } }
    }
};
struct EpiSwiGLU {
    static constexpr bool PERM = true, AFTER_DRAIN = false;
    bf16_t* H; int ldh; int nloc; int pm0;
    __device__ __forceinline__ void operator()(const f32x4 (&acc)[2][2][4][2], const Unit& u, int wr, int wc, int fr, int fq) const {
        const int row0 = (u.pm - pm0) * BM + wr * 64 + fr; const int col0 = (u.pn % nloc) * 128 + wc * 32 + 8 * fq;
#pragma unroll
        for (int ai = 0; ai < 2; ++ai)
#pragma unroll
            for (int m = 0; m < 4; ++m) { bf16_t* rowp = H + (size_t)(row0 + ai * HALF + m * 16) * ldh + col0;
                float r[8];
#pragma unroll
                for (int n = 0; n < 2; ++n)
#pragma unroll
                    for (int j = 0; j < 4; ++j) { const float g = acc[ai][0][m][n][j], up = acc[ai][1][m][n][j]; r[n * 4 + j] = g * __builtin_amdgcn_rcpf(1.0f + __expf(-g)) * up; }
                u32x4 w; w.x = cvt_pk_bf16(r[0], r[1]); w.y = cvt_pk_bf16(r[2], r[3]); w.z = cvt_pk_bf16(r[4], r[5]); w.w = cvt_pk_bf16(r[6], r[7]);
                *(u32x4*)(rowp) = w; }
    }
};
struct EpiBfPlain {
    static constexpr bool PERM = true, AFTER_DRAIN = false;
    bf16_t* O; int ldc; int nloc;
    __device__ __forceinline__ void operator()(const f32x4 (&acc)[2][2][4][2], const Unit& u, int wr, int wc, int fr, int fq) const {
        const int row0 = u.pm * BM + wr * 64 + fr; const int col0 = (u.pn % nloc) * BM + wc * 32 + 8 * fq;
#pragma unroll
        for (int ai = 0; ai < 2; ++ai)
#pragma unroll
            for (int m = 0; m < 4; ++m) { bf16_t* rowp = O + (size_t)(row0 + ai * HALF + m * 16) * ldc + col0;
#pragma unroll
                for (int bj = 0; bj < 2; ++bj) { const f32x4 v0 = acc[ai][bj][m][0], v1 = acc[ai][bj][m][1];
                    u32x4 w; w.x = cvt_pk_bf16(v0[0], v0[1]); w.y = cvt_pk_bf16(v0[2], v0[3]); w.z = cvt_pk_bf16(v1[0], v1[1]); w.w = cvt_pk_bf16(v1[2], v1[3]);
                    *(u32x4*)(rowp + bj * HALF) = w; } }
    }
};
struct MoeOrder {
    int ps[9]; int p0, p1, nloc, G, c; int a_off;
    __device__ __forceinline__ bool next(int i, Unit& u) const {
        const int L = i * G + c; const int np = p1 - p0; if (L >= np * nloc) return false;
        const int p = p0 + L / nloc, pl = L % nloc; int e = 0;
#pragma unroll
        for (int k = 1; k < 8; ++k) e += (p >= ps[k]) ? 1 : 0;
        u.pm = p + a_off; u.pn = e * nloc + pl; return true;
    }
    __device__ __forceinline__ void a_ready(const Unit&) const {}
    __device__ __forceinline__ void done(const Unit&) const {}
};
}
struct Ctx {
    LAS unsigned char* lds; gu32* ctl; int tid, lane, wave, G, gw, NGW;
    const float* const __attribute__((address_space(4)))* in; float* out; unsigned char* ws;
};
#define WSP(T, off) ((T*)(C.ws + (off)))

template <class MapF>
__device__ __forceinline__ void transpose_item(const float* W, int K, int N, bf16* WT, MapF map, LAS float* scr, int item, int lane) {
    const int nblk = N / 32, kb = item / nblk, nb = item % nblk, k0 = 64 * kb, n0 = 32 * nb;
#pragma unroll 8
    for (int i = 0; i < 32; ++i) { const int kk = 2 * i + (lane >> 5); scr[kk * 33 + (lane & 31)] = W[(size_t)(k0 + kk) * N + n0 + (lane & 31)]; }
    LDS_WAIT(); asm volatile("" ::: "memory");
    const int c = lane & 7; const int r0 = map(n0);
#pragma unroll
    for (int j = 0; j < 4; ++j) { const int n = (lane >> 3) + 8 * j; const LAS float* s = scr + (8 * c) * 33 + n;
        v4u o; o.x = pk2(s[0 * 33], s[1 * 33]); o.y = pk2(s[2 * 33], s[3 * 33]); o.z = pk2(s[4 * 33], s[5 * 33]); o.w = pk2(s[6 * 33], s[7 * 33]);
        *(GAS v4u*)(WT + (size_t)(r0 + n) * K + k0 + 8 * c) = o; }
    LDS_WAIT(); asm volatile("" ::: "memory");
}
struct MapId { __device__ __forceinline__ int operator()(int n0) const { return n0; } };
struct MapWin { __device__ __forceinline__ int operator()(int n0) const { return n0 < 2048 ? n0 : (n0 < 2080 ? n0 + 768 : n0 - 32); } };
struct MapGU { int up; __device__ __forceinline__ int operator()(int n0) const { return (n0 >> 7) * 256 + (n0 & 127) + up * 128; } };

__device__ __forceinline__ void p0_weights(Ctx& C) {
    LAS float* scr = (LAS float*)(C.lds + C.wave * 16384);
    constexpr int I_IN = (D / 64) * (NIN / 32), I_OUT = (D / 64) * (D / 32), I_G = (D / 64) * (FF / 32), I_D = (FF / 64) * (D / 32);
    constexpr int NITEMS = 2 * I_IN + 2 * I_OUT + 2 * I_G + I_D;
    for (int it = C.gw; it < NITEMS; it += C.NGW) {
        int r = it;
        if (r < 2 * I_IN) { const int l = r / I_IN; transpose_item(C.in[8] + (size_t)l * D * NIN, D, NIN, WSP(bf16, WS_WIN) + (size_t)l * NINP * D, MapWin(), scr, r % I_IN, C.lane); continue; } r -= 2 * I_IN;
        if (r < 2 * I_OUT) { const int l = r / I_OUT; transpose_item(C.in[15] + (size_t)l * D * D, D, D, WSP(bf16, WS_WOUT) + (size_t)l * D * D, MapId(), scr, r % I_OUT, C.lane); continue; } r -= 2 * I_OUT;
        if (r < I_G) { transpose_item(C.in[16], D, FF, WSP(bf16, WS_WGU), MapGU{0}, scr, r, C.lane); continue; } r -= I_G;
        if (r < I_G) { transpose_item(C.in[17], D, FF, WSP(bf16, WS_WGU), MapGU{1}, scr, r, C.lane); continue; } r -= I_G;
        transpose_item(C.in[18], FF, D, WSP(bf16, WS_WD), MapId(), scr, r, C.lane);
    }
    for (int i = C.gw * 64 + C.lane; i < 2 * 28672; i += C.NGW * 64) { const int l = i / 28672, j = i % 28672;
        *(GAS v4u*)(WSP(bf16, WS_WIN) + (size_t)l * NINP * D + (size_t)NIN * D + (size_t)j * 8) = (v4u){0u, 0u, 0u, 0u}; }
    for (int i = C.gw * 64 + C.lane; i < T * 32; i += C.NGW * 64) { const int t = i >> 5, a = i & 31;
        const float pos = (float)((a < 16) ? (t >> 6) : (t & 63)); const float fr = powf(10000.0f, -(float)(a & 15) / 16.0f);
        float sn, cs; sincosf(pos * fr, &sn, &cs);
        WSP(float, WS_ROPE)[i] = cs; WSP(float, WS_ROPE)[T * 32 + i] = sn; }
}
__device__ __forceinline__ void p0_mods(Ctx& C) {
    LAS float* sc = (LAS float*)C.lds;
    LAS float* part = (LAS float*)(C.lds + 32768);
    const int nblk = 2 * 6144 / 64;
    bool staged = false;
    for (int cb = blockIdx.x; cb < nblk; cb += C.G) {
        if (!staged) { for (int i = C.tid; i < 5 * 1024; i += 512) { const float v = (i < 4096) ? C.in[1][i] : C.in[3][i - 4096]; sc[i] = silu_f(v); } staged = true; }
        __syncthreads();
        const int l = cb / 96, j = (cb % 96) * 64 + C.lane;
        const float* wm = C.in[4] + (size_t)l * D * 6144 + j;
        float a0 = 0.f, a1 = 0.f, a2 = 0.f, a3 = 0.f, a4 = 0.f;
        const int kb = C.wave * 128;
#pragma unroll 8
        for (int k = 0; k < 128; ++k) { const float w = wm[(size_t)(kb + k) * 6144];
            a0 += sc[kb + k] * w; a1 += sc[1024 + kb + k] * w; a2 += sc[2048 + kb + k] * w; a3 += sc[3072 + kb + k] * w; a4 += sc[4096 + kb + k] * w; }
        part[(C.wave * 5 + 0) * 64 + C.lane] = a0; part[(C.wave * 5 + 1) * 64 + C.lane] = a1; part[(C.wave * 5 + 2) * 64 + C.lane] = a2;
        part[(C.wave * 5 + 3) * 64 + C.lane] = a3; part[(C.wave * 5 + 4) * 64 + C.lane] = a4;
        __syncthreads();
        if (C.tid < 320) { const int i = C.tid / 64, ln = C.tid % 64; const int jj = (cb % 96) * 64 + ln;
            float s = 0.f;
#pragma unroll
            for (int w = 0; w < 8; ++w) s += part[(w * 5 + i) * 64 + ln];
            s += C.in[5][l * 6144 + jj];
            const int chunk = jj >> 10, col = jj & 1023;
            if (chunk == 1) s = C.in[6][l * 1024 + col] * (1.0f + s);
            if (chunk == 4) s = C.in[7][l * 1024 + col] * (1.0f + s);
            WSP(float, WS_MODS)[((size_t)(l * 5 + i) * 6 + chunk) * 1024 + col] = s; }
        __syncthreads();
    }
}
__device__ __forceinline__ const float* mods_ptr(Ctx& C, int l, int i, int chunk) { return WSP(float, WS_MODS) + ((size_t)(l * 5 + i) * 6 + chunk) * 1024; }

typedef unsigned u32x2n __attribute__((ext_vector_type(2)));
template <bool ROUTE, bool XBF  >
__device__ __forceinline__ void norm_mod(Ctx& C, const void* xl, const void* xc, int nrows, int l, int chA, int chS, bf16* dst) {
    float rw[ROUTE ? 16 : 1][8];
    if (ROUTE) {
#pragma unroll
        for (int j = 0; j < 4; ++j)
#pragma unroll
            for (int q = 0; q < 4; ++q) { const f32x4 a = *(const f32x4*)(C.in[19] + (size_t)(4 * C.lane + 256 * j + q) * 8), b = *(const f32x4*)(C.in[19] + (size_t)(4 * C.lane + 256 * j + q) * 8 + 4);
                rw[j * 4 + q][0] = a.x; rw[j * 4 + q][1] = a.y; rw[j * 4 + q][2] = a.z; rw[j * 4 + q][3] = a.w; rw[j * 4 + q][4] = b.x; rw[j * 4 + q][5] = b.y; rw[j * 4 + q][6] = b.z; rw[j * 4 + q][7] = b.w; }
    }
    for (int m = C.gw; m < nrows; m += C.NGW) {
        const bool isc = m >= ML; const int bidx = isc ? 4 : (m >> 13);
        const size_t xoff = isc ? (size_t)(m - ML) * D : (size_t)m * D; const void* xbase = isc ? xc : xl;
        const GAS f32x4* Ap = (const GAS f32x4*)mods_ptr(C, l, bidx, chA) + C.lane; const GAS f32x4* Sp = (const GAS f32x4*)mods_ptr(C, l, bidx, chS) + C.lane;
        f32x4 v[4]; float s2 = 0.f;
#pragma unroll
        for (int j = 0; j < 4; ++j) {
            if (XBF) { const u32x2n w = *(const GAS u32x2n*)((const bf16*)xbase + xoff + 4 * C.lane + 256 * j); v[j] = (f32x4){bflo(w.x), bfhi(w.x), bflo(w.y), bfhi(w.y)}; }
            else v[j] = ((const GAS f32x4*)((const float*)xbase + xoff) + C.lane)[64 * j];
            s2 += (v[j].x * v[j].x + v[j].y * v[j].y) + (v[j].z * v[j].z + v[j].w * v[j].w); }
        const float rstd = 1.0f / sqrtf(wave_sum(s2) * (1.f / D) + EPS);
#pragma unroll
        for (int j = 0; j < 4; ++j) v[j] = v[j] * rstd * Ap[64 * j] + Sp[64 * j];
        GAS unsigned long long* o8 = (GAS unsigned long long*)(dst + (size_t)m * D) + C.lane;
#pragma unroll
        for (int j = 0; j < 4; ++j) o8[64 * j] = (unsigned long long)pk2(v[j].x, v[j].y) | ((unsigned long long)pk2(v[j].z, v[j].w) << 32);
        if (ROUTE) {
            float lg[8];
#pragma unroll
            for (int e = 0; e < 8; ++e) { float s = 0.f;
#pragma unroll
                for (int j = 0; j < 4; ++j) s += (v[j].x * rw[j * 4 + 0][e] + v[j].y * rw[j * 4 + 1][e]) + (v[j].z * rw[j * 4 + 2][e] + v[j].w * rw[j * 4 + 3][e]);
                lg[e] = wave_sum(s) + C.in[20][e]; }
            if (C.lane == 0) {
                int e0 = 0; float v0 = lg[0];
#pragma unroll
                for (int e = 1; e < 8; ++e) if (lg[e] > v0) { v0 = lg[e]; e0 = e; }
                int e1 = -1; float v1 = -INFINITY;
#pragma unroll
                for (int e = 0; e < 8; ++e) if (e != e0 && lg[e] > v1) { v1 = lg[e]; e1 = e; }
                const float w0 = 1.0f / (1.0f + expf(v1 - v0)), w1 = 1.0f - w0;
                const int s0 = (int)__hip_atomic_fetch_add(C.ctl + CW_CNT + 64 * e0, 1u, RLX_AGENT), s1 = (int)__hip_atomic_fetch_add(C.ctl + CW_CNT + 64 * e1, 1u, RLX_AGENT);
                WSP(int, WS_ROUTE)[m * 4 + 0] = e0; WSP(int, WS_ROUTE)[m * 4 + 1] = s0; WSP(int, WS_ROUTE)[m * 4 + 2] = e1; WSP(int, WS_ROUTE)[m * 4 + 3] = s1;
                WSP(float, WS_RW)[m * 2 + 0] = w0; WSP(float, WS_RW)[m * 2 + 1] = w1;
            }
        }
    }
}
__device__ __forceinline__ void load8(const bf16* p, float (&f)[8]) { const v4u w = *(const GAS v4u*)p; f[0] = bflo(w.x); f[1] = bfhi(w.x); f[2] = bflo(w.y); f[3] = bfhi(w.y); f[4] = bflo(w.z); f[5] = bfhi(w.z); f[6] = bflo(w.w); f[7] = bfhi(w.w); }
__device__ __forceinline__ void store8(bf16* p, const float (&f)[8]) { v4u w; w.x = pk2(f[0], f[1]); w.y = pk2(f[2], f[3]); w.z = pk2(f[4], f[5]); w.w = pk2(f[6], f[7]); *(GAS v4u*)p = w; }
__device__ __forceinline__ float sum8(float v) { v += __shfl_xor(v, 1); v += __shfl_xor(v, 2); v += __shfl_xor(v, 4); return v; }

__device__ __forceinline__ void p3_prep(Ctx& C, int l) {
    const int lane = C.lane;
    const bf16* qraw = WSP(bf16, WS_QRAW); const bf16* kvraw = WSP(bf16, WS_KVRAW); const float* ab = WSP(float, WS_AB);
    bf16* mix = WSP(bf16, WS_MIX); bf16* kall = WSP(bf16, WS_KALL); bf16* vall = WSP(bf16, WS_VALL);
    const float* ropec = WSP(float, WS_ROPE); const float* ropes = ropec + T * 32;
    const int jj = (lane & 7) * 8;
    float qw[8], kw[8];
#pragma unroll
    for (int i = 0; i < 8; ++i) { qw[i] = C.in[13][l * 64 + jj + i]; kw[i] = C.in[14][l * 64 + jj + i]; }
    const int gd = (lane >> 3) & 1, gh = lane & 7;
    const float neg_a = -expf(C.in[10][l * 16 + gd * 8 + gh]), dtb = C.in[11][l * 16 + gd * 8 + gh];
    for (int m = C.gw; m < MT; m += C.NGW) {
        const bool isc = m >= ML; const int b = isc ? (m - ML) >> 8 : m >> 13; const int t = isc ? (m - ML) & 255 : m & 8191;
        {
            float f[8]; load8(qraw + (size_t)m * 512 + lane * 8, f);
            float ss = 0.f;
#pragma unroll
            for (int i = 0; i < 8; ++i) ss += f[i] * f[i];
            const float r = 1.0f / sqrtf(sum8(ss) * (1.f / 64.f) + EPS);
#pragma unroll
            for (int i = 0; i < 8; ++i) f[i] = f[i] * r * qw[i];
            if (!isc) {
                float o[8];
#pragma unroll
                for (int i = 0; i < 8; ++i) o[i] = __shfl_xor(f[i], 4);
                const int a0 = jj & 31; const bool first = jj < 32;
#pragma unroll
                for (int i = 0; i < 8; ++i) { const float cs = ropec[t * 32 + a0 + i], sn = ropes[t * 32 + a0 + i]; f[i] = first ? (f[i] * cs - o[i] * sn) : (f[i] * cs + o[i] * sn); }
            }
#pragma unroll
            for (int i = 0; i < 8; ++i) f[i] *= QSCALE;
            store8(mix + (size_t)m * 1024 + 512 + lane * 8, f);
        }
        {
            const size_t krow = (size_t)b * TK + (isc ? T + t : t);
            if (lane < 32) {
                float f[8]; load8(kvraw + (size_t)m * 256 + lane * 8, f);
                if (lane < 16) {
                    float ss = 0.f;
#pragma unroll
                    for (int i = 0; i < 8; ++i) ss += f[i] * f[i];
                    const float r = 1.0f / sqrtf(sum8(ss) * (1.f / 64.f) + EPS);
#pragma unroll
                    for (int i = 0; i < 8; ++i) f[i] = f[i] * r * kw[i];
                    float o[8];
#pragma unroll
                    for (int i = 0; i < 8; ++i) o[i] = __shfl_xor(f[i], 4);
                    if (!isc) { const int a0 = jj & 31; const bool first = jj < 32;
#pragma unroll
                        for (int i = 0; i < 8; ++i) { const float cs = ropec[t * 32 + a0 + i], sn = ropes[t * 32 + a0 + i]; f[i] = first ? (f[i] * cs - o[i] * sn) : (f[i] * cs + o[i] * sn); } }
                    store8(kall + krow * 128 + lane * 8, f);
                } else {
                    store8(vall + krow * 128 + (lane - 16) * 8, f);
                }
            }
        }
        if (lane < 16) {
            const float a = ab[(size_t)m * 32 + lane], bb = ab[(size_t)m * 32 + 16 + lane];
            const float xx = a + dtb; const float sp = xx > 20.f ? xx : log1pf(expf(xx));
            WSP(float, WS_G)[((size_t)gd * MT + m) * 8 + gh] = neg_a * sp;
            WSP(float, WS_BETA)[((size_t)gd * MT + m) * 8 + gh] = 1.0f / (1.0f + expf(-bb));
        }
    }
}

__device__ __forceinline__ float silu_fast(float x) { return x * __builtin_amdgcn_rcpf(1.0f + __expf(-x)); }
__device__ __forceinline__ void p3b_dnconv(Ctx& C, int l) {
    const bf16* dnraw = WSP(bf16, WS_DNRAW); bf16* qdn = WSP(bf16, WS_QDN); bf16* kdn = WSP(bf16, WS_KDN); bf16* kt = WSP(bf16, WS_KT); bf16* vt = WSP(bf16, WS_VT);
    const float* cwl = C.in[9] + (size_t)l * 5 * 1536;
    LAS unsigned char* wl = C.lds + C.wave * 16384;
    if (C.gw < 85 * 24) {
        const int hs = C.gw % 24, sg = hs >> 3, h = hs & 7; const int ch0 = sg * 512 + h * 64;
        float wv[5];
#pragma unroll
        for (int tp = 0; tp < 5; ++tp) wv[tp] = cwl[tp * 1536 + ch0 + C.lane];
        const int lr = C.lane >> 3, lc = C.lane & 7;
        v4u stg[9];
#define DNC_REQ(ckk) do { const int t0_ = ((ckk) < 512) ? (((ckk) & 127) * 64) : ((((ckk) - 512) & 3) * 64); const int tlen_ = ((ckk) < 512) ? T : LC; \
            _Pragma("unroll") for (int i = 0; i < 9; ++i) { const int r_ = i * 8 + lr; const int tt_ = t0_ - 2 + r_; const bool ok_ = r_ < 68 && tt_ >= 0 && tt_ < tlen_; \
                stg[i] = ok_ ? *(const GAS v4u*)(dnraw + ((size_t)(ckk) * 64 - 2 + r_) * 1536 + ch0 + lc * 8) : (v4u){0u, 0u, 0u, 0u}; } } while (0)
        int ck = C.gw / 24;
        if (ck < 528) DNC_REQ(ck);
        for (; ck < 528; ck += 85) {
            asm volatile("s_waitcnt lgkmcnt(0)" ::: "memory");
#pragma unroll
            for (int i = 0; i < 9; ++i) { const int r = i * 8 + lr; if (r < 68) *(LAS v4u*)(wl + r * 144 + lc * 16) = stg[i]; }
            asm volatile("s_waitcnt lgkmcnt(0)" ::: "memory");
            if (ck + 85 < 528) DNC_REQ(ck + 85);
            const int m = ck * 64 + C.lane;
            float y[64];
#pragma unroll
            for (int i = 0; i < 64; ++i) y[i] = 0.f;
#pragma unroll
            for (int tp = 0; tp < 5; ++tp) {
#pragma unroll
                for (int cg = 0; cg < 8; ++cg) { const v4u w = *(const LAS v4u*)(wl + (C.lane + tp) * 144 + cg * 16);
                    const float f[8] = {bflo(w.x), bfhi(w.x), bflo(w.y), bfhi(w.y), bflo(w.z), bfhi(w.z), bflo(w.w), bfhi(w.w)};
#pragma unroll
                    for (int i = 0; i < 8; ++i) y[cg * 8 + i] += f[i] * __builtin_bit_cast(float, __builtin_amdgcn_readlane(__builtin_bit_cast(int, wv[tp]), cg * 8 + i)); } }
            float ss = 0.f;
#pragma unroll
            for (int i = 0; i < 64; ++i) { y[i] = silu_fast(y[i]); ss += y[i] * y[i]; }
            if (sg < 2) { const float r = (1.0f / sqrtf(ss + EPS)) * (sg == 0 ? 0.125f : 1.0f);
#pragma unroll
                for (int i = 0; i < 64; ++i) y[i] *= r; }
            if (sg < 2) { bf16* dst = (sg == 0 ? qdn : kdn) + (size_t)m * 512 + h * 64;
#pragma unroll
                for (int cg = 0; cg < 8; ++cg) { float f[8];
#pragma unroll
                    for (int i = 0; i < 8; ++i) f[i] = y[cg * 8 + i];
                    store8(dst + cg * 8, f); } }
            if (sg >= 1) { bf16* dst = (sg == 1 ? kt : vt) + ((size_t)ck * 8 + h) * 4096 + C.lane;
#pragma unroll
                for (int i = 0; i < 64; i += 2) { const unsigned w = pk2(y[i], y[i + 1]); dst[i * 64] = (bf16)(w & 0xffffu); dst[(i + 1) * 64] = (bf16)(w >> 16); } }
        }
#undef DNC_REQ
    }
    asm volatile("s_waitcnt lgkmcnt(0)" ::: "memory");
}

__device__ __forceinline__ int chunk_ck(int b, int cc) { return cc < 4 ? 512 + b * 4 + cc : b * 128 + (cc - 4); }
__device__ __forceinline__ int chunk_row(int b, int cc, int dir, int i) { const int ii = dir ? 63 - i : i; return cc < 4 ? ML + b * LC + cc * 64 + ii : b * T + (cc - 4) * 64 + ii; }
struct MapGUE { int off; __device__ __forceinline__ int operator()(int n0) const { return off + (n0 >> 7) * 256 + (n0 & 127); } };
__device__ __forceinline__ void moe_weights(Ctx& C) {
    LAS float* scr = (LAS float*)(C.lds + C.wave * 16384);
    constexpr int I_G = (D / 64) * (EF / 32), I_D = (EF / 64) * (D / 32);
    constexpr int NITEMS = NE * (2 * I_G + I_D);
    for (int it = C.gw; it < NITEMS; it += C.NGW) {
        const int e = it / (2 * I_G + I_D); int r = it % (2 * I_G + I_D);
        if (r < I_G) { transpose_item(C.in[21] + (size_t)e * D * EF, D, EF, WSP(bf16, WS_MGU), MapGUE{e * 7168}, scr, r, C.lane); continue; } r -= I_G;
        if (r < I_G) { transpose_item(C.in[22] + (size_t)e * D * EF, D, EF, WSP(bf16, WS_MGU), MapGUE{e * 7168 + 128}, scr, r, C.lane); continue; } r -= I_G;
        transpose_item(C.in[23] + (size_t)e * EF * D, EF, D, WSP(bf16, WS_MD) + (size_t)e * D * EF, MapId(), scr, r, C.lane);
    }
}
__device__ __forceinline__ void moe_panel_starts(Ctx& C, int (&ps)[9], int (&cnt)[8]) {
    int acc = 0;
#pragma unroll
    for (int e = 0; e < 8; ++e) { cnt[e] = (int)__hip_atomic_load(C.ctl + CW_CNT + 64 * e, RLX_AGENT); ps[e] = acc; acc += (cnt[e] + 255) >> 8; }
    ps[8] = acc;
}
__device__ __forceinline__ void moe_scatter(Ctx& C, const bf16* xn2) {
    int ps[9], cnt[8]; moe_panel_starts(C, ps, cnt);
    bf16* xs = WSP(bf16, WS_XS); const int* route = WSP(int, WS_ROUTE); int* pos = WSP(int, WS_POS);
    for (int m = C.gw; m < ML; m += C.NGW) {
        const int e0 = route[m * 4 + 0], s0 = route[m * 4 + 1], e1 = route[m * 4 + 2], s1 = route[m * 4 + 3];
        int p0 = 0, p1 = 0;
#pragma unroll
        for (int e = 0; e < 8; ++e) { p0 = (e == e0) ? ps[e] : p0; p1 = (e == e1) ? ps[e] : p1; }
        const int r0 = p0 * 256 + s0, r1 = p1 * 256 + s1;
        const GAS v4u* src = (const GAS v4u*)(xn2 + (size_t)m * D) + C.lane; GAS v4u* d0 = (GAS v4u*)(xs + (size_t)r0 * D) + C.lane; GAS v4u* d1 = (GAS v4u*)(xs + (size_t)r1 * D) + C.lane;
        const v4u a = src[0], b = src[64]; d0[0] = a; d0[64] = b; d1[0] = a; d1[64] = b;

        if (C.lane == 0) { pos[m * 2 + 0] = r0; pos[m * 2 + 1] = r1; }
    }
#pragma unroll
    for (int e = 0; e < 8; ++e) { const int nb = ps[e + 1] * 256 - (ps[e] * 256 + cnt[e]); const int rb = ps[e] * 256 + cnt[e];
        for (int r = C.gw; r < nb; r += C.NGW) { GAS v4u* d = (GAS v4u*)(xs + (size_t)(rb + r) * D) + C.lane; d[0] = (v4u){0u, 0u, 0u, 0u}; d[64] = (v4u){0u, 0u, 0u, 0u}; } }
}
__device__ __forceinline__ void moe_final(Ctx& C, int l) {
    const bf16* ys = WSP(bf16, WS_XS); const int* route = WSP(int, WS_POS); const float* rwt = WSP(float, WS_RW);
    for (int m = C.gw; m < ML; m += C.NGW) {
        const int r0 = route[m * 2 + 0], r1 = route[m * 2 + 1]; const float w0 = rwt[m * 2], w1 = rwt[m * 2 + 1];
        const int bidx = m >> 13; const float* g2 = mods_ptr(C, l, bidx, 5);
        float x[16]; float ss = 0.f;
#pragma unroll
        for (int j = 0; j < 2; ++j) { const int c0 = j * 512 + C.lane * 8; float a[8], bb[8]; load8(ys + (size_t)r0 * D + c0, a); load8(ys + (size_t)r1 * D + c0, bb);
            float xv[8]; load8(WSP(bf16, WS_XB2) + (size_t)m * D + c0, xv);
            const f32x4 ga = *(const GAS f32x4*)(g2 + c0), gb = *(const GAS f32x4*)(g2 + c0 + 4);
            const float gv[8] = {ga.x, ga.y, ga.z, ga.w, gb.x, gb.y, gb.z, gb.w};
#pragma unroll
            for (int i = 0; i < 8; ++i) { const float v = xv[i] + gv[i] * (w0 * a[i] + w1 * bb[i]); x[j * 8 + i] = v; ss += v * v; } }
        const float rstd = 1.0f / sqrtf(wave_sum(ss) * (1.f / D) + EPS);
#pragma unroll
        for (int j = 0; j < 2; ++j) { const int c0 = j * 512 + C.lane * 8;
            const f32x4 fa = *(const GAS f32x4*)(C.in[24] + c0), fb = *(const GAS f32x4*)(C.in[24] + c0 + 4);
            f32x4 oa = {x[j * 8 + 0] * rstd * fa.x, x[j * 8 + 1] * rstd * fa.y, x[j * 8 + 2] * rstd * fa.z, x[j * 8 + 3] * rstd * fa.w};
            f32x4 ob = {x[j * 8 + 4] * rstd * fb.x, x[j * 8 + 5] * rstd * fb.y, x[j * 8 + 6] * rstd * fb.z, x[j * 8 + 7] * rstd * fb.w};
            *(GAS f32x4*)(C.out + (size_t)m * D + c0) = oa; *(GAS f32x4*)(C.out + (size_t)m * D + c0 + 4) = ob; }
    }
}
typedef float f32x4_t __attribute__((ext_vector_type(4)));
__device__ __forceinline__ int pi_idx(int t, int m) { return 32 * (t >> 1) + 8 * (m >> 2) + 4 * (t & 1) + (m & 3); }
constexpr size_t DN_UNITS = (size_t)NB * 8 * 2 * NCH;
__device__ __forceinline__ int wq_next(gu32* head, int lane) { unsigned v = 0; if (lane == 0) v = __hip_atomic_fetch_add(head, 1u, RLX_AGENT); return (int)__builtin_amdgcn_readfirstlane(v); }
__device__ __forceinline__ void p5_dn1_fast(Ctx& C, int l) {
    const int lane = C.lane, l15 = lane & 15, g = lane >> 4;
    LAS unsigned char* wl = C.lds + C.wave * 16384;
    LAS float* Aimg = (LAS float*)wl;
    const bf16* kdn = WSP(bf16, WS_KDN); const bf16* kt = WSP(bf16, WS_KT); const bf16* vt = WSP(bf16, WS_VT);
    const float* G = WSP(float, WS_G); const float* BT = WSP(float, WS_BETA);
    uint2* FU = WSP(uint2, WS_U); v4u* FW = WSP(v4u, WS_W);
    gu32* qh = C.ctl + CW_Q + 64 * (2 * l);
    for (int u = wq_next(qh, lane); u < (int)DN_UNITS; u = wq_next(qh, lane)) {
        const int cc = u % NCH, dir = (u / NCH) & 1, h = (u / (2 * NCH)) & 7, b = u / (16 * NCH);
        const int ck = chunk_ck(b, cc); const size_t m0 = (size_t)ck * 64;
        float gr = G[((size_t)dir * MT + m0 + lane) * 8 + h]; const float be = BT[((size_t)dir * MT + m0 + lane) * 8 + h];
        if (dir) gr = __shfl(gr, 63 - lane);
#pragma unroll
        for (int o = 1; o < 64; o <<= 1) { const float n = __shfl_up(gr, o); if (lane >= o) gr += n; }
        if (dir) gr = __shfl(gr, 63 - lane);
        const float gcv = gr;
        { float* gcb = WSP(float, WS_GCB) + (size_t)u * 192; gcb[lane] = gcv; gcb[64 + lane] = __shfl(gcv, pi_idx((lane >> 2) & 3, 4 * (lane >> 4) + (lane & 3))); const float gl_ = __shfl(gcv, dir ? 0 : 63); if (lane == 0) gcb[128] = gl_;
          ((bf16*)(gcb + 132))[lane] = (bf16)(pk2(__expf(gl_ - __shfl(gcv, pi_idx((lane >> 2) & 3, 4 * (lane >> 4) + (lane & 3)))), 0.f) & 0xffffu); }
        bf16x8 kf[4][2];
#pragma unroll
        for (int t = 0; t < 4; ++t)
#pragma unroll
            for (int s = 0; s < 2; ++s) kf[t][s] = *(const bf16x8*)(kdn + (m0 + 16 * t + l15) * 512 + h * 64 + 32 * s + 8 * g);
        float gcol[4];
#pragma unroll
        for (int tj = 0; tj < 4; ++tj) gcol[tj] = __shfl(gcv, 16 * tj + l15);
#pragma unroll
        for (int ti = 0; ti < 4; ++ti) {
            float grow[4], brow[4];
#pragma unroll
            for (int r = 0; r < 4; ++r) { grow[r] = __shfl(gcv, 16 * ti + 4 * g + r); brow[r] = __shfl(be, 16 * ti + 4 * g + r); }
#pragma unroll
            for (int tj = 0; tj < 4; ++tj) {
                f32x4_t acc = {0.f, 0.f, 0.f, 0.f};
                acc = __builtin_amdgcn_mfma_f32_16x16x32_bf16(kf[ti][0], kf[tj][0], acc, 0, 0, 0);
                acc = __builtin_amdgcn_mfma_f32_16x16x32_bf16(kf[ti][1], kf[tj][1], acc, 0, 0, 0);
#pragma unroll
                for (int r = 0; r < 4; ++r) { const int si = 16 * ti + 4 * g + r, sj = 16 * tj + l15; const int ci = dir ? 63 - si : si, cj = dir ? 63 - sj : sj;
                    if (ci > cj) Aimg[cj * 64 + ci] = brow[r] * acc[r] * __expf(grow[r] - gcol[tj]); }
            }
        }
        asm volatile("s_waitcnt lgkmcnt(0)" ::: "memory");
        float tcol[64];
#pragma unroll
        for (int i = 0; i < 64; ++i) tcol[i] = (i == lane) ? 1.f : 0.f;
#pragma unroll
        for (int jb = 0; jb < 16; ++jb) {
            f32x4_t d[4];
#pragma unroll
            for (int c = 0; c < 4; ++c) d[c] = *(const LAS f32x4_t*)(Aimg + (4 * jb + c) * 64 + 4 * jb);
            const float t0 = tcol[4 * jb];
            const float t1 = tcol[4 * jb + 1] - d[0][1] * t0;
            const float t2 = tcol[4 * jb + 2] - d[0][2] * t0 - d[1][2] * t1;
            const float t3 = tcol[4 * jb + 3] - d[0][3] * t0 - d[1][3] * t1 - d[2][3] * t2;
            tcol[4 * jb + 1] = t1; tcol[4 * jb + 2] = t2; tcol[4 * jb + 3] = t3;
#pragma unroll
            for (int i4 = jb + 1; i4 < 16; ++i4) {
                const f32x4_t a0 = *(const LAS f32x4_t*)(Aimg + (4 * jb + 0) * 64 + 4 * i4), a1 = *(const LAS f32x4_t*)(Aimg + (4 * jb + 1) * 64 + 4 * i4);
                const f32x4_t a2 = *(const LAS f32x4_t*)(Aimg + (4 * jb + 2) * 64 + 4 * i4), a3 = *(const LAS f32x4_t*)(Aimg + (4 * jb + 3) * 64 + 4 * i4);
#pragma unroll
                for (int k = 0; k < 4; ++k) { float x = tcol[4 * i4 + k];
                    asm("v_fma_f32 %0, -%1, %2, %0" : "+v"(x) : "v"(a0[k]), "v"(t0)); asm("v_fma_f32 %0, -%1, %2, %0" : "+v"(x) : "v"(a1[k]), "v"(t1));
                    asm("v_fma_f32 %0, -%1, %2, %0" : "+v"(x) : "v"(a2[k]), "v"(t2)); asm("v_fma_f32 %0, -%1, %2, %0" : "+v"(x) : "v"(a3[k]), "v"(t3)); tcol[4 * i4 + k] = x; }
                if (((i4 - jb) & 3) == 0) __builtin_amdgcn_sched_barrier(0); }
            __builtin_amdgcn_sched_barrier(0); }
        asm volatile("s_waitcnt lgkmcnt(0)" ::: "memory");
        {   const int kap = dir ? 63 - lane : lane; const float bk = __shfl(be, kap), egk = __expf(__shfl(gcv, kap));
            LAS bf16* Tb = (LAS bf16*)wl; LAS bf16* Tg = Tb + 4096;
#pragma unroll
            for (int i = 0; i < 64; ++i) { const int rho = dir ? 63 - i : i; const float v = tcol[i] * bk; const unsigned w = pk2(v, -v * egk); Tb[rho * 64 + kap] = (bf16)(w & 0xffffu); Tg[rho * 64 + kap] = (bf16)(w >> 16); } }
        asm volatile("s_waitcnt lgkmcnt(0)" ::: "memory");
        {   const LAS bf16* Tb = (const LAS bf16*)wl; const LAS bf16* Tg = Tb + 4096;
            const bf16* vtb = vt + ((size_t)ck * 8 + h) * 4096; const bf16* ktb = kt + ((size_t)ck * 8 + h) * 4096;
            bf16x8 ta[4][2];
#pragma unroll
            for (int t = 0; t < 4; ++t)
#pragma unroll
                for (int p = 0; p < 2; ++p) ta[t][p] = *(const LAS bf16x8*)(Tb + pi_idx(t, l15) * 64 + 32 * p + 8 * g);
#pragma unroll
            for (int ne = 0; ne < 4; ++ne) {
                const bf16x8 vb0 = *(const bf16x8*)(vtb + (16 * ne + l15) * 64 + 8 * g), vb1 = *(const bf16x8*)(vtb + (16 * ne + l15) * 64 + 32 + 8 * g);
#pragma unroll
                for (int t = 0; t < 4; ++t) { f32x4_t acc = {0.f, 0.f, 0.f, 0.f};
                    acc = __builtin_amdgcn_mfma_f32_16x16x32_bf16(ta[t][0], vb0, acc, 0, 0, 0);
                    acc = __builtin_amdgcn_mfma_f32_16x16x32_bf16(ta[t][1], vb1, acc, 0, 0, 0);
                    uint2 w; w.x = pk2(acc[0], acc[1]); w.y = pk2(acc[2], acc[3]);
                    FU[(((size_t)u * 4 + ne) * 4 + t) * 64 + lane] = w; }
            }
#pragma unroll
            for (int t = 0; t < 4; ++t)
#pragma unroll
                for (int p = 0; p < 2; ++p) ta[t][p] = *(const LAS bf16x8*)(Tg + pi_idx(t, l15) * 64 + 32 * p + 8 * g);
#pragma unroll
            for (int pd = 0; pd < 2; ++pd) {
                bf16x8 ka[2][2];
#pragma unroll
                for (int hh = 0; hh < 2; ++hh)
#pragma unroll
                    for (int p = 0; p < 2; ++p) ka[hh][p] = *(const bf16x8*)(ktb + pi_idx(2 * pd + hh, l15) * 64 + 32 * p + 8 * g);
#pragma unroll
                for (int nc = 0; nc < 4; ++nc) { f32x4_t a0 = {0.f, 0.f, 0.f, 0.f}, a1 = {0.f, 0.f, 0.f, 0.f};
                    a0 = __builtin_amdgcn_mfma_f32_16x16x32_bf16(ka[0][0], ta[nc][0], a0, 0, 0, 0); a0 = __builtin_amdgcn_mfma_f32_16x16x32_bf16(ka[0][1], ta[nc][1], a0, 0, 0, 0);
                    a1 = __builtin_amdgcn_mfma_f32_16x16x32_bf16(ka[1][0], ta[nc][0], a1, 0, 0, 0); a1 = __builtin_amdgcn_mfma_f32_16x16x32_bf16(ka[1][1], ta[nc][1], a1, 0, 0, 0);
                    v4u w; w.x = pk2(a0[0], a0[1]); w.y = pk2(a0[2], a0[3]); w.z = pk2(a1[0], a1[1]); w.w = pk2(a1[2], a1[3]);
                    FW[(((size_t)u * 4 + nc) * 2 + pd) * 64 + lane] = w; }
            }
        }
        asm volatile("s_waitcnt lgkmcnt(0)" ::: "memory");
    }
}

__device__ __forceinline__ float dn_gcum(const float* G, int dir, size_t m0, int h, int lane) {
    float gr = G[((size_t)dir * MT + m0 + lane) * 8 + h];
    if (dir) gr = __shfl(gr, 63 - lane);
#pragma unroll
    for (int o = 1; o < 64; o <<= 1) { const float n = __shfl_up(gr, o); if (lane >= o) gr += n; }
    if (dir) gr = __shfl(gr, 63 - lane);
    return gr;
}
__device__ __forceinline__ bf16x8 pack8(const f32x4_t& a, const f32x4_t& b) { v4u w; w.x = pk2(a[0], a[1]); w.y = pk2(a[2], a[3]); w.z = pk2(b[0], b[1]); w.w = pk2(b[2], b[3]); return __builtin_bit_cast(bf16x8, w); }
constexpr int DN2_SLOT = 25600, DN2_NSLOT = 4;
__device__ __forceinline__ void dn2_issue(const v4u* FW, const uint2* FU, const bf16* kt, const float* GCB, int b, int h, int dir, int st, int lw, int lane, unsigned lds_slot) {
    const int l15 = lane & 15, g = lane >> 4;
    const int cc = dir == 0 ? st : (st < 4 ? 3 - st : NCH + 3 - st);
    const size_t u = ((size_t)((b * 8 + h) * 2 + dir)) * NCH + cc; const int ck = chunk_ck(b, cc);
    const unsigned char* fw = (const unsigned char*)(FW + u * 8 * 64); const unsigned char* fu = (const unsigned char*)(FU + u * 4 * 4 * 64);
    const unsigned char* ktb = (const unsigned char*)(kt + ((size_t)ck * 8 + h) * 4096); const unsigned char* gb = (const unsigned char*)(GCB + u * 192);
#pragma unroll
    for (int k = 0; k < 2; ++k) { const int j = 2 * lw + k;
        attn64::glds16(fw + j * 1024 + lane * 16, (unsigned)__builtin_amdgcn_readfirstlane(lds_slot + j * 1024));
        attn64::glds16(ktb + pi_idx(j >> 1, l15) * 128 + (j & 1) * 64 + g * 16, (unsigned)__builtin_amdgcn_readfirstlane(lds_slot + 8192 + j * 1024));
        attn64::glds16(fu + j * 1024 + lane * 16, (unsigned)__builtin_amdgcn_readfirstlane(lds_slot + 16384 + j * 1024)); }
    attn64::glds16(gb + 512 + (lane % 10) * 16, (unsigned)__builtin_amdgcn_readfirstlane(lds_slot + 24576));
}
__device__ __forceinline__ void p6_dn2_fast(Ctx& C, bool dry = false) {
    const int lane = C.lane, g = lane >> 4;
    const v4u* FW = WSP(v4u, WS_W); uint2* FU = WSP(uint2, WS_U); const bf16* kt = WSP(bf16, WS_KT); const float* GCB = WSP(float, WS_GCB);
    v4u* SS = WSP(v4u, WS_XN);
    const unsigned lds0 = (unsigned)(uintptr_t)C.lds;
    for (int ch = blockIdx.x; ch < NB * 8 * 2; ch += C.G) {
        const int dir = ch & 1, h = (ch >> 1) & 7, b = ch >> 4;
        __syncthreads();
        if (C.wave >= 4) {
            const int lw = C.wave - 4;
            dn2_issue(FW, FU, kt, GCB, b, h, dir, 0, lw, lane, lds0 + 0 * DN2_SLOT); dn2_issue(FW, FU, kt, GCB, b, h, dir, 1, lw, lane, lds0 + 1 * DN2_SLOT); dn2_issue(FW, FU, kt, GCB, b, h, dir, 2, lw, lane, lds0 + 2 * DN2_SLOT);
            for (int st = 0; st < NCH; ++st) {
                if (st + 2 < NCH) asm volatile("s_waitcnt vmcnt(14)" ::: "memory"); else if (st + 1 < NCH) asm volatile("s_waitcnt vmcnt(7)" ::: "memory"); else asm volatile("s_waitcnt vmcnt(0)" ::: "memory");
                __builtin_amdgcn_s_barrier();
                if (st + 3 < NCH) dn2_issue(FW, FU, kt, GCB, b, h, dir, st + 3, lw, lane, lds0 + ((st + 3) & 3) * DN2_SLOT);
            }
        } else {
            const int dvq = C.wave;
            f32x4_t S[4];
#pragma unroll
            for (int t = 0; t < 4; ++t) S[t] = (f32x4_t){0.f, 0.f, 0.f, 0.f};
            bf16x8 Sf[2]; Sf[0] = (bf16x8){0, 0, 0, 0, 0, 0, 0, 0}; Sf[1] = Sf[0];
            for (int st = 0; st < NCH; ++st) {
                asm volatile("s_waitcnt lgkmcnt(0)" ::: "memory");
                __builtin_amdgcn_s_barrier();
                asm volatile("" ::: "memory");
                const LAS unsigned char* sl = C.lds + (st & 3) * DN2_SLOT;
                const int cc = dir == 0 ? st : (st < 4 ? 3 - st : NCH + 3 - st);
                const size_t u = ((size_t)((b * 8 + h) * 2 + dir)) * NCH + cc;
                if (!dry) { SS[((u * 4 + dvq) * 2 + 0) * 64 + lane] = __builtin_bit_cast(v4u, Sf[0]); SS[((u * 4 + dvq) * 2 + 1) * 64 + lane] = __builtin_bit_cast(v4u, Sf[1]); }
                const float gl = *(const LAS float*)(sl + 24576); const float egl = __expf(gl);
                const v4u ef0 = *(const LAS v4u*)(sl + 24576 + 16 + g * 32), ef1 = *(const LAS v4u*)(sl + 24576 + 32 + g * 32);
                f32x4_t vn[4];
#pragma unroll
                for (int t = 0; t < 4; ++t) { typedef unsigned u32x2v __attribute__((ext_vector_type(2))); const u32x2v uu = *(const LAS u32x2v*)(sl + 16384 + dvq * 2048 + t * 512 + lane * 8);
                    const bf16x8 a0 = *(const LAS bf16x8*)(sl + (t * 2 + 0) * 1024 + lane * 16), a1 = *(const LAS bf16x8*)(sl + (t * 2 + 1) * 1024 + lane * 16);
                    vn[t] = (f32x4_t){bflo(uu.x), bfhi(uu.x), bflo(uu.y), bfhi(uu.y)};
                    vn[t] = __builtin_amdgcn_mfma_f32_16x16x32_bf16(a0, Sf[0], vn[t], 0, 0, 0);
                    vn[t] = __builtin_amdgcn_mfma_f32_16x16x32_bf16(a1, Sf[1], vn[t], 0, 0, 0); }
                if (!dry) { v4u* VN = (v4u*)(FU + ((u * 4 + dvq) * 4) * 64);
                    VN[0 * 64 + lane] = __builtin_bit_cast(v4u, pack8(vn[0], vn[1])); VN[1 * 64 + lane] = __builtin_bit_cast(v4u, pack8(vn[2], vn[3])); }
#pragma unroll
                for (int t = 0; t < 4; ++t) { const v4u& e = (t < 2) ? ef0 : ef1; const unsigned w0 = e[(t & 1) * 2], w1 = e[(t & 1) * 2 + 1];
                    vn[t][0] *= bflo(w0); vn[t][1] *= bfhi(w0); vn[t][2] *= bflo(w1); vn[t][3] *= bfhi(w1); }
                const bf16x8 vs0 = pack8(vn[0], vn[1]), vs1 = pack8(vn[2], vn[3]);
#pragma unroll
                for (int t = 0; t < 4; ++t) { const bf16x8 k0 = *(const LAS bf16x8*)(sl + 8192 + (t * 2 + 0) * 1024 + lane * 16), k1 = *(const LAS bf16x8*)(sl + 8192 + (t * 2 + 1) * 1024 + lane * 16);
                    S[t] = S[t] * egl;
                    S[t] = __builtin_amdgcn_mfma_f32_16x16x32_bf16(k0, vs0, S[t], 0, 0, 0);
                    S[t] = __builtin_amdgcn_mfma_f32_16x16x32_bf16(k1, vs1, S[t], 0, 0, 0); }
                Sf[0] = pack8(S[0], S[1]); Sf[1] = pack8(S[2], S[3]);
            }
            if (dry) { *(LAS v4u*)(C.lds + 110000 + (C.wave * 64 + lane) * 16) = __builtin_bit_cast(v4u, Sf[0]); }
        }
    }
    __syncthreads();
}
__device__ __forceinline__ void p7_dn3_fast(Ctx& C, int l) {
    const int lane = C.lane, l15 = lane & 15, g = lane >> 4;
    const bf16* qdn = WSP(bf16, WS_QDN); const bf16* kdn = WSP(bf16, WS_KDN);
    const v4u* VNb = WSP(v4u, WS_U); const v4u* SS = WSP(v4u, WS_XN); const bf16* zb = WSP(bf16, WS_ZB); bf16* mix = WSP(bf16, WS_MIX);
    LAS unsigned char* wl = C.lds + C.wave * 16384; const unsigned wl_addr = (unsigned)(uintptr_t)wl;
    const int cc0 = (l == 0) ? 0 : 4; const int ncc = NCH - cc0;
    gu32* qh = C.ctl + CW_Q + 64 * (2 * l + 1);
    for (int un = wq_next(qh, lane); un < NB * 8 * ncc; un = wq_next(qh, lane)) {
        const int cc = cc0 + un % ncc, h = (un / ncc) & 7, b = un / (8 * ncc);
        const int ck = chunk_ck(b, cc); const size_t m0 = (size_t)ck * 64;
        const size_t u0 = ((size_t)((b * 8 + h) * 2 + 0)) * NCH + cc;
        asm volatile("s_waitcnt lgkmcnt(0)" ::: "memory");
#pragma unroll
        for (int f = 0; f < 8; ++f) { attn64::glds16(SS + (u0 * 8 + f) * 64 + lane, (unsigned)__builtin_amdgcn_readfirstlane(wl_addr + f * 1024)); attn64::glds16(VNb + (u0 * 8 + f) * 64 + lane, (unsigned)__builtin_amdgcn_readfirstlane(wl_addr + 8192 + f * 1024)); }
        bf16x8 kf[4][2], qf[4][2];
#pragma unroll
        for (int t = 0; t < 4; ++t)
#pragma unroll
            for (int p = 0; p < 2; ++p) { kf[t][p] = *(const bf16x8*)(kdn + (m0 + pi_idx(t, l15)) * 512 + h * 64 + 32 * p + 8 * g); qf[t][p] = *(const bf16x8*)(qdn + (m0 + pi_idx(t, l15)) * 512 + h * 64 + 32 * p + 8 * g); }
        const float* gcb0 = WSP(float, WS_GCB) + u0 * 192; const float* gcb1 = gcb0 + (size_t)NCH * 192;
        f32x4_t o[4][4];
#pragma unroll
        for (int ni = 0; ni < 4; ++ni)
#pragma unroll
            for (int ne = 0; ne < 4; ++ne) o[ni][ne] = (f32x4_t){0.f, 0.f, 0.f, 0.f};
#pragma unroll
        for (int dir = 0; dir < 2; ++dir) {
            const float* gcbd = dir ? gcb1 : gcb0;
            f32x4_t rowg[4]; float gi[4];
#pragma unroll
            for (int t = 0; t < 4; ++t) { rowg[t] = *(const f32x4_t*)(gcbd + 64 + g * 16 + t * 4); gi[t] = gcbd[pi_idx(t, l15)]; }
            if (dir == 1) { const size_t u1 = u0 + NCH;
                asm volatile("s_waitcnt lgkmcnt(0)" ::: "memory");
#pragma unroll
                for (int f = 0; f < 8; ++f) { attn64::glds16(SS + (u1 * 8 + f) * 64 + lane, (unsigned)__builtin_amdgcn_readfirstlane(wl_addr + f * 1024)); attn64::glds16(VNb + (u1 * 8 + f) * 64 + lane, (unsigned)__builtin_amdgcn_readfirstlane(wl_addr + 8192 + f * 1024)); } }
            asm volatile("s_waitcnt vmcnt(0)" ::: "memory");
#pragma unroll
            for (int ni = 0; ni < 4; ++ni) {
                const int si = pi_idx(ni, l15);
                f32x4_t pt[4];
#pragma unroll
                for (int tj = 0; tj < 4; ++tj) { f32x4_t a = {0.f, 0.f, 0.f, 0.f};
                    a = __builtin_amdgcn_mfma_f32_16x16x32_bf16(kf[tj][0], qf[ni][0], a, 0, 0, 0);
                    a = __builtin_amdgcn_mfma_f32_16x16x32_bf16(kf[tj][1], qf[ni][1], a, 0, 0, 0);
#pragma unroll
                    for (int r = 0; r < 4; ++r) { const int sj = pi_idx(tj, 4 * g + r); const bool keep = dir ? (si <= sj) : (si >= sj);
                        a[r] = keep ? a[r] * __expf(gi[ni] - rowg[tj][r]) : 0.f; }
                    pt[tj] = a; }
                const bf16x8 pa0 = pack8(pt[0], pt[1]), pa1 = pack8(pt[2], pt[3]);
                float erow[4];
#pragma unroll
                for (int r = 0; r < 4; ++r) erow[r] = __expf(rowg[ni][r]);
#pragma unroll
                for (int ne = 0; ne < 4; ++ne) {
                    const bf16x8 s0 = *(const LAS bf16x8*)(wl + (ne * 2 + 0) * 1024 + lane * 16), s1 = *(const LAS bf16x8*)(wl + (ne * 2 + 1) * 1024 + lane * 16);
                    const bf16x8 v0 = *(const LAS bf16x8*)(wl + 8192 + (ne * 2 + 0) * 1024 + lane * 16), v1 = *(const LAS bf16x8*)(wl + 8192 + (ne * 2 + 1) * 1024 + lane * 16);
                    f32x4_t qs = {0.f, 0.f, 0.f, 0.f};
                    qs = __builtin_amdgcn_mfma_f32_16x16x32_bf16(qf[ni][0], s0, qs, 0, 0, 0);
                    qs = __builtin_amdgcn_mfma_f32_16x16x32_bf16(qf[ni][1], s1, qs, 0, 0, 0);
#pragma unroll
                    for (int r = 0; r < 4; ++r) o[ni][ne][r] += qs[r] * erow[r];
                    o[ni][ne] = __builtin_amdgcn_mfma_f32_16x16x32_bf16(pa0, v0, o[ni][ne], 0, 0, 0);
                    o[ni][ne] = __builtin_amdgcn_mfma_f32_16x16x32_bf16(pa1, v1, o[ni][ne], 0, 0, 0);
                    if (ne & 1) __builtin_amdgcn_sched_barrier(0); }
            }
        }
        asm volatile("s_waitcnt lgkmcnt(0)" ::: "memory");
        {   LAS bf16* ot = (LAS bf16*)wl;
#pragma unroll
            for (int ni = 0; ni < 4; ++ni)
#pragma unroll
                for (int ne = 0; ne < 4; ++ne) { const unsigned w0 = pk2(o[ni][ne][0], o[ni][ne][1]), w1 = pk2(o[ni][ne][2], o[ni][ne][3]); const int e = 16 * ne + l15;
                    ot[pi_idx(ni, 4 * g + 0) * 64 + e] = (bf16)(w0 & 0xffffu); ot[pi_idx(ni, 4 * g + 1) * 64 + e] = (bf16)(w0 >> 16);
                    ot[pi_idx(ni, 4 * g + 2) * 64 + e] = (bf16)(w1 & 0xffffu); ot[pi_idx(ni, 4 * g + 3) * 64 + e] = (bf16)(w1 >> 16); }
            asm volatile("s_waitcnt lgkmcnt(0)" ::: "memory");
            const size_t row = m0 + lane; float ov[64]; float ss = 0.f;
#pragma unroll
            for (int c = 0; c < 8; ++c) { const v4u w = *(const LAS v4u*)(wl + lane * 128 + c * 16);
                ov[c * 8 + 0] = bflo(w.x); ov[c * 8 + 1] = bfhi(w.x); ov[c * 8 + 2] = bflo(w.y); ov[c * 8 + 3] = bfhi(w.y); ov[c * 8 + 4] = bflo(w.z); ov[c * 8 + 5] = bfhi(w.z); ov[c * 8 + 6] = bflo(w.w); ov[c * 8 + 7] = bfhi(w.w); }
#pragma unroll
            for (int i = 0; i < 64; ++i) ss += ov[i] * ov[i];
            const float rs = 1.0f / sqrtf(ss * (1.f / 64.f) + EPS);
#pragma unroll
            for (int c = 0; c < 8; ++c) { float z[8]; load8(zb + row * 512 + h * 64 + c * 8, z); float r8[8];
#pragma unroll
                for (int i = 0; i < 8; ++i) r8[i] = ov[c * 8 + i] * rs * C.in[12][l * 64 + c * 8 + i] * silu_f(z[i]);
                store8(mix + row * 1024 + h * 64 + c * 8, r8); }
        }
    }
    asm volatile("s_waitcnt lgkmcnt(0)" ::: "memory");
}
__device__ __forceinline__ void p4_attn_fast(Ctx& C, char* ldsg, int l, bool dry = false) {
    const int bx = blockIdx.x; const int vcu = (C.G % 8 == 0) ? (bx % 8) * (C.G / 8) + bx / 8 : bx;
    attn64::bf16* mix = (attn64::bf16*)WSP(bf16, WS_MIX); attn64::bf16* omix = dry ? (attn64::bf16*)WSP(bf16, WS_XN) : mix;     const attn64::bf16* kall = (const attn64::bf16*)WSP(bf16, WS_KALL); const attn64::bf16* vall = (const attn64::bf16*)WSP(bf16, WS_VALL);
    float mq = fabsf(C.in[13][l * 64 + C.lane]), mk = fabsf(C.in[14][l * 64 + C.lane]);
#pragma unroll
    for (int o = 1; o < 64; o <<= 1) { mq = fmaxf(mq, __shfl_xor(mq, o)); mk = fmaxf(mk, __shfl_xor(mk, o)); }
    const float mref = 64.0f * QSCALE * mq * mk * 1.02f;
    const int nun = NB * 8 * (T / 256) + (l == 0 ? NB * 8 : 0);
    for (int L = vcu; L < nun; L += C.G) {
        int qrow, krow, nt, h;
        if (L < 1024) { const int within = L & 255, bh = within >> 3, qb = (within & 7) + 8 * (L >> 8); const int b = bh >> 3; h = bh & 7; qrow = b * T + qb * 256; krow = b * TK; nt = TK / 64; }
        else { const int b = (L - 1024) >> 3; h = L & 7; qrow = ML + b * LC; krow = b * TK + T; nt = LC / 64; }
        const int kvh = h >> 2;
        attn64::attn_unit<8>(mix + (size_t)qrow * 1024 + 512 + h * 64, omix + (size_t)qrow * 1024 + 512 + h * 64, kall + (size_t)krow * 128 + kvh * 64, vall + (size_t)krow * 128 + kvh * 64, nt, ldsg, mref);
    }
    __syncthreads();
}
__device__ __forceinline__ void tile64(Ctx& C, const bf16* X, int lda, const bf16* Wt, int ldb, int K, float (&r)[8]) {
    typedef pg8::bf16x8 frag_t; typedef pg8::f32x4 c4_t;
    const int lane = C.lane, r16 = lane & 15, g = lane >> 4, w = C.wave;
    const int npair = K >> 6, pbase = npair >> 3, prem = npair & 7;
    const int np = pbase + (w < prem ? 1 : 0), pstart = w * pbase + (w < prem ? w : prem);
    const bf16* xp = X + (size_t)r16 * lda + pstart * 64 + 16 * g;
    const bf16* wp = Wt + (size_t)r16 * ldb + pstart * 64 + 16 * g;
    c4_t acc[4][4];
#pragma unroll
    for (int a = 0; a < 4; ++a)
#pragma unroll
        for (int b = 0; b < 4; ++b) acc[a][b] = (c4_t){0.f, 0.f, 0.f, 0.f};
    frag_t xa[8], wa[8], xb[8], wb[8];
#define T64_LD(xf, wf, p) do { _Pragma("unroll") for (int t_ = 0; t_ < 4; ++t_) { const bf16* xq_ = xp + (size_t)(16 * t_) * lda + 64 * (p); const bf16* wq_ = wp + (size_t)(16 * t_) * ldb + 64 * (p); \
        xf[2 * t_] = *(const GAS frag_t*)(xq_); xf[2 * t_ + 1] = *(const GAS frag_t*)(xq_ + 8); wf[2 * t_] = *(const GAS frag_t*)(wq_); wf[2 * t_ + 1] = *(const GAS frag_t*)(wq_ + 8); } } while (0)
#define T64_MM(xf, wf) do { _Pragma("unroll") for (int h_ = 0; h_ < 2; ++h_) _Pragma("unroll") for (int nt_ = 0; nt_ < 4; ++nt_) _Pragma("unroll") for (int mt_ = 0; mt_ < 4; ++mt_) \
        acc[nt_][mt_] = __builtin_amdgcn_mfma_f32_16x16x32_bf16(wf[2 * nt_ + h_], xf[2 * mt_ + h_], acc[nt_][mt_], 0, 0, 0); } while (0)
#define T64_SB __builtin_amdgcn_sched_barrier(0)
    T64_LD(xa, wa, 0); if (1 < np) T64_LD(xb, wb, 1); T64_SB;
    for (int p = 0; p < np; p += 2) {
        T64_MM(xa, wa); T64_SB;
        if (p + 2 < np) T64_LD(xa, wa, p + 2); T64_SB;
        if (p + 1 < np) T64_MM(xb, wb); T64_SB;
        if (p + 3 < np) T64_LD(xb, wb, p + 3); T64_SB;
    }
#undef T64_SB
#undef T64_LD
#undef T64_MM
    LAS unsigned char* P = C.lds + w * 16384;
#pragma unroll
    for (int nt = 0; nt < 4; ++nt)
#pragma unroll
        for (int mt = 0; mt < 4; ++mt) { const int m = 16 * mt + r16, nb = (16 * nt + 4 * g) * 4; *(LAS c4_t*)(P + m * 256 + (nb ^ (r16 << 4))) = acc[nt][mt]; }
    __syncthreads();
    const int m = 8 * w + (lane >> 3), cb = (lane & 7) * 32, sw = (m & 15) << 4;
#pragma unroll
    for (int i = 0; i < 8; ++i) r[i] = 0.f;
#pragma unroll
    for (int q = 0; q < 8; ++q) { const LAS unsigned char* Q = C.lds + q * 16384 + m * 256; const c4_t a = *(const LAS c4_t*)(Q + (cb ^ sw)), b = *(const LAS c4_t*)(Q + ((cb + 16) ^ sw));
        r[0] += a[0]; r[1] += a[1]; r[2] += a[2]; r[3] += a[3]; r[4] += b[0]; r[5] += b[1]; r[6] += b[2]; r[7] += b[3]; }
    __syncthreads();
}
template <bool XF32> __device__ __forceinline__ void ctx_res_tiles(Ctx& C, const bf16* X, int lda, const bf16* Wt, int K, const void* xin, bf16* out, const float* gate) {
    for (int tI = blockIdx.x; tI < 256; tI += C.G) {
        const int xcd = tI & 7, idx = tI >> 3, ti = 8 * (xcd & 1) + (idx & 7), tj = 4 * (xcd >> 1) + (idx >> 3);
        float r[8]; tile64(C, X + (size_t)(64 * ti) * lda, lda, Wt + (size_t)(64 * tj) * K, K, K, r);
        const size_t off = (size_t)(64 * ti + 8 * C.wave + (C.lane >> 3)) * D + 64 * tj + 8 * (C.lane & 7);
        float x[8];
        if (XF32) { const f32x4 a = *(const GAS f32x4*)((const float*)xin + off), b = *(const GAS f32x4*)((const float*)xin + off + 4); x[0] = a.x; x[1] = a.y; x[2] = a.z; x[3] = a.w; x[4] = b.x; x[5] = b.y; x[6] = b.z; x[7] = b.w; }
        else load8((const bf16*)xin + off, x);
        const f32x4 ga = *(const GAS f32x4*)(gate + 64 * tj + 8 * (C.lane & 7)), gb = *(const GAS f32x4*)(gate + 64 * tj + 8 * (C.lane & 7) + 4);
        const float o[8] = {x[0] + ga.x * r[0], x[1] + ga.y * r[1], x[2] + ga.z * r[2], x[3] + ga.w * r[3], x[4] + gb.x * r[4], x[5] + gb.y * r[5], x[6] + gb.z * r[6], x[7] + gb.w * r[7]};
        store8(out + off, o);
    }
}
__device__ __forceinline__ void moe_down_tiles(Ctx& C, const int (&ps)[9], int p0, int p1) {
    const bf16* hm = WSP(bf16, WS_HM); const bf16* md = WSP(bf16, WS_MD); bf16* ys = WSP(bf16, WS_XS);
    const int nt = (p1 - p0) * 64;
    for (int tI = blockIdx.x; tI < nt; tI += C.G) {
        const int p = p0 + (tI >> 6), mi = (tI >> 4) & 3, nj = tI & 15; int e = 0;
#pragma unroll
        for (int k = 1; k < 8; ++k) e += (p >= ps[k]) ? 1 : 0;
        float r[8]; tile64(C, hm + (size_t)((p - p0) * 256 + 64 * mi) * EF, EF, md + (size_t)e * D * EF + (size_t)(64 * nj) * EF, EF, EF, r);
        store8(ys + (size_t)(p * 256 + 64 * mi + 8 * C.wave + (C.lane >> 3)) * D + 64 * nj + 8 * (C.lane & 7), r);
    }
}
#define STAMP() do {} while (0)
#define RELOAD() do { int t_ = threadIdx.x; asm volatile("" : "+v"(t_)); C.tid = t_; C.lane = t_ & 63; C.wave = __builtin_amdgcn_readfirstlane(t_ >> 6); C.gw = blockIdx.x * NWAVES + C.wave; } while (0)
#define GRID_BAR() do { XcdBarrier b2_ = bar; asm volatile("" : "+s"(b2_.x), "+s"(b2_.bar)); xcd_barrier(b2_); RELOAD(); STAMP(); } while (0)
template <int l> __device__ __forceinline__ void layer_fn(Ctx& C, const XcdBarrier& bar, unsigned char* lds) {
        bf16* const xb1 = (bf16*)C.out;
        const void* xl = (l == 0) ? (const void*)C.in[0] : (const void*)xb1; const void* xc = (l == 0) ? (const void*)C.in[2] : (const void*)WSP(bf16, WS_XC);
        norm_mod<false, l != 0>(C, xl, xc, MT, l, 1, 0, WSP(bf16, WS_XN));
        GRID_BAR();
        {   pg8::Gemm g{WSP(bf16, WS_XN), WSP(bf16, WS_WIN) + (size_t)l * NINP * D, MT, NINP, D}; pg8::StaticOrder S; S.init(MT, NINP, C.G, (int)blockIdx.x);
            pg8::EpiIn E{WSP(bf16, WS_DNRAW), WSP(bf16, WS_ZB), WSP(bf16, WS_QRAW), WSP(bf16, WS_KVRAW), WSP(float, WS_AB)};
            pg8::gemm_phase<pg8::EpiIn, pg8::StaticOrder, true, true>(C.lds, g, S, E); }
        GRID_BAR();
        p3_prep(C, l);
        RELOAD();
        p3b_dnconv(C, l);
        GRID_BAR();
        p4_attn_fast(C, (char*)lds, l);
        STAMP();
        RELOAD();
        p5_dn1_fast(C, l);
        GRID_BAR();
        p6_dn2_fast(C);
        GRID_BAR();
        p7_dn3_fast(C, l);
        GRID_BAR();
        {   const int Mo = ML;
            pg8::Gemm g{WSP(bf16, WS_MIX), WSP(bf16, WS_WOUT) + (size_t)l * D * D, Mo, D, D}; pg8::StaticOrder S; S.init(Mo, D, C.G, (int)blockIdx.x);
            pg8::EpiRes<l == 0> E{xl, (l == 0) ? xb1 : WSP(bf16, WS_XB2), xc, WSP(bf16, WS_XC), mods_ptr(C, l, 0, 2), 6 * 1024};
            pg8::gemm_phase<pg8::EpiRes<l == 0>, pg8::StaticOrder, true, true>(C.lds, g, S, E); }
        if (l == 0) { RELOAD(); ctx_res_tiles<true>(C, WSP(bf16, WS_MIX) + (size_t)ML * D, D, WSP(bf16, WS_WOUT), D, C.in[2], WSP(bf16, WS_XC), mods_ptr(C, 0, 4, 2)); }
        GRID_BAR();
        if (l == 0) {
            norm_mod<false, true>(C, xb1, WSP(bf16, WS_XC), MT, l, 4, 3, WSP(bf16, WS_XN));
            GRID_BAR();
            {   pg8::Gemm g{WSP(bf16, WS_XN), WSP(bf16, WS_WGU), MT, 2 * FF, D}; pg8::StaticOrder S; S.init(MT, 2 * FF, C.G, (int)blockIdx.x);
                pg8::EpiSwiGLU E{WSP(bf16, WS_H), FF, 22, 0};
                pg8::gemm_phase<pg8::EpiSwiGLU, pg8::StaticOrder, true, true>(C.lds, g, S, E); }
            GRID_BAR();
            {   pg8::Gemm g{WSP(bf16, WS_H), WSP(bf16, WS_WD), ML, D, FF}; pg8::StaticOrder S; S.init(ML, D, C.G, (int)blockIdx.x);
                pg8::EpiRes<false> E{xb1, xb1, WSP(bf16, WS_XC), WSP(bf16, WS_XC), mods_ptr(C, l, 0, 5), 6 * 1024};
                pg8::gemm_phase<pg8::EpiRes<false>, pg8::StaticOrder, true, true>(C.lds, g, S, E); }
            RELOAD(); ctx_res_tiles<false>(C, WSP(bf16, WS_H) + (size_t)ML * FF, FF, WSP(bf16, WS_WD), FF, WSP(bf16, WS_XC), WSP(bf16, WS_XC), mods_ptr(C, 0, 4, 5));
            GRID_BAR();
        } else {
            norm_mod<true, true>(C, WSP(bf16, WS_XB2), WSP(bf16, WS_XC), ML, l, 4, 3, WSP(bf16, WS_HM));
            RELOAD();
            moe_weights(C);
            GRID_BAR();
            moe_scatter(C, WSP(bf16, WS_HM));
            GRID_BAR();
            int ps[9], cnt[8]; moe_panel_starts(C, ps, cnt);
            const int per = SS_PANELS;
            for (int ss = 0; ss < NSS; ++ss) {
                const int p0 = ss * per, p1 = (p0 + per < ps[8]) ? p0 + per : ps[8];
                if (p0 < p1) {
                    pg8::MoeOrder S;
#pragma unroll
                    for (int k = 0; k < 9; ++k) S.ps[k] = ps[k];
                    S.p0 = p0; S.p1 = p1; S.nloc = 28; S.G = C.G; S.c = (int)blockIdx.x; S.a_off = 0;
                    pg8::Gemm g{WSP(bf16, WS_XS), WSP(bf16, WS_MGU), 0, 0, D};
                    pg8::EpiSwiGLU E{WSP(bf16, WS_HM), EF, 28, p0};
                    pg8::gemm_phase<pg8::EpiSwiGLU, pg8::MoeOrder, true, true>(C.lds, g, S, E);
                }
                GRID_BAR();
                if (p0 < p1 && p1 - p0 <= 12) { moe_down_tiles(C, ps, p0, p1); }
                else if (p0 < p1) {
                    pg8::MoeOrder S;
#pragma unroll
                    for (int k = 0; k < 9; ++k) S.ps[k] = ps[k];
                    S.p0 = p0; S.p1 = p1; S.nloc = 4; S.G = C.G; S.c = (int)blockIdx.x; S.a_off = -p0;
                    pg8::Gemm g{WSP(bf16, WS_HM), WSP(bf16, WS_MD), 0, 0, EF};
                    pg8::EpiBfPlain E{WSP(bf16, WS_XS) + (size_t)p0 * 256 * D, D, 4};
                    pg8::gemm_phase<pg8::EpiBfPlain, pg8::MoeOrder, true, true>(C.lds, g, S, E);
                }
                GRID_BAR();
            }
            moe_final(C, l);
        }
    }
struct Args { const float* in[25]; float* out; unsigned char* ws; };
__global__ void __launch_bounds__(NWAVES * 64, 2) mk_fwd(Args args) {
    extern __shared__ __attribute__((aligned(16))) unsigned char lds[];
    Ctx C;
    C.lds = (LAS unsigned char*)lds; C.tid = threadIdx.x; C.lane = C.tid & 63; C.wave = __builtin_amdgcn_readfirstlane(C.tid >> 6);
    C.G = gridDim.x; C.gw = blockIdx.x * NWAVES + C.wave; C.NGW = C.G * NWAVES;
    C.in = (const float* const __attribute__((address_space(4)))*)__builtin_amdgcn_kernarg_segment_ptr();
    C.out = args.out; C.ws = args.ws; C.ctl = (gu32*)args.ws;
    volatile LAS unsigned* MISC = (volatile LAS unsigned*)(C.lds + MISC_OFF);
    for (int u = C.tid; u < (LDS_BYTES - LDSCTL_OFF) / 4; u += NWAVES * 64) ((LAS unsigned*)(C.lds + LDSCTL_OFF))[u] = 0u;
    __syncthreads();
    XcdBarrier bar = xcd_barrier_post((unsigned*)(C.ctl + CW_BAR), MISC + 8);
    p0_weights(C); __syncthreads(); RELOAD(); p0_mods(C);
    GRID_BAR();
    layer_fn<0>(C, bar, lds);
    layer_fn<1>(C, bar, lds);
}

extern "C" void kernel_launch(void* const* d_in, const int* in_sizes, int n_in, void* d_out, int out_size, void* d_ws, size_t ws_size, hipStream_t stream) {
    static int grid = 0;
    if (grid == 0) {
        int dev = 0, cus = 0;
        if (n_in != 25 || out_size != ML * D || ws_size < (size_t)560 * MiB) { fprintf(stderr, "kernel_launch: unexpected problem (n_in %d out %d ws %zu)\n", n_in, out_size, ws_size); grid = -1; return; }
        if (hipGetDevice(&dev) != hipSuccess || hipDeviceGetAttribute(&cus, hipDeviceAttributeMultiprocessorCount, dev) != hipSuccess) { grid = -1; return; }
        if (hipFuncSetAttribute((const void*)mk_fwd, hipFuncAttributeMaxDynamicSharedMemorySize, LDS_BYTES) != hipSuccess) { grid = -1; return; }
        (void)hipGetLastError();
        grid = cus;
    }
    if (grid < 0) return;
    (void)hipMemsetAsync((char*)d_ws, 0, CTL_ZERO_BYTES, stream);
    Args a{};
    for (int i = 0; i < 25; ++i) a.in[i] = (const float*)d_in[i];
    a.out = (float*)d_out; a.ws = (unsigned char*)d_ws;
    hipLaunchKernelGGL(mk_fwd, dim3(grid), dim3(NWAVES * 64), LDS_BYTES, stream, a);
}
```

```cpp
#include <hip/hip_runtime.h>
#include <hip/hip_bf16.h>
#include <cstdio>
#include <cstdint>
#include <cmath>
namespace pg8 {
#define PG8_LAS __attribute__((address_space(3)))
typedef unsigned short bf16_t;
typedef short bf16x8 __attribute__((ext_vector_type(8)));
typedef float f32x4 __attribute__((ext_vector_type(4)));
typedef unsigned u32x4 __attribute__((ext_vector_type(4)));
constexpr int BM = 256, BK = 64, HALF = 128, HTB = HALF * BK * 2  , STAGE_BYTES = 8 * HTB, NXCD = 8, WGM = 8;

__host__ __device__ __forceinline__ int lds_byte(int r, int c) { const int st = (r >> 4) * 2 + (c >> 5), rr = r & 15, cc = c & 31, ob = rr * 64 + cc * 2; return st * 1024 + (ob ^ (((ob >> 9) & 1) << 5)); }
__host__ __device__ __forceinline__ void stage_rc(int b, int& R, int& C) { const int st = b / 1024, sb = b % 1024, swz = sb ^ (((sb >> 9) & 1) << 5); R = (st >> 1) * 16 + swz / 64; C = (st & 1) * 32 + (swz % 64) / 2; }
__host__ __device__ __forceinline__ int perm32(int rho) { const int n = rho >> 4, i = rho & 15; return 8 * (i >> 2) + 4 * n + (i & 3); }

struct Unit { int pm, pn; };
struct Gemm { const bf16_t* A; const bf16_t* Bt; int M, N, K; };

struct StaticOrder {
    int nM, nN, nwg, G, c;
    __host__ __device__ void init(int M, int N, int G_, int c_) { nM = M / BM; nN = N / BM; nwg = nM * nN; G = G_; c = c_; }
    __host__ __device__ bool next(int i, Unit& u) const {
        const long L = (long)i * G + c; if (L >= nwg) return false;
        int wgid = (int)L; { const int q = nwg / NXCD, r = nwg % NXCD, xcd = wgid % NXCD, off = wgid / NXCD; wgid = (xcd < r ? xcd * (q + 1) : r * (q + 1) + (xcd - r) * q) + off; }
        const int nig = WGM * nN, gid = wgid / nig, fm = gid * WGM, gsz = (nM - fm) < WGM ? (nM - fm) : WGM;
        u.pm = fm + ((wgid % nig) % gsz); u.pn = (wgid % nig) / gsz; return true;
    }
    __device__ __forceinline__ void a_ready(const Unit&) const {}
    __device__ __forceinline__ void done(const Unit&) const {}
};

__device__ __forceinline__ unsigned cvt_pk_bf16(float lo, float hi) { unsigned r; asm volatile("v_cvt_pk_bf16_f32 %0, %1, %2" : "=v"(r) : "v"(lo), "v"(hi)); return r; }
typedef float f32x2 __attribute__((ext_vector_type(2)));
__device__ __forceinline__ f32x2 gelu_pk(f32x2 v) {
    const f32x2 av = __builtin_elementwise_abs(v), d = av * 0.2316418882f + 1.0f;
    f32x2 t; t.x = __builtin_amdgcn_rcpf(d.x); t.y = __builtin_amdgcn_rcpf(d.y);
    f32x2 q = t * 0.5307027145f + (-0.7265760135f); q = q * t + 0.7107068705f; q = q * t + (-0.142248368f); q = q * t + 0.127414796f; q = q * t;
    const f32x2 s = (v * v) * (-0.72134752044f);
    f32x2 e; e.x = __builtin_amdgcn_exp2f(s.x); e.y = __builtin_amdgcn_exp2f(s.y);
    const f32x2 m = v * (q * e), r = v - m;
    f32x2 o; o.x = v.x < 0.f ? m.x : r.x; o.y = v.y < 0.f ? m.y : r.y; return o;
}

template <int ACT  > struct EpiBf16 {
    static constexpr bool PERM = true, AFTER_DRAIN = false; static_assert(ACT == 0 || ACT == 1, "EpiBf16: ACT is 0 (none) or 1 (gelu_pk)");
    bf16_t* O; int ldc; const float* bias; int split_cols; size_t split_stride; float scale0;
    __device__ __forceinline__ void operator()(const f32x4 (&acc)[2][2][4][2], const Unit& u, int wr, int wc, int fr, int fq) const {
        const int row0 = u.pm * BM + wr * 64 + fr; int colt = u.pn * BM; bf16_t* base = O;
        float sc = 1.f; if (split_cols) { const int t = colt / split_cols; base += (size_t)t * split_stride; colt -= t * split_cols; if (t == 0) sc = scale0; }
        const int col0 = colt + wc * 32 + 8 * fq, bcol0 = u.pn * BM + wc * 32 + 8 * fq;
        f32x4 bv[2][2];
#pragma unroll
        for (int bj = 0; bj < 2; ++bj)
#pragma unroll
            for (int n = 0; n < 2; ++n) bv[bj][n] = bias ? *(const f32x4*)(bias + bcol0 + bj * HALF + 4 * n) : (f32x4){0.f, 0.f, 0.f, 0.f};
#pragma unroll
        for (int ai = 0; ai < 2; ++ai)
#pragma unroll
            for (int m = 0; m < 4; ++m) { bf16_t* rowp = base + (size_t)(row0 + ai * HALF + m * 16) * ldc + col0;
#pragma unroll
                for (int bj = 0; bj < 2; ++bj) { f32x4 v0 = acc[ai][bj][m][0] + bv[bj][0], v1 = acc[ai][bj][m][1] + bv[bj][1];
                    if (ACT == 1) { f32x2 a = gelu_pk((f32x2){v0[0], v0[1]}), b = gelu_pk((f32x2){v0[2], v0[3]}), c = gelu_pk((f32x2){v1[0], v1[1]}), d = gelu_pk((f32x2){v1[2], v1[3]});
                        v0 = (f32x4){a.x, a.y, b.x, b.y}; v1 = (f32x4){c.x, c.y, d.x, d.y}; }
                    v0 = v0 * sc; v1 = v1 * sc; u32x4 w; w.x = cvt_pk_bf16(v0[0], v0[1]); w.y = cvt_pk_bf16(v0[2], v0[3]); w.z = cvt_pk_bf16(v1[0], v1[1]); w.w = cvt_pk_bf16(v1[2], v1[3]);
                    *(u32x4*)(rowp + bj * HALF) = w; } }
    }
};

template <class Epi, class Sched, bool ALIGN_EPI = false, bool SP2 = false>
__device__ __forceinline__ void gemm_phase(PG8_LAS unsigned char* lds, const Gemm g, const Sched& S, const Epi& E) {
    int tid_ = threadIdx.x; asm volatile("" : "+v"(tid_));
    const int tid = tid_, wid = __builtin_amdgcn_readfirstlane(tid >> 6), lane = tid & 63, wr = wid >> 2, wc = wid & 3, fr = lane & 15, fq = lane >> 4;
    const int K = g.K, nt = K / BK;
    unsigned voffA[2], voffB[2];
#pragma unroll
    for (int i = 0; i < 2; ++i) { int R, C; stage_rc(tid * 16 + i * 8192, R, C); const int Rb = Epi::PERM ? ((R & ~31) + perm32(R & 31)) : R;
        voffA[i] = (unsigned)(R * K + C) * 2u; voffB[i] = (unsigned)(Rb * K + C) * 2u; }
    const size_t kstep = (size_t)(BK * 2);
    const size_t hstep = (size_t)HALF * K * 2;
    const size_t tstep = 2 * hstep;
    const unsigned ldsw = (unsigned)wid * 1024u;
    const int aoff = lds_byte(wr * 64 + fr, fq * 8), boff = lds_byte(wc * 32 + fr, fq * 8);
#define PG8_SA(b, h) (((b) * 2 + (h)) * HTB)
#define PG8_SB(b, h) ((4 + (b) * 2 + (h)) * HTB)
#define PG8_STAGE(bufoff, gbase, voff) do { _Pragma("unroll") for (int _i = 0; _i < 2; ++_i) \
        __builtin_amdgcn_global_load_lds((const unsigned*)((const char*)(gbase) + (voff)[_i]), (PG8_LAS unsigned*)(lds + (bufoff) + ldsw + _i * 8192), 16, 0, 0); } while (0)
#define PG8_LDA(dst, b, h) do { _Pragma("unroll") for (int m = 0; m < 4; ++m) _Pragma("unroll") for (int k = 0; k < 2; ++k) dst[m][k] = *(const PG8_LAS bf16x8*)(lds + PG8_SA(b, h) + aoff + m * 2048 + k * 1024); } while (0)
#define PG8_LDB(dst, b, h) do { _Pragma("unroll") for (int n = 0; n < 2; ++n) _Pragma("unroll") for (int k = 0; k < 2; ++k) dst[n][k] = *(const PG8_LAS bf16x8*)(lds + PG8_SB(b, h) + boff + n * 2048 + k * 1024); } while (0)
#define PG8_MMA(ai, bj, At, Bt) do { __builtin_amdgcn_s_setprio(1); _Pragma("unroll") for (int m = 0; m < 4; ++m) _Pragma("unroll") for (int n = 0; n < 2; ++n) _Pragma("unroll") for (int k = 0; k < 2; ++k) \
        acc[ai][bj][m][n] = __builtin_amdgcn_mfma_f32_16x16x32_bf16(Bt[n][k], At[m][k], acc[ai][bj][m][n], 0, 0, 0); __builtin_amdgcn_s_setprio(0); } while (0)
#define PG8_WAIT_V(n) asm volatile("s_waitcnt vmcnt(" #n ")" ::: "memory")
#define PG8_WAIT_L(n) asm volatile("s_waitcnt lgkmcnt(" #n ")" ::: "memory")
#define PG8_BAR __builtin_amdgcn_s_barrier()
#define PG8_SCHED __builtin_amdgcn_sched_barrier(0)
    Unit cur, nxt; int ui = 0;
    if (!S.next(0, cur)) return;
    f32x4 acc[2][2][4][2];
#pragma unroll
    for (int a = 0; a < 2; ++a)
#pragma unroll
        for (int b = 0; b < 2; ++b)
#pragma unroll
            for (int m = 0; m < 4; ++m)
#pragma unroll
                for (int n = 0; n < 2; ++n) acc[a][b][m][n] = (f32x4){0.f, 0.f, 0.f, 0.f};
    bf16x8 At[4][2], B0[2][2], B1[2][2];
    const char* cA = (const char*)g.A + (size_t)cur.pm * tstep; const char* cB = (const char*)g.Bt + (size_t)cur.pn * tstep;
    S.a_ready(cur);
    if constexpr (SP2) {
        PG8_STAGE(PG8_SB(0, 0), cB, voffB); PG8_STAGE(PG8_SB(0, 1), cB + hstep, voffB); PG8_STAGE(PG8_SA(0, 0), cA, voffA); PG8_STAGE(PG8_SA(0, 1), cA + hstep, voffA);
        if (wr == 1) PG8_BAR;
        PG8_WAIT_V(2); PG8_BAR;
        PG8_STAGE(PG8_SB(1, 0), cB + kstep, voffB); PG8_STAGE(PG8_SA(1, 0), cA + kstep, voffA); PG8_STAGE(PG8_SB(1, 1), cB + hstep + kstep, voffB);
        PG8_WAIT_V(6); PG8_BAR;
    } else {
        PG8_STAGE(PG8_SB(0, 0), cB, voffB); PG8_STAGE(PG8_SA(0, 0), cA, voffA); PG8_STAGE(PG8_SB(0, 1), cB + hstep, voffB); PG8_STAGE(PG8_SA(0, 1), cA + hstep, voffA);
        if (wr == 1) PG8_BAR;
        PG8_WAIT_V(4); PG8_BAR;
        PG8_STAGE(PG8_SB(1, 0), cB + kstep, voffB); PG8_STAGE(PG8_SA(1, 0), cA + kstep, voffA); PG8_STAGE(PG8_SB(1, 1), cB + hstep + kstep, voffB);
        PG8_WAIT_V(6); PG8_BAR;
    }
    for (;;) {
        const bool has_next = S.next(ui + 1, nxt);
        const char* nA = has_next ? (const char*)g.A + (size_t)nxt.pm * tstep : cA; const char* nB = has_next ? (const char*)g.Bt + (size_t)nxt.pn * tstep : cB;
        for (int t = 0; t < nt; t += 2) {
            const bool last = (t == nt - 2);
            const char* a1 = cA + (size_t)(t + 1) * kstep;
            const char* a2 = last ? nA : cA + (size_t)(t + 2) * kstep; const char* b2 = last ? nB : cB + (size_t)(t + 2) * kstep;
            const char* a3 = a2 + kstep; const char* b3 = b2 + kstep;
            if (last && has_next) S.a_ready(nxt);
            if constexpr (SP2) {
            PG8_LDB(B0, 0, 0); PG8_LDB(B1, 0, 1); PG8_SCHED; PG8_LDA(At, 0, 0); PG8_STAGE(PG8_SA(1, 1), a1 + hstep, voffA);
            PG8_WAIT_V(8); PG8_WAIT_L(0); PG8_BAR; PG8_MMA(0, 0, At, B0); PG8_MMA(0, 1, At, B1); PG8_BAR; PG8_SCHED;
            PG8_LDA(At, 0, 1); PG8_STAGE(PG8_SB(0, 0), b2, voffB); PG8_STAGE(PG8_SB(0, 1), b2 + hstep, voffB); PG8_STAGE(PG8_SA(0, 0), a2, voffA);
            PG8_WAIT_V(8); PG8_WAIT_L(0); PG8_BAR; PG8_MMA(1, 0, At, B0); PG8_MMA(1, 1, At, B1); PG8_BAR; PG8_SCHED;
            PG8_LDB(B0, 1, 0); PG8_LDB(B1, 1, 1); PG8_SCHED; PG8_LDA(At, 1, 0); PG8_STAGE(PG8_SA(0, 1), a2 + hstep, voffA);
            PG8_WAIT_V(8); PG8_WAIT_L(0); PG8_BAR; PG8_MMA(0, 0, At, B0); PG8_MMA(0, 1, At, B1); PG8_BAR; PG8_SCHED;
            PG8_LDA(At, 1, 1); PG8_STAGE(PG8_SB(1, 0), b3, voffB); PG8_STAGE(PG8_SB(1, 1), b3 + hstep, voffB); PG8_STAGE(PG8_SA(1, 0), a3, voffA);
            PG8_WAIT_V(8); PG8_WAIT_L(0); PG8_BAR; PG8_MMA(1, 0, At, B0); PG8_MMA(1, 1, At, B1); PG8_BAR; PG8_SCHED;
            } else {
            PG8_LDB(B0, 0, 0); PG8_SCHED; PG8_LDA(At, 0, 0); PG8_STAGE(PG8_SA(1, 1), a1 + hstep, voffA);
            PG8_WAIT_L(8); PG8_BAR; PG8_WAIT_L(0); PG8_MMA(0, 0, At, B0); PG8_BAR; PG8_SCHED;
            PG8_LDB(B1, 0, 1); PG8_STAGE(PG8_SB(0, 0), b2, voffB);
            PG8_BAR; PG8_WAIT_L(0); PG8_MMA(0, 1, At, B1); PG8_BAR;
            PG8_LDA(At, 0, 1); PG8_STAGE(PG8_SA(0, 0), a2, voffA);
            PG8_BAR; PG8_WAIT_L(0); PG8_MMA(1, 0, At, B0); PG8_BAR; PG8_SCHED;
            PG8_STAGE(PG8_SB(0, 1), b2 + hstep, voffB);
            PG8_WAIT_V(6); PG8_BAR; PG8_MMA(1, 1, At, B1); PG8_BAR;
            PG8_LDB(B0, 1, 0); PG8_SCHED; PG8_LDA(At, 1, 0); PG8_STAGE(PG8_SA(0, 1), a2 + hstep, voffA);
            PG8_WAIT_L(8); PG8_BAR; PG8_WAIT_L(0); PG8_MMA(0, 0, At, B0); PG8_BAR; PG8_SCHED;
            PG8_LDB(B1, 1, 1); PG8_STAGE(PG8_SB(1, 0), b3, voffB);
            PG8_BAR; PG8_WAIT_L(0); PG8_MMA(0, 1, At, B1); PG8_BAR;
            PG8_LDA(At, 1, 1); PG8_STAGE(PG8_SA(1, 0), a3, voffA);
            PG8_BAR; PG8_WAIT_L(0); PG8_MMA(1, 0, At, B0); PG8_BAR; PG8_SCHED;
            PG8_STAGE(PG8_SB(1, 1), b3 + hstep, voffB);
            PG8_WAIT_V(6); PG8_BAR; PG8_MMA(1, 1, At, B1); PG8_BAR;
            }
        }
        if constexpr (ALIGN_EPI) { if (wr == 0) PG8_BAR; }
        if constexpr (!Epi::AFTER_DRAIN) { E(acc, cur, wr, wc, fr, fq); S.done(cur); }
        if (!has_next) break;
#pragma unroll
        for (int a = 0; a < 2; ++a)
#pragma unroll
            for (int b = 0; b < 2; ++b)
#pragma unroll
                for (int m = 0; m < 4; ++m)
#pragma unroll
                    for (int n = 0; n < 2; ++n) acc[a][b][m][n] = (f32x4){0.f, 0.f, 0.f, 0.f};
        cur = nxt; cA = nA; cB = nB; ++ui;
        if constexpr (ALIGN_EPI) { if (wr == 1) PG8_BAR; }
    }
    PG8_WAIT_V(0);
    if constexpr (!ALIGN_EPI) { if (wr == 0) PG8_BAR; }
    PG8_BAR;
    if constexpr (Epi::AFTER_DRAIN) { E.fused(acc, cur, wr, wc, fr, fq, lds, wid, lane); S.done(cur); }
#undef PG8_SA
#undef PG8_SB
#undef PG8_STAGE
#undef PG8_LDA
#undef PG8_LDB
#undef PG8_MMA
#undef PG8_WAIT_V
#undef PG8_WAIT_L
#undef PG8_BAR
#undef PG8_SCHED
}
}
namespace attn64 {
using bf16=__hip_bfloat16;
using bf16x8=__attribute__((ext_vector_type(8)))short;
using s16x4=__attribute__((ext_vector_type(4)))short;
using f32x16=__attribute__((ext_vector_type(16)))float;
using u32x4=__attribute__((ext_vector_type(4)))unsigned;
constexpr int D=64,QP=1024,KP=128;
constexpr int NW=8,QBLK=32,QB=QBLK*NW,KVBLK=64;
__device__ __forceinline__ int crow(int r,int hi){return (r&3)+8*(r>>2)+4*hi;}
#define SBAR() __builtin_amdgcn_sched_barrier(0)
constexpr int NSLOT=3, SLOTB=8192;
constexpr int LDS_K=0, LDS_V=NSLOT*SLOTB, LDS_WS=2*NSLOT*SLOTB, LDS_OST=LDS_WS+NW*64*4, LDS_BYTES=LDS_OST+NW*4096;
constexpr float C2=0.125f*1.4426950408889634f;
__device__ __forceinline__ void glds16(const void*gsrc,unsigned lds_dst){unsigned keep;
  asm volatile("s_mov_b32 %0, m0\n\ts_mov_b32 m0, %2\n\ts_nop 0\n\tglobal_load_lds_dwordx4 %1, off\n\ts_mov_b32 m0, %0":"=&s"(keep):"v"(gsrc),"s"(lds_dst):"memory");}
__device__ __forceinline__ float max3f(float a,float b,float c){float r;asm("v_max3_f32 %0, %1, %2, %3":"=v"(r):"v"(a),"v"(b),"v"(c));return r;}
__device__ __forceinline__ float max2f(float a,float b){float r;asm("v_max_f32_e32 %0, %1, %2":"=v"(r):"v"(a),"v"(b));return r;}
__device__ __forceinline__ float fadd_s(float a,float b){float r;asm("v_add_f32_e32 %0, %1, %2":"=v"(r):"v"(a),"v"(b));return r;}
__device__ __forceinline__ float fsub_s(float a,float b){float r;asm("v_sub_f32_e32 %0, %1, %2":"=v"(r):"v"(a),"v"(b));return r;}
typedef float f32x2_t __attribute__((ext_vector_type(2))); typedef __bf16 bf16x2_t __attribute__((ext_vector_type(2)));
__device__ __forceinline__ unsigned cvtpk_s(float lo,float hi){f32x2_t v={lo,hi};bf16x2_t b=__builtin_convertvector(v,bf16x2_t);return __builtin_bit_cast(unsigned,b);}
#define WAIT_BAR(N) asm volatile("s_waitcnt vmcnt(" #N ") lgkmcnt(0)\n\ts_barrier":::"memory")

__device__ __forceinline__ void qkt(f32x16&p0,f32x16&p1,const char*Kslot,const bf16x8*qr,const f32x16&negm,int r32,int hi){
  const char*kb=Kslot+hi*1024+r32*16;
  #pragma unroll
  for(int d0=0;d0<4;++d0){
    const bf16x8 b0=*reinterpret_cast<const bf16x8*>(kb+d0*2048);
    const bf16x8 b1=*reinterpret_cast<const bf16x8*>(kb+d0*2048+512);
    if(d0==0){p0=__builtin_amdgcn_mfma_f32_32x32x16_bf16(b0,qr[0],negm,0,0,0);p1=__builtin_amdgcn_mfma_f32_32x32x16_bf16(b1,qr[0],negm,0,0,0);}
    else{p0=__builtin_amdgcn_mfma_f32_32x32x16_bf16(b0,qr[d0],p0,0,0,0);p1=__builtin_amdgcn_mfma_f32_32x32x16_bf16(b1,qr[d0],p1,0,0,0);}}
}
typedef __attribute__((address_space(3))) const char* lds_cptr;
typedef short v4i16_t __attribute__((ext_vector_type(4)));
__device__ __forceinline__ void kload8(bf16x8*kf,lds_cptr kp){
  kf[0]=*(const __attribute__((address_space(3))) bf16x8*)(kp);      kf[1]=*(const __attribute__((address_space(3))) bf16x8*)(kp+512);
  kf[2]=*(const __attribute__((address_space(3))) bf16x8*)(kp+2048); kf[3]=*(const __attribute__((address_space(3))) bf16x8*)(kp+2560);
  kf[4]=*(const __attribute__((address_space(3))) bf16x8*)(kp+4096); kf[5]=*(const __attribute__((address_space(3))) bf16x8*)(kp+4608);
  kf[6]=*(const __attribute__((address_space(3))) bf16x8*)(kp+6144); kf[7]=*(const __attribute__((address_space(3))) bf16x8*)(kp+6656);
}
__device__ __forceinline__ void kload2(bf16x8*kf,lds_cptr kp,int j){ kf[2*j]=*(const __attribute__((address_space(3))) bf16x8*)(kp+j*2048); kf[2*j+1]=*(const __attribute__((address_space(3))) bf16x8*)(kp+j*2048+512); }
__device__ __forceinline__ s16x4 vtr(lds_cptr p){ return __builtin_bit_cast(s16x4,__builtin_amdgcn_ds_read_tr16_b64_v4i16((__attribute__((address_space(3))) v4i16_t*)p)); }
__device__ __forceinline__ float rowmax(const f32x16&p0,const f32x16&p1){
  float a=max3f(p0[0],p0[1],p1[0]),b=max3f(p0[2],p0[3],p1[1]);a=max3f(a,p1[2],p1[3]);
  #pragma unroll
  for(int r=4;r<16;r+=4){a=max3f(a,p0[r],p0[r+1]);b=max3f(b,p0[r+2],p0[r+3]);a=max3f(a,p1[r],p1[r+1]);b=max3f(b,p1[r+2],p1[r+3]);}
  const float m=max2f(a,b);
  auto rr=__builtin_amdgcn_permlane32_swap(__float_as_uint(m),__float_as_uint(m),false,false);
  return max2f(__uint_as_float(rr[0]),__uint_as_float(rr[1]));
}
__device__ __forceinline__ void pv(f32x16*o,int vb,bf16x8 pa0,bf16x8 pa1,bf16x8 pa2,bf16x8 pa3){
  #pragma unroll
  for(int d0=0;d0<2;++d0){s16x4 lo[4],hi[4];
    #pragma unroll
    for(int ks=0;ks<4;++ks){
      asm volatile("ds_read_b64_tr_b16 %0,%1 offset:%c2":"=&v"(lo[ks]):"v"(vb),"i"(d0*4096+ks*1024):"memory");
      asm volatile("ds_read_b64_tr_b16 %0,%1 offset:%c2":"=&v"(hi[ks]):"v"(vb),"i"(d0*4096+ks*1024+512):"memory");}
    asm volatile("s_waitcnt lgkmcnt(0)":::"memory");SBAR();
    #define PK(k) (bf16x8){lo[k][0],lo[k][1],lo[k][2],lo[k][3],hi[k][0],hi[k][1],hi[k][2],hi[k][3]}
    o[d0]=__builtin_amdgcn_mfma_f32_32x32x16_bf16(pa0,PK(0),o[d0],0,0,0);
    o[d0]=__builtin_amdgcn_mfma_f32_32x32x16_bf16(pa1,PK(1),o[d0],0,0,0);
    o[d0]=__builtin_amdgcn_mfma_f32_32x32x16_bf16(pa2,PK(2),o[d0],0,0,0);
    o[d0]=__builtin_amdgcn_mfma_f32_32x32x16_bf16(pa3,PK(3),o[d0],0,0,0);
    #undef PK
  }
}

#ifndef ATTN_STORE16
#define ATTN_STORE16(p,v) (*(u32x4*)(p)=(v))
#endif
template<int THRL> __device__ __forceinline__ void attn_unit(const bf16*Q0,bf16*O0,const bf16*__restrict__ Kh,const bf16*__restrict__ Vh,const int NT,char*shm,const float mref){
  int tid_=threadIdx.x; asm volatile("":"+v"(tid_)); const int tid=tid_,lane=tid&63,r32=lane&31,hi=lane>>5; const int wid=__builtin_amdgcn_readfirstlane(tid>>6);
  const bf16*Qw=Q0+(long)(wid*QBLK)*QP;
  const unsigned lds0=(unsigned)(uintptr_t)shm;
  float*wsf=(float*)(shm+LDS_WS)+wid*64;
  const bf16*ksrc=Kh+(long)lane*KP+wid*8;
  const bf16*vsrc=Vh+(long)(16*(wid&3)+(lane>>2))*KP+(wid>>2)*32+(lane&3)*8;
  const unsigned kdst=lds0+LDS_K+wid*1024, vdst=lds0+LDS_V+wid*1024;
  #define DMA_K(t,slot) glds16(ksrc+(long)(t)*KVBLK*KP,(unsigned)__builtin_amdgcn_readfirstlane(kdst+(slot)))
  #define DMA_V(t,slot) glds16(vsrc+(long)(t)*KVBLK*KP,(unsigned)__builtin_amdgcn_readfirstlane(vdst+(slot)))
  const int vb0=(int)(lds0+LDS_V)+((lane>>4)&1)*32+(lane&3)*8+(4*hi+((lane&15)>>2))*64;
  const char*Kbase=shm+LDS_K; bf16x8 kf[8];
  const lds_cptr shm3=(lds_cptr)shm; const lds_cptr kp0=shm3+LDS_K+hi*1024+r32*16; const lds_cptr vp0=shm3+LDS_V+((lane>>4)&1)*32+(lane&3)*8+(4*hi+((lane&15)>>2))*64;
  DMA_K(0,0);DMA_V(0,0);DMA_K(1,SLOTB);
  bf16x8 qr[4];
  #pragma unroll
  for(int d0=0;d0<4;++d0)qr[d0]=*reinterpret_cast<const bf16x8*>(&Qw[(long)r32*QP+d0*16+hi*8]);
  float l_reg=0.f;f32x16 o[2];o[0]=f32x16{};o[1]=f32x16{};f32x16 negm;
  _Pragma("unroll") for(int r=0;r<16;++r)negm[r]=-mref;
  asm volatile("":"+v"(negm));
  #define CMASK(P0,P1,t) do{}while(0)
  #define START(P0,P1) do{ _Pragma("unroll") for(int r=0;r<16;++r)P0[r]=__builtin_amdgcn_exp2f(P0[r]); }while(0)
  #define RESC() do{}while(0)
  f32x16 pA0,pA1,pB0,pB1;
  int sl_prev=0,sl_cur=0,sl_next=SLOTB;
  #define ROT() do{sl_prev=sl_cur;sl_cur=sl_next;sl_next=(sl_next==(NSLOT-1)*SLOTB)?0:sl_next+SLOTB;}while(0)
  DMA_K(2,2*SLOTB);
  WAIT_BAR(3);
  qkt(pA0,pA1,Kbase,qr,negm,r32,hi);asm volatile("s_nop 15\n\ts_nop 7":"+v"(pA0),"+v"(pA1));CMASK(pA0,pA1,0);
  START(pA0,pA1);
  _Pragma("unroll") for(int r=0;r<16;++r)pA1[r]=__builtin_amdgcn_exp2f(pA1[r]);
  WAIT_BAR(0);
  DMA_K(3,0);DMA_V(1,SLOTB);
  ROT();
  kload8(kf,kp0+sl_cur);
  WAIT_BAR(2);
  s16x4 vlo[8],vhi[8]; u32x4 pw0,pw1,pw2,pw3;
  #define PKW(P,B) cvtpk_s(P[B],P[B+1])
  #define PAF(k) __builtin_bit_cast(bf16x8,pw##k)
  #define VFR(i) (bf16x8){vlo[i][0],vlo[i][1],vlo[i][2],vlo[i][3],vhi[i][0],vhi[i][1],vhi[i][2],vhi[i][3]}
  #define PIN(x) asm volatile("":"+v"(x))
  #define MX3(a,b,c) __builtin_fmaxf(__builtin_fmaxf((a),(b)),(c))
  #define GAPA(MF,A0,A1,A2,A3,W0,W1,PW) do{ MF; sacc+=A0; sacc+=A1; sacc+=A2; sacc+=A3; PIN(sacc); W0; W1; PIN(PW); SBAR(); }while(0)
  #define EX(v) __builtin_amdgcn_exp2f(v)
  #define GAPB(MF,X,B) do{ MF; X[B]=EX(X[B]); X[B+1]=EX(X[B+1]); X[B+2]=EX(X[B+2]); X[B+3]=EX(X[B+3]); PIN(X); SBAR(); }while(0)
  #define VRD(i) do{ vlo[i]=vtr(vp_+(((i)>>2)*4096+((i)&3)*1024)); vhi[i]=vtr(vp_+(((i)>>2)*4096+((i)&3)*1024+512)); }while(0)
  #define KRD(G,j) do{ if(G){ kload2(kf,kp0+sl_next,j); SBAR(); } }while(0)
  #define STEP(C0,C1,P0,P1,t,GK,GV,GL) do{ SBAR(); \
    const lds_cptr vp_=vp0+sl_prev; \
    VRD(0); SBAR(); float sacc=(P0[0]+P0[1]); \
    GAPA(C0=__builtin_amdgcn_mfma_f32_32x32x16_bf16(kf[0],qr[0],negm,0,0,0), P0[2],P0[3],P0[4],P0[5],     pw0[0]=PKW(P0,0), pw0[1]=PKW(P0,2), pw0); \
    VRD(4); SBAR(); GAPA(C1=__builtin_amdgcn_mfma_f32_32x32x16_bf16(kf[1],qr[0],negm,0,0,0), P0[6],P0[7],P0[8],P0[9],     pw0[2]=PKW(P0,4), pw0[3]=PKW(P0,6), pw0); \
    VRD(1); SBAR(); GAPA(C0=__builtin_amdgcn_mfma_f32_32x32x16_bf16(kf[2],qr[1],C0,0,0,0),   P0[10],P0[11],P0[12],P0[13], pw1[0]=PKW(P0,8), pw1[1]=PKW(P0,10), pw1); \
    VRD(5); SBAR(); GAPA(C1=__builtin_amdgcn_mfma_f32_32x32x16_bf16(kf[3],qr[1],C1,0,0,0),   P0[14],P0[15],P1[0],P1[1],   pw1[2]=PKW(P0,12),pw1[3]=PKW(P0,14), pw1); \
    VRD(2); SBAR(); GAPA(C0=__builtin_amdgcn_mfma_f32_32x32x16_bf16(kf[4],qr[2],C0,0,0,0),   P1[2],P1[3],P1[4],P1[5],     pw2[0]=PKW(P1,0), pw2[1]=PKW(P1,2), pw2); \
    VRD(6); SBAR(); GAPA(C1=__builtin_amdgcn_mfma_f32_32x32x16_bf16(kf[5],qr[2],C1,0,0,0),   P1[6],P1[7],P1[8],P1[9],     pw2[2]=PKW(P1,4), pw2[3]=PKW(P1,6), pw2); \
    VRD(3); SBAR(); GAPA(C0=__builtin_amdgcn_mfma_f32_32x32x16_bf16(kf[6],qr[3],C0,0,0,0),   P1[10],P1[11],P1[12],P1[13], pw3[0]=PKW(P1,8), pw3[1]=PKW(P1,10), pw3); \
    VRD(7); SBAR(); GAPA(C1=__builtin_amdgcn_mfma_f32_32x32x16_bf16(kf[7],qr[3],C1,0,0,0),   P1[14],P1[15],0.f,0.f,       pw3[2]=PKW(P1,12),pw3[3]=PKW(P1,14), pw3); \
    l_reg+=sacc; \
    if(GK){DMA_K((t)+3,sl_cur);} if(GV){DMA_V((t)+1,sl_next);} \
    CMASK(C0,C1,t); \
    SBAR(); \
    GAPB(o[0]=__builtin_amdgcn_mfma_f32_32x32x16_bf16(PAF(0),VFR(0),o[0],0,0,0), C0,0); \
    GAPB(o[1]=__builtin_amdgcn_mfma_f32_32x32x16_bf16(PAF(0),VFR(4),o[1],0,0,0), C0,4); \
    KRD(GL,0); GAPB(o[0]=__builtin_amdgcn_mfma_f32_32x32x16_bf16(PAF(1),VFR(1),o[0],0,0,0), C0,8); \
    KRD(GL,1); GAPB(o[1]=__builtin_amdgcn_mfma_f32_32x32x16_bf16(PAF(1),VFR(5),o[1],0,0,0), C0,12); \
    KRD(GL,2); GAPB(o[0]=__builtin_amdgcn_mfma_f32_32x32x16_bf16(PAF(2),VFR(2),o[0],0,0,0), C1,0); \
    KRD(GL,3); GAPB(o[1]=__builtin_amdgcn_mfma_f32_32x32x16_bf16(PAF(2),VFR(6),o[1],0,0,0), C1,4); \
    GAPB(o[0]=__builtin_amdgcn_mfma_f32_32x32x16_bf16(PAF(3),VFR(3),o[0],0,0,0), C1,8); \
    GAPB(o[1]=__builtin_amdgcn_mfma_f32_32x32x16_bf16(PAF(3),VFR(7),o[1],0,0,0), C1,12); \
    }while(0)
  int t=1;
  for(;t+5<NT;t+=2){
    STEP(pB0,pB1,pA0,pA1,t,true,true,true);     WAIT_BAR(2); RESC(); ROT();
    STEP(pA0,pA1,pB0,pB1,t+1,true,true,true);   WAIT_BAR(2); RESC(); ROT();
  }
  #define ENDW(tt) do{ if((tt)+3<NT){WAIT_BAR(2);} else if((tt)+2<NT){WAIT_BAR(1);} else {WAIT_BAR(0);} }while(0)
  for(;t+1<NT;t+=2){
    STEP(pB0,pB1,pA0,pA1,t,(t+3<NT),(t+1<NT),(t+1<NT));       ENDW(t);   RESC(); ROT();
    STEP(pA0,pA1,pB0,pB1,t+1,(t+4<NT),(t+2<NT),(t+2<NT));     ENDW(t+1); RESC(); ROT();
  }
  STEP(pB0,pB1,pA0,pA1,NT-1,false,false,false); RESC();
  { float sacc=pB0[0]+pB0[1]; _Pragma("unroll") for(int r=2;r<16;++r)sacc+=pB0[r]; _Pragma("unroll") for(int r=0;r<16;++r)sacc+=pB1[r]; l_reg+=sacc;
    pw0=(u32x4){PKW(pB0,0),PKW(pB0,2),PKW(pB0,4),PKW(pB0,6)};pw1=(u32x4){PKW(pB0,8),PKW(pB0,10),PKW(pB0,12),PKW(pB0,14)};pw2=(u32x4){PKW(pB1,0),PKW(pB1,2),PKW(pB1,4),PKW(pB1,6)};pw3=(u32x4){PKW(pB1,8),PKW(pB1,10),PKW(pB1,12),PKW(pB1,14)};
    SBAR(); pv(o,vb0+sl_cur,PAF(0),PAF(1),PAF(2),PAF(3)); }
  #undef PKW
  #undef PAF
  #undef VFR
  #undef PIN
  #undef MX3
  #undef GAPA
  #undef GAPB
  #undef EX
  #undef VRD
  #undef KRD
  #undef STEP
  #undef ENDW
  {auto rr=__builtin_amdgcn_permlane32_swap(__float_as_uint(l_reg),__float_as_uint(l_reg),false,false);l_reg=__uint_as_float(rr[0])+__uint_as_float(rr[1]);}
  if(hi==0)wsf[32+r32]=l_reg;asm volatile("s_waitcnt lgkmcnt(0)":::"memory");
  float rli[16];
  #pragma unroll
  for(int r=0;r<16;++r)rli[r]=__builtin_amdgcn_rcpf(wsf[32+crow(r,hi)]);
  bf16*Ow=O0+(long)(wid*QBLK)*QP;
  { bf16*stg=(bf16*)(shm+LDS_OST)+wid*2048;
    #pragma unroll
    for(int r=0;r<16;++r){const int orow=crow(r,hi);
      #pragma unroll
      for(int d0=0;d0<2;++d0)stg[orow*64+d0*32+r32]=__float2bfloat16(o[d0][r]*rli[r]);}
    asm volatile("s_waitcnt lgkmcnt(0)":::"memory");
    #pragma unroll
    for(int i=0;i<4;++i){const int row=i*8+(lane>>3),ch=lane&7; const u32x4 v=*(const u32x4*)(stg+row*64+ch*8); ATTN_STORE16(Ow+(long)row*QP+ch*8,v);} }
  asm volatile("s_waitcnt lgkmcnt(0)\n\ts_barrier":::"memory");
  #undef DMA_K
  #undef DMA_V
  #undef CMASK
  #undef START
  #undef RESC
  #undef ROT
}

typedef int i32x8 __attribute__((ext_vector_type(8)));
__device__ __forceinline__ void attn_unit8(const unsigned char*Q8,bf16*O0,const unsigned char*K8,const unsigned char*V8,const int NT,char*shm,const float mref){
  int tid_=threadIdx.x; asm volatile("":"+v"(tid_)); const int tid=tid_,lane=tid&63,r32=lane&31,hi=lane>>5; const int wid=__builtin_amdgcn_readfirstlane(tid>>6);
  const unsigned lds0=(unsigned)(uintptr_t)shm; const lds_cptr shm3=(lds_cptr)shm;
  constexpr int SL=8192, OST=32768, LWS=65536;
  const unsigned char*dsrc=(wid<4)?(K8+(long)lane*128+wid*16):(V8+(long)lane*64+(wid-4)*16); const long dstep=(wid<4)?(long)64*128:(long)4096;
  const unsigned ddst=lds0+((wid<4)?wid*1024:4096+(wid-4)*1024);
  #define DMA8(t) glds16(dsrc+(long)(t)*dstep,(unsigned)__builtin_amdgcn_readfirstlane(ddst+((t)&3)*SL))
  DMA8(0); if(1<NT)DMA8(1); if(2<NT)DMA8(2);
  const unsigned char*qp=Q8+(long)(wid*32+r32)*512+32*hi; const u32x4 q0=*(const u32x4*)qp,q1=*(const u32x4*)(qp+16);
  const i32x8 qf={(int)q0[0],(int)q0[1],(int)q0[2],(int)q0[3],(int)q1[0],(int)q1[1],(int)q1[2],(int)q1[3]};
  f32x16 o0=f32x16{},o1=f32x16{},negm; float l_reg=0.f;
  _Pragma("unroll") for(int r=0;r<16;++r)negm[r]=15.0f-mref;
  asm volatile("":"+v"(negm));
  asm volatile("s_waitcnt vmcnt(0)":::"memory");
  for(int t=0;t<NT;++t){
    if(t+2<NT)asm volatile("s_waitcnt vmcnt(2) lgkmcnt(0)\n\ts_barrier":::"memory"); else if(t+1<NT)asm volatile("s_waitcnt vmcnt(1) lgkmcnt(0)\n\ts_barrier":::"memory"); else asm volatile("s_waitcnt vmcnt(0) lgkmcnt(0)\n\ts_barrier":::"memory");
    if(t+3<NT)DMA8(t+3);
    const lds_cptr ks=shm3+(t&3)*SL+(2*hi)*1024+r32*16, vs=shm3+(t&3)*SL+4096+(2*hi)*1024+r32*16;
    typedef __attribute__((address_space(3))) const u32x4* l4p;
    const u32x4 ka=*(l4p)(ks),kb=*(l4p)(ks+1024),kc=*(l4p)(ks+512),kd=*(l4p)(ks+1024+512);
    const i32x8 kf0={(int)ka[0],(int)ka[1],(int)ka[2],(int)ka[3],(int)kb[0],(int)kb[1],(int)kb[2],(int)kb[3]}, kf1={(int)kc[0],(int)kc[1],(int)kc[2],(int)kc[3],(int)kd[0],(int)kd[1],(int)kd[2],(int)kd[3]};
    f32x16 p0=__builtin_amdgcn_mfma_scale_f32_32x32x64_f8f6f4(kf0,qf,negm,0,0,0,0,0,0);
    f32x16 p1=__builtin_amdgcn_mfma_scale_f32_32x32x64_f8f6f4(kf1,qf,negm,0,0,0,0,0,0);
    const u32x4 va=*(l4p)(vs),vb=*(l4p)(vs+1024),vc=*(l4p)(vs+512),vd=*(l4p)(vs+1024+512);
    const i32x8 vf0={(int)va[0],(int)va[1],(int)va[2],(int)va[3],(int)vb[0],(int)vb[1],(int)vb[2],(int)vb[3]}, vf1={(int)vc[0],(int)vc[1],(int)vc[2],(int)vc[3],(int)vd[0],(int)vd[1],(int)vd[2],(int)vd[3]};
    _Pragma("unroll") for(int r=0;r<16;++r){p0[r]=__builtin_amdgcn_exp2f(p0[r]);p1[r]=__builtin_amdgcn_exp2f(p1[r]);}
    float sa=p0[0]+p0[1],sb=p1[0]+p1[1];
    _Pragma("unroll") for(int r=2;r<16;++r){sa+=p0[r];sb+=p1[r];}
    l_reg+=sa+sb;
    i32x8 pw;
    _Pragma("unroll") for(int j=0;j<4;++j){int w=0;w=__builtin_amdgcn_cvt_pk_bf8_f32(p0[4*j],p0[4*j+1],w,false);w=__builtin_amdgcn_cvt_pk_bf8_f32(p0[4*j+2],p0[4*j+3],w,true);pw[j]=w;
      int v=0;v=__builtin_amdgcn_cvt_pk_bf8_f32(p1[4*j],p1[4*j+1],v,false);v=__builtin_amdgcn_cvt_pk_bf8_f32(p1[4*j+2],p1[4*j+3],v,true);pw[4+j]=v;}
    o0=__builtin_amdgcn_mfma_scale_f32_32x32x64_f8f6f4(pw,vf0,o0,1,0,0,0,0,0);
    o1=__builtin_amdgcn_mfma_scale_f32_32x32x64_f8f6f4(pw,vf1,o1,1,0,0,0,0,0);
  }
  #undef DMA8
  float*wsf=(float*)(shm+LWS)+wid*64;
  {auto rr=__builtin_amdgcn_permlane32_swap(__float_as_uint(l_reg),__float_as_uint(l_reg),false,false);l_reg=__uint_as_float(rr[0])+__uint_as_float(rr[1]);}
  if(hi==0)wsf[r32]=l_reg;asm volatile("s_waitcnt lgkmcnt(0)":::"memory");
  float rli[16];
  #pragma unroll
  for(int r=0;r<16;++r)rli[r]=__builtin_amdgcn_rcpf(wsf[crow(r,hi)]);
  bf16*Ow=O0+(long)(wid*32)*QP;
  { bf16*stg=(bf16*)(shm+OST)+wid*2048;
    #pragma unroll
    for(int r=0;r<16;++r){const int orow=crow(r,hi); stg[orow*64+r32]=__float2bfloat16(o0[r]*rli[r]); stg[orow*64+32+r32]=__float2bfloat16(o1[r]*rli[r]);}
    asm volatile("s_waitcnt lgkmcnt(0)":::"memory");
    #pragma unroll
    for(int i=0;i<4;++i){const int row=i*8+(lane>>3),ch=lane&7; const u32x4 v=*(const u32x4*)(stg+row*64+ch*8); *(u32x4*)(Ow+(long)row*QP+ch*8)=v;} }
  asm volatile("s_waitcnt lgkmcnt(0)\n\ts_barrier":::"memory");
}
constexpr int ATTN_LDS_BYTES=LDS_BYTES;
#undef SBAR
#undef WAIT_BAR
}
#define GAS __attribute__((address_space(1)))
#define LAS __attribute__((address_space(3)))
typedef unsigned short bf16;
typedef unsigned v4u __attribute__((ext_vector_type(4)));
typedef float f32x4 __attribute__((ext_vector_type(4)));
typedef short bf16x8 __attribute__((ext_vector_type(8)));
typedef GAS unsigned gu32;
typedef GAS unsigned long long gu64;
#define RLX_AGENT __ATOMIC_RELAXED, __HIP_MEMORY_SCOPE_AGENT
#define LDS_WAIT() asm volatile("s_waitcnt lgkmcnt(0)" ::: "memory")
#define VM_WAIT() asm volatile("s_waitcnt vmcnt(0)" ::: "memory")
__device__ __forceinline__ unsigned long long rt() { return __builtin_amdgcn_s_memrealtime(); }
__device__ __forceinline__ unsigned f2bf(float f) { unsigned u = __builtin_bit_cast(unsigned, f); return (u + 0x7fffu + ((u >> 16) & 1u)) >> 16; }
typedef float pk_f32x2_t __attribute__((ext_vector_type(2))); typedef __bf16 pk_bf16x2_t __attribute__((ext_vector_type(2)));
__device__ __forceinline__ unsigned pk2(float lo, float hi) { pk_f32x2_t v = {lo, hi}; pk_bf16x2_t b = __builtin_convertvector(v, pk_bf16x2_t); return __builtin_bit_cast(unsigned, b); }
#define XB_TMO      128
#define XB_XCNT(j)  (256  + 64 * (j))
#define XB_XSUB(j)  (1280 + 64 * (j))
#define XB_XGEN(j)  (2304 + 64 * (j))
#define XB_TOP      3328
#define XB_TOPGEN   3392
#define XCD_BAR_WORDS 3456
#define XB_SPIN_CAP (1u << 18)

__device__ __forceinline__ unsigned xb_ld(unsigned* p)              { return __hip_atomic_load(p, __ATOMIC_RELAXED, __HIP_MEMORY_SCOPE_AGENT); }
__device__ __forceinline__ unsigned xb_add(unsigned* p, unsigned v) { return __hip_atomic_fetch_add(p, v, __ATOMIC_RELAXED, __HIP_MEMORY_SCOPE_AGENT); }
__device__ __forceinline__ unsigned xb_xcc_id() { return (unsigned)__builtin_amdgcn_s_getreg((3 << 11) | 20) & 0xFu; }
#define XB_SPIN(cond, bar) do { unsigned _sp = 0; while (cond) { __builtin_amdgcn_s_sleep(1); \
    if ((++_sp & 255u) == 0u) { if (xb_ld(&(bar)[XB_TMO])) break; if (_sp > XB_SPIN_CAP) { atomicAdd(&(bar)[XB_TMO], 1u); break; } } } } while (0)

struct XcdBarrier {
    unsigned* bar; unsigned x;
    volatile LAS unsigned* st;
};

__device__ __forceinline__ XcdBarrier xcd_barrier_post(unsigned* bar, volatile LAS unsigned* st) {
    XcdBarrier b; b.bar = bar; b.x = xb_xcc_id(); b.st = st;
    if (threadIdx.x == 0) (void)xb_add(&bar[XB_XCNT(b.x)], 1u);
    return b;
}
__device__ __forceinline__ void xcd_barrier_complete(unsigned* bar, unsigned x, unsigned& nloc, unsigned& nx) {
    const unsigned G = gridDim.x * gridDim.y * gridDim.z;
    unsigned sum, cnt, mine, sp = 0u;
    for (;;) {
        sum = 0u; cnt = 0u; mine = 0u;
#pragma unroll
        for (unsigned j = 0; j < 16; ++j) { const unsigned c = xb_ld(&bar[XB_XCNT(j)]); sum += c; cnt += (c > 0u) ? 1u : 0u; mine = (j == x) ? c : mine; }
        if (sum == G) break;
        __builtin_amdgcn_s_sleep(1);
        if ((++sp & 255u) == 0u) { if (xb_ld(&bar[XB_TMO])) break; if (sp > XB_SPIN_CAP) { atomicAdd(&bar[XB_TMO], 1u); break; } }
    }
    nloc = mine > 0u ? mine : 1u; nx = cnt > 0u ? cnt : 1u;
}

__device__ __forceinline__ void xcd_barrier(const XcdBarrier& b) {
    asm volatile("s_waitcnt vmcnt(0)" ::: "memory");
    __syncthreads();
    if (threadIdx.x == 0) {
        unsigned* bar = b.bar;
        __builtin_amdgcn_s_waitcnt(0);
        unsigned nloc = b.st[0], nx = b.st[1];
        if (nloc == 0u) { xcd_barrier_complete(bar, b.x, nloc, nx); b.st[0] = nloc; b.st[1] = nx; }
        const unsigned old = xb_add(&bar[XB_XSUB(b.x)], 1u);
        const unsigned gen = old / nloc;
        if (old + 1u == (gen + 1u) * nloc) {
            __builtin_amdgcn_fence(__ATOMIC_RELEASE, "agent");
            asm volatile("s_waitcnt vmcnt(0)" ::: "memory");
            const unsigned og = xb_add(&bar[XB_TOP], 1u);
            const unsigned tg = og / nx;
            if (og + 1u == (tg + 1u) * nx) xb_add(&bar[XB_TOPGEN], 1u);
            else XB_SPIN(xb_ld(&bar[XB_TOPGEN]) == tg, bar);
            __builtin_amdgcn_fence(__ATOMIC_ACQUIRE, "agent");
            xb_add(&bar[XB_XGEN(b.x)], 1u);
            asm volatile("s_waitcnt vmcnt(0)" ::: "memory");
        } else {
            XB_SPIN(xb_ld(&bar[XB_XGEN(b.x)]) == gen, bar);
            __builtin_amdgcn_fence(__ATOMIC_ACQUIRE, "agent");
            asm volatile("s_waitcnt vmcnt(0)" ::: "memory");
        }
    }
    __syncthreads();
}
constexpr int NB = 4, T = 8192, LC = 256, D = 1024, NLAYER = 2;
constexpr int ML = NB * T, MC = NB * LC, MT = ML + MC;
constexpr int NIN = 2848, NINP = 3072;
constexpr int FF = 2816, EF = 3584, NE = 8;
constexpr int TK = T + LC;
constexpr int NCH = TK / 64;
constexpr float EPS = 1e-6f;
constexpr float QSCALE = 0.125f * 1.4426950408889634f;

constexpr int NWAVES = 8;
constexpr int LDS_BYTES = 147456;
constexpr int RING_BYTES = 131072, LDSCTL_OFF = RING_BYTES, MISC_OFF = LDSCTL_OFF + 320;

constexpr size_t MiB = 1u << 20;
constexpr size_t CTL_ZERO_BYTES = 1 * MiB;
constexpr int CW_BAR = 4096;
constexpr int CW_CNT = 16384;
constexpr int CW_Q = 17408;
constexpr size_t WS_MODS = 1 * MiB;
constexpr size_t WS_ROUTE = 1 * MiB + 512 * 1024;
constexpr size_t WS_RW = WS_ROUTE + (size_t)ML * 16;
constexpr size_t WS_POS = WS_RW + (size_t)ML * 8;
constexpr size_t WS_XC = 3 * MiB;
constexpr size_t WS_ROPE = 7 * MiB;
constexpr size_t WS_WIN = 9 * MiB;
constexpr size_t WS_WOUT = 21 * MiB;
constexpr size_t WS_WGU = 25 * MiB;
constexpr size_t WS_WD = 36 * MiB;
constexpr size_t WS_G = 42 * MiB;
constexpr size_t WS_BETA = WS_G + (size_t)2 * MT * 8 * 4;
constexpr size_t WS_AB = 47 * MiB;
constexpr size_t WS_KALL = 52 * MiB;
constexpr size_t WS_VALL = 61 * MiB;
constexpr size_t WS_DYN = 70 * MiB;
constexpr size_t WS_XN = WS_DYN;
constexpr size_t WS_OF = WS_XN, WS_OB = WS_XN + 33 * MiB;
constexpr size_t WS_DNRAW = WS_XN + 66 * MiB;
constexpr size_t WS_QRAW = WS_DNRAW + 99 * MiB;
constexpr size_t WS_KVRAW = WS_QRAW + 33 * MiB;
constexpr size_t WS_U = WS_DNRAW, WS_W = WS_DNRAW + 66 * MiB;
constexpr size_t WS_ZB = WS_KVRAW + 17 * MiB;
constexpr size_t WS_QDN = WS_ZB + 33 * MiB;
constexpr size_t WS_KDN = WS_QDN + 33 * MiB;
constexpr size_t WS_KT = WS_KDN + 33 * MiB;
constexpr size_t WS_VT = WS_KT + 33 * MiB;
constexpr size_t WS_MIX = WS_VT + 33 * MiB;
constexpr size_t WS_MIX_END = WS_MIX + 66 * MiB;
constexpr size_t WS_GCB = WS_MIX_END + 1 * MiB;
constexpr size_t WS_H = WS_DNRAW;
constexpr size_t WS_XB2 = WS_DYN;
constexpr size_t WS_MGU = WS_DYN + 64 * MiB;
constexpr size_t WS_MD = WS_MGU + 112 * MiB;
constexpr size_t WS_XS = WS_MD + 56 * MiB;
constexpr int SS_PANELS = 64, NSS = 5;
constexpr size_t WS_HM = WS_XS + 132 * MiB;
constexpr size_t WS_END = WS_HM + 112 * MiB;
static_assert(WS_END <= 560 * MiB, "ws map (MoE)");
static_assert(WS_W + 66 * MiB <= WS_ZB && WS_H + (size_t)MT * FF * 2 <= WS_MIX && WS_MIX_END <= 560 * MiB && WS_POS + (size_t)ML * 8 <= WS_XC, "ws map");

typedef unsigned short bf16;
__device__ __forceinline__ float bf2f(unsigned short h) { return __uint_as_float(((unsigned)h) << 16); }
__device__ __forceinline__ float bflo(unsigned w) { return __uint_as_float(w << 16); }
__device__ __forceinline__ float bfhi(unsigned w) { return __uint_as_float(w & 0xffff0000u); }
__device__ __forceinline__ float wave_sum(float v) {
#pragma unroll
    for (int o = 1; o < 64; o <<= 1) v += __shfl_xor(v, o);
    return v;
}
__device__ __forceinline__ float silu_f(float x) { return x * __builtin_amdgcn_rcpf(1.0f + __expf(-x)); }
namespace pg8 {
struct EpiIn {
    static constexpr bool PERM = true, AFTER_DRAIN = false;
    bf16_t* dnraw; bf16_t* zb; bf16_t* qraw; bf16_t* kvraw; float* ab;
    __device__ __forceinline__ void operator()(const f32x4 (&acc)[2][2][4][2], const Unit& u, int wr, int wc, int fr, int fq) const {
        const int row0 = u.pm * BM + wr * 64 + fr; const int pn = u.pn;
        if (pn < 11) {
            bf16_t* base; int ldc, coff;
            if (pn < 6) { base = dnraw; ldc = 1536; coff = pn * 256; } else if (pn < 8) { base = zb; ldc = 512; coff = (pn - 6) * 256; }
            else if (pn < 10) { base = qraw; ldc = 512; coff = (pn - 8) * 256; } else { base = kvraw; ldc = 256; coff = 0; }
            const int col0 = coff + wc * 32 + 8 * fq;
#pragma unroll
            for (int ai = 0; ai < 2; ++ai)
#pragma unroll
                for (int m = 0; m < 4; ++m) { bf16_t* rowp = base + (size_t)(row0 + ai * HALF + m * 16) * ldc + col0;
#pragma unroll
                    for (int bj = 0; bj < 2; ++bj) { const f32x4 v0 = acc[ai][bj][m][0], v1 = acc[ai][bj][m][1];
                        u32x4 w; w.x = cvt_pk_bf16(v0[0], v0[1]); w.y = cvt_pk_bf16(v0[2], v0[3]); w.z = cvt_pk_bf16(v1[0], v1[1]); w.w = cvt_pk_bf16(v1[2], v1[3]);
                        *(u32x4*)(rowp + bj * HALF) = w; } }
        } else if (wc == 0) {
#pragma unroll
            for (int ai = 0; ai < 2; ++ai)
#pragma unroll
                for (int m = 0; m < 4; ++m) { float* rowp = ab + (size_t)(row0 + ai * HALF + m * 16) * 32 + 8 * fq;
                    *(f32x4*)(rowp) = acc[ai][0][m][0]; *(f32x4*)(rowp + 4) = acc[ai][0][m][1]; }
        }
    }
};
template <bool XF32> struct EpiRes {
    static constexpr bool PERM = true, AFTER_DRAIN = false;
    const void* xin_l; bf16_t* out_l; const void* xin_c; bf16_t* out_c; const float* gate; int gstride;
    __device__ __forceinline__ void operator()(const f32x4 (&acc)[2][2][4][2], const Unit& u, int wr, int wc, int fr, int fq) const {
        const int pm = u.pm; const bool isc = pm >= 128; const int bidx = isc ? 4 : (pm >> 5);
        const void* xin = isc ? xin_c : xin_l; bf16_t* out = isc ? out_c : out_l; const int prow = isc ? pm - 128 : pm;
        const int row0 = prow * BM + wr * 64 + fr; const int col0 = u.pn * BM + wc * 32 + 8 * fq; const float* gp = gate + (size_t)bidx * gstride + col0;
        f32x4 gv[2][2];
#pragma unroll
        for (int bj = 0; bj < 2; ++bj)
#pragma unroll
            for (int n = 0; n < 2; ++n) gv[bj][n] = *(const f32x4*)(gp + bj * HALF + 4 * n);
#pragma unroll
        for (int ai = 0; ai < 2; ++ai)
#pragma unroll
            for (int m = 0; m < 4; ++m) { const size_t off = (size_t)(row0 + ai * HALF + m * 16) * 1024 + col0;
#pragma unroll
                for (int bj = 0; bj < 2; ++bj) { f32x4 x0, x1;
                    if (XF32) { x0 = *(const f32x4*)((const float*)xin + off + bj * HALF); x1 = *(const f32x4*)((const float*)xin + off + bj * HALF + 4); }
                    else { const u32x4 w = *(const u32x4*)((const bf16_t*)xin + off + bj * HALF);
                        x0 = (f32x4){__uint_as_float(w.x << 16), __uint_as_float(w.x & 0xffff0000u), __uint_as_float(w.y << 16), __uint_as_float(w.y & 0xffff0000u)};
                        x1 = (f32x4){__uint_as_float(w.z << 16), __uint_as_float(w.z & 0xffff0000u), __uint_as_float(w.w << 16), __uint_as_float(w.w & 0xffff0000u)}; }
                    const f32x4 v0 = x0 + gv[bj][0] * acc[ai][bj][m][0], v1 = x1 + gv[bj][1] * acc[ai][bj][m][1];
                    u32x4 o; o.x = cvt_pk_bf16(v0[0], v0[1]); o.y = cvt_pk_bf16(v0[2], v0[3]); o.z = cvt_pk_bf16(v1[0], v1[1]); o.w = cvt_pk_bf16(v1[2], v1[3]);
                    *(u32x4*)(out + off + bj * HALF) = o; } }
    }
};
struct EpiSwiGLU {
    static constexpr bool PERM = true, AFTER_DRAIN = false;
    bf16_t* H; int ldh; int nloc; int pm0;
    __device__ __forceinline__ void operator()(const f32x4 (&acc)[2][2][4][2], const Unit& u, int wr, int wc, int fr, int fq) const {
        const int row0 = (u.pm - pm0) * BM + wr * 64 + fr; const int col0 = (u.pn % nloc) * 128 + wc * 32 + 8 * fq;
#pragma unroll
        for (int ai = 0; ai < 2; ++ai)
#pragma unroll
            for (int m = 0; m < 4; ++m) { bf16_t* rowp = H + (size_t)(row0 + ai * HALF + m * 16) * ldh + col0;
                float r[8];
#pragma unroll
                for (int n = 0; n < 2; ++n)
#pragma unroll
                    for (int j = 0; j < 4; ++j) { const float g = acc[ai][0][m][n][j], up = acc[ai][1][m][n][j]; r[n * 4 + j] = g * __builtin_amdgcn_rcpf(1.0f + __expf(-g)) * up; }
                u32x4 w; w.x = cvt_pk_bf16(r[0], r[1]); w.y = cvt_pk_bf16(r[2], r[3]); w.z = cvt_pk_bf16(r[4], r[5]); w.w = cvt_pk_bf16(r[6], r[7]);
                *(u32x4*)(rowp) = w; }
    }
};
struct EpiBfPlain {
    static constexpr bool PERM = true, AFTER_DRAIN = false;
    bf16_t* O; int ldc; int nloc;
    __device__ __forceinline__ void operator()(const f32x4 (&acc)[2][2][4][2], const Unit& u, int wr, int wc, int fr, int fq) const {
        const int row0 = u.pm * BM + wr * 64 + fr; const int col0 = (u.pn % nloc) * BM + wc * 32 + 8 * fq;
#pragma unroll
        for (int ai = 0; ai < 2; ++ai)
#pragma unroll
            for (int m = 0; m < 4; ++m) { bf16_t* rowp = O + (size_t)(row0 + ai * HALF + m * 16) * ldc + col0;
#pragma unroll
                for (int bj = 0; bj < 2; ++bj) { const f32x4 v0 = acc[ai][bj][m][0], v1 = acc[ai][bj][m][1];
                    u32x4 w; w.x = cvt_pk_bf16(v0[0], v0[1]); w.y = cvt_pk_bf16(v0[2], v0[3]); w.z = cvt_pk_bf16(v1[0], v1[1]); w.w = cvt_pk_bf16(v1[2], v1[3]);
                    *(u32x4*)(rowp + bj * HALF) = w; } }
    }
};
struct MoeOrder {
    int ps[9]; int p0, p1, nloc, G, c; int a_off;
    __device__ __forceinline__ bool next(int i, Unit& u) const {
        const int L = i * G + c; const int np = p1 - p0; if (L >= np * nloc) return false;
        const int p = p0 + L / nloc, pl = L % nloc; int e = 0;
#pragma unroll
        for (int k = 1; k < 8; ++k) e += (p >= ps[k]) ? 1 : 0;
        u.pm = p + a_off; u.pn = e * nloc + pl; return true;
    }
    __device__ __forceinline__ void a_ready(const Unit&) const {}
    __device__ __forceinline__ void done(const Unit&) const {}
};
}
struct Ctx {
    LAS unsigned char* lds; gu32* ctl; int tid, lane, wave, G, gw, NGW;
    const float* const __attribute__((address_space(4)))* in; float* out; unsigned char* ws;
};
#define WSP(T, off) ((T*)(C.ws + (off)))

template <class MapF>
__device__ __forceinline__ void transpose_item(const float* W, int K, int N, bf16* WT, MapF map, LAS float* scr, int item, int lane) {
    const int nblk = N / 32, kb = item / nblk, nb = item % nblk, k0 = 64 * kb, n0 = 32 * nb;
#pragma unroll 8
    for (int i = 0; i < 32; ++i) { const int kk = 2 * i + (lane >> 5); scr[kk * 33 + (lane & 31)] = W[(size_t)(k0 + kk) * N + n0 + (lane & 31)]; }
    LDS_WAIT(); asm volatile("" ::: "memory");
    const int c = lane & 7; const int r0 = map(n0);
#pragma unroll
    for (int j = 0; j < 4; ++j) { const int n = (lane >> 3) + 8 * j; const LAS float* s = scr + (8 * c) * 33 + n;
        v4u o; o.x = pk2(s[0 * 33], s[1 * 33]); o.y = pk2(s[2 * 33], s[3 * 33]); o.z = pk2(s[4 * 33], s[5 * 33]); o.w = pk2(s[6 * 33], s[7 * 33]);
        *(GAS v4u*)(WT + (size_t)(r0 + n) * K + k0 + 8 * c) = o; }
    LDS_WAIT(); asm volatile("" ::: "memory");
}
struct MapId { __device__ __forceinline__ int operator()(int n0) const { return n0; } };
struct MapWin { __device__ __forceinline__ int operator()(int n0) const { return n0 < 2048 ? n0 : (n0 < 2080 ? n0 + 768 : n0 - 32); } };
struct MapGU { int up; __device__ __forceinline__ int operator()(int n0) const { return (n0 >> 7) * 256 + (n0 & 127) + up * 128; } };

__device__ __forceinline__ void p0_weights(Ctx& C) {
    LAS float* scr = (LAS float*)(C.lds + C.wave * 16384);
    constexpr int I_IN = (D / 64) * (NIN / 32), I_OUT = (D / 64) * (D / 32), I_G = (D / 64) * (FF / 32), I_D = (FF / 64) * (D / 32);
    constexpr int NITEMS = 2 * I_IN + 2 * I_OUT + 2 * I_G + I_D;
    for (int it = C.gw; it < NITEMS; it += C.NGW) {
        int r = it;
        if (r < 2 * I_IN) { const int l = r / I_IN; transpose_item(C.in[8] + (size_t)l * D * NIN, D, NIN, WSP(bf16, WS_WIN) + (size_t)l * NINP * D, MapWin(), scr, r % I_IN, C.lane); continue; } r -= 2 * I_IN;
        if (r < 2 * I_OUT) { const int l = r / I_OUT; transpose_item(C.in[15] + (size_t)l * D * D, D, D, WSP(bf16, WS_WOUT) + (size_t)l * D * D, MapId(), scr, r % I_OUT, C.lane); continue; } r -= 2 * I_OUT;
        if (r < I_G) { transpose_item(C.in[16], D, FF, WSP(bf16, WS_WGU), MapGU{0}, scr, r, C.lane); continue; } r -= I_G;
        if (r < I_G) { transpose_item(C.in[17], D, FF, WSP(bf16, WS_WGU), MapGU{1}, scr, r, C.lane); continue; } r -= I_G;
        transpose_item(C.in[18], FF, D, WSP(bf16, WS_WD), MapId(), scr, r, C.lane);
    }
    for (int i = C.gw * 64 + C.lane; i < 2 * 28672; i += C.NGW * 64) { const int l = i / 28672, j = i % 28672;
        *(GAS v4u*)(WSP(bf16, WS_WIN) + (size_t)l * NINP * D + (size_t)NIN * D + (size_t)j * 8) = (v4u){0u, 0u, 0u, 0u}; }
    for (int i = C.gw * 64 + C.lane; i < T * 32; i += C.NGW * 64) { const int t = i >> 5, a = i & 31;
        const float pos = (float)((a < 16) ? (t >> 6) : (t & 63)); const float fr = powf(10000.0f, -(float)(a & 15) / 16.0f);
        float sn, cs; sincosf(pos * fr, &sn, &cs);
        WSP(float, WS_ROPE)[i] = cs; WSP(float, WS_ROPE)[T * 32 + i] = sn; }
}
__device__ __forceinline__ void p0_mods(Ctx& C) {
    LAS float* sc = (LAS float*)C.lds;
    LAS float* part = (LAS float*)(C.lds + 32768);
    const int nblk = 2 * 6144 / 64;
    bool staged = false;
    for (int cb = blockIdx.x; cb < nblk; cb += C.G) {
        if (!staged) { for (int i = C.tid; i < 5 * 1024; i += 512) { const float v = (i < 4096) ? C.in[1][i] : C.in[3][i - 4096]; sc[i] = silu_f(v); } staged = true; }
        __syncthreads();
        const int l = cb / 96, j = (cb % 96) * 64 + C.lane;
        const float* wm = C.in[4] + (size_t)l * D * 6144 + j;
        float a0 = 0.f, a1 = 0.f, a2 = 0.f, a3 = 0.f, a4 = 0.f;
        const int kb = C.wave * 128;
#pragma unroll 8
        for (int k = 0; k < 128; ++k) { const float w = wm[(size_t)(kb + k) * 6144];
            a0 += sc[kb + k] * w; a1 += sc[1024 + kb + k] * w; a2 += sc[2048 + kb + k] * w; a3 += sc[3072 + kb + k] * w; a4 += sc[4096 + kb + k] * w; }
        part[(C.wave * 5 + 0) * 64 + C.lane] = a0; part[(C.wave * 5 + 1) * 64 + C.lane] = a1; part[(C.wave * 5 + 2) * 64 + C.lane] = a2;
        part[(C.wave * 5 + 3) * 64 + C.lane] = a3; part[(C.wave * 5 + 4) * 64 + C.lane] = a4;
        __syncthreads();
        if (C.tid < 320) { const int i = C.tid / 64, ln = C.tid % 64; const int jj = (cb % 96) * 64 + ln;
            float s = 0.f;
#pragma unroll
            for (int w = 0; w < 8; ++w) s += part[(w * 5 + i) * 64 + ln];
            s += C.in[5][l * 6144 + jj];
            const int chunk = jj >> 10, col = jj & 1023;
            if (chunk == 1) s = C.in[6][l * 1024 + col] * (1.0f + s);
            if (chunk == 4) s = C.in[7][l * 1024 + col] * (1.0f + s);
            WSP(float, WS_MODS)[((size_t)(l * 5 + i) * 6 + chunk) * 1024 + col] = s; }
        __syncthreads();
    }
}
__device__ __forceinline__ const float* mods_ptr(Ctx& C, int l, int i, int chunk) { return WSP(float, WS_MODS) + ((size_t)(l * 5 + i) * 6 + chunk) * 1024; }

typedef unsigned u32x2n __attribute__((ext_vector_type(2)));
template <bool ROUTE, bool XBF  >
__device__ __forceinline__ void norm_mod(Ctx& C, const void* xl, const void* xc, int nrows, int l, int chA, int chS, bf16* dst) {
    float rw[ROUTE ? 16 : 1][8];
    if (ROUTE) {
#pragma unroll
        for (int j = 0; j < 4; ++j)
#pragma unroll
            for (int q = 0; q < 4; ++q) { const f32x4 a = *(const f32x4*)(C.in[19] + (size_t)(4 * C.lane + 256 * j + q) * 8), b = *(const f32x4*)(C.in[19] + (size_t)(4 * C.lane + 256 * j + q) * 8 + 4);
                rw[j * 4 + q][0] = a.x; rw[j * 4 + q][1] = a.y; rw[j * 4 + q][2] = a.z; rw[j * 4 + q][3] = a.w; rw[j * 4 + q][4] = b.x; rw[j * 4 + q][5] = b.y; rw[j * 4 + q][6] = b.z; rw[j * 4 + q][7] = b.w; }
    }
    for (int m = C.gw; m < nrows; m += C.NGW) {
        const bool isc = m >= ML; const int bidx = isc ? 4 : (m >> 13);
        const size_t xoff = isc ? (size_t)(m - ML) * D : (size_t)m * D; const void* xbase = isc ? xc : xl;
        const GAS f32x4* Ap = (const GAS f32x4*)mods_ptr(C, l, bidx, chA) + C.lane; const GAS f32x4* Sp = (const GAS f32x4*)mods_ptr(C, l, bidx, chS) + C.lane;
        f32x4 v[4]; float s2 = 0.f;
#pragma unroll
        for (int j = 0; j < 4; ++j) {
            if (XBF) { const u32x2n w = *(const GAS u32x2n*)((const bf16*)xbase + xoff + 4 * C.lane + 256 * j); v[j] = (f32x4){bflo(w.x), bfhi(w.x), bflo(w.y), bfhi(w.y)}; }
            else v[j] = ((const GAS f32x4*)((const float*)xbase + xoff) + C.lane)[64 * j];
            s2 += (v[j].x * v[j].x + v[j].y * v[j].y) + (v[j].z * v[j].z + v[j].w * v[j].w); }
        const float rstd = 1.0f / sqrtf(wave_sum(s2) * (1.f / D) + EPS);
#pragma unroll
        for (int j = 0; j < 4; ++j) v[j] = v[j] * rstd * Ap[64 * j] + Sp[64 * j];
        GAS unsigned long long* o8 = (GAS unsigned long long*)(dst + (size_t)m * D) + C.lane;
#pragma unroll
        for (int j = 0; j < 4; ++j) o8[64 * j] = (unsigned long long)pk2(v[j].x, v[j].y) | ((unsigned long long)pk2(v[j].z, v[j].w) << 32);
        if (ROUTE) {
            float lg[8];
#pragma unroll
            for (int e = 0; e < 8; ++e) { float s = 0.f;
#pragma unroll
                for (int j = 0; j < 4; ++j) s += (v[j].x * rw[j * 4 + 0][e] + v[j].y * rw[j * 4 + 1][e]) + (v[j].z * rw[j * 4 + 2][e] + v[j].w * rw[j * 4 + 3][e]);
                lg[e] = wave_sum(s) + C.in[20][e]; }
            if (C.lane == 0) {
                int e0 = 0; float v0 = lg[0];
#pragma unroll
                for (int e = 1; e < 8; ++e) if (lg[e] > v0) { v0 = lg[e]; e0 = e; }
                int e1 = -1; float v1 = -INFINITY;
#pragma unroll
                for (int e = 0; e < 8; ++e) if (e != e0 && lg[e] > v1) { v1 = lg[e]; e1 = e; }
                const float w0 = 1.0f / (1.0f + expf(v1 - v0)), w1 = 1.0f - w0;
                const int s0 = (int)__hip_atomic_fetch_add(C.ctl + CW_CNT + 64 * e0, 1u, RLX_AGENT), s1 = (int)__hip_atomic_fetch_add(C.ctl + CW_CNT + 64 * e1, 1u, RLX_AGENT);
                WSP(int, WS_ROUTE)[m * 4 + 0] = e0; WSP(int, WS_ROUTE)[m * 4 + 1] = s0; WSP(int, WS_ROUTE)[m * 4 + 2] = e1; WSP(int, WS_ROUTE)[m * 4 + 3] = s1;
                WSP(float, WS_RW)[m * 2 + 0] = w0; WSP(float, WS_RW)[m * 2 + 1] = w1;
            }
        }
    }
}
__device__ __forceinline__ void load8(const bf16* p, float (&f)[8]) { const v4u w = *(const GAS v4u*)p; f[0] = bflo(w.x); f[1] = bfhi(w.x); f[2] = bflo(w.y); f[3] = bfhi(w.y); f[4] = bflo(w.z); f[5] = bfhi(w.z); f[6] = bflo(w.w); f[7] = bfhi(w.w); }
__device__ __forceinline__ void store8(bf16* p, const float (&f)[8]) { v4u w; w.x = pk2(f[0], f[1]); w.y = pk2(f[2], f[3]); w.z = pk2(f[4], f[5]); w.w = pk2(f[6], f[7]); *(GAS v4u*)p = w; }
__device__ __forceinline__ float sum8(float v) { v += __shfl_xor(v, 1); v += __shfl_xor(v, 2); v += __shfl_xor(v, 4); return v; }

__device__ __forceinline__ unsigned cvt4_fp8(float a, float b, float c, float d) { int w = 0; w = __builtin_amdgcn_cvt_pk_fp8_f32(a, b, w, false); w = __builtin_amdgcn_cvt_pk_fp8_f32(c, d, w, true); return (unsigned)w; }
constexpr float SQS = 0.42466090014400953f;
__device__ __forceinline__ void p3_prep(Ctx& C, int l) {
    const int lane = C.lane;
    const bf16* qraw = WSP(bf16, WS_QRAW); const bf16* kvraw = WSP(bf16, WS_KVRAW); const float* ab = WSP(float, WS_AB);
    unsigned char* q8 = WSP(unsigned char, WS_XN); unsigned char* k8 = WSP(unsigned char, WS_KALL); unsigned char* v8 = WSP(unsigned char, WS_VALL);
    const float* ropec = WSP(float, WS_ROPE); const float* ropes = ropec + T * 32;
    const int jj = (lane & 7) * 8;
    float qw[8], kw[8];
#pragma unroll
    for (int i = 0; i < 8; ++i) { qw[i] = C.in[13][l * 64 + jj + i]; kw[i] = C.in[14][l * 64 + jj + i]; }
    const int gd = (lane >> 3) & 1, gh = lane & 7;
    const float neg_a = -expf(C.in[10][l * 16 + gd * 8 + gh]), dtb = C.in[11][l * 16 + gd * 8 + gh];
    for (int m = C.gw; m < MT; m += C.NGW) {
        const bool isc = m >= ML; const int b = isc ? (m - ML) >> 8 : m >> 13; const int t = isc ? (m - ML) & 255 : m & 8191;
        {
            float f[8]; load8(qraw + (size_t)m * 512 + lane * 8, f);
            float ss = 0.f;
#pragma unroll
            for (int i = 0; i < 8; ++i) ss += f[i] * f[i];
            const float r = 1.0f / sqrtf(sum8(ss) * (1.f / 64.f) + EPS);
#pragma unroll
            for (int i = 0; i < 8; ++i) f[i] = f[i] * r * qw[i];
            if (!isc) {
                float o[8];
#pragma unroll
                for (int i = 0; i < 8; ++i) o[i] = __shfl_xor(f[i], 4);
                const int a0 = jj & 31; const bool first = jj < 32;
#pragma unroll
                for (int i = 0; i < 8; ++i) { const float cs = ropec[t * 32 + a0 + i], sn = ropes[t * 32 + a0 + i]; f[i] = first ? (f[i] * cs - o[i] * sn) : (f[i] * cs + o[i] * sn); }
            }
#pragma unroll
            for (int i = 0; i < 8; ++i) f[i] *= SQS;
            *(GAS u32x2n*)(q8 + (size_t)m * 512 + lane * 8) = (u32x2n){cvt4_fp8(f[0], f[1], f[2], f[3]), cvt4_fp8(f[4], f[5], f[6], f[7])};
        }
        {
            const size_t krow = (size_t)b * TK + (isc ? T + t : t);
            if (lane < 32) {
                float f[8]; load8(kvraw + (size_t)m * 256 + lane * 8, f);
                if (lane < 16) {
                    float ss = 0.f;
#pragma unroll
                    for (int i = 0; i < 8; ++i) ss += f[i] * f[i];
                    const float r = 1.0f / sqrtf(sum8(ss) * (1.f / 64.f) + EPS);
#pragma unroll
                    for (int i = 0; i < 8; ++i) f[i] = f[i] * r * kw[i];
                    float o[8];
#pragma unroll
                    for (int i = 0; i < 8; ++i) o[i] = __shfl_xor(f[i], 4);
                    if (!isc) { const int a0 = jj & 31; const bool first = jj < 32;
#pragma unroll
                        for (int i = 0; i < 8; ++i) { const float cs = ropec[t * 32 + a0 + i], sn = ropes[t * 32 + a0 + i]; f[i] = first ? (f[i] * cs - o[i] * sn) : (f[i] * cs + o[i] * sn); } }
#pragma unroll
                    for (int i = 0; i < 8; ++i) f[i] *= SQS;
                    *(GAS u32x2n*)(k8 + krow * 128 + lane * 8) = (u32x2n){cvt4_fp8(f[0], f[1], f[2], f[3]), cvt4_fp8(f[4], f[5], f[6], f[7])};
                } else {
                    const int pos = isc ? T + t : t, kk = pos & 63, vh = (lane - 16) >> 3, n0 = ((lane - 16) & 7) * 8;
                    unsigned char* vt = v8 + ((size_t)((b * 2 + vh) * (TK / 64) + (pos >> 6))) * 4096 + 32 * ((kk >> 2) & 1) + ((kk >> 5) << 4) + (((kk >> 3) & 3) << 2) + (kk & 3);
                    const unsigned w0 = cvt4_fp8(f[0], f[1], f[2], f[3]), w1 = cvt4_fp8(f[4], f[5], f[6], f[7]);
#pragma unroll
                    for (int i = 0; i < 4; ++i) { vt[(size_t)(n0 + i) * 64] = (unsigned char)(w0 >> (8 * i)); vt[(size_t)(n0 + 4 + i) * 64] = (unsigned char)(w1 >> (8 * i)); }
                }
            }
        }
        if (lane < 16) {
            const float a = ab[(size_t)m * 32 + lane], bb = ab[(size_t)m * 32 + 16 + lane];
            const float xx = a + dtb; const float sp = xx > 20.f ? xx : log1pf(expf(xx));
            WSP(float, WS_G)[((size_t)gd * MT + m) * 8 + gh] = neg_a * sp;
            WSP(float, WS_BETA)[((size_t)gd * MT + m) * 8 + gh] = 1.0f / (1.0f + expf(-bb));
        }
    }
}

__device__ __forceinline__ float silu_fast(float x) { return x * __builtin_amdgcn_rcpf(1.0f + __expf(-x)); }
__device__ __forceinline__ void p3b_dnconv(Ctx& C, int l) {
    const bf16* dnraw = WSP(bf16, WS_DNRAW); bf16* qdn = WSP(bf16, WS_QDN); bf16* kdn = WSP(bf16, WS_KDN); bf16* kt = WSP(bf16, WS_KT); bf16* vt = WSP(bf16, WS_VT);
    const float* cwl = C.in[9] + (size_t)l * 5 * 1536;
    LAS unsigned char* wl = C.lds + C.wave * 16384;
    if (C.gw < 85 * 24) {
        const int hs = C.gw % 24, sg = hs >> 3, h = hs & 7; const int ch0 = sg * 512 + h * 64;
        float wv[5];
#pragma unroll
        for (int tp = 0; tp < 5; ++tp) wv[tp] = cwl[tp * 1536 + ch0 + C.lane];
        const int lr = C.lane >> 3, lc = C.lane & 7;
        v4u stg[9];
#define DNC_REQ(ckk) do { const int t0_ = ((ckk) < 512) ? (((ckk) & 127) * 64) : ((((ckk) - 512) & 3) * 64); const int tlen_ = ((ckk) < 512) ? T : LC; \
            _Pragma("unroll") for (int i = 0; i < 9; ++i) { const int r_ = i * 8 + lr; const int tt_ = t0_ - 2 + r_; const bool ok_ = r_ < 68 && tt_ >= 0 && tt_ < tlen_; \
                stg[i] = ok_ ? *(const GAS v4u*)(dnraw + ((size_t)(ckk) * 64 - 2 + r_) * 1536 + ch0 + lc * 8) : (v4u){0u, 0u, 0u, 0u}; } } while (0)
        int ck = C.gw / 24;
        if (ck < 528) DNC_REQ(ck);
        for (; ck < 528; ck += 85) {
            asm volatile("s_waitcnt lgkmcnt(0)" ::: "memory");
#pragma unroll
            for (int i = 0; i < 9; ++i) { const int r = i * 8 + lr; if (r < 68) *(LAS v4u*)(wl + r * 144 + lc * 16) = stg[i]; }
            asm volatile("s_waitcnt lgkmcnt(0)" ::: "memory");
            if (ck + 85 < 528) DNC_REQ(ck + 85);
            const int m = ck * 64 + C.lane;
            float y[64];
#pragma unroll
            for (int i = 0; i < 64; ++i) y[i] = 0.f;
#pragma unroll
            for (int tp = 0; tp < 5; ++tp) {
#pragma unroll
                for (int cg = 0; cg < 8; ++cg) { const v4u w = *(const LAS v4u*)(wl + (C.lane + tp) * 144 + cg * 16);
                    const float f[8] = {bflo(w.x), bfhi(w.x), bflo(w.y), bfhi(w.y), bflo(w.z), bfhi(w.z), bflo(w.w), bfhi(w.w)};
#pragma unroll
                    for (int i = 0; i < 8; ++i) y[cg * 8 + i] += f[i] * __builtin_bit_cast(float, __builtin_amdgcn_readlane(__builtin_bit_cast(int, wv[tp]), cg * 8 + i)); } }
            float ss = 0.f;
#pragma unroll
            for (int i = 0; i < 64; ++i) { y[i] = silu_fast(y[i]); ss += y[i] * y[i]; }
            if (sg < 2) { const float r = (1.0f / sqrtf(ss + EPS)) * (sg == 0 ? 0.125f : 1.0f);
#pragma unroll
                for (int i = 0; i < 64; ++i) y[i] *= r; }
            if (sg < 2) { bf16* dst = (sg == 0 ? qdn : kdn) + (size_t)m * 512 + h * 64;
#pragma unroll
                for (int cg = 0; cg < 8; ++cg) { float f[8];
#pragma unroll
                    for (int i = 0; i < 8; ++i) f[i] = y[cg * 8 + i];
                    store8(dst + cg * 8, f); } }
            if (sg >= 1) { bf16* dst = (sg == 1 ? kt : vt) + ((size_t)ck * 8 + h) * 4096 + C.lane;
#pragma unroll
                for (int i = 0; i < 64; i += 2) { const unsigned w = pk2(y[i], y[i + 1]); dst[i * 64] = (bf16)(w & 0xffffu); dst[(i + 1) * 64] = (bf16)(w >> 16); } }
        }
#undef DNC_REQ
    }
    asm volatile("s_waitcnt lgkmcnt(0)" ::: "memory");
}

__device__ __forceinline__ int chunk_ck(int b, int cc) { return cc < 4 ? 512 + b * 4 + cc : b * 128 + (cc - 4); }
__device__ __forceinline__ int chunk_row(int b, int cc, int dir, int i) { const int ii = dir ? 63 - i : i; return cc < 4 ? ML + b * LC + cc * 64 + ii : b * T + (cc - 4) * 64 + ii; }
struct MapGUE { int off; __device__ __forceinline__ int operator()(int n0) const { return off + (n0 >> 7) * 256 + (n0 & 127); } };
__device__ __forceinline__ void moe_weights(Ctx& C) {
    LAS float* scr = (LAS float*)(C.lds + C.wave * 16384);
    constexpr int I_G = (D / 64) * (EF / 32), I_D = (EF / 64) * (D / 32);
    constexpr int NITEMS = NE * (2 * I_G + I_D);
    for (int it = C.gw; it < NITEMS; it += C.NGW) {
        const int e = it / (2 * I_G + I_D); int r = it % (2 * I_G + I_D);
        if (r < I_G) { transpose_item(C.in[21] + (size_t)e * D * EF, D, EF, WSP(bf16, WS_MGU), MapGUE{e * 7168}, scr, r, C.lane); continue; } r -= I_G;
        if (r < I_G) { transpose_item(C.in[22] + (size_t)e * D * EF, D, EF, WSP(bf16, WS_MGU), MapGUE{e * 7168 + 128}, scr, r, C.lane); continue; } r -= I_G;
        transpose_item(C.in[23] + (size_t)e * EF * D, EF, D, WSP(bf16, WS_MD) + (size_t)e * D * EF, MapId(), scr, r, C.lane);
    }
}
__device__ __forceinline__ void moe_panel_starts(Ctx& C, int (&ps)[9], int (&cnt)[8]) {
    int acc = 0;
#pragma unroll
    for (int e = 0; e < 8; ++e) { cnt[e] = (int)__hip_atomic_load(C.ctl + CW_CNT + 64 * e, RLX_AGENT); ps[e] = acc; acc += (cnt[e] + 255) >> 8; }
    ps[8] = acc;
}
__device__ __forceinline__ void moe_scatter(Ctx& C, const bf16* xn2) {
    int ps[9], cnt[8]; moe_panel_starts(C, ps, cnt);
    bf16* xs = WSP(bf16, WS_XS); const int* route = WSP(int, WS_ROUTE); int* pos = WSP(int, WS_POS);
    for (int m = C.gw; m < ML; m += C.NGW) {
        const int e0 = route[m * 4 + 0], s0 = route[m * 4 + 1], e1 = route[m * 4 + 2], s1 = route[m * 4 + 3];
        int p0 = 0, p1 = 0;
#pragma unroll
        for (int e = 0; e < 8; ++e) { p0 = (e == e0) ? ps[e] : p0; p1 = (e == e1) ? ps[e] : p1; }
        const int r0 = p0 * 256 + s0, r1 = p1 * 256 + s1;
        const GAS v4u* src = (const GAS v4u*)(xn2 + (size_t)m * D) + C.lane; GAS v4u* d0 = (GAS v4u*)(xs + (size_t)r0 * D) + C.lane; GAS v4u* d1 = (GAS v4u*)(xs + (size_t)r1 * D) + C.lane;
        const v4u a = src[0], b = src[64]; d0[0] = a; d0[64] = b; d1[0] = a; d1[64] = b;

        if (C.lane == 0) { pos[m * 2 + 0] = r0; pos[m * 2 + 1] = r1; }
    }
#pragma unroll
    for (int e = 0; e < 8; ++e) { const int nb = ps[e + 1] * 256 - (ps[e] * 256 + cnt[e]); const int rb = ps[e] * 256 + cnt[e];
        for (int r = C.gw; r < nb; r += C.NGW) { GAS v4u* d = (GAS v4u*)(xs + (size_t)(rb + r) * D) + C.lane; d[0] = (v4u){0u, 0u, 0u, 0u}; d[64] = (v4u){0u, 0u, 0u, 0u}; } }
}
__device__ __forceinline__ void moe_final(Ctx& C, int l) {
    const bf16* ys = WSP(bf16, WS_XS); const int* route = WSP(int, WS_POS); const float* rwt = WSP(float, WS_RW);
    for (int m = C.gw; m < ML; m += C.NGW) {
        const int r0 = route[m * 2 + 0], r1 = route[m * 2 + 1]; const float w0 = rwt[m * 2], w1 = rwt[m * 2 + 1];
        const int bidx = m >> 13; const float* g2 = mods_ptr(C, l, bidx, 5);
        float x[16]; float ss = 0.f;
#pragma unroll
        for (int j = 0; j < 2; ++j) { const int c0 = j * 512 + C.lane * 8; float a[8], bb[8]; load8(ys + (size_t)r0 * D + c0, a); load8(ys + (size_t)r1 * D + c0, bb);
            float xv[8]; load8(WSP(bf16, WS_XB2) + (size_t)m * D + c0, xv);
            const f32x4 ga = *(const GAS f32x4*)(g2 + c0), gb = *(const GAS f32x4*)(g2 + c0 + 4);
            const float gv[8] = {ga.x, ga.y, ga.z, ga.w, gb.x, gb.y, gb.z, gb.w};
#pragma unroll
            for (int i = 0; i < 8; ++i) { const float v = xv[i] + gv[i] * (w0 * a[i] + w1 * bb[i]); x[j * 8 + i] = v; ss += v * v; } }
        const float rstd = 1.0f / sqrtf(wave_sum(ss) * (1.f / D) + EPS);
#pragma unroll
        for (int j = 0; j < 2; ++j) { const int c0 = j * 512 + C.lane * 8;
            const f32x4 fa = *(const GAS f32x4*)(C.in[24] + c0), fb = *(const GAS f32x4*)(C.in[24] + c0 + 4);
            f32x4 oa = {x[j * 8 + 0] * rstd * fa.x, x[j * 8 + 1] * rstd * fa.y, x[j * 8 + 2] * rstd * fa.z, x[j * 8 + 3] * rstd * fa.w};
            f32x4 ob = {x[j * 8 + 4] * rstd * fb.x, x[j * 8 + 5] * rstd * fb.y, x[j * 8 + 6] * rstd * fb.z, x[j * 8 + 7] * rstd * fb.w};
            *(GAS f32x4*)(C.out + (size_t)m * D + c0) = oa; *(GAS f32x4*)(C.out + (size_t)m * D + c0 + 4) = ob; }
    }
}
typedef float f32x4_t __attribute__((ext_vector_type(4)));
__device__ __forceinline__ int pi_idx(int t, int m) { return 32 * (t >> 1) + 8 * (m >> 2) + 4 * (t & 1) + (m & 3); }
constexpr size_t DN_UNITS = (size_t)NB * 8 * 2 * NCH;
__device__ __forceinline__ int wq_next(gu32* head, int lane) { unsigned v = 0; if (lane == 0) v = __hip_atomic_fetch_add(head, 1u, RLX_AGENT); return (int)__builtin_amdgcn_readfirstlane(v); }
__device__ __forceinline__ void p5_dn1_fast(Ctx& C, int l) {
    const int lane = C.lane, l15 = lane & 15, g = lane >> 4;
    LAS unsigned char* wl = C.lds + C.wave * 16384;
    LAS float* Aimg = (LAS float*)wl;
    const bf16* kdn = WSP(bf16, WS_KDN); const bf16* kt = WSP(bf16, WS_KT); const bf16* vt = WSP(bf16, WS_VT);
    const float* G = WSP(float, WS_G); const float* BT = WSP(float, WS_BETA);
    uint2* FU = WSP(uint2, WS_U); v4u* FW = WSP(v4u, WS_W);
    gu32* qh = C.ctl + CW_Q + 64 * (2 * l);
    for (int u = wq_next(qh, lane); u < (int)DN_UNITS; u = wq_next(qh, lane)) {
        const int cc = u % NCH, dir = (u / NCH) & 1, h = (u / (2 * NCH)) & 7, b = u / (16 * NCH);
        const int ck = chunk_ck(b, cc); const size_t m0 = (size_t)ck * 64;
        float gr = G[((size_t)dir * MT + m0 + lane) * 8 + h]; const float be = BT[((size_t)dir * MT + m0 + lane) * 8 + h];
        if (dir) gr = __shfl(gr, 63 - lane);
#pragma unroll
        for (int o = 1; o < 64; o <<= 1) { const float n = __shfl_up(gr, o); if (lane >= o) gr += n; }
        if (dir) gr = __shfl(gr, 63 - lane);
        const float gcv = gr;
        { float* gcb = WSP(float, WS_GCB) + (size_t)u * 192; gcb[lane] = gcv; gcb[64 + lane] = __shfl(gcv, pi_idx((lane >> 2) & 3, 4 * (lane >> 4) + (lane & 3))); const float gl_ = __shfl(gcv, dir ? 0 : 63); if (lane == 0) gcb[128] = gl_;
          ((bf16*)(gcb + 132))[lane] = (bf16)(pk2(__expf(gl_ - __shfl(gcv, pi_idx((lane >> 2) & 3, 4 * (lane >> 4) + (lane & 3)))), 0.f) & 0xffffu); }
        bf16x8 kf[4][2];
#pragma unroll
        for (int t = 0; t < 4; ++t)
#pragma unroll
            for (int s = 0; s < 2; ++s) kf[t][s] = *(const bf16x8*)(kdn + (m0 + 16 * t + l15) * 512 + h * 64 + 32 * s + 8 * g);
        float gcol[4];
#pragma unroll
        for (int tj = 0; tj < 4; ++tj) gcol[tj] = __shfl(gcv, 16 * tj + l15);
#pragma unroll
        for (int ti = 0; ti < 4; ++ti) {
            float grow[4], brow[4];
#pragma unroll
            for (int r = 0; r < 4; ++r) { grow[r] = __shfl(gcv, 16 * ti + 4 * g + r); brow[r] = __shfl(be, 16 * ti + 4 * g + r); }
#pragma unroll
            for (int tj = 0; tj < 4; ++tj) {
                f32x4_t acc = {0.f, 0.f, 0.f, 0.f};
                acc = __builtin_amdgcn_mfma_f32_16x16x32_bf16(kf[ti][0], kf[tj][0], acc, 0, 0, 0);
                acc = __builtin_amdgcn_mfma_f32_16x16x32_bf16(kf[ti][1], kf[tj][1], acc, 0, 0, 0);
#pragma unroll
                for (int r = 0; r < 4; ++r) { const int si = 16 * ti + 4 * g + r, sj = 16 * tj + l15; const int ci = dir ? 63 - si : si, cj = dir ? 63 - sj : sj;
                    if (ci > cj) Aimg[cj * 64 + ci] = brow[r] * acc[r] * __expf(grow[r] - gcol[tj]); }
            }
        }
        asm volatile("s_waitcnt lgkmcnt(0)" ::: "memory");
        float tcol[64];
#pragma unroll
        for (int i = 0; i < 64; ++i) tcol[i] = (i == lane) ? 1.f : 0.f;
#pragma unroll
        for (int jb = 0; jb < 16; ++jb) {
            f32x4_t d[4];
#pragma unroll
            for (int c = 0; c < 4; ++c) d[c] = *(const LAS f32x4_t*)(Aimg + (4 * jb + c) * 64 + 4 * jb);
            const float t0 = tcol[4 * jb];
            const float t1 = tcol[4 * jb + 1] - d[0][1] * t0;
            const float t2 = tcol[4 * jb + 2] - d[0][2] * t0 - d[1][2] * t1;
            const float t3 = tcol[4 * jb + 3] - d[0][3] * t0 - d[1][3] * t1 - d[2][3] * t2;
            tcol[4 * jb + 1] = t1; tcol[4 * jb + 2] = t2; tcol[4 * jb + 3] = t3;
#pragma unroll
            for (int i4 = jb + 1; i4 < 16; ++i4) {
                const f32x4_t a0 = *(const LAS f32x4_t*)(Aimg + (4 * jb + 0) * 64 + 4 * i4), a1 = *(const LAS f32x4_t*)(Aimg + (4 * jb + 1) * 64 + 4 * i4);
                const f32x4_t a2 = *(const LAS f32x4_t*)(Aimg + (4 * jb + 2) * 64 + 4 * i4), a3 = *(const LAS f32x4_t*)(Aimg + (4 * jb + 3) * 64 + 4 * i4);
#pragma unroll
                for (int k = 0; k < 4; ++k) { float x = tcol[4 * i4 + k];
                    asm("v_fma_f32 %0, -%1, %2, %0" : "+v"(x) : "v"(a0[k]), "v"(t0)); asm("v_fma_f32 %0, -%1, %2, %0" : "+v"(x) : "v"(a1[k]), "v"(t1));
                    asm("v_fma_f32 %0, -%1, %2, %0" : "+v"(x) : "v"(a2[k]), "v"(t2)); asm("v_fma_f32 %0, -%1, %2, %0" : "+v"(x) : "v"(a3[k]), "v"(t3)); tcol[4 * i4 + k] = x; }
                if (((i4 - jb) & 3) == 0) __builtin_amdgcn_sched_barrier(0); }
            __builtin_amdgcn_sched_barrier(0); }
        asm volatile("s_waitcnt lgkmcnt(0)" ::: "memory");
        {   const int kap = dir ? 63 - lane : lane; const float bk = __shfl(be, kap), egk = __expf(__shfl(gcv, kap));
            LAS bf16* Tb = (LAS bf16*)wl; LAS bf16* Tg = Tb + 4096;
#pragma unroll
            for (int i = 0; i < 64; ++i) { const int rho = dir ? 63 - i : i; const float v = tcol[i] * bk; const unsigned w = pk2(v, -v * egk); Tb[rho * 64 + kap] = (bf16)(w & 0xffffu); Tg[rho * 64 + kap] = (bf16)(w >> 16); } }
        asm volatile("s_waitcnt lgkmcnt(0)" ::: "memory");
        {   const LAS bf16* Tb = (const LAS bf16*)wl; const LAS bf16* Tg = Tb + 4096;
            const bf16* vtb = vt + ((size_t)ck * 8 + h) * 4096; const bf16* ktb = kt + ((size_t)ck * 8 + h) * 4096;
            bf16x8 ta[4][2];
#pragma unroll
            for (int t = 0; t < 4; ++t)
#pragma unroll
                for (int p = 0; p < 2; ++p) ta[t][p] = *(const LAS bf16x8*)(Tb + pi_idx(t, l15) * 64 + 32 * p + 8 * g);
#pragma unroll
            for (int ne = 0; ne < 4; ++ne) {
                const bf16x8 vb0 = *(const bf16x8*)(vtb + (16 * ne + l15) * 64 + 8 * g), vb1 = *(const bf16x8*)(vtb + (16 * ne + l15) * 64 + 32 + 8 * g);
#pragma unroll
                for (int t = 0; t < 4; ++t) { f32x4_t acc = {0.f, 0.f, 0.f, 0.f};
                    acc = __builtin_amdgcn_mfma_f32_16x16x32_bf16(ta[t][0], vb0, acc, 0, 0, 0);
                    acc = __builtin_amdgcn_mfma_f32_16x16x32_bf16(ta[t][1], vb1, acc, 0, 0, 0);
                    uint2 w; w.x = pk2(acc[0], acc[1]); w.y = pk2(acc[2], acc[3]);
                    FU[(((size_t)u * 4 + ne) * 4 + t) * 64 + lane] = w; }
            }
#pragma unroll
            for (int t = 0; t < 4; ++t)
#pragma unroll
                for (int p = 0; p < 2; ++p) ta[t][p] = *(const LAS bf16x8*)(Tg + pi_idx(t, l15) * 64 + 32 * p + 8 * g);
#pragma unroll
            for (int pd = 0; pd < 2; ++pd) {
                bf16x8 ka[2][2];
#pragma unroll
                for (int hh = 0; hh < 2; ++hh)
#pragma unroll
                    for (int p = 0; p < 2; ++p) ka[hh][p] = *(const bf16x8*)(ktb + pi_idx(2 * pd + hh, l15) * 64 + 32 * p + 8 * g);
#pragma unroll
                for (int nc = 0; nc < 4; ++nc) { f32x4_t a0 = {0.f, 0.f, 0.f, 0.f}, a1 = {0.f, 0.f, 0.f, 0.f};
                    a0 = __builtin_amdgcn_mfma_f32_16x16x32_bf16(ka[0][0], ta[nc][0], a0, 0, 0, 0); a0 = __builtin_amdgcn_mfma_f32_16x16x32_bf16(ka[0][1], ta[nc][1], a0, 0, 0, 0);
                    a1 = __builtin_amdgcn_mfma_f32_16x16x32_bf16(ka[1][0], ta[nc][0], a1, 0, 0, 0); a1 = __builtin_amdgcn_mfma_f32_16x16x32_bf16(ka[1][1], ta[nc][1], a1, 0, 0, 0);
                    v4u w; w.x = pk2(a0[0], a0[1]); w.y = pk2(a0[2], a0[3]); w.z = pk2(a1[0], a1[1]); w.w = pk2(a1[2], a1[3]);
                    FW[(((size_t)u * 4 + nc) * 2 + pd) * 64 + lane] = w; }
            }
        }
        asm volatile("s_waitcnt lgkmcnt(0)" ::: "memory");
    }
}

__device__ __forceinline__ float dn_gcum(const float* G, int dir, size_t m0, int h, int lane) {
    float gr = G[((size_t)dir * MT + m0 + lane) * 8 + h];
    if (dir) gr = __shfl(gr, 63 - lane);
#pragma unroll
    for (int o = 1; o < 64; o <<= 1) { const float n = __shfl_up(gr, o); if (lane >= o) gr += n; }
    if (dir) gr = __shfl(gr, 63 - lane);
    return gr;
}
__device__ __forceinline__ bf16x8 pack8(const f32x4_t& a, const f32x4_t& b) { v4u w; w.x = pk2(a[0], a[1]); w.y = pk2(a[2], a[3]); w.z = pk2(b[0], b[1]); w.w = pk2(b[2], b[3]); return __builtin_bit_cast(bf16x8, w); }
constexpr int DN2_SLOT = 25600, DN2_NSLOT = 4;
__device__ __forceinline__ void dn2_issue(const v4u* FW, const uint2* FU, const bf16* kt, const float* GCB, int b, int h, int dir, int st, int lw, int lane, unsigned lds_slot) {
    const int l15 = lane & 15, g = lane >> 4;
    const int cc = dir == 0 ? st : (st < 4 ? 3 - st : NCH + 3 - st);
    const size_t u = ((size_t)((b * 8 + h) * 2 + dir)) * NCH + cc; const int ck = chunk_ck(b, cc);
    const unsigned char* fw = (const unsigned char*)(FW + u * 8 * 64); const unsigned char* fu = (const unsigned char*)(FU + u * 4 * 4 * 64);
    const unsigned char* ktb = (const unsigned char*)(kt + ((size_t)ck * 8 + h) * 4096); const unsigned char* gb = (const unsigned char*)(GCB + u * 192);
#pragma unroll
    for (int k = 0; k < 2; ++k) { const int j = 2 * lw + k;
        attn64::glds16(fw + j * 1024 + lane * 16, (unsigned)__builtin_amdgcn_readfirstlane(lds_slot + j * 1024));
        attn64::glds16(ktb + pi_idx(j >> 1, l15) * 128 + (j & 1) * 64 + g * 16, (unsigned)__builtin_amdgcn_readfirstlane(lds_slot + 8192 + j * 1024));
        attn64::glds16(fu + j * 1024 + lane * 16, (unsigned)__builtin_amdgcn_readfirstlane(lds_slot + 16384 + j * 1024)); }
    attn64::glds16(gb + 512 + (lane % 10) * 16, (unsigned)__builtin_amdgcn_readfirstlane(lds_slot + 24576));
}
__device__ __forceinline__ void p6_dn2_fast(Ctx& C, bool dry = false) {
    const int lane = C.lane, g = lane >> 4;
    const v4u* FW = WSP(v4u, WS_W); uint2* FU = WSP(uint2, WS_U); const bf16* kt = WSP(bf16, WS_KT); const float* GCB = WSP(float, WS_GCB);
    v4u* SS = WSP(v4u, WS_XN);
    const unsigned lds0 = (unsigned)(uintptr_t)C.lds;
    for (int ch = blockIdx.x; ch < NB * 8 * 2; ch += C.G) {
        const int dir = ch & 1, h = (ch >> 1) & 7, b = ch >> 4;
        __syncthreads();
        if (C.wave >= 4) {
            const int lw = C.wave - 4;
            dn2_issue(FW, FU, kt, GCB, b, h, dir, 0, lw, lane, lds0 + 0 * DN2_SLOT); dn2_issue(FW, FU, kt, GCB, b, h, dir, 1, lw, lane, lds0 + 1 * DN2_SLOT); dn2_issue(FW, FU, kt, GCB, b, h, dir, 2, lw, lane, lds0 + 2 * DN2_SLOT);
            for (int st = 0; st < NCH; ++st) {
                if (st + 2 < NCH) asm volatile("s_waitcnt vmcnt(14)" ::: "memory"); else if (st + 1 < NCH) asm volatile("s_waitcnt vmcnt(7)" ::: "memory"); else asm volatile("s_waitcnt vmcnt(0)" ::: "memory");
                __builtin_amdgcn_s_barrier();
                if (st + 3 < NCH) dn2_issue(FW, FU, kt, GCB, b, h, dir, st + 3, lw, lane, lds0 + ((st + 3) & 3) * DN2_SLOT);
            }
        } else {
            const int dvq = C.wave;
            f32x4_t S[4];
#pragma unroll
            for (int t = 0; t < 4; ++t) S[t] = (f32x4_t){0.f, 0.f, 0.f, 0.f};
            bf16x8 Sf[2]; Sf[0] = (bf16x8){0, 0, 0, 0, 0, 0, 0, 0}; Sf[1] = Sf[0];
            for (int st = 0; st < NCH; ++st) {
                asm volatile("s_waitcnt lgkmcnt(0)" ::: "memory");
                __builtin_amdgcn_s_barrier();
                asm volatile("" ::: "memory");
                const LAS unsigned char* sl = C.lds + (st & 3) * DN2_SLOT;
                const int cc = dir == 0 ? st : (st < 4 ? 3 - st : NCH + 3 - st);
                const size_t u = ((size_t)((b * 8 + h) * 2 + dir)) * NCH + cc;
                if (!dry) { SS[((u * 4 + dvq) * 2 + 0) * 64 + lane] = __builtin_bit_cast(v4u, Sf[0]); SS[((u * 4 + dvq) * 2 + 1) * 64 + lane] = __builtin_bit_cast(v4u, Sf[1]); }
                const float gl = *(const LAS float*)(sl + 24576); const float egl = __expf(gl);
                const v4u ef0 = *(const LAS v4u*)(sl + 24576 + 16 + g * 32), ef1 = *(const LAS v4u*)(sl + 24576 + 32 + g * 32);
                f32x4_t vn[4];
#pragma unroll
                for (int t = 0; t < 4; ++t) { typedef unsigned u32x2v __attribute__((ext_vector_type(2))); const u32x2v uu = *(const LAS u32x2v*)(sl + 16384 + dvq * 2048 + t * 512 + lane * 8);
                    const bf16x8 a0 = *(const LAS bf16x8*)(sl + (t * 2 + 0) * 1024 + lane * 16), a1 = *(const LAS bf16x8*)(sl + (t * 2 + 1) * 1024 + lane * 16);
                    vn[t] = (f32x4_t){bflo(uu.x), bfhi(uu.x), bflo(uu.y), bfhi(uu.y)};
                    vn[t] = __builtin_amdgcn_mfma_f32_16x16x32_bf16(a0, Sf[0], vn[t], 0, 0, 0);
                    vn[t] = __builtin_amdgcn_mfma_f32_16x16x32_bf16(a1, Sf[1], vn[t], 0, 0, 0); }
                if (!dry) { v4u* VN = (v4u*)(FU + ((u * 4 + dvq) * 4) * 64);
                    VN[0 * 64 + lane] = __builtin_bit_cast(v4u, pack8(vn[0], vn[1])); VN[1 * 64 + lane] = __builtin_bit_cast(v4u, pack8(vn[2], vn[3])); }
#pragma unroll
                for (int t = 0; t < 4; ++t) { const v4u& e = (t < 2) ? ef0 : ef1; const unsigned w0 = e[(t & 1) * 2], w1 = e[(t & 1) * 2 + 1];
                    vn[t][0] *= bflo(w0); vn[t][1] *= bfhi(w0); vn[t][2] *= bflo(w1); vn[t][3] *= bfhi(w1); }
                const bf16x8 vs0 = pack8(vn[0], vn[1]), vs1 = pack8(vn[2], vn[3]);
#pragma unroll
                for (int t = 0; t < 4; ++t) { const bf16x8 k0 = *(const LAS bf16x8*)(sl + 8192 + (t * 2 + 0) * 1024 + lane * 16), k1 = *(const LAS bf16x8*)(sl + 8192 + (t * 2 + 1) * 1024 + lane * 16);
                    S[t] = S[t] * egl;
                    S[t] = __builtin_amdgcn_mfma_f32_16x16x32_bf16(k0, vs0, S[t], 0, 0, 0);
                    S[t] = __builtin_amdgcn_mfma_f32_16x16x32_bf16(k1, vs1, S[t], 0, 0, 0); }
                Sf[0] = pack8(S[0], S[1]); Sf[1] = pack8(S[2], S[3]);
            }
            if (dry) { *(LAS v4u*)(C.lds + 110000 + (C.wave * 64 + lane) * 16) = __builtin_bit_cast(v4u, Sf[0]); }
        }
    }
    __syncthreads();
}
__device__ __forceinline__ void p7_dn3_fast(Ctx& C, int l) {
    const int lane = C.lane, l15 = lane & 15, g = lane >> 4;
    const bf16* qdn = WSP(bf16, WS_QDN); const bf16* kdn = WSP(bf16, WS_KDN);
    const v4u* VNb = WSP(v4u, WS_U); const v4u* SS = WSP(v4u, WS_XN); const bf16* zb = WSP(bf16, WS_ZB); bf16* mix = WSP(bf16, WS_MIX);
    LAS unsigned char* wl = C.lds + C.wave * 16384; const unsigned wl_addr = (unsigned)(uintptr_t)wl;
    const int cc0 = (l == 0) ? 0 : 4; const int ncc = NCH - cc0;
    gu32* qh = C.ctl + CW_Q + 64 * (2 * l + 1);
    for (int un = wq_next(qh, lane); un < NB * 8 * ncc; un = wq_next(qh, lane)) {
        const int cc = cc0 + un % ncc, h = (un / ncc) & 7, b = un / (8 * ncc);
        const int ck = chunk_ck(b, cc); const size_t m0 = (size_t)ck * 64;
        const size_t u0 = ((size_t)((b * 8 + h) * 2 + 0)) * NCH + cc;
        asm volatile("s_waitcnt lgkmcnt(0)" ::: "memory");
#pragma unroll
        for (int f = 0; f < 8; ++f) { attn64::glds16(SS + (u0 * 8 + f) * 64 + lane, (unsigned)__builtin_amdgcn_readfirstlane(wl_addr + f * 1024)); attn64::glds16(VNb + (u0 * 8 + f) * 64 + lane, (unsigned)__builtin_amdgcn_readfirstlane(wl_addr + 8192 + f * 1024)); }
        bf16x8 kf[4][2], qf[4][2];
#pragma unroll
        for (int t = 0; t < 4; ++t)
#pragma unroll
            for (int p = 0; p < 2; ++p) { kf[t][p] = *(const bf16x8*)(kdn + (m0 + pi_idx(t, l15)) * 512 + h * 64 + 32 * p + 8 * g); qf[t][p] = *(const bf16x8*)(qdn + (m0 + pi_idx(t, l15)) * 512 + h * 64 + 32 * p + 8 * g); }
        const float* gcb0 = WSP(float, WS_GCB) + u0 * 192; const float* gcb1 = gcb0 + (size_t)NCH * 192;
        f32x4_t o[4][4];
#pragma unroll
        for (int ni = 0; ni < 4; ++ni)
#pragma unroll
            for (int ne = 0; ne < 4; ++ne) o[ni][ne] = (f32x4_t){0.f, 0.f, 0.f, 0.f};
#pragma unroll
        for (int dir = 0; dir < 2; ++dir) {
            const float* gcbd = dir ? gcb1 : gcb0;
            f32x4_t rowg[4]; float gi[4];
#pragma unroll
            for (int t = 0; t < 4; ++t) { rowg[t] = *(const f32x4_t*)(gcbd + 64 + g * 16 + t * 4); gi[t] = gcbd[pi_idx(t, l15)]; }
            if (dir == 1) { const size_t u1 = u0 + NCH;
                asm volatile("s_waitcnt lgkmcnt(0)" ::: "memory");
#pragma unroll
                for (int f = 0; f < 8; ++f) { attn64::glds16(SS + (u1 * 8 + f) * 64 + lane, (unsigned)__builtin_amdgcn_readfirstlane(wl_addr + f * 1024)); attn64::glds16(VNb + (u1 * 8 + f) * 64 + lane, (unsigned)__builtin_amdgcn_readfirstlane(wl_addr + 8192 + f * 1024)); } }
            asm volatile("s_waitcnt vmcnt(0)" ::: "memory");
#pragma unroll
            for (int ni = 0; ni < 4; ++ni) {
                const int si = pi_idx(ni, l15);
                f32x4_t pt[4];
#pragma unroll
                for (int tj = 0; tj < 4; ++tj) { f32x4_t a = {0.f, 0.f, 0.f, 0.f};
                    a = __builtin_amdgcn_mfma_f32_16x16x32_bf16(kf[tj][0], qf[ni][0], a, 0, 0, 0);
                    a = __builtin_amdgcn_mfma_f32_16x16x32_bf16(kf[tj][1], qf[ni][1], a, 0, 0, 0);
#pragma unroll
                    for (int r = 0; r < 4; ++r) { const int sj = pi_idx(tj, 4 * g + r); const bool keep = dir ? (si <= sj) : (si >= sj);
                        a[r] = keep ? a[r] * __expf(gi[ni] - rowg[tj][r]) : 0.f; }
                    pt[tj] = a; }
                const bf16x8 pa0 = pack8(pt[0], pt[1]), pa1 = pack8(pt[2], pt[3]);
                float erow[4];
#pragma unroll
                for (int r = 0; r < 4; ++r) erow[r] = __expf(rowg[ni][r]);
#pragma unroll
                for (int ne = 0; ne < 4; ++ne) {
                    const bf16x8 s0 = *(const LAS bf16x8*)(wl + (ne * 2 + 0) * 1024 + lane * 16), s1 = *(const LAS bf16x8*)(wl + (ne * 2 + 1) * 1024 + lane * 16);
                    const bf16x8 v0 = *(const LAS bf16x8*)(wl + 8192 + (ne * 2 + 0) * 1024 + lane * 16), v1 = *(const LAS bf16x8*)(wl + 8192 + (ne * 2 + 1) * 1024 + lane * 16);
                    f32x4_t qs = {0.f, 0.f, 0.f, 0.f};
                    qs = __builtin_amdgcn_mfma_f32_16x16x32_bf16(qf[ni][0], s0, qs, 0, 0, 0);
                    qs = __builtin_amdgcn_mfma_f32_16x16x32_bf16(qf[ni][1], s1, qs, 0, 0, 0);
#pragma unroll
                    for (int r = 0; r < 4; ++r) o[ni][ne][r] += qs[r] * erow[r];
                    o[ni][ne] = __builtin_amdgcn_mfma_f32_16x16x32_bf16(pa0, v0, o[ni][ne], 0, 0, 0);
                    o[ni][ne] = __builtin_amdgcn_mfma_f32_16x16x32_bf16(pa1, v1, o[ni][ne], 0, 0, 0);
                    if (ne & 1) __builtin_amdgcn_sched_barrier(0); }
            }
        }
        asm volatile("s_waitcnt lgkmcnt(0)" ::: "memory");
        {   LAS bf16* ot = (LAS bf16*)wl;
#pragma unroll
            for (int ni = 0; ni < 4; ++ni)
#pragma unroll
                for (int ne = 0; ne < 4; ++ne) { const unsigned w0 = pk2(o[ni][ne][0], o[ni][ne][1]), w1 = pk2(o[ni][ne][2], o[ni][ne][3]); const int e = 16 * ne + l15;
                    ot[pi_idx(ni, 4 * g + 0) * 64 + e] = (bf16)(w0 & 0xffffu); ot[pi_idx(ni, 4 * g + 1) * 64 + e] = (bf16)(w0 >> 16);
                    ot[pi_idx(ni, 4 * g + 2) * 64 + e] = (bf16)(w1 & 0xffffu); ot[pi_idx(ni, 4 * g + 3) * 64 + e] = (bf16)(w1 >> 16); }
            asm volatile("s_waitcnt lgkmcnt(0)" ::: "memory");
            const size_t row = m0 + lane; float ov[64]; float ss = 0.f;
#pragma unroll
            for (int c = 0; c < 8; ++c) { const v4u w = *(const LAS v4u*)(wl + lane * 128 + c * 16);
                ov[c * 8 + 0] = bflo(w.x); ov[c * 8 + 1] = bfhi(w.x); ov[c * 8 + 2] = bflo(w.y); ov[c * 8 + 3] = bfhi(w.y); ov[c * 8 + 4] = bflo(w.z); ov[c * 8 + 5] = bfhi(w.z); ov[c * 8 + 6] = bflo(w.w); ov[c * 8 + 7] = bfhi(w.w); }
#pragma unroll
            for (int i = 0; i < 64; ++i) ss += ov[i] * ov[i];
            const float rs = 1.0f / sqrtf(ss * (1.f / 64.f) + EPS);
#pragma unroll
            for (int c = 0; c < 8; ++c) { float z[8]; load8(zb + row * 512 + h * 64 + c * 8, z); float r8[8];
#pragma unroll
                for (int i = 0; i < 8; ++i) r8[i] = ov[c * 8 + i] * rs * C.in[12][l * 64 + c * 8 + i] * silu_f(z[i]);
                store8(mix + row * 1024 + h * 64 + c * 8, r8); }
        }
    }
    asm volatile("s_waitcnt lgkmcnt(0)" ::: "memory");
}
__device__ __forceinline__ void p4_attn_fast(Ctx& C, char* ldsg, int l, bool dry = false) {
    const int bx = blockIdx.x; const int vcu = (C.G % 8 == 0) ? (bx % 8) * (C.G / 8) + bx / 8 : bx;
    attn64::bf16* mix = (attn64::bf16*)WSP(bf16, WS_MIX); attn64::bf16* omix = mix; const unsigned char* q8 = WSP(unsigned char, WS_XN); const unsigned char* k8 = WSP(unsigned char, WS_KALL); const unsigned char* v8 = WSP(unsigned char, WS_VALL);     const attn64::bf16* kall = (const attn64::bf16*)WSP(bf16, WS_KALL); const attn64::bf16* vall = (const attn64::bf16*)WSP(bf16, WS_VALL);
    float mq = fabsf(C.in[13][l * 64 + C.lane]), mk = fabsf(C.in[14][l * 64 + C.lane]);
#pragma unroll
    for (int o = 1; o < 64; o <<= 1) { mq = fmaxf(mq, __shfl_xor(mq, o)); mk = fmaxf(mk, __shfl_xor(mk, o)); }
    const float mref = 64.0f * QSCALE * mq * mk * 1.02f;
    const int nun = NB * 8 * (T / 256) + (l == 0 ? NB * 8 : 0);
    for (int L = vcu; L < nun; L += C.G) {
        int qrow, krow, nt, h;
        if (L < 1024) { const int within = L & 255, bh = within >> 3, qb = (within & 7) + 8 * (L >> 8); const int b = bh >> 3; h = bh & 7; qrow = b * T + qb * 256; krow = b * TK; nt = TK / 64; }
        else { const int b = (L - 1024) >> 3; h = L & 7; qrow = ML + b * LC; krow = b * TK + T; nt = LC / 64; }
        const int kvh = h >> 2;
        attn64::attn_unit8(q8 + (size_t)qrow * 512 + h * 64, omix + (size_t)qrow * 1024 + 512 + h * 64, k8 + (size_t)krow * 128 + kvh * 64, v8 + ((size_t)((krow / TK) * 2 + kvh) * (TK / 64) + (krow % TK) / 64) * 4096, nt, ldsg, mref);
    }
    __syncthreads();
}
__device__ __forceinline__ void tile64(Ctx& C, const bf16* X, int lda, const bf16* Wt, int ldb, int K, float (&r)[8]) {
    typedef pg8::bf16x8 frag_t; typedef pg8::f32x4 c4_t;
    const int lane = C.lane, r16 = lane & 15, g = lane >> 4, w = C.wave;
    const int npair = K >> 6, pbase = npair >> 3, prem = npair & 7;
    const int np = pbase + (w < prem ? 1 : 0), pstart = w * pbase + (w < prem ? w : prem);
    const bf16* xp = X + (size_t)r16 * lda + pstart * 64 + 16 * g;
    const bf16* wp = Wt + (size_t)r16 * ldb + pstart * 64 + 16 * g;
    c4_t acc[4][4];
#pragma unroll
    for (int a = 0; a < 4; ++a)
#pragma unroll
        for (int b = 0; b < 4; ++b) acc[a][b] = (c4_t){0.f, 0.f, 0.f, 0.f};
    frag_t xa[8], wa[8], xb[8], wb[8];
#define T64_LD(xf, wf, p) do { _Pragma("unroll") for (int t_ = 0; t_ < 4; ++t_) { const bf16* xq_ = xp + (size_t)(16 * t_) * lda + 64 * (p); const bf16* wq_ = wp + (size_t)(16 * t_) * ldb + 64 * (p); \
        xf[2 * t_] = *(const GAS frag_t*)(xq_); xf[2 * t_ + 1] = *(const GAS frag_t*)(xq_ + 8); wf[2 * t_] = *(const GAS frag_t*)(wq_); wf[2 * t_ + 1] = *(const GAS frag_t*)(wq_ + 8); } } while (0)
#define T64_MM(xf, wf) do { _Pragma("unroll") for (int h_ = 0; h_ < 2; ++h_) _Pragma("unroll") for (int nt_ = 0; nt_ < 4; ++nt_) _Pragma("unroll") for (int mt_ = 0; mt_ < 4; ++mt_) \
        acc[nt_][mt_] = __builtin_amdgcn_mfma_f32_16x16x32_bf16(wf[2 * nt_ + h_], xf[2 * mt_ + h_], acc[nt_][mt_], 0, 0, 0); } while (0)
#define T64_SB __builtin_amdgcn_sched_barrier(0)
    T64_LD(xa, wa, 0); if (1 < np) T64_LD(xb, wb, 1); T64_SB;
    for (int p = 0; p < np; p += 2) {
        T64_MM(xa, wa); T64_SB;
        if (p + 2 < np) T64_LD(xa, wa, p + 2); T64_SB;
        if (p + 1 < np) T64_MM(xb, wb); T64_SB;
        if (p + 3 < np) T64_LD(xb, wb, p + 3); T64_SB;
    }
#undef T64_SB
#undef T64_LD
#undef T64_MM
    LAS unsigned char* P = C.lds + w * 16384;
#pragma unroll
    for (int nt = 0; nt < 4; ++nt)
#pragma unroll
        for (int mt = 0; mt < 4; ++mt) { const int m = 16 * mt + r16, nb = (16 * nt + 4 * g) * 4; *(LAS c4_t*)(P + m * 256 + (nb ^ (r16 << 4))) = acc[nt][mt]; }
    __syncthreads();
    const int m = 8 * w + (lane >> 3), cb = (lane & 7) * 32, sw = (m & 15) << 4;
#pragma unroll
    for (int i = 0; i < 8; ++i) r[i] = 0.f;
#pragma unroll
    for (int q = 0; q < 8; ++q) { const LAS unsigned char* Q = C.lds + q * 16384 + m * 256; const c4_t a = *(const LAS c4_t*)(Q + (cb ^ sw)), b = *(const LAS c4_t*)(Q + ((cb + 16) ^ sw));
        r[0] += a[0]; r[1] += a[1]; r[2] += a[2]; r[3] += a[3]; r[4] += b[0]; r[5] += b[1]; r[6] += b[2]; r[7] += b[3]; }
    __syncthreads();
}
template <bool XF32> __device__ __forceinline__ void ctx_res_tiles(Ctx& C, const bf16* X, int lda, const bf16* Wt, int K, const void* xin, bf16* out, const float* gate) {
    for (int tI = blockIdx.x; tI < 256; tI += C.G) {
        const int xcd = tI & 7, idx = tI >> 3, ti = 8 * (xcd & 1) + (idx & 7), tj = 4 * (xcd >> 1) + (idx >> 3);
        float r[8]; tile64(C, X + (size_t)(64 * ti) * lda, lda, Wt + (size_t)(64 * tj) * K, K, K, r);
        const size_t off = (size_t)(64 * ti + 8 * C.wave + (C.lane >> 3)) * D + 64 * tj + 8 * (C.lane & 7);
        float x[8];
        if (XF32) { const f32x4 a = *(const GAS f32x4*)((const float*)xin + off), b = *(const GAS f32x4*)((const float*)xin + off + 4); x[0] = a.x; x[1] = a.y; x[2] = a.z; x[3] = a.w; x[4] = b.x; x[5] = b.y; x[6] = b.z; x[7] = b.w; }
        else load8((const bf16*)xin + off, x);
        const f32x4 ga = *(const GAS f32x4*)(gate + 64 * tj + 8 * (C.lane & 7)), gb = *(const GAS f32x4*)(gate + 64 * tj + 8 * (C.lane & 7) + 4);
        const float o[8] = {x[0] + ga.x * r[0], x[1] + ga.y * r[1], x[2] + ga.z * r[2], x[3] + ga.w * r[3], x[4] + gb.x * r[4], x[5] + gb.y * r[5], x[6] + gb.z * r[6], x[7] + gb.w * r[7]};
        store8(out + off, o);
    }
}
__device__ __forceinline__ void moe_down_tiles(Ctx& C, const int (&ps)[9], int p0, int p1) {
    const bf16* hm = WSP(bf16, WS_HM); const bf16* md = WSP(bf16, WS_MD); bf16* ys = WSP(bf16, WS_XS);
    const int nt = (p1 - p0) * 64;
    for (int tI = blockIdx.x; tI < nt; tI += C.G) {
        const int p = p0 + (tI >> 6), mi = (tI >> 4) & 3, nj = tI & 15; int e = 0;
#pragma unroll
        for (int k = 1; k < 8; ++k) e += (p >= ps[k]) ? 1 : 0;
        float r[8]; tile64(C, hm + (size_t)((p - p0) * 256 + 64 * mi) * EF, EF, md + (size_t)e * D * EF + (size_t)(64 * nj) * EF, EF, EF, r);
        store8(ys + (size_t)(p * 256 + 64 * mi + 8 * C.wave + (C.lane >> 3)) * D + 64 * nj + 8 * (C.lane & 7), r);
    }
}
#define STAMP() do {} while (0)
#define RELOAD() do { int t_ = threadIdx.x; asm volatile("" : "+v"(t_)); C.tid = t_; C.lane = t_ & 63; C.wave = __builtin_amdgcn_readfirstlane(t_ >> 6); C.gw = blockIdx.x * NWAVES + C.wave; } while (0)
#define GRID_BAR() do { XcdBarrier b2_ = bar; asm volatile("" : "+s"(b2_.x), "+s"(b2_.bar)); xcd_barrier(b2_); RELOAD(); STAMP(); } while (0)
template <int l> __device__ __forceinline__ void layer_fn(Ctx& C, const XcdBarrier& bar, unsigned char* lds) {
        bf16* const xb1 = (bf16*)C.out;
        const void* xl = (l == 0) ? (const void*)C.in[0] : (const void*)xb1; const void* xc = (l == 0) ? (const void*)C.in[2] : (const void*)WSP(bf16, WS_XC);
        norm_mod<false, l != 0>(C, xl, xc, MT, l, 1, 0, WSP(bf16, WS_XN));
        GRID_BAR();
        {   pg8::Gemm g{WSP(bf16, WS_XN), WSP(bf16, WS_WIN) + (size_t)l * NINP * D, MT, NINP, D}; pg8::StaticOrder S; S.init(MT, NINP, C.G, (int)blockIdx.x);
            pg8::EpiIn E{WSP(bf16, WS_DNRAW), WSP(bf16, WS_ZB), WSP(bf16, WS_QRAW), WSP(bf16, WS_KVRAW), WSP(float, WS_AB)};
            pg8::gemm_phase<pg8::EpiIn, pg8::StaticOrder, true, true>(C.lds, g, S, E); }
        GRID_BAR();
        p3_prep(C, l);
        RELOAD();
        p3b_dnconv(C, l);
        GRID_BAR();
        p4_attn_fast(C, (char*)lds, l);
        STAMP();
        RELOAD();
        p5_dn1_fast(C, l);
        GRID_BAR();
        p6_dn2_fast(C);
        GRID_BAR();
        p7_dn3_fast(C, l);
        GRID_BAR();
        {   const int Mo = ML;
            pg8::Gemm g{WSP(bf16, WS_MIX), WSP(bf16, WS_WOUT) + (size_t)l * D * D, Mo, D, D}; pg8::StaticOrder S; S.init(Mo, D, C.G, (int)blockIdx.x);
            pg8::EpiRes<l == 0> E{xl, (l == 0) ? xb1 : WSP(bf16, WS_XB2), xc, WSP(bf16, WS_XC), mods_ptr(C, l, 0, 2), 6 * 1024};
            pg8::gemm_phase<pg8::EpiRes<l == 0>, pg8::StaticOrder, true, true>(C.lds, g, S, E); }
        if (l == 0) { RELOAD(); ctx_res_tiles<true>(C, WSP(bf16, WS_MIX) + (size_t)ML * D, D, WSP(bf16, WS_WOUT), D, C.in[2], WSP(bf16, WS_XC), mods_ptr(C, 0, 4, 2)); }
        GRID_BAR();
        if (l == 0) {
            norm_mod<false, true>(C, xb1, WSP(bf16, WS_XC), MT, l, 4, 3, WSP(bf16, WS_XN));
            GRID_BAR();
            {   pg8::Gemm g{WSP(bf16, WS_XN), WSP(bf16, WS_WGU), MT, 2 * FF, D}; pg8::StaticOrder S; S.init(MT, 2 * FF, C.G, (int)blockIdx.x);
                pg8::EpiSwiGLU E{WSP(bf16, WS_H), FF, 22, 0};
                pg8::gemm_phase<pg8::EpiSwiGLU, pg8::StaticOrder, true, true>(C.lds, g, S, E); }
            GRID_BAR();
            {   pg8::Gemm g{WSP(bf16, WS_H), WSP(bf16, WS_WD), ML, D, FF}; pg8::StaticOrder S; S.init(ML, D, C.G, (int)blockIdx.x);
                pg8::EpiRes<false> E{xb1, xb1, WSP(bf16, WS_XC), WSP(bf16, WS_XC), mods_ptr(C, l, 0, 5), 6 * 1024};
                pg8::gemm_phase<pg8::EpiRes<false>, pg8::StaticOrder, true, true>(C.lds, g, S, E); }
            RELOAD(); ctx_res_tiles<false>(C, WSP(bf16, WS_H) + (size_t)ML * FF, FF, WSP(bf16, WS_WD), FF, WSP(bf16, WS_XC), WSP(bf16, WS_XC), mods_ptr(C, 0, 4, 5));
            GRID_BAR();
        } else {
            norm_mod<true, true>(C, WSP(bf16, WS_XB2), WSP(bf16, WS_XC), ML, l, 4, 3, WSP(bf16, WS_HM));
            RELOAD();
            moe_weights(C);
            GRID_BAR();
            moe_scatter(C, WSP(bf16, WS_HM));
            GRID_BAR();
            int ps[9], cnt[8]; moe_panel_starts(C, ps, cnt);
            const int per = SS_PANELS;
            for (int ss = 0; ss < NSS; ++ss) {
                const int p0 = ss * per, p1 = (p0 + per < ps[8]) ? p0 + per : ps[8];
                if (p0 < p1) {
                    pg8::MoeOrder S;
#pragma unroll
                    for (int k = 0; k < 9; ++k) S.ps[k] = ps[k];
                    S.p0 = p0; S.p1 = p1; S.nloc = 28; S.G = C.G; S.c = (int)blockIdx.x; S.a_off = 0;
                    pg8::Gemm g{WSP(bf16, WS_XS), WSP(bf16, WS_MGU), 0, 0, D};
                    pg8::EpiSwiGLU E{WSP(bf16, WS_HM), EF, 28, p0};
                    pg8::gemm_phase<pg8::EpiSwiGLU, pg8::MoeOrder, true, true>(C.lds, g, S, E);
                }
                GRID_BAR();
                if (p0 < p1 && p1 - p0 <= 12) { moe_down_tiles(C, ps, p0, p1); }
                else if (p0 < p1) {
                    pg8::MoeOrder S;
#pragma unroll
                    for (int k = 0; k < 9; ++k) S.ps[k] = ps[k];
                    S.p0 = p0; S.p1 = p1; S.nloc = 4; S.G = C.G; S.c = (int)blockIdx.x; S.a_off = -p0;
                    pg8::Gemm g{WSP(bf16, WS_HM), WSP(bf16, WS_MD), 0, 0, EF};
                    pg8::EpiBfPlain E{WSP(bf16, WS_XS) + (size_t)p0 * 256 * D, D, 4};
                    pg8::gemm_phase<pg8::EpiBfPlain, pg8::MoeOrder, true, true>(C.lds, g, S, E);
                }
                GRID_BAR();
            }
            moe_final(C, l);
        }
    }
struct Args { const float* in[25]; float* out; unsigned char* ws; };
__global__ void __launch_bounds__(NWAVES * 64, 2) mk_fwd(Args args) {
    extern __shared__ __attribute__((aligned(16))) unsigned char lds[];
    Ctx C;
    C.lds = (LAS unsigned char*)lds; C.tid = threadIdx.x; C.lane = C.tid & 63; C.wave = __builtin_amdgcn_readfirstlane(C.tid >> 6);
    C.G = gridDim.x; C.gw = blockIdx.x * NWAVES + C.wave; C.NGW = C.G * NWAVES;
    C.in = (const float* const __attribute__((address_space(4)))*)__builtin_amdgcn_kernarg_segment_ptr();
    C.out = args.out; C.ws = args.ws; C.ctl = (gu32*)args.ws;
    volatile LAS unsigned* MISC = (volatile LAS unsigned*)(C.lds + MISC_OFF);
    for (int u = C.tid; u < (LDS_BYTES - LDSCTL_OFF) / 4; u += NWAVES * 64) ((LAS unsigned*)(C.lds + LDSCTL_OFF))[u] = 0u;
    __syncthreads();
    XcdBarrier bar = xcd_barrier_post((unsigned*)(C.ctl + CW_BAR), MISC + 8);
    p0_weights(C); __syncthreads(); RELOAD(); p0_mods(C);
    GRID_BAR();
    layer_fn<0>(C, bar, lds);
    layer_fn<1>(C, bar, lds);
}

extern "C" void kernel_launch(void* const* d_in, const int* in_sizes, int n_in, void* d_out, int out_size, void* d_ws, size_t ws_size, hipStream_t stream) {
    static int grid = 0;
    if (grid == 0) {
        int dev = 0, cus = 0;
        if (n_in != 25 || out_size != ML * D || ws_size < (size_t)560 * MiB) { fprintf(stderr, "kernel_launch: unexpected problem (n_in %d out %d ws %zu)\n", n_in, out_size, ws_size); grid = -1; return; }
        if (hipGetDevice(&dev) != hipSuccess || hipDeviceGetAttribute(&cus, hipDeviceAttributeMultiprocessorCount, dev) != hipSuccess) { grid = -1; return; }
        if (hipFuncSetAttribute((const void*)mk_fwd, hipFuncAttributeMaxDynamicSharedMemorySize, LDS_BYTES) != hipSuccess) { grid = -1; return; }
        (void)hipGetLastError();
        grid = cus;
    }
    if (grid < 0) return;
    (void)hipMemsetAsync((char*)d_ws, 0, CTL_ZERO_BYTES, stream);
    Args a{};
    for (int i = 0; i < 25; ++i) a.in[i] = (const float*)d_in[i];
    a.out = (float*)d_out; a.ws = (unsigned char*)d_ws;
    hipLaunchKernelGGL(mk_fwd, dim3(grid), dim3(NWAVES * 64), LDS_BYTES, stream, a);
}
```

```cpp
#include <hip/hip_runtime.h>
#include <hip/hip_bf16.h>
#include <cstdio>
#include <cstdint>
#include <cmath>
namespace pg8 {
#define PG8_LAS __attribute__((address_space(3)))
typedef unsigned short bf16_t;
typedef short bf16x8 __attribute__((ext_vector_type(8)));
typedef float f32x4 __attribute__((ext_vector_type(4)));
typedef unsigned u32x4 __attribute__((ext_vector_type(4)));
constexpr int BM = 256, BK = 64, HALF = 128, HTB = HALF * BK * 2  , STAGE_BYTES = 8 * HTB, NXCD = 8, WGM = 8;

__host__ __device__ __forceinline__ int lds_byte(int r, int c) { const int st = (r >> 4) * 2 + (c >> 5), rr = r & 15, cc = c & 31, ob = rr * 64 + cc * 2; return st * 1024 + (ob ^ (((ob >> 9) & 1) << 5)); }
__host__ __device__ __forceinline__ void stage_rc(int b, int& R, int& C) { const int st = b / 1024, sb = b % 1024, swz = sb ^ (((sb >> 9) & 1) << 5); R = (st >> 1) * 16 + swz / 64; C = (st & 1) * 32 + (swz % 64) / 2; }
__host__ __device__ __forceinline__ int perm32(int rho) { const int n = rho >> 4, i = rho & 15; return 8 * (i >> 2) + 4 * n + (i & 3); }

struct Unit { int pm, pn; };
struct Gemm { const bf16_t* A; const bf16_t* Bt; int M, N, K; };

struct StaticOrder {
    int nM, nN, nwg, G, c;
    __host__ __device__ void init(int M, int N, int G_, int c_) { nM = M / BM; nN = N / BM; nwg = nM * nN; G = G_; c = c_; }
    __host__ __device__ bool next(int i, Unit& u) const {
        const long L = (long)i * G + c; if (L >= nwg) return false;
        int wgid = (int)L; { const int q = nwg / NXCD, r = nwg % NXCD, xcd = wgid % NXCD, off = wgid / NXCD; wgid = (xcd < r ? xcd * (q + 1) : r * (q + 1) + (xcd - r) * q) + off; }
        const int nig = WGM * nN, gid = wgid / nig, fm = gid * WGM, gsz = (nM - fm) < WGM ? (nM - fm) : WGM;
        u.pm = fm + ((wgid % nig) % gsz); u.pn = (wgid % nig) / gsz; return true;
    }
    __device__ __forceinline__ void a_ready(const Unit&) const {}
    __device__ __forceinline__ void done(const Unit&) const {}
};

__device__ __forceinline__ unsigned cvt_pk_bf16(float lo, float hi) { unsigned r; asm volatile("v_cvt_pk_bf16_f32 %0, %1, %2" : "=v"(r) : "v"(lo), "v"(hi)); return r; }
typedef float f32x2 __attribute__((ext_vector_type(2)));
__device__ __forceinline__ f32x2 gelu_pk(f32x2 v) {
    const f32x2 av = __builtin_elementwise_abs(v), d = av * 0.2316418882f + 1.0f;
    f32x2 t; t.x = __builtin_amdgcn_rcpf(d.x); t.y = __builtin_amdgcn_rcpf(d.y);
    f32x2 q = t * 0.5307027145f + (-0.7265760135f); q = q * t + 0.7107068705f; q = q * t + (-0.142248368f); q = q * t + 0.127414796f; q = q * t;
    const f32x2 s = (v * v) * (-0.72134752044f);
    f32x2 e; e.x = __builtin_amdgcn_exp2f(s.x); e.y = __builtin_amdgcn_exp2f(s.y);
    const f32x2 m = v * (q * e), r = v - m;
    f32x2 o; o.x = v.x < 0.f ? m.x : r.x; o.y = v.y < 0.f ? m.y : r.y; return o;
}

template <int ACT  > struct EpiBf16 {
    static constexpr bool PERM = true, AFTER_DRAIN = false; static_assert(ACT == 0 || ACT == 1, "EpiBf16: ACT is 0 (none) or 1 (gelu_pk)");
    bf16_t* O; int ldc; const float* bias; int split_cols; size_t split_stride; float scale0;
    __device__ __forceinline__ void operator()(const f32x4 (&acc)[2][2][4][2], const Unit& u, int wr, int wc, int fr, int fq) const {
        const int row0 = u.pm * BM + wr * 64 + fr; int colt = u.pn * BM; bf16_t* base = O;
        float sc = 1.f; if (split_cols) { const int t = colt / split_cols; base += (size_t)t * split_stride; colt -= t * split_cols; if (t == 0) sc = scale0; }
        const int col0 = colt + wc * 32 + 8 * fq, bcol0 = u.pn * BM + wc * 32 + 8 * fq;
        f32x4 bv[2][2];
#pragma unroll
        for (int bj = 0; bj < 2; ++bj)
#pragma unroll
            for (int n = 0; n < 2; ++n) bv[bj][n] = bias ? *(const f32x4*)(bias + bcol0 + bj * HALF + 4 * n) : (f32x4){0.f, 0.f, 0.f, 0.f};
#pragma unroll
        for (int ai = 0; ai < 2; ++ai)
#pragma unroll
            for (int m = 0; m < 4; ++m) { bf16_t* rowp = base + (size_t)(row0 + ai * HALF + m * 16) * ldc + col0;
#pragma unroll
                for (int bj = 0; bj < 2; ++bj) { f32x4 v0 = acc[ai][bj][m][0] + bv[bj][0], v1 = acc[ai][bj][m][1] + bv[bj][1];
                    if (ACT == 1) { f32x2 a = gelu_pk((f32x2){v0[0], v0[1]}), b = gelu_pk((f32x2){v0[2], v0[3]}), c = gelu_pk((f32x2){v1[0], v1[1]}), d = gelu_pk((f32x2){v1[2], v1[3]});
                        v0 = (f32x4){a.x, a.y, b.x, b.y}; v1 = (f32x4){c.x, c.y, d.x, d.y}; }
                    v0 = v0 * sc; v1 = v1 * sc; u32x4 w; w.x = cvt_pk_bf16(v0[0], v0[1]); w.y = cvt_pk_bf16(v0[2], v0[3]); w.z = cvt_pk_bf16(v1[0], v1[1]); w.w = cvt_pk_bf16(v1[2], v1[3]);
                    *(u32x4*)(rowp + bj * HALF) = w; } }
    }
};

template <class Epi, class Sched, bool ALIGN_EPI = false, bool SP2 = false>
__device__ __forceinline__ void gemm_phase(PG8_LAS unsigned char* lds, const Gemm g, const Sched& S, const Epi& E) {
    int tid_ = threadIdx.x; asm volatile("" : "+v"(tid_));
    const int tid = tid_, wid = __builtin_amdgcn_readfirstlane(tid >> 6), lane = tid & 63, wr = wid >> 2, wc = wid & 3, fr = lane & 15, fq = lane >> 4;
    const int K = g.K, nt = K / BK;
    unsigned voffA[2], voffB[2];
#pragma unroll
    for (int i = 0; i < 2; ++i) { int R, C; stage_rc(tid * 16 + i * 8192, R, C); const int Rb = Epi::PERM ? ((R & ~31) + perm32(R & 31)) : R;
        voffA[i] = (unsigned)(R * K + C) * 2u; voffB[i] = (unsigned)(Rb * K + C) * 2u; }
    const size_t kstep = (size_t)(BK * 2);
    const size_t hstep = (size_t)HALF * K * 2;
    const size_t tstep = 2 * hstep;
    const unsigned ldsw = (unsigned)wid * 1024u;
    const int aoff = lds_byte(wr * 64 + fr, fq * 8), boff = lds_byte(wc * 32 + fr, fq * 8);
#define PG8_SA(b, h) (((b) * 2 + (h)) * HTB)
#define PG8_SB(b, h) ((4 + (b) * 2 + (h)) * HTB)
#define PG8_STAGE(bufoff, gbase, voff) do { _Pragma("unroll") for (int _i = 0; _i < 2; ++_i) \
        __builtin_amdgcn_global_load_lds((const unsigned*)((const char*)(gbase) + (voff)[_i]), (PG8_LAS unsigned*)(lds + (bufoff) + ldsw + _i * 8192), 16, 0, 0); } while (0)
#define PG8_LDA(dst, b, h) do { _Pragma("unroll") for (int m = 0; m < 4; ++m) _Pragma("unroll") for (int k = 0; k < 2; ++k) dst[m][k] = *(const PG8_LAS bf16x8*)(lds + PG8_SA(b, h) + aoff + m * 2048 + k * 1024); } while (0)
#define PG8_LDB(dst, b, h) do { _Pragma("unroll") for (int n = 0; n < 2; ++n) _Pragma("unroll") for (int k = 0; k < 2; ++k) dst[n][k] = *(const PG8_LAS bf16x8*)(lds + PG8_SB(b, h) + boff + n * 2048 + k * 1024); } while (0)
#define PG8_MMA(ai, bj, At, Bt) do { __builtin_amdgcn_s_setprio(1); _Pragma("unroll") for (int m = 0; m < 4; ++m) _Pragma("unroll") for (int n = 0; n < 2; ++n) _Pragma("unroll") for (int k = 0; k < 2; ++k) \
        acc[ai][bj][m][n] = __builtin_amdgcn_mfma_f32_16x16x32_bf16(Bt[n][k], At[m][k], acc[ai][bj][m][n], 0, 0, 0); __builtin_amdgcn_s_setprio(0); } while (0)
#define PG8_WAIT_V(n) asm volatile("s_waitcnt vmcnt(" #n ")" ::: "memory")
#define PG8_WAIT_L(n) asm volatile("s_waitcnt lgkmcnt(" #n ")" ::: "memory")
#define PG8_BAR __builtin_amdgcn_s_barrier()
#define PG8_SCHED __builtin_amdgcn_sched_barrier(0)
    Unit cur, nxt; int ui = 0;
    if (!S.next(0, cur)) return;
    f32x4 acc[2][2][4][2];
#pragma unroll
    for (int a = 0; a < 2; ++a)
#pragma unroll
        for (int b = 0; b < 2; ++b)
#pragma unroll
            for (int m = 0; m < 4; ++m)
#pragma unroll
                for (int n = 0; n < 2; ++n) acc[a][b][m][n] = (f32x4){0.f, 0.f, 0.f, 0.f};
    bf16x8 At[4][2], B0[2][2], B1[2][2];
    const char* cA = (const char*)g.A + (size_t)cur.pm * tstep; const char* cB = (const char*)g.Bt + (size_t)cur.pn * tstep;
    S.a_ready(cur);
    if constexpr (SP2) {
        PG8_STAGE(PG8_SB(0, 0), cB, voffB); PG8_STAGE(PG8_SB(0, 1), cB + hstep, voffB); PG8_STAGE(PG8_SA(0, 0), cA, voffA); PG8_STAGE(PG8_SA(0, 1), cA + hstep, voffA);
        if (wr == 1) PG8_BAR;
        PG8_WAIT_V(2); PG8_BAR;
        PG8_STAGE(PG8_SB(1, 0), cB + kstep, voffB); PG8_STAGE(PG8_SA(1, 0), cA + kstep, voffA); PG8_STAGE(PG8_SB(1, 1), cB + hstep + kstep, voffB);
        PG8_WAIT_V(6); PG8_BAR;
    } else {
        PG8_STAGE(PG8_SB(0, 0), cB, voffB); PG8_STAGE(PG8_SA(0, 0), cA, voffA); PG8_STAGE(PG8_SB(0, 1), cB + hstep, voffB); PG8_STAGE(PG8_SA(0, 1), cA + hstep, voffA);
        if (wr == 1) PG8_BAR;
        PG8_WAIT_V(4); PG8_BAR;
        PG8_STAGE(PG8_SB(1, 0), cB + kstep, voffB); PG8_STAGE(PG8_SA(1, 0), cA + kstep, voffA); PG8_STAGE(PG8_SB(1, 1), cB + hstep + kstep, voffB);
        PG8_WAIT_V(6); PG8_BAR;
    }
    for (;;) {
        const bool has_next = S.next(ui + 1, nxt);
        const char* nA = has_next ? (const char*)g.A + (size_t)nxt.pm * tstep : cA; const char* nB = has_next ? (const char*)g.Bt + (size_t)nxt.pn * tstep : cB;
        for (int t = 0; t < nt; t += 2) {
            const bool last = (t == nt - 2);
            const char* a1 = cA + (size_t)(t + 1) * kstep;
            const char* a2 = last ? nA : cA + (size_t)(t + 2) * kstep; const char* b2 = last ? nB : cB + (size_t)(t + 2) * kstep;
            const char* a3 = a2 + kstep; const char* b3 = b2 + kstep;
            if (last && has_next) S.a_ready(nxt);
            if constexpr (SP2) {
            PG8_LDB(B0, 0, 0); PG8_LDB(B1, 0, 1); PG8_SCHED; PG8_LDA(At, 0, 0); PG8_STAGE(PG8_SA(1, 1), a1 + hstep, voffA);
            PG8_WAIT_V(8); PG8_WAIT_L(0); PG8_BAR; PG8_MMA(0, 0, At, B0); PG8_MMA(0, 1, At, B1); PG8_BAR; PG8_SCHED;
            PG8_LDA(At, 0, 1); PG8_STAGE(PG8_SB(0, 0), b2, voffB); PG8_STAGE(PG8_SB(0, 1), b2 + hstep, voffB); PG8_STAGE(PG8_SA(0, 0), a2, voffA);
            PG8_WAIT_V(8); PG8_WAIT_L(0); PG8_BAR; PG8_MMA(1, 0, At, B0); PG8_MMA(1, 1, At, B1); PG8_BAR; PG8_SCHED;
            PG8_LDB(B0, 1, 0); PG8_LDB(B1, 1, 1); PG8_SCHED; PG8_LDA(At, 1, 0); PG8_STAGE(PG8_SA(0, 1), a2 + hstep, voffA);
            PG8_WAIT_V(8); PG8_WAIT_L(0); PG8_BAR; PG8_MMA(0, 0, At, B0); PG8_MMA(0, 1, At, B1); PG8_BAR; PG8_SCHED;
            PG8_LDA(At, 1, 1); PG8_STAGE(PG8_SB(1, 0), b3, voffB); PG8_STAGE(PG8_SB(1, 1), b3 + hstep, voffB); PG8_STAGE(PG8_SA(1, 0), a3, voffA);
            PG8_WAIT_V(8); PG8_WAIT_L(0); PG8_BAR; PG8_MMA(1, 0, At, B0); PG8_MMA(1, 1, At, B1); PG8_BAR; PG8_SCHED;
            } else {
            PG8_LDB(B0, 0, 0); PG8_SCHED; PG8_LDA(At, 0, 0); PG8_STAGE(PG8_SA(1, 1), a1 + hstep, voffA);
            PG8_WAIT_L(8); PG8_BAR; PG8_WAIT_L(0); PG8_MMA(0, 0, At, B0); PG8_BAR; PG8_SCHED;
            PG8_LDB(B1, 0, 1); PG8_STAGE(PG8_SB(0, 0), b2, voffB);
            PG8_BAR; PG8_WAIT_L(0); PG8_MMA(0, 1, At, B1); PG8_BAR;
            PG8_LDA(At, 0, 1); PG8_STAGE(PG8_SA(0, 0), a2, voffA);
            PG8_BAR; PG8_WAIT_L(0); PG8_MMA(1, 0, At, B0); PG8_BAR; PG8_SCHED;
            PG8_STAGE(PG8_SB(0, 1), b2 + hstep, voffB);
            PG8_WAIT_V(6); PG8_BAR; PG8_MMA(1, 1, At, B1); PG8_BAR;
            PG8_LDB(B0, 1, 0); PG8_SCHED; PG8_LDA(At, 1, 0); PG8_STAGE(PG8_SA(0, 1), a2 + hstep, voffA);
            PG8_WAIT_L(8); PG8_BAR; PG8_WAIT_L(0); PG8_MMA(0, 0, At, B0); PG8_BAR; PG8_SCHED;
            PG8_LDB(B1, 1, 1); PG8_STAGE(PG8_SB(1, 0), b3, voffB);
            PG8_BAR; PG8_WAIT_L(0); PG8_MMA(0, 1, At, B1); PG8_BAR;
            PG8_LDA(At, 1, 1); PG8_STAGE(PG8_SA(1, 0), a3, voffA);
            PG8_BAR; PG8_WAIT_L(0); PG8_MMA(1, 0, At, B0); PG8_BAR; PG8_SCHED;
            PG8_STAGE(PG8_SB(1, 1), b3 + hstep, voffB);
            PG8_WAIT_V(6); PG8_BAR; PG8_MMA(1, 1, At, B1); PG8_BAR;
            }
        }
        if constexpr (ALIGN_EPI) { if (wr == 0) PG8_BAR; }
        if constexpr (!Epi::AFTER_DRAIN) { E(acc, cur, wr, wc, fr, fq); S.done(cur); }
        if (!has_next) break;
#pragma unroll
        for (int a = 0; a < 2; ++a)
#pragma unroll
            for (int b = 0; b < 2; ++b)
#pragma unroll
                for (int m = 0; m < 4; ++m)
#pragma unroll
                    for (int n = 0; n < 2; ++n) acc[a][b][m][n] = (f32x4){0.f, 0.f, 0.f, 0.f};
        cur = nxt; cA = nA; cB = nB; ++ui;
        if constexpr (ALIGN_EPI) { if (wr == 1) PG8_BAR; }
    }
    PG8_WAIT_V(0);
    if constexpr (!ALIGN_EPI) { if (wr == 0) PG8_BAR; }
    PG8_BAR;
    if constexpr (Epi::AFTER_DRAIN) { E.fused(acc, cur, wr, wc, fr, fq, lds, wid, lane); S.done(cur); }
#undef PG8_SA
#undef PG8_SB
#undef PG8_STAGE
#undef PG8_LDA
#undef PG8_LDB
#undef PG8_MMA
#undef PG8_WAIT_V
#undef PG8_WAIT_L
#undef PG8_BAR
#undef PG8_SCHED
}
}
namespace attn64 {
using bf16=__hip_bfloat16;
using bf16x8=__attribute__((ext_vector_type(8)))short;
using s16x4=__attribute__((ext_vector_type(4)))short;
using f32x16=__attribute__((ext_vector_type(16)))float;
using u32x4=__attribute__((ext_vector_type(4)))unsigned;
constexpr int D=64,QP=1024,KP=128;
constexpr int NW=8,QBLK=32,QB=QBLK*NW,KVBLK=64;
__device__ __forceinline__ int crow(int r,int hi){return (r&3)+8*(r>>2)+4*hi;}
#define SBAR() __builtin_amdgcn_sched_barrier(0)
constexpr int NSLOT=3, SLOTB=8192;
constexpr int LDS_K=0, LDS_V=NSLOT*SLOTB, LDS_WS=2*NSLOT*SLOTB, LDS_OST=LDS_WS+NW*64*4, LDS_BYTES=LDS_OST+NW*4096;
constexpr float C2=0.125f*1.4426950408889634f;
__device__ __forceinline__ void glds16(const void*gsrc,unsigned lds_dst){unsigned keep;
  asm volatile("s_mov_b32 %0, m0\n\ts_mov_b32 m0, %2\n\ts_nop 0\n\tglobal_load_lds_dwordx4 %1, off\n\ts_mov_b32 m0, %0":"=&s"(keep):"v"(gsrc),"s"(lds_dst):"memory");}
__device__ __forceinline__ float max3f(float a,float b,float c){float r;asm("v_max3_f32 %0, %1, %2, %3":"=v"(r):"v"(a),"v"(b),"v"(c));return r;}
__device__ __forceinline__ float max2f(float a,float b){float r;asm("v_max_f32_e32 %0, %1, %2":"=v"(r):"v"(a),"v"(b));return r;}
__device__ __forceinline__ float fadd_s(float a,float b){float r;asm("v_add_f32_e32 %0, %1, %2":"=v"(r):"v"(a),"v"(b));return r;}
__device__ __forceinline__ float fsub_s(float a,float b){float r;asm("v_sub_f32_e32 %0, %1, %2":"=v"(r):"v"(a),"v"(b));return r;}
typedef float f32x2_t __attribute__((ext_vector_type(2))); typedef __bf16 bf16x2_t __attribute__((ext_vector_type(2)));
__device__ __forceinline__ unsigned cvtpk_s(float lo,float hi){f32x2_t v={lo,hi};bf16x2_t b=__builtin_convertvector(v,bf16x2_t);return __builtin_bit_cast(unsigned,b);}
#define WAIT_BAR(N) asm volatile("s_waitcnt vmcnt(" #N ") lgkmcnt(0)\n\ts_barrier":::"memory")

__device__ __forceinline__ void qkt(f32x16&p0,f32x16&p1,const char*Kslot,const bf16x8*qr,const f32x16&negm,int r32,int hi){
  const char*kb=Kslot+hi*1024+r32*16;
  #pragma unroll
  for(int d0=0;d0<4;++d0){
    const bf16x8 b0=*reinterpret_cast<const bf16x8*>(kb+d0*2048);
    const bf16x8 b1=*reinterpret_cast<const bf16x8*>(kb+d0*2048+512);
    if(d0==0){p0=__builtin_amdgcn_mfma_f32_32x32x16_bf16(b0,qr[0],negm,0,0,0);p1=__builtin_amdgcn_mfma_f32_32x32x16_bf16(b1,qr[0],negm,0,0,0);}
    else{p0=__builtin_amdgcn_mfma_f32_32x32x16_bf16(b0,qr[d0],p0,0,0,0);p1=__builtin_amdgcn_mfma_f32_32x32x16_bf16(b1,qr[d0],p1,0,0,0);}}
}
typedef __attribute__((address_space(3))) const char* lds_cptr;
typedef short v4i16_t __attribute__((ext_vector_type(4)));
__device__ __forceinline__ void kload8(bf16x8*kf,lds_cptr kp){
  kf[0]=*(const __attribute__((address_space(3))) bf16x8*)(kp);      kf[1]=*(const __attribute__((address_space(3))) bf16x8*)(kp+512);
  kf[2]=*(const __attribute__((address_space(3))) bf16x8*)(kp+2048); kf[3]=*(const __attribute__((address_space(3))) bf16x8*)(kp+2560);
  kf[4]=*(const __attribute__((address_space(3))) bf16x8*)(kp+4096); kf[5]=*(const __attribute__((address_space(3))) bf16x8*)(kp+4608);
  kf[6]=*(const __attribute__((address_space(3))) bf16x8*)(kp+6144); kf[7]=*(const __attribute__((address_space(3))) bf16x8*)(kp+6656);
}
__device__ __forceinline__ void kload2(bf16x8*kf,lds_cptr kp,int j){ kf[2*j]=*(const __attribute__((address_space(3))) bf16x8*)(kp+j*2048); kf[2*j+1]=*(const __attribute__((address_space(3))) bf16x8*)(kp+j*2048+512); }
__device__ __forceinline__ s16x4 vtr(lds_cptr p){ return __builtin_bit_cast(s16x4,__builtin_amdgcn_ds_read_tr16_b64_v4i16((__attribute__((address_space(3))) v4i16_t*)p)); }
__device__ __forceinline__ float rowmax(const f32x16&p0,const f32x16&p1){
  float a=max3f(p0[0],p0[1],p1[0]),b=max3f(p0[2],p0[3],p1[1]);a=max3f(a,p1[2],p1[3]);
  #pragma unroll
  for(int r=4;r<16;r+=4){a=max3f(a,p0[r],p0[r+1]);b=max3f(b,p0[r+2],p0[r+3]);a=max3f(a,p1[r],p1[r+1]);b=max3f(b,p1[r+2],p1[r+3]);}
  const float m=max2f(a,b);
  auto rr=__builtin_amdgcn_permlane32_swap(__float_as_uint(m),__float_as_uint(m),false,false);
  return max2f(__uint_as_float(rr[0]),__uint_as_float(rr[1]));
}
__device__ __forceinline__ void pv(f32x16*o,int vb,bf16x8 pa0,bf16x8 pa1,bf16x8 pa2,bf16x8 pa3){
  #pragma unroll
  for(int d0=0;d0<2;++d0){s16x4 lo[4],hi[4];
    #pragma unroll
    for(int ks=0;ks<4;++ks){
      asm volatile("ds_read_b64_tr_b16 %0,%1 offset:%c2":"=&v"(lo[ks]):"v"(vb),"i"(d0*4096+ks*1024):"memory");
      asm volatile("ds_read_b64_tr_b16 %0,%1 offset:%c2":"=&v"(hi[ks]):"v"(vb),"i"(d0*4096+ks*1024+512):"memory");}
    asm volatile("s_waitcnt lgkmcnt(0)":::"memory");SBAR();
    #define PK(k) (bf16x8){lo[k][0],lo[k][1],lo[k][2],lo[k][3],hi[k][0],hi[k][1],hi[k][2],hi[k][3]}
    o[d0]=__builtin_amdgcn_mfma_f32_32x32x16_bf16(pa0,PK(0),o[d0],0,0,0);
    o[d0]=__builtin_amdgcn_mfma_f32_32x32x16_bf16(pa1,PK(1),o[d0],0,0,0);
    o[d0]=__builtin_amdgcn_mfma_f32_32x32x16_bf16(pa2,PK(2),o[d0],0,0,0);
    o[d0]=__builtin_amdgcn_mfma_f32_32x32x16_bf16(pa3,PK(3),o[d0],0,0,0);
    #undef PK
  }
}

#ifndef ATTN_STORE16
#define ATTN_STORE16(p,v) (*(u32x4*)(p)=(v))
#endif
template<int THRL> __device__ __forceinline__ void attn_unit(const bf16*Q0,bf16*O0,const bf16*__restrict__ Kh,const bf16*__restrict__ Vh,const int NT,char*shm,const float mref){
  int tid_=threadIdx.x; asm volatile("":"+v"(tid_)); const int tid=tid_,lane=tid&63,r32=lane&31,hi=lane>>5; const int wid=__builtin_amdgcn_readfirstlane(tid>>6);
  const bf16*Qw=Q0+(long)(wid*QBLK)*QP;
  const unsigned lds0=(unsigned)(uintptr_t)shm;
  float*wsf=(float*)(shm+LDS_WS)+wid*64;
  const bf16*ksrc=Kh+(long)lane*KP+wid*8;
  const bf16*vsrc=Vh+(long)(16*(wid&3)+(lane>>2))*KP+(wid>>2)*32+(lane&3)*8;
  const unsigned kdst=lds0+LDS_K+wid*1024, vdst=lds0+LDS_V+wid*1024;
  #define DMA_K(t,slot) glds16(ksrc+(long)(t)*KVBLK*KP,(unsigned)__builtin_amdgcn_readfirstlane(kdst+(slot)))
  #define DMA_V(t,slot) glds16(vsrc+(long)(t)*KVBLK*KP,(unsigned)__builtin_amdgcn_readfirstlane(vdst+(slot)))
  const int vb0=(int)(lds0+LDS_V)+((lane>>4)&1)*32+(lane&3)*8+(4*hi+((lane&15)>>2))*64;
  const char*Kbase=shm+LDS_K; bf16x8 kf[8];
  const lds_cptr shm3=(lds_cptr)shm; const lds_cptr kp0=shm3+LDS_K+hi*1024+r32*16; const lds_cptr vp0=shm3+LDS_V+((lane>>4)&1)*32+(lane&3)*8+(4*hi+((lane&15)>>2))*64;
  DMA_K(0,0);DMA_V(0,0);DMA_K(1,SLOTB);
  bf16x8 qr[4];
  #pragma unroll
  for(int d0=0;d0<4;++d0)qr[d0]=*reinterpret_cast<const bf16x8*>(&Qw[(long)r32*QP+d0*16+hi*8]);
  float l_reg=0.f;f32x16 o[2];o[0]=f32x16{};o[1]=f32x16{};f32x16 negm;
  _Pragma("unroll") for(int r=0;r<16;++r)negm[r]=-mref;
  asm volatile("":"+v"(negm));
  #define CMASK(P0,P1,t) do{}while(0)
  #define START(P0,P1) do{ _Pragma("unroll") for(int r=0;r<16;++r)P0[r]=__builtin_amdgcn_exp2f(P0[r]); }while(0)
  #define RESC() do{}while(0)
  f32x16 pA0,pA1,pB0,pB1;
  int sl_prev=0,sl_cur=0,sl_next=SLOTB;
  #define ROT() do{sl_prev=sl_cur;sl_cur=sl_next;sl_next=(sl_next==(NSLOT-1)*SLOTB)?0:sl_next+SLOTB;}while(0)
  DMA_K(2,2*SLOTB);
  WAIT_BAR(3);
  qkt(pA0,pA1,Kbase,qr,negm,r32,hi);asm volatile("s_nop 15\n\ts_nop 7":"+v"(pA0),"+v"(pA1));CMASK(pA0,pA1,0);
  START(pA0,pA1);
  _Pragma("unroll") for(int r=0;r<16;++r)pA1[r]=__builtin_amdgcn_exp2f(pA1[r]);
  WAIT_BAR(0);
  DMA_K(3,0);DMA_V(1,SLOTB);
  ROT();
  kload8(kf,kp0+sl_cur);
  WAIT_BAR(2);
  s16x4 vlo[8],vhi[8]; u32x4 pw0,pw1,pw2,pw3;
  #define PKW(P,B) cvtpk_s(P[B],P[B+1])
  #define PAF(k) __builtin_bit_cast(bf16x8,pw##k)
  #define VFR(i) (bf16x8){vlo[i][0],vlo[i][1],vlo[i][2],vlo[i][3],vhi[i][0],vhi[i][1],vhi[i][2],vhi[i][3]}
  #define PIN(x) asm volatile("":"+v"(x))
  #define MX3(a,b,c) __builtin_fmaxf(__builtin_fmaxf((a),(b)),(c))
  #define GAPA(MF,A0,A1,A2,A3,W0,W1,PW) do{ MF; sacc+=A0; sacc+=A1; sacc+=A2; sacc+=A3; PIN(sacc); W0; W1; PIN(PW); SBAR(); }while(0)
  #define EX(v) __builtin_amdgcn_exp2f(v)
  #define GAPB(MF,X,B) do{ MF; X[B]=EX(X[B]); X[B+1]=EX(X[B+1]); X[B+2]=EX(X[B+2]); X[B+3]=EX(X[B+3]); PIN(X); SBAR(); }while(0)
  #define VRD(i) do{ vlo[i]=vtr(vp_+(((i)>>2)*4096+((i)&3)*1024)); vhi[i]=vtr(vp_+(((i)>>2)*4096+((i)&3)*1024+512)); }while(0)
  #define KRD(G,j) do{ if(G){ kload2(kf,kp0+sl_next,j); SBAR(); } }while(0)
  #define STEP(C0,C1,P0,P1,t,GK,GV,GL) do{ SBAR(); \
    const lds_cptr vp_=vp0+sl_prev; \
    VRD(0); SBAR(); float sacc=(P0[0]+P0[1]); \
    GAPA(C0=__builtin_amdgcn_mfma_f32_32x32x16_bf16(kf[0],qr[0],negm,0,0,0), P0[2],P0[3],P0[4],P0[5],     pw0[0]=PKW(P0,0), pw0[1]=PKW(P0,2), pw0); \
    VRD(4); SBAR(); GAPA(C1=__builtin_amdgcn_mfma_f32_32x32x16_bf16(kf[1],qr[0],negm,0,0,0), P0[6],P0[7],P0[8],P0[9],     pw0[2]=PKW(P0,4), pw0[3]=PKW(P0,6), pw0); \
    VRD(1); SBAR(); GAPA(C0=__builtin_amdgcn_mfma_f32_32x32x16_bf16(kf[2],qr[1],C0,0,0,0),   P0[10],P0[11],P0[12],P0[13], pw1[0]=PKW(P0,8), pw1[1]=PKW(P0,10), pw1); \
    VRD(5); SBAR(); GAPA(C1=__builtin_amdgcn_mfma_f32_32x32x16_bf16(kf[3],qr[1],C1,0,0,0),   P0[14],P0[15],P1[0],P1[1],   pw1[2]=PKW(P0,12),pw1[3]=PKW(P0,14), pw1); \
    VRD(2); SBAR(); GAPA(C0=__builtin_amdgcn_mfma_f32_32x32x16_bf16(kf[4],qr[2],C0,0,0,0),   P1[2],P1[3],P1[4],P1[5],     pw2[0]=PKW(P1,0), pw2[1]=PKW(P1,2), pw2); \
    VRD(6); SBAR(); GAPA(C1=__builtin_amdgcn_mfma_f32_32x32x16_bf16(kf[5],qr[2],C1,0,0,0),   P1[6],P1[7],P1[8],P1[9],     pw2[2]=PKW(P1,4), pw2[3]=PKW(P1,6), pw2); \
    VRD(3); SBAR(); GAPA(C0=__builtin_amdgcn_mfma_f32_32x32x16_bf16(kf[6],qr[3],C0,0,0,0),   P1[10],P1[11],P1[12],P1[13], pw3[0]=PKW(P1,8), pw3[1]=PKW(P1,10), pw3); \
    VRD(7); SBAR(); GAPA(C1=__builtin_amdgcn_mfma_f32_32x32x16_bf16(kf[7],qr[3],C1,0,0,0),   P1[14],P1[15],0.f,0.f,       pw3[2]=PKW(P1,12),pw3[3]=PKW(P1,14), pw3); \
    l_reg+=sacc; \
    if(GK){DMA_K((t)+3,sl_cur);} if(GV){DMA_V((t)+1,sl_next);} \
    CMASK(C0,C1,t); \
    SBAR(); \
    GAPB(o[0]=__builtin_amdgcn_mfma_f32_32x32x16_bf16(PAF(0),VFR(0),o[0],0,0,0), C0,0); \
    GAPB(o[1]=__builtin_amdgcn_mfma_f32_32x32x16_bf16(PAF(0),VFR(4),o[1],0,0,0), C0,4); \
    KRD(GL,0); GAPB(o[0]=__builtin_amdgcn_mfma_f32_32x32x16_bf16(PAF(1),VFR(1),o[0],0,0,0), C0,8); \
    KRD(GL,1); GAPB(o[1]=__builtin_amdgcn_mfma_f32_32x32x16_bf16(PAF(1),VFR(5),o[1],0,0,0), C0,12); \
    KRD(GL,2); GAPB(o[0]=__builtin_amdgcn_mfma_f32_32x32x16_bf16(PAF(2),VFR(2),o[0],0,0,0), C1,0); \
    KRD(GL,3); GAPB(o[1]=__builtin_amdgcn_mfma_f32_32x32x16_bf16(PAF(2),VFR(6),o[1],0,0,0), C1,4); \
    GAPB(o[0]=__builtin_amdgcn_mfma_f32_32x32x16_bf16(PAF(3),VFR(3),o[0],0,0,0), C1,8); \
    GAPB(o[1]=__builtin_amdgcn_mfma_f32_32x32x16_bf16(PAF(3),VFR(7),o[1],0,0,0), C1,12); \
    }while(0)
  int t=1;
  for(;t+5<NT;t+=2){
    STEP(pB0,pB1,pA0,pA1,t,true,true,true);     WAIT_BAR(2); RESC(); ROT();
    STEP(pA0,pA1,pB0,pB1,t+1,true,true,true);   WAIT_BAR(2); RESC(); ROT();
  }
  #define ENDW(tt) do{ if((tt)+3<NT){WAIT_BAR(2);} else if((tt)+2<NT){WAIT_BAR(1);} else {WAIT_BAR(0);} }while(0)
  for(;t+1<NT;t+=2){
    STEP(pB0,pB1,pA0,pA1,t,(t+3<NT),(t+1<NT),(t+1<NT));       ENDW(t);   RESC(); ROT();
    STEP(pA0,pA1,pB0,pB1,t+1,(t+4<NT),(t+2<NT),(t+2<NT));     ENDW(t+1); RESC(); ROT();
  }
  STEP(pB0,pB1,pA0,pA1,NT-1,false,false,false); RESC();
  { float sacc=pB0[0]+pB0[1]; _Pragma("unroll") for(int r=2;r<16;++r)sacc+=pB0[r]; _Pragma("unroll") for(int r=0;r<16;++r)sacc+=pB1[r]; l_reg+=sacc;
    pw0=(u32x4){PKW(pB0,0),PKW(pB0,2),PKW(pB0,4),PKW(pB0,6)};pw1=(u32x4){PKW(pB0,8),PKW(pB0,10),PKW(pB0,12),PKW(pB0,14)};pw2=(u32x4){PKW(pB1,0),PKW(pB1,2),PKW(pB1,4),PKW(pB1,6)};pw3=(u32x4){PKW(pB1,8),PKW(pB1,10),PKW(pB1,12),PKW(pB1,14)};
    SBAR(); pv(o,vb0+sl_cur,PAF(0),PAF(1),PAF(2),PAF(3)); }
  #undef PKW
  #undef PAF
  #undef VFR
  #undef PIN
  #undef MX3
  #undef GAPA
  #undef GAPB
  #undef EX
  #undef VRD
  #undef KRD
  #undef STEP
  #undef ENDW
  {auto rr=__builtin_amdgcn_permlane32_swap(__float_as_uint(l_reg),__float_as_uint(l_reg),false,false);l_reg=__uint_as_float(rr[0])+__uint_as_float(rr[1]);}
  if(hi==0)wsf[32+r32]=l_reg;asm volatile("s_waitcnt lgkmcnt(0)":::"memory");
  float rli[16];
  #pragma unroll
  for(int r=0;r<16;++r)rli[r]=__builtin_amdgcn_rcpf(wsf[32+crow(r,hi)]);
  bf16*Ow=O0+(long)(wid*QBLK)*QP;
  { bf16*stg=(bf16*)(shm+LDS_OST)+wid*2048;
    #pragma unroll
    for(int r=0;r<16;++r){const int orow=crow(r,hi);
      #pragma unroll
      for(int d0=0;d0<2;++d0)stg[orow*64+d0*32+r32]=__float2bfloat16(o[d0][r]*rli[r]);}
    asm volatile("s_waitcnt lgkmcnt(0)":::"memory");
    #pragma unroll
    for(int i=0;i<4;++i){const int row=i*8+(lane>>3),ch=lane&7; const u32x4 v=*(const u32x4*)(stg+row*64+ch*8); ATTN_STORE16(Ow+(long)row*QP+ch*8,v);} }
  asm volatile("s_waitcnt lgkmcnt(0)\n\ts_barrier":::"memory");
  #undef DMA_K
  #undef DMA_V
  #undef CMASK
  #undef START
  #undef RESC
  #undef ROT
}

typedef int i32x8 __attribute__((ext_vector_type(8)));
__device__ __forceinline__ void attn_unit8(const unsigned char*Q8,bf16*O0,const unsigned char*K8,const unsigned char*V8,const int NT,char*shm,const float mref){
  int tid_=threadIdx.x; asm volatile("":"+v"(tid_)); const int tid=tid_,lane=tid&63,r32=lane&31,hi=lane>>5; const int wid=__builtin_amdgcn_readfirstlane(tid>>6);
  const unsigned lds0=(unsigned)(uintptr_t)shm; const lds_cptr shm3=(lds_cptr)shm;
  constexpr int SL=8192, OST=32768, LWS=65536;
  const unsigned char*dsrc=(wid<4)?(K8+(long)lane*128+wid*16):(V8+(long)lane*64+(wid-4)*16); const long dstep=(wid<4)?(long)64*128:(long)4096;
  const unsigned ddst=lds0+((wid<4)?wid*1024:4096+(wid-4)*1024);
  #define DMA8(t) glds16(dsrc+(long)(t)*dstep,(unsigned)__builtin_amdgcn_readfirstlane(ddst+((t)&3)*SL))
  DMA8(0); if(1<NT)DMA8(1); if(2<NT)DMA8(2);
  const unsigned char*qp=Q8+(long)(wid*32+r32)*512+32*hi; const u32x4 q0=*(const u32x4*)qp,q1=*(const u32x4*)(qp+16);
  const i32x8 qf={(int)q0[0],(int)q0[1],(int)q0[2],(int)q0[3],(int)q1[0],(int)q1[1],(int)q1[2],(int)q1[3]};
  f32x16 o0=f32x16{},o1=f32x16{},ol=f32x16{},negm;
  i32x8 ones; _Pragma("unroll") for(int j=0;j<8;++j)ones[j]=0x38383838;
  asm volatile("":"+v"(ones));
  _Pragma("unroll") for(int r=0;r<16;++r)negm[r]=15.0f-mref;
  asm volatile("":"+v"(negm));
  typedef __attribute__((address_space(3))) const u32x4* l4p;
  #define KFR(t,K0,K1) do{ const lds_cptr ks_=shm3+((t)&3)*SL+(2*hi)*1024+r32*16; const u32x4 ka=*(l4p)(ks_),kb=*(l4p)(ks_+1024),kc=*(l4p)(ks_+512),kd=*(l4p)(ks_+1024+512); \
      K0=(i32x8){(int)ka[0],(int)ka[1],(int)ka[2],(int)ka[3],(int)kb[0],(int)kb[1],(int)kb[2],(int)kb[3]}; K1=(i32x8){(int)kc[0],(int)kc[1],(int)kc[2],(int)kc[3],(int)kd[0],(int)kd[1],(int)kd[2],(int)kd[3]}; }while(0)
  asm volatile("s_waitcnt vmcnt(0)":::"memory");
  asm volatile("s_barrier":::"memory");
  f32x16 p0,p1;
  { i32x8 kf0,kf1; KFR(0,kf0,kf1);
    p0=__builtin_amdgcn_mfma_scale_f32_32x32x64_f8f6f4(kf0,qf,negm,0,0,0,0,0,0); p1=__builtin_amdgcn_mfma_scale_f32_32x32x64_f8f6f4(kf1,qf,negm,0,0,0,0,0,0); }
  for(int t=0;t<NT;++t){
    if(t+2<NT)asm volatile("s_waitcnt vmcnt(1) lgkmcnt(0)\n\ts_barrier":::"memory"); else asm volatile("s_waitcnt vmcnt(0) lgkmcnt(0)\n\ts_barrier":::"memory");
    if(t+3<NT)DMA8(t+3);
    f32x16 n0,n1;
    if(t+1<NT){ i32x8 kf0,kf1; KFR(t+1,kf0,kf1);
      n0=__builtin_amdgcn_mfma_scale_f32_32x32x64_f8f6f4(kf0,qf,negm,0,0,0,0,0,0); n1=__builtin_amdgcn_mfma_scale_f32_32x32x64_f8f6f4(kf1,qf,negm,0,0,0,0,0,0); }
    const lds_cptr vs=shm3+(t&3)*SL+4096+(2*hi)*1024+r32*16;
    const u32x4 va=*(l4p)(vs),vb=*(l4p)(vs+1024),vc=*(l4p)(vs+512),vd=*(l4p)(vs+1024+512);
    const i32x8 vf0={(int)va[0],(int)va[1],(int)va[2],(int)va[3],(int)vb[0],(int)vb[1],(int)vb[2],(int)vb[3]}, vf1={(int)vc[0],(int)vc[1],(int)vc[2],(int)vc[3],(int)vd[0],(int)vd[1],(int)vd[2],(int)vd[3]};
    _Pragma("unroll") for(int r=0;r<16;++r){p0[r]=__builtin_amdgcn_exp2f(p0[r]);p1[r]=__builtin_amdgcn_exp2f(p1[r]);}
    i32x8 pw;
    _Pragma("unroll") for(int j=0;j<4;++j){int w=0;w=__builtin_amdgcn_cvt_pk_bf8_f32(p0[4*j],p0[4*j+1],w,false);w=__builtin_amdgcn_cvt_pk_bf8_f32(p0[4*j+2],p0[4*j+3],w,true);pw[j]=w;
      int v=0;v=__builtin_amdgcn_cvt_pk_bf8_f32(p1[4*j],p1[4*j+1],v,false);v=__builtin_amdgcn_cvt_pk_bf8_f32(p1[4*j+2],p1[4*j+3],v,true);pw[4+j]=v;}
    o0=__builtin_amdgcn_mfma_scale_f32_32x32x64_f8f6f4(pw,vf0,o0,1,0,0,0,0,0);
    o1=__builtin_amdgcn_mfma_scale_f32_32x32x64_f8f6f4(pw,vf1,o1,1,0,0,0,0,0);
    ol=__builtin_amdgcn_mfma_scale_f32_32x32x64_f8f6f4(pw,ones,ol,1,0,0,0,0,0);
    if(t+1<NT){p0=n0;p1=n1;}
  }
  #undef KFR
  #undef DMA8
  float rli[16];
  #pragma unroll
  for(int r=0;r<16;++r)rli[r]=__builtin_amdgcn_rcpf(ol[r]);
  bf16*Ow=O0+(long)(wid*32)*QP;
  { bf16*stg=(bf16*)(shm+OST)+wid*2048;
    #pragma unroll
    for(int r=0;r<16;++r){const int orow=crow(r,hi); stg[orow*64+r32]=__float2bfloat16(o0[r]*rli[r]); stg[orow*64+32+r32]=__float2bfloat16(o1[r]*rli[r]);}
    asm volatile("s_waitcnt lgkmcnt(0)":::"memory");
    #pragma unroll
    for(int i=0;i<4;++i){const int row=i*8+(lane>>3),ch=lane&7; const u32x4 v=*(const u32x4*)(stg+row*64+ch*8); *(u32x4*)(Ow+(long)row*QP+ch*8)=v;} }
  asm volatile("s_waitcnt lgkmcnt(0)\n\ts_barrier":::"memory");
}
constexpr int ATTN_LDS_BYTES=LDS_BYTES;
#undef SBAR
#undef WAIT_BAR
}
#define GAS __attribute__((address_space(1)))
#define LAS __attribute__((address_space(3)))
typedef unsigned short bf16;
typedef unsigned v4u __attribute__((ext_vector_type(4)));
typedef float f32x4 __attribute__((ext_vector_type(4)));
typedef short bf16x8 __attribute__((ext_vector_type(8)));
typedef GAS unsigned gu32;
typedef GAS unsigned long long gu64;
#define RLX_AGENT __ATOMIC_RELAXED, __HIP_MEMORY_SCOPE_AGENT
#define LDS_WAIT() asm volatile("s_waitcnt lgkmcnt(0)" ::: "memory")
#define VM_WAIT() asm volatile("s_waitcnt vmcnt(0)" ::: "memory")
__device__ __forceinline__ unsigned long long rt() { return __builtin_amdgcn_s_memrealtime(); }
__device__ __forceinline__ unsigned f2bf(float f) { unsigned u = __builtin_bit_cast(unsigned, f); return (u + 0x7fffu + ((u >> 16) & 1u)) >> 16; }
typedef float pk_f32x2_t __attribute__((ext_vector_type(2))); typedef __bf16 pk_bf16x2_t __attribute__((ext_vector_type(2)));
__device__ __forceinline__ unsigned pk2(float lo, float hi) { pk_f32x2_t v = {lo, hi}; pk_bf16x2_t b = __builtin_convertvector(v, pk_bf16x2_t); return __builtin_bit_cast(unsigned, b); }
#define XB_TMO      128
#define XB_XCNT(j)  (256  + 64 * (j))
#define XB_XSUB(j)  (1280 + 64 * (j))
#define XB_XGEN(j)  (2304 + 64 * (j))
#define XB_TOP      3328
#define XB_TOPGEN   3392
#define XCD_BAR_WORDS 3456
#define XB_SPIN_CAP (1u << 18)

__device__ __forceinline__ unsigned xb_ld(unsigned* p)              { return __hip_atomic_load(p, __ATOMIC_RELAXED, __HIP_MEMORY_SCOPE_AGENT); }
__device__ __forceinline__ unsigned xb_add(unsigned* p, unsigned v) { return __hip_atomic_fetch_add(p, v, __ATOMIC_RELAXED, __HIP_MEMORY_SCOPE_AGENT); }
__device__ __forceinline__ unsigned xb_xcc_id() { return (unsigned)__builtin_amdgcn_s_getreg((3 << 11) | 20) & 0xFu; }
#define XB_SPIN(cond, bar) do { unsigned _sp = 0; while (cond) { __builtin_amdgcn_s_sleep(1); \
    if ((++_sp & 255u) == 0u) { if (xb_ld(&(bar)[XB_TMO])) break; if (_sp > XB_SPIN_CAP) { atomicAdd(&(bar)[XB_TMO], 1u); break; } } } } while (0)

struct XcdBarrier {
    unsigned* bar; unsigned x;
    volatile LAS unsigned* st;
};

__device__ __forceinline__ XcdBarrier xcd_barrier_post(unsigned* bar, volatile LAS unsigned* st) {
    XcdBarrier b; b.bar = bar; b.x = xb_xcc_id(); b.st = st;
    if (threadIdx.x == 0) (void)xb_add(&bar[XB_XCNT(b.x)], 1u);
    return b;
}
__device__ __forceinline__ void xcd_barrier_complete(unsigned* bar, unsigned x, unsigned& nloc, unsigned& nx) {
    const unsigned G = gridDim.x * gridDim.y * gridDim.z;
    unsigned sum, cnt, mine, sp = 0u;
    for (;;) {
        sum = 0u; cnt = 0u; mine = 0u;
#pragma unroll
        for (unsigned j = 0; j < 16; ++j) { const unsigned c = xb_ld(&bar[XB_XCNT(j)]); sum += c; cnt += (c > 0u) ? 1u : 0u; mine = (j == x) ? c : mine; }
        if (sum == G) break;
        __builtin_amdgcn_s_sleep(1);
        if ((++sp & 255u) == 0u) { if (xb_ld(&bar[XB_TMO])) break; if (sp > XB_SPIN_CAP) { atomicAdd(&bar[XB_TMO], 1u); break; } }
    }
    nloc = mine > 0u ? mine : 1u; nx = cnt > 0u ? cnt : 1u;
}

__device__ __forceinline__ void xcd_barrier(const XcdBarrier& b) {
    asm volatile("s_waitcnt vmcnt(0)" ::: "memory");
    __syncthreads();
    if (threadIdx.x == 0) {
        unsigned* bar = b.bar;
        __builtin_amdgcn_s_waitcnt(0);
        unsigned nloc = b.st[0], nx = b.st[1];
        if (nloc == 0u) { xcd_barrier_complete(bar, b.x, nloc, nx); b.st[0] = nloc; b.st[1] = nx; }
        const unsigned old = xb_add(&bar[XB_XSUB(b.x)], 1u);
        const unsigned gen = old / nloc;
        if (old + 1u == (gen + 1u) * nloc) {
            __builtin_amdgcn_fence(__ATOMIC_RELEASE, "agent");
            asm volatile("s_waitcnt vmcnt(0)" ::: "memory");
            const unsigned og = xb_add(&bar[XB_TOP], 1u);
            const unsigned tg = og / nx;
            if (og + 1u == (tg + 1u) * nx) xb_add(&bar[XB_TOPGEN], 1u);
            else XB_SPIN(xb_ld(&bar[XB_TOPGEN]) == tg, bar);
            __builtin_amdgcn_fence(__ATOMIC_ACQUIRE, "agent");
            xb_add(&bar[XB_XGEN(b.x)], 1u);
            asm volatile("s_waitcnt vmcnt(0)" ::: "memory");
        } else {
            XB_SPIN(xb_ld(&bar[XB_XGEN(b.x)]) == gen, bar);
            __builtin_amdgcn_fence(__ATOMIC_ACQUIRE, "agent");
            asm volatile("s_waitcnt vmcnt(0)" ::: "memory");
        }
    }
    __syncthreads();
}
constexpr int NB = 4, T = 8192, LC = 256, D = 1024, NLAYER = 2;
constexpr int ML = NB * T, MC = NB * LC, MT = ML + MC;
constexpr int NIN = 2848, NINP = 3072;
constexpr int FF = 2816, EF = 3584, NE = 8;
constexpr int TK = T + LC;
constexpr int NCH = TK / 64;
constexpr float EPS = 1e-6f;
constexpr float QSCALE = 0.125f * 1.4426950408889634f;

constexpr int NWAVES = 8;
constexpr int LDS_BYTES = 147456;
constexpr int RING_BYTES = 131072, LDSCTL_OFF = RING_BYTES, MISC_OFF = LDSCTL_OFF + 320;

constexpr size_t MiB = 1u << 20;
constexpr size_t CTL_ZERO_BYTES = 1 * MiB;
constexpr int CW_BAR = 4096;
constexpr int CW_CNT = 16384;
constexpr int CW_Q = 17408;
constexpr size_t WS_MODS = 1 * MiB;
constexpr size_t WS_ROUTE = 1 * MiB + 512 * 1024;
constexpr size_t WS_RW = WS_ROUTE + (size_t)ML * 16;
constexpr size_t WS_POS = WS_RW + (size_t)ML * 8;
constexpr size_t WS_XC = 3 * MiB;
constexpr size_t WS_ROPE = 7 * MiB;
constexpr size_t WS_WIN = 9 * MiB;
constexpr size_t WS_WOUT = 21 * MiB;
constexpr size_t WS_WGU = 25 * MiB;
constexpr size_t WS_WD = 36 * MiB;
constexpr size_t WS_G = 42 * MiB;
constexpr size_t WS_BETA = WS_G + (size_t)2 * MT * 8 * 4;
constexpr size_t WS_AB = 47 * MiB;
constexpr size_t WS_KALL = 52 * MiB;
constexpr size_t WS_VALL = 61 * MiB;
constexpr size_t WS_DYN = 70 * MiB;
constexpr size_t WS_XN = WS_DYN;
constexpr size_t WS_OF = WS_XN, WS_OB = WS_XN + 33 * MiB;
constexpr size_t WS_DNRAW = WS_XN + 66 * MiB;
constexpr size_t WS_QRAW = WS_DNRAW + 99 * MiB;
constexpr size_t WS_KVRAW = WS_QRAW + 33 * MiB;
constexpr size_t WS_U = WS_DNRAW, WS_W = WS_DNRAW + 66 * MiB;
constexpr size_t WS_ZB = WS_KVRAW + 17 * MiB;
constexpr size_t WS_QDN = WS_ZB + 33 * MiB;
constexpr size_t WS_KDN = WS_QDN + 33 * MiB;
constexpr size_t WS_KT = WS_KDN + 33 * MiB;
constexpr size_t WS_VT = WS_KT + 33 * MiB;
constexpr size_t WS_MIX = WS_VT + 33 * MiB;
constexpr size_t WS_MIX_END = WS_MIX + 66 * MiB;
constexpr size_t WS_GCB = WS_MIX_END + 1 * MiB;
constexpr size_t WS_H = WS_DNRAW;
constexpr size_t WS_XB2 = WS_DYN;
constexpr size_t WS_MGU = WS_DYN + 64 * MiB;
constexpr size_t WS_MD = WS_MGU + 112 * MiB;
constexpr size_t WS_XS = WS_MD + 56 * MiB;
constexpr int SS_PANELS = 64, NSS = 5;
constexpr size_t WS_HM = WS_XS + 132 * MiB;
constexpr size_t WS_END = WS_HM + 112 * MiB;
static_assert(WS_END <= 560 * MiB, "ws map (MoE)");
static_assert(WS_W + 66 * MiB <= WS_ZB && WS_H + (size_t)MT * FF * 2 <= WS_MIX && WS_MIX_END <= 560 * MiB && WS_POS + (size_t)ML * 8 <= WS_XC, "ws map");

typedef unsigned short bf16;
__device__ __forceinline__ float bf2f(unsigned short h) { return __uint_as_float(((unsigned)h) << 16); }
__device__ __forceinline__ float bflo(unsigned w) { return __uint_as_float(w << 16); }
__device__ __forceinline__ float bfhi(unsigned w) { return __uint_as_float(w & 0xffff0000u); }
__device__ __forceinline__ float wave_sum(float v) {
#pragma unroll
    for (int o = 1; o < 64; o <<= 1) v += __shfl_xor(v, o);
    return v;
}
__device__ __forceinline__ float silu_f(float x) { return x * __builtin_amdgcn_rcpf(1.0f + __expf(-x)); }
namespace pg8 {
struct EpiIn {
    static constexpr bool PERM = true, AFTER_DRAIN = false;
    bf16_t* dnraw; bf16_t* zb; bf16_t* qraw; bf16_t* kvraw; float* ab;
    __device__ __forceinline__ void operator()(const f32x4 (&acc)[2][2][4][2], const Unit& u, int wr, int wc, int fr, int fq) const {
        const int row0 = u.pm * BM + wr * 64 + fr; const int pn = u.pn;
        if (pn < 11) {
            bf16_t* base; int ldc, coff;
            if (pn < 6) { base = dnraw; ldc = 1536; coff = pn * 256; } else if (pn < 8) { base = zb; ldc = 512; coff = (pn - 6) * 256; }
            else if (pn < 10) { base = qraw; ldc = 512; coff = (pn - 8) * 256; } else { base = kvraw; ldc = 256; coff = 0; }
            const int col0 = coff + wc * 32 + 8 * fq;
#pragma unroll
            for (int ai = 0; ai < 2; ++ai)
#pragma unroll
                for (int m = 0; m < 4; ++m) { bf16_t* rowp = base + (size_t)(row0 + ai * HALF + m * 16) * ldc + col0;
#pragma unroll
                    for (int bj = 0; bj < 2; ++bj) { const f32x4 v0 = acc[ai][bj][m][0], v1 = acc[ai][bj][m][1];
                        u32x4 w; w.x = cvt_pk_bf16(v0[0], v0[1]); w.y = cvt_pk_bf16(v0[2], v0[3]); w.z = cvt_pk_bf16(v1[0], v1[1]); w.w = cvt_pk_bf16(v1[2], v1[3]);
                        *(u32x4*)(rowp + bj * HALF) = w; } }
        } else if (wc == 0) {
#pragma unroll
            for (int ai = 0; ai < 2; ++ai)
#pragma unroll
                for (int m = 0; m < 4; ++m) { float* rowp = ab + (size_t)(row0 + ai * HALF + m * 16) * 32 + 8 * fq;
                    *(f32x4*)(rowp) = acc[ai][0][m][0]; *(f32x4*)(rowp + 4) = acc[ai][0][m][1]; }
        }
    }
};
template <bool XF32> struct EpiRes {
    static constexpr bool PERM = true, AFTER_DRAIN = false;
    const void* xin_l; bf16_t* out_l; const void* xin_c; bf16_t* out_c; const float* gate; int gstride;
    __device__ __forceinline__ void operator()(const f32x4 (&acc)[2][2][4][2], const Unit& u, int wr, int wc, int fr, int fq) const {
        const int pm = u.pm; const bool isc = pm >= 128; const int bidx = isc ? 4 : (pm >> 5);
        const void* xin = isc ? xin_c : xin_l; bf16_t* out = isc ? out_c : out_l; const int prow = isc ? pm - 128 : pm;
        const int row0 = prow * BM + wr * 64 + fr; const int col0 = u.pn * BM + wc * 32 + 8 * fq; const float* gp = gate + (size_t)bidx * gstride + col0;
        f32x4 gv[2][2];
#pragma unroll
        for (int bj = 0; bj < 2; ++bj)
#pragma unroll
            for (int n = 0; n < 2; ++n) gv[bj][n] = *(const f32x4*)(gp + bj * HALF + 4 * n);
#pragma unroll
        for (int ai = 0; ai < 2; ++ai)
#pragma unroll
            for (int m = 0; m < 4; ++m) { const size_t off = (size_t)(row0 + ai * HALF + m * 16) * 1024 + col0;
#pragma unroll
                for (int bj = 0; bj < 2; ++bj) { f32x4 x0, x1;
                    if (XF32) { x0 = *(const f32x4*)((const float*)xin + off + bj * HALF); x1 = *(const f32x4*)((const float*)xin + off + bj * HALF + 4); }
                    else { const u32x4 w = *(const u32x4*)((const bf16_t*)xin + off + bj * HALF);
                        x0 = (f32x4){__uint_as_float(w.x << 16), __uint_as_float(w.x & 0xffff0000u), __uint_as_float(w.y << 16), __uint_as_float(w.y & 0xffff0000u)};
                        x1 = (f32x4){__uint_as_float(w.z << 16), __uint_as_float(w.z & 0xffff0000u), __uint_as_float(w.w << 16), __uint_as_float(w.w & 0xffff0000u)}; }
                    const f32x4 v0 = x0 + gv[bj][0] * acc[ai][bj][m][0], v1 = x1 + gv[bj][1] * acc[ai][bj][m][1];
                    u32x4 o; o.x = cvt_pk_bf16(v0[0], v0[1]); o.y = cvt_pk_bf16(v0[2], v0[3]); o.z = cvt_pk_bf16(v1[0], v1[1]); o.w = cvt_pk_bf16(v1[2], v1[3]);
                    *(u32x4*)(out + off + bj * HALF) = o; } }
    }
};
struct EpiSwiGLU {
    static constexpr bool PERM = true, AFTER_DRAIN = false;
    bf16_t* H; int ldh; int nloc; int pm0;
    __device__ __forceinline__ void operator()(const f32x4 (&acc)[2][2][4][2], const Unit& u, int wr, int wc, int fr, int fq) const {
        const int row0 = (u.pm - pm0) * BM + wr * 64 + fr; const int col0 = (u.pn % nloc) * 128 + wc * 32 + 8 * fq;
#pragma unroll
        for (int ai = 0; ai < 2; ++ai)
#pragma unroll
            for (int m = 0; m < 4; ++m) { bf16_t* rowp = H + (size_t)(row0 + ai * HALF + m * 16) * ldh + col0;
                float r[8];
#pragma unroll
                for (int n = 0; n < 2; ++n)
#pragma unroll
                    for (int j = 0; j < 4; ++j) { const float g = acc[ai][0][m][n][j], up = acc[ai][1][m][n][j]; r[n * 4 + j] = g * __builtin_amdgcn_rcpf(1.0f + __expf(-g)) * up; }
                u32x4 w; w.x = cvt_pk_bf16(r[0], r[1]); w.y = cvt_pk_bf16(r[2], r[3]); w.z = cvt_pk_bf16(r[4], r[5]); w.w = cvt_pk_bf16(r[6], r[7]);
                *(u32x4*)(rowp) = w; }
    }
};
struct EpiBfPlain {
    static constexpr bool PERM = true, AFTER_DRAIN = false;
    bf16_t* O; int ldc; int nloc;
    __device__ __forceinline__ void operator()(const f32x4 (&acc)[2][2][4][2], const Unit& u, int wr, int wc, int fr, int fq) const {
        const int row0 = u.pm * BM + wr * 64 + fr; const int col0 = (u.pn % nloc) * BM + wc * 32 + 8 * fq;
#pragma unroll
        for (int ai = 0; ai < 2; ++ai)
#pragma unroll
            for (int m = 0; m < 4; ++m) { bf16_t* rowp = O + (size_t)(row0 + ai * HALF + m * 16) * ldc + col0;
#pragma unroll
                for (int bj = 0; bj < 2; ++bj) { const f32x4 v0 = acc[ai][bj][m][0], v1 = acc[ai][bj][m][1];
                    u32x4 w; w.x = cvt_pk_bf16(v0[0], v0[1]); w.y = cvt_pk_bf16(v0[2], v0[3]); w.z = cvt_pk_bf16(v1[0], v1[1]); w.w = cvt_pk_bf16(v1[2], v1[3]);
                    *(u32x4*)(rowp + bj * HALF) = w; } }
    }
};
struct MoeOrder {
    int ps[9]; int p0, p1, nloc, G, c; int a_off;
    __device__ __forceinline__ bool next(int i, Unit& u) const {
        const int L = i * G + c; const int np = p1 - p0; if (L >= np * nloc) return false;
        const int p = p0 + L / nloc, pl = L % nloc; int e = 0;
#pragma unroll
        for (int k = 1; k < 8; ++k) e += (p >= ps[k]) ? 1 : 0;
        u.pm = p + a_off; u.pn = e * nloc + pl; return true;
    }
    __device__ __forceinline__ void a_ready(const Unit&) const {}
    __device__ __forceinline__ void done(const Unit&) const {}
};
}
struct Ctx {
    LAS unsigned char* lds; gu32* ctl; int tid, lane, wave, G, gw, NGW;
    const float* const __attribute__((address_space(4)))* in; float* out; unsigned char* ws;
};
#define WSP(T, off) ((T*)(C.ws + (off)))

template <class MapF>
__device__ __forceinline__ void transpose_item(const float* W, int K, int N, bf16* WT, MapF map, LAS float* scr, int item, int lane) {
    const int nblk = N / 32, kb = item / nblk, nb = item % nblk, k0 = 64 * kb, n0 = 32 * nb;
#pragma unroll 8
    for (int i = 0; i < 32; ++i) { const int kk = 2 * i + (lane >> 5); scr[kk * 33 + (lane & 31)] = W[(size_t)(k0 + kk) * N + n0 + (lane & 31)]; }
    LDS_WAIT(); asm volatile("" ::: "memory");
    const int c = lane & 7; const int r0 = map(n0);
#pragma unroll
    for (int j = 0; j < 4; ++j) { const int n = (lane >> 3) + 8 * j; const LAS float* s = scr + (8 * c) * 33 + n;
        v4u o; o.x = pk2(s[0 * 33], s[1 * 33]); o.y = pk2(s[2 * 33], s[3 * 33]); o.z = pk2(s[4 * 33], s[5 * 33]); o.w = pk2(s[6 * 33], s[7 * 33]);
        *(GAS v4u*)(WT + (size_t)(r0 + n) * K + k0 + 8 * c) = o; }
    LDS_WAIT(); asm volatile("" ::: "memory");
}
struct MapId { __device__ __forceinline__ int operator()(int n0) const { return n0; } };
struct MapWin { __device__ __forceinline__ int operator()(int n0) const { return n0 < 2048 ? n0 : (n0 < 2080 ? n0 + 768 : n0 - 32); } };
struct MapGU { int up; __device__ __forceinline__ int operator()(int n0) const { return (n0 >> 7) * 256 + (n0 & 127) + up * 128; } };

__device__ __forceinline__ void p0_weights(Ctx& C) {
    LAS float* scr = (LAS float*)(C.lds + C.wave * 16384);
    constexpr int I_IN = (D / 64) * (NIN / 32), I_OUT = (D / 64) * (D / 32), I_G = (D / 64) * (FF / 32), I_D = (FF / 64) * (D / 32);
    constexpr int NITEMS = 2 * I_IN + 2 * I_OUT + 2 * I_G + I_D;
    for (int it = C.gw; it < NITEMS; it += C.NGW) {
        int r = it;
        if (r < 2 * I_IN) { const int l = r / I_IN; transpose_item(C.in[8] + (size_t)l * D * NIN, D, NIN, WSP(bf16, WS_WIN) + (size_t)l * NINP * D, MapWin(), scr, r % I_IN, C.lane); continue; } r -= 2 * I_IN;
        if (r < 2 * I_OUT) { const int l = r / I_OUT; transpose_item(C.in[15] + (size_t)l * D * D, D, D, WSP(bf16, WS_WOUT) + (size_t)l * D * D, MapId(), scr, r % I_OUT, C.lane); continue; } r -= 2 * I_OUT;
        if (r < I_G) { transpose_item(C.in[16], D, FF, WSP(bf16, WS_WGU), MapGU{0}, scr, r, C.lane); continue; } r -= I_G;
        if (r < I_G) { transpose_item(C.in[17], D, FF, WSP(bf16, WS_WGU), MapGU{1}, scr, r, C.lane); continue; } r -= I_G;
        transpose_item(C.in[18], FF, D, WSP(bf16, WS_WD), MapId(), scr, r, C.lane);
    }
    for (int i = C.gw * 64 + C.lane; i < 2 * 28672; i += C.NGW * 64) { const int l = i / 28672, j = i % 28672;
        *(GAS v4u*)(WSP(bf16, WS_WIN) + (size_t)l * NINP * D + (size_t)NIN * D + (size_t)j * 8) = (v4u){0u, 0u, 0u, 0u}; }
    for (int i = C.gw * 64 + C.lane; i < T * 32; i += C.NGW * 64) { const int t = i >> 5, a = i & 31;
        const float pos = (float)((a < 16) ? (t >> 6) : (t & 63)); const float fr = powf(10000.0f, -(float)(a & 15) / 16.0f);
        float sn, cs; sincosf(pos * fr, &sn, &cs);
        WSP(float, WS_ROPE)[i] = cs; WSP(float, WS_ROPE)[T * 32 + i] = sn; }
}
__device__ __forceinline__ void p0_mods(Ctx& C) {
    LAS float* sc = (LAS float*)C.lds;
    LAS float* part = (LAS float*)(C.lds + 32768);
    const int nblk = 2 * 6144 / 64;
    bool staged = false;
    for (int cb = blockIdx.x; cb < nblk; cb += C.G) {
        if (!staged) { for (int i = C.tid; i < 5 * 1024; i += 512) { const float v = (i < 4096) ? C.in[1][i] : C.in[3][i - 4096]; sc[i] = silu_f(v); } staged = true; }
        __syncthreads();
        const int l = cb / 96, j = (cb % 96) * 64 + C.lane;
        const float* wm = C.in[4] + (size_t)l * D * 6144 + j;
        float a0 = 0.f, a1 = 0.f, a2 = 0.f, a3 = 0.f, a4 = 0.f;
        const int kb = C.wave * 128;
#pragma unroll 8
        for (int k = 0; k < 128; ++k) { const float w = wm[(size_t)(kb + k) * 6144];
            a0 += sc[kb + k] * w; a1 += sc[1024 + kb + k] * w; a2 += sc[2048 + kb + k] * w; a3 += sc[3072 + kb + k] * w; a4 += sc[4096 + kb + k] * w; }
        part[(C.wave * 5 + 0) * 64 + C.lane] = a0; part[(C.wave * 5 + 1) * 64 + C.lane] = a1; part[(C.wave * 5 + 2) * 64 + C.lane] = a2;
        part[(C.wave * 5 + 3) * 64 + C.lane] = a3; part[(C.wave * 5 + 4) * 64 + C.lane] = a4;
        __syncthreads();
        if (C.tid < 320) { const int i = C.tid / 64, ln = C.tid % 64; const int jj = (cb % 96) * 64 + ln;
            float s = 0.f;
#pragma unroll
            for (int w = 0; w < 8; ++w) s += part[(w * 5 + i) * 64 + ln];
            s += C.in[5][l * 6144 + jj];
            const int chunk = jj >> 10, col = jj & 1023;
            if (chunk == 1) s = C.in[6][l * 1024 + col] * (1.0f + s);
            if (chunk == 4) s = C.in[7][l * 1024 + col] * (1.0f + s);
            WSP(float, WS_MODS)[((size_t)(l * 5 + i) * 6 + chunk) * 1024 + col] = s; }
        __syncthreads();
    }
}
__device__ __forceinline__ const float* mods_ptr(Ctx& C, int l, int i, int chunk) { return WSP(float, WS_MODS) + ((size_t)(l * 5 + i) * 6 + chunk) * 1024; }

typedef unsigned u32x2n __attribute__((ext_vector_type(2)));
template <bool ROUTE, bool XBF  >
__device__ __forceinline__ void norm_mod(Ctx& C, const void* xl, const void* xc, int nrows, int l, int chA, int chS, bf16* dst) {
    float rw[ROUTE ? 16 : 1][8];
    if (ROUTE) {
#pragma unroll
        for (int j = 0; j < 4; ++j)
#pragma unroll
            for (int q = 0; q < 4; ++q) { const f32x4 a = *(const f32x4*)(C.in[19] + (size_t)(4 * C.lane + 256 * j + q) * 8), b = *(const f32x4*)(C.in[19] + (size_t)(4 * C.lane + 256 * j + q) * 8 + 4);
                rw[j * 4 + q][0] = a.x; rw[j * 4 + q][1] = a.y; rw[j * 4 + q][2] = a.z; rw[j * 4 + q][3] = a.w; rw[j * 4 + q][4] = b.x; rw[j * 4 + q][5] = b.y; rw[j * 4 + q][6] = b.z; rw[j * 4 + q][7] = b.w; }
    }
    for (int m = C.gw; m < nrows; m += C.NGW) {
        const bool isc = m >= ML; const int bidx = isc ? 4 : (m >> 13);
        const size_t xoff = isc ? (size_t)(m - ML) * D : (size_t)m * D; const void* xbase = isc ? xc : xl;
        const GAS f32x4* Ap = (const GAS f32x4*)mods_ptr(C, l, bidx, chA) + C.lane; const GAS f32x4* Sp = (const GAS f32x4*)mods_ptr(C, l, bidx, chS) + C.lane;
        f32x4 v[4]; float s2 = 0.f;
#pragma unroll
        for (int j = 0; j < 4; ++j) {
            if (XBF) { const u32x2n w = *(const GAS u32x2n*)((const bf16*)xbase + xoff + 4 * C.lane + 256 * j); v[j] = (f32x4){bflo(w.x), bfhi(w.x), bflo(w.y), bfhi(w.y)}; }
            else v[j] = ((const GAS f32x4*)((const float*)xbase + xoff) + C.lane)[64 * j];
            s2 += (v[j].x * v[j].x + v[j].y * v[j].y) + (v[j].z * v[j].z + v[j].w * v[j].w); }
        const float rstd = 1.0f / sqrtf(wave_sum(s2) * (1.f / D) + EPS);
#pragma unroll
        for (int j = 0; j < 4; ++j) v[j] = v[j] * rstd * Ap[64 * j] + Sp[64 * j];
        GAS unsigned long long* o8 = (GAS unsigned long long*)(dst + (size_t)m * D) + C.lane;
#pragma unroll
        for (int j = 0; j < 4; ++j) o8[64 * j] = (unsigned long long)pk2(v[j].x, v[j].y) | ((unsigned long long)pk2(v[j].z, v[j].w) << 32);
        if (ROUTE) {
            float lg[8];
#pragma unroll
            for (int e = 0; e < 8; ++e) { float s = 0.f;
#pragma unroll
                for (int j = 0; j < 4; ++j) s += (v[j].x * rw[j * 4 + 0][e] + v[j].y * rw[j * 4 + 1][e]) + (v[j].z * rw[j * 4 + 2][e] + v[j].w * rw[j * 4 + 3][e]);
                lg[e] = wave_sum(s) + C.in[20][e]; }
            if (C.lane == 0) {
                int e0 = 0; float v0 = lg[0];
#pragma unroll
                for (int e = 1; e < 8; ++e) if (lg[e] > v0) { v0 = lg[e]; e0 = e; }
                int e1 = -1; float v1 = -INFINITY;
#pragma unroll
                for (int e = 0; e < 8; ++e) if (e != e0 && lg[e] > v1) { v1 = lg[e]; e1 = e; }
                const float w0 = 1.0f / (1.0f + expf(v1 - v0)), w1 = 1.0f - w0;
                const int s0 = (int)__hip_atomic_fetch_add(C.ctl + CW_CNT + 64 * e0, 1u, RLX_AGENT), s1 = (int)__hip_atomic_fetch_add(C.ctl + CW_CNT + 64 * e1, 1u, RLX_AGENT);
                WSP(int, WS_ROUTE)[m * 4 + 0] = e0; WSP(int, WS_ROUTE)[m * 4 + 1] = s0; WSP(int, WS_ROUTE)[m * 4 + 2] = e1; WSP(int, WS_ROUTE)[m * 4 + 3] = s1;
                WSP(float, WS_RW)[m * 2 + 0] = w0; WSP(float, WS_RW)[m * 2 + 1] = w1;
            }
        }
    }
}
__device__ __forceinline__ void load8(const bf16* p, float (&f)[8]) { const v4u w = *(const GAS v4u*)p; f[0] = bflo(w.x); f[1] = bfhi(w.x); f[2] = bflo(w.y); f[3] = bfhi(w.y); f[4] = bflo(w.z); f[5] = bfhi(w.z); f[6] = bflo(w.w); f[7] = bfhi(w.w); }
__device__ __forceinline__ void store8(bf16* p, const float (&f)[8]) { v4u w; w.x = pk2(f[0], f[1]); w.y = pk2(f[2], f[3]); w.z = pk2(f[4], f[5]); w.w = pk2(f[6], f[7]); *(GAS v4u*)p = w; }
__device__ __forceinline__ float sum8(float v) { v += __shfl_xor(v, 1); v += __shfl_xor(v, 2); v += __shfl_xor(v, 4); return v; }

__device__ __forceinline__ unsigned cvt4_fp8(float a, float b, float c, float d) { int w = 0; w = __builtin_amdgcn_cvt_pk_fp8_f32(a, b, w, false); w = __builtin_amdgcn_cvt_pk_fp8_f32(c, d, w, true); return (unsigned)w; }
constexpr float SQS = 0.42466090014400953f;
__device__ __forceinline__ void p3_prep(Ctx& C, int l) {
    const int lane = C.lane;
    const bf16* qraw = WSP(bf16, WS_QRAW); const bf16* kvraw = WSP(bf16, WS_KVRAW); const float* ab = WSP(float, WS_AB);
    unsigned char* q8 = WSP(unsigned char, WS_XN); unsigned char* k8 = WSP(unsigned char, WS_KALL); unsigned char* v8 = WSP(unsigned char, WS_VALL);
    const float* ropec = WSP(float, WS_ROPE); const float* ropes = ropec + T * 32;
    const int jj = (lane & 7) * 8;
    float qw[8], kw[8];
#pragma unroll
    for (int i = 0; i < 8; ++i) { qw[i] = C.in[13][l * 64 + jj + i]; kw[i] = C.in[14][l * 64 + jj + i]; }
    const int gd = (lane >> 3) & 1, gh = lane & 7;
    const float neg_a = -expf(C.in[10][l * 16 + gd * 8 + gh]), dtb = C.in[11][l * 16 + gd * 8 + gh];
    for (int m = C.gw; m < MT; m += C.NGW) {
        const bool isc = m >= ML; const int b = isc ? (m - ML) >> 8 : m >> 13; const int t = isc ? (m - ML) & 255 : m & 8191;
        {
            float f[8]; load8(qraw + (size_t)m * 512 + lane * 8, f);
            float ss = 0.f;
#pragma unroll
            for (int i = 0; i < 8; ++i) ss += f[i] * f[i];
            const float r = 1.0f / sqrtf(sum8(ss) * (1.f / 64.f) + EPS);
#pragma unroll
            for (int i = 0; i < 8; ++i) f[i] = f[i] * r * qw[i];
            if (!isc) {
                float o[8];
#pragma unroll
                for (int i = 0; i < 8; ++i) o[i] = __shfl_xor(f[i], 4);
                const int a0 = jj & 31; const bool first = jj < 32;
#pragma unroll
                for (int i = 0; i < 8; ++i) { const float cs = ropec[t * 32 + a0 + i], sn = ropes[t * 32 + a0 + i]; f[i] = first ? (f[i] * cs - o[i] * sn) : (f[i] * cs + o[i] * sn); }
            }
#pragma unroll
            for (int i = 0; i < 8; ++i) f[i] *= SQS;
            *(GAS u32x2n*)(q8 + (size_t)m * 512 + lane * 8) = (u32x2n){cvt4_fp8(f[0], f[1], f[2], f[3]), cvt4_fp8(f[4], f[5], f[6], f[7])};
        }
        {
            const size_t krow = (size_t)b * TK + (isc ? T + t : t);
            if (lane < 32) {
                float f[8]; load8(kvraw + (size_t)m * 256 + lane * 8, f);
                if (lane < 16) {
                    float ss = 0.f;
#pragma unroll
                    for (int i = 0; i < 8; ++i) ss += f[i] * f[i];
                    const float r = 1.0f / sqrtf(sum8(ss) * (1.f / 64.f) + EPS);
#pragma unroll
                    for (int i = 0; i < 8; ++i) f[i] = f[i] * r * kw[i];
                    float o[8];
#pragma unroll
                    for (int i = 0; i < 8; ++i) o[i] = __shfl_xor(f[i], 4);
                    if (!isc) { const int a0 = jj & 31; const bool first = jj < 32;
#pragma unroll
                        for (int i = 0; i < 8; ++i) { const float cs = ropec[t * 32 + a0 + i], sn = ropes[t * 32 + a0 + i]; f[i] = first ? (f[i] * cs - o[i] * sn) : (f[i] * cs + o[i] * sn); } }
#pragma unroll
                    for (int i = 0; i < 8; ++i) f[i] *= SQS;
                    *(GAS u32x2n*)(k8 + krow * 128 + lane * 8) = (u32x2n){cvt4_fp8(f[0], f[1], f[2], f[3]), cvt4_fp8(f[4], f[5], f[6], f[7])};
                } else {
                    const int pos = isc ? T + t : t, kk = pos & 63, vh = (lane - 16) >> 3, n0 = ((lane - 16) & 7) * 8;
                    unsigned char* vt = v8 + ((size_t)((b * 2 + vh) * (TK / 64) + (pos >> 6))) * 4096 + 32 * ((kk >> 2) & 1) + ((kk >> 5) << 4) + (((kk >> 3) & 3) << 2) + (kk & 3);
                    const unsigned w0 = cvt4_fp8(f[0], f[1], f[2], f[3]), w1 = cvt4_fp8(f[4], f[5], f[6], f[7]);
#pragma unroll
                    for (int i = 0; i < 4; ++i) { vt[(size_t)(n0 + i) * 64] = (unsigned char)(w0 >> (8 * i)); vt[(size_t)(n0 + 4 + i) * 64] = (unsigned char)(w1 >> (8 * i)); }
                }
            }
        }
        if (lane < 16) {
            const float a = ab[(size_t)m * 32 + lane], bb = ab[(size_t)m * 32 + 16 + lane];
            const float xx = a + dtb; const float sp = xx > 20.f ? xx : log1pf(expf(xx));
            WSP(float, WS_G)[((size_t)gd * MT + m) * 8 + gh] = neg_a * sp;
            WSP(float, WS_BETA)[((size_t)gd * MT + m) * 8 + gh] = 1.0f / (1.0f + expf(-bb));
        }
    }
}

__device__ __forceinline__ float silu_fast(float x) { return x * __builtin_amdgcn_rcpf(1.0f + __expf(-x)); }
__device__ __forceinline__ void p3b_dnconv(Ctx& C, int l) {
    const bf16* dnraw = WSP(bf16, WS_DNRAW); bf16* qdn = WSP(bf16, WS_QDN); bf16* kdn = WSP(bf16, WS_KDN); bf16* kt = WSP(bf16, WS_KT); bf16* vt = WSP(bf16, WS_VT);
    const float* cwl = C.in[9] + (size_t)l * 5 * 1536;
    LAS unsigned char* wl = C.lds + C.wave * 16384;
    if (C.gw < 85 * 24) {
        const int hs = C.gw % 24, sg = hs >> 3, h = hs & 7; const int ch0 = sg * 512 + h * 64;
        float wv[5];
#pragma unroll
        for (int tp = 0; tp < 5; ++tp) wv[tp] = cwl[tp * 1536 + ch0 + C.lane];
        const int lr = C.lane >> 3, lc = C.lane & 7;
        v4u stg[9];
#define DNC_REQ(ckk) do { const int t0_ = ((ckk) < 512) ? (((ckk) & 127) * 64) : ((((ckk) - 512) & 3) * 64); const int tlen_ = ((ckk) < 512) ? T : LC; \
            _Pragma("unroll") for (int i = 0; i < 9; ++i) { const int r_ = i * 8 + lr; const int tt_ = t0_ - 2 + r_; const bool ok_ = r_ < 68 && tt_ >= 0 && tt_ < tlen_; \
                stg[i] = ok_ ? *(const GAS v4u*)(dnraw + ((size_t)(ckk) * 64 - 2 + r_) * 1536 + ch0 + lc * 8) : (v4u){0u, 0u, 0u, 0u}; } } while (0)
        int ck = C.gw / 24;
        if (ck < 528) DNC_REQ(ck);
        for (; ck < 528; ck += 85) {
            asm volatile("s_waitcnt lgkmcnt(0)" ::: "memory");
#pragma unroll
            for (int i = 0; i < 9; ++i) { const int r = i * 8 + lr; if (r < 68) *(LAS v4u*)(wl + r * 144 + lc * 16) = stg[i]; }
            asm volatile("s_waitcnt lgkmcnt(0)" ::: "memory");
            if (ck + 85 < 528) DNC_REQ(ck + 85);
            const int m = ck * 64 + C.lane;
            float y[64];
#pragma unroll
            for (int i = 0; i < 64; ++i) y[i] = 0.f;
#pragma unroll
            for (int tp = 0; tp < 5; ++tp) {
#pragma unroll
                for (int cg = 0; cg < 8; ++cg) { const v4u w = *(const LAS v4u*)(wl + (C.lane + tp) * 144 + cg * 16);
                    const float f[8] = {bflo(w.x), bfhi(w.x), bflo(w.y), bfhi(w.y), bflo(w.z), bfhi(w.z), bflo(w.w), bfhi(w.w)};
#pragma unroll
                    for (int i = 0; i < 8; ++i) y[cg * 8 + i] += f[i] * __builtin_bit_cast(float, __builtin_amdgcn_readlane(__builtin_bit_cast(int, wv[tp]), cg * 8 + i)); } }
            float ss = 0.f;
#pragma unroll
            for (int i = 0; i < 64; ++i) { y[i] = silu_fast(y[i]); ss += y[i] * y[i]; }
            if (sg < 2) { const float r = (1.0f / sqrtf(ss + EPS)) * (sg == 0 ? 0.125f : 1.0f);
#pragma unroll
                for (int i = 0; i < 64; ++i) y[i] *= r; }
            if (sg < 2) { bf16* dst = (sg == 0 ? qdn : kdn) + (size_t)m * 512 + h * 64;
#pragma unroll
                for (int cg = 0; cg < 8; ++cg) { float f[8];
#pragma unroll
                    for (int i = 0; i < 8; ++i) f[i] = y[cg * 8 + i];
                    store8(dst + cg * 8, f); } }
            if (sg >= 1) { bf16* dst = (sg == 1 ? kt : vt) + ((size_t)ck * 8 + h) * 4096 + C.lane;
#pragma unroll
                for (int i = 0; i < 64; i += 2) { const unsigned w = pk2(y[i], y[i + 1]); dst[i * 64] = (bf16)(w & 0xffffu); dst[(i + 1) * 64] = (bf16)(w >> 16); } }
        }
#undef DNC_REQ
    }
    asm volatile("s_waitcnt lgkmcnt(0)" ::: "memory");
}

__device__ __forceinline__ int chunk_ck(int b, int cc) { return cc < 4 ? 512 + b * 4 + cc : b * 128 + (cc - 4); }
__device__ __forceinline__ int chunk_row(int b, int cc, int dir, int i) { const int ii = dir ? 63 - i : i; return cc < 4 ? ML + b * LC + cc * 64 + ii : b * T + (cc - 4) * 64 + ii; }
struct MapGUE { int off; __device__ __forceinline__ int operator()(int n0) const { return off + (n0 >> 7) * 256 + (n0 & 127); } };
__device__ __forceinline__ void moe_weights(Ctx& C) {
    LAS float* scr = (LAS float*)(C.lds + C.wave * 16384);
    constexpr int I_G = (D / 64) * (EF / 32), I_D = (EF / 64) * (D / 32);
    constexpr int NITEMS = NE * (2 * I_G + I_D);
    for (int it = C.gw; it < NITEMS; it += C.NGW) {
        const int e = it / (2 * I_G + I_D); int r = it % (2 * I_G + I_D);
        if (r < I_G) { transpose_item(C.in[21] + (size_t)e * D * EF, D, EF, WSP(bf16, WS_MGU), MapGUE{e * 7168}, scr, r, C.lane); continue; } r -= I_G;
        if (r < I_G) { transpose_item(C.in[22] + (size_t)e * D * EF, D, EF, WSP(bf16, WS_MGU), MapGUE{e * 7168 + 128}, scr, r, C.lane); continue; } r -= I_G;
        transpose_item(C.in[23] + (size_t)e * EF * D, EF, D, WSP(bf16, WS_MD) + (size_t)e * D * EF, MapId(), scr, r, C.lane);
    }
}
__device__ __forceinline__ void moe_panel_starts(Ctx& C, int (&ps)[9], int (&cnt)[8]) {
    int acc = 0;
#pragma unroll
    for (int e = 0; e < 8; ++e) { cnt[e] = (int)__hip_atomic_load(C.ctl + CW_CNT + 64 * e, RLX_AGENT); ps[e] = acc; acc += (cnt[e] + 255) >> 8; }
    ps[8] = acc;
}
__device__ __forceinline__ void moe_scatter(Ctx& C, const bf16* xn2) {
    int ps[9], cnt[8]; moe_panel_starts(C, ps, cnt);
    bf16* xs = WSP(bf16, WS_XS); const int* route = WSP(int, WS_ROUTE); int* pos = WSP(int, WS_POS);
    for (int m = C.gw; m < ML; m += C.NGW) {
        const int e0 = route[m * 4 + 0], s0 = route[m * 4 + 1], e1 = route[m * 4 + 2], s1 = route[m * 4 + 3];
        int p0 = 0, p1 = 0;
#pragma unroll
        for (int e = 0; e < 8; ++e) { p0 = (e == e0) ? ps[e] : p0; p1 = (e == e1) ? ps[e] : p1; }
        const int r0 = p0 * 256 + s0, r1 = p1 * 256 + s1;
        const GAS v4u* src = (const GAS v4u*)(xn2 + (size_t)m * D) + C.lane; GAS v4u* d0 = (GAS v4u*)(xs + (size_t)r0 * D) + C.lane; GAS v4u* d1 = (GAS v4u*)(xs + (size_t)r1 * D) + C.lane;
        const v4u a = src[0], b = src[64]; d0[0] = a; d0[64] = b; d1[0] = a; d1[64] = b;

        if (C.lane == 0) { pos[m * 2 + 0] = r0; pos[m * 2 + 1] = r1; }
    }
#pragma unroll
    for (int e = 0; e < 8; ++e) { const int nb = ps[e + 1] * 256 - (ps[e] * 256 + cnt[e]); const int rb = ps[e] * 256 + cnt[e];
        for (int r = C.gw; r < nb; r += C.NGW) { GAS v4u* d = (GAS v4u*)(xs + (size_t)(rb + r) * D) + C.lane; d[0] = (v4u){0u, 0u, 0u, 0u}; d[64] = (v4u){0u, 0u, 0u, 0u}; } }
}
__device__ __forceinline__ void moe_final(Ctx& C, int l) {
    const bf16* ys = WSP(bf16, WS_XS); const int* route = WSP(int, WS_POS); const float* rwt = WSP(float, WS_RW);
    for (int m = C.gw; m < ML; m += C.NGW) {
        const int r0 = route[m * 2 + 0], r1 = route[m * 2 + 1]; const float w0 = rwt[m * 2], w1 = rwt[m * 2 + 1];
        const int bidx = m >> 13; const float* g2 = mods_ptr(C, l, bidx, 5);
        float x[16]; float ss = 0.f;
#pragma unroll
        for (int j = 0; j < 2; ++j) { const int c0 = j * 512 + C.lane * 8; float a[8], bb[8]; load8(ys + (size_t)r0 * D + c0, a); load8(ys + (size_t)r1 * D + c0, bb);
            float xv[8]; load8(WSP(bf16, WS_XB2) + (size_t)m * D + c0, xv);
            const f32x4 ga = *(const GAS f32x4*)(g2 + c0), gb = *(const GAS f32x4*)(g2 + c0 + 4);
            const float gv[8] = {ga.x, ga.y, ga.z, ga.w, gb.x, gb.y, gb.z, gb.w};
#pragma unroll
            for (int i = 0; i < 8; ++i) { const float v = xv[i] + gv[i] * (w0 * a[i] + w1 * bb[i]); x[j * 8 + i] = v; ss += v * v; } }
        const float rstd = 1.0f / sqrtf(wave_sum(ss) * (1.f / D) + EPS);
#pragma unroll
        for (int j = 0; j < 2; ++j) { const int c0 = j * 512 + C.lane * 8;
            const f32x4 fa = *(const GAS f32x4*)(C.in[24] + c0), fb = *(const GAS f32x4*)(C.in[24] + c0 + 4);
            f32x4 oa = {x[j * 8 + 0] * rstd * fa.x, x[j * 8 + 1] * rstd * fa.y, x[j * 8 + 2] * rstd * fa.z, x[j * 8 + 3] * rstd * fa.w};
            f32x4 ob = {x[j * 8 + 4] * rstd * fb.x, x[j * 8 + 5] * rstd * fb.y, x[j * 8 + 6] * rstd * fb.z, x[j * 8 + 7] * rstd * fb.w};
            *(GAS f32x4*)(C.out + (size_t)m * D + c0) = oa; *(GAS f32x4*)(C.out + (size_t)m * D + c0 + 4) = ob; }
    }
}
typedef float f32x4_t __attribute__((ext_vector_type(4)));
__device__ __forceinline__ int pi_idx(int t, int m) { return 32 * (t >> 1) + 8 * (m >> 2) + 4 * (t & 1) + (m & 3); }
constexpr size_t DN_UNITS = (size_t)NB * 8 * 2 * NCH;
__device__ __forceinline__ int wq_next(gu32* head, int lane) { unsigned v = 0; if (lane == 0) v = __hip_atomic_fetch_add(head, 1u, RLX_AGENT); return (int)__builtin_amdgcn_readfirstlane(v); }
__device__ __forceinline__ void p5_dn1_fast(Ctx& C, int l) {
    const int lane = C.lane, l15 = lane & 15, g = lane >> 4;
    LAS unsigned char* wl = C.lds + C.wave * 16384;
    LAS float* Aimg = (LAS float*)wl;
    const bf16* kdn = WSP(bf16, WS_KDN); const bf16* kt = WSP(bf16, WS_KT); const bf16* vt = WSP(bf16, WS_VT);
    const float* G = WSP(float, WS_G); const float* BT = WSP(float, WS_BETA);
    uint2* FU = WSP(uint2, WS_U); v4u* FW = WSP(v4u, WS_W);
    gu32* qh = C.ctl + CW_Q + 64 * (2 * l);
    for (int u = wq_next(qh, lane); u < (int)DN_UNITS; u = wq_next(qh, lane)) {
        const int cc = u % NCH, dir = (u / NCH) & 1, h = (u / (2 * NCH)) & 7, b = u / (16 * NCH);
        const int ck = chunk_ck(b, cc); const size_t m0 = (size_t)ck * 64;
        float gr = G[((size_t)dir * MT + m0 + lane) * 8 + h]; const float be = BT[((size_t)dir * MT + m0 + lane) * 8 + h];
        if (dir) gr = __shfl(gr, 63 - lane);
#pragma unroll
        for (int o = 1; o < 64; o <<= 1) { const float n = __shfl_up(gr, o); if (lane >= o) gr += n; }
        if (dir) gr = __shfl(gr, 63 - lane);
        const float gcv = gr;
        { float* gcb = WSP(float, WS_GCB) + (size_t)u * 192; gcb[lane] = gcv; gcb[64 + lane] = __shfl(gcv, pi_idx((lane >> 2) & 3, 4 * (lane >> 4) + (lane & 3))); const float gl_ = __shfl(gcv, dir ? 0 : 63); if (lane == 0) gcb[128] = gl_;
          ((bf16*)(gcb + 132))[lane] = (bf16)(pk2(__expf(gl_ - __shfl(gcv, pi_idx((lane >> 2) & 3, 4 * (lane >> 4) + (lane & 3)))), 0.f) & 0xffffu); }
        bf16x8 kf[4][2];
#pragma unroll
        for (int t = 0; t < 4; ++t)
#pragma unroll
            for (int s = 0; s < 2; ++s) kf[t][s] = *(const bf16x8*)(kdn + (m0 + 16 * t + l15) * 512 + h * 64 + 32 * s + 8 * g);
        float gcol[4];
#pragma unroll
        for (int tj = 0; tj < 4; ++tj) gcol[tj] = __shfl(gcv, 16 * tj + l15);
#pragma unroll
        for (int ti = 0; ti < 4; ++ti) {
            float grow[4], brow[4];
#pragma unroll
            for (int r = 0; r < 4; ++r) { grow[r] = __shfl(gcv, 16 * ti + 4 * g + r); brow[r] = __shfl(be, 16 * ti + 4 * g + r); }
#pragma unroll
            for (int tj = 0; tj < 4; ++tj) {
                f32x4_t acc = {0.f, 0.f, 0.f, 0.f};
                acc = __builtin_amdgcn_mfma_f32_16x16x32_bf16(kf[ti][0], kf[tj][0], acc, 0, 0, 0);
                acc = __builtin_amdgcn_mfma_f32_16x16x32_bf16(kf[ti][1], kf[tj][1], acc, 0, 0, 0);
#pragma unroll
                for (int r = 0; r < 4; ++r) { const int si = 16 * ti + 4 * g + r, sj = 16 * tj + l15; const int ci = dir ? 63 - si : si, cj = dir ? 63 - sj : sj;
                    if (ci > cj) Aimg[cj * 64 + ci] = brow[r] * acc[r] * __expf(grow[r] - gcol[tj]); }
            }
        }
        asm volatile("s_waitcnt lgkmcnt(0)" ::: "memory");
        float tcol[64];
#pragma unroll
        for (int i = 0; i < 64; ++i) tcol[i] = (i == lane) ? 1.f : 0.f;
#pragma unroll
        for (int jb = 0; jb < 16; ++jb) {
            f32x4_t d[4];
#pragma unroll
            for (int c = 0; c < 4; ++c) d[c] = *(const LAS f32x4_t*)(Aimg + (4 * jb + c) * 64 + 4 * jb);
            const float t0 = tcol[4 * jb];
            const float t1 = tcol[4 * jb + 1] - d[0][1] * t0;
            const float t2 = tcol[4 * jb + 2] - d[0][2] * t0 - d[1][2] * t1;
            const float t3 = tcol[4 * jb + 3] - d[0][3] * t0 - d[1][3] * t1 - d[2][3] * t2;
            tcol[4 * jb + 1] = t1; tcol[4 * jb + 2] = t2; tcol[4 * jb + 3] = t3;
#pragma unroll
            for (int i4 = jb + 1; i4 < 16; ++i4) {
                const f32x4_t a0 = *(const LAS f32x4_t*)(Aimg + (4 * jb + 0) * 64 + 4 * i4), a1 = *(const LAS f32x4_t*)(Aimg + (4 * jb + 1) * 64 + 4 * i4);
                const f32x4_t a2 = *(const LAS f32x4_t*)(Aimg + (4 * jb + 2) * 64 + 4 * i4), a3 = *(const LAS f32x4_t*)(Aimg + (4 * jb + 3) * 64 + 4 * i4);
#pragma unroll
                for (int k = 0; k < 4; ++k) { float x = tcol[4 * i4 + k];
                    asm("v_fma_f32 %0, -%1, %2, %0" : "+v"(x) : "v"(a0[k]), "v"(t0)); asm("v_fma_f32 %0, -%1, %2, %0" : "+v"(x) : "v"(a1[k]), "v"(t1));
                    asm("v_fma_f32 %0, -%1, %2, %0" : "+v"(x) : "v"(a2[k]), "v"(t2)); asm("v_fma_f32 %0, -%1, %2, %0" : "+v"(x) : "v"(a3[k]), "v"(t3)); tcol[4 * i4 + k] = x; }
                if (((i4 - jb) & 3) == 0) __builtin_amdgcn_sched_barrier(0); }
            __builtin_amdgcn_sched_barrier(0); }
        asm volatile("s_waitcnt lgkmcnt(0)" ::: "memory");
        {   const int kap = dir ? 63 - lane : lane; const float bk = __shfl(be, kap), egk = __expf(__shfl(gcv, kap));
            LAS bf16* Tb = (LAS bf16*)wl; LAS bf16* Tg = Tb + 4096;
#pragma unroll
            for (int i = 0; i < 64; ++i) { const int rho = dir ? 63 - i : i; const float v = tcol[i] * bk; const unsigned w = pk2(v, -v * egk); Tb[rho * 64 + kap] = (bf16)(w & 0xffffu); Tg[rho * 64 + kap] = (bf16)(w >> 16); } }
        asm volatile("s_waitcnt lgkmcnt(0)" ::: "memory");
        {   const LAS bf16* Tb = (const LAS bf16*)wl; const LAS bf16* Tg = Tb + 4096;
            const bf16* vtb = vt + ((size_t)ck * 8 + h) * 4096; const bf16* ktb = kt + ((size_t)ck * 8 + h) * 4096;
            bf16x8 ta[4][2];
#pragma unroll
            for (int t = 0; t < 4; ++t)
#pragma unroll
                for (int p = 0; p < 2; ++p) ta[t][p] = *(const LAS bf16x8*)(Tb + pi_idx(t, l15) * 64 + 32 * p + 8 * g);
#pragma unroll
            for (int ne = 0; ne < 4; ++ne) {
                const bf16x8 vb0 = *(const bf16x8*)(vtb + (16 * ne + l15) * 64 + 8 * g), vb1 = *(const bf16x8*)(vtb + (16 * ne + l15) * 64 + 32 + 8 * g);
#pragma unroll
                for (int t = 0; t < 4; ++t) { f32x4_t acc = {0.f, 0.f, 0.f, 0.f};
                    acc = __builtin_amdgcn_mfma_f32_16x16x32_bf16(ta[t][0], vb0, acc, 0, 0, 0);
                    acc = __builtin_amdgcn_mfma_f32_16x16x32_bf16(ta[t][1], vb1, acc, 0, 0, 0);
                    uint2 w; w.x = pk2(acc[0], acc[1]); w.y = pk2(acc[2], acc[3]);
                    FU[(((size_t)u * 4 + ne) * 4 + t) * 64 + lane] = w; }
            }
#pragma unroll
            for (int t = 0; t < 4; ++t)
#pragma unroll
                for (int p = 0; p < 2; ++p) ta[t][p] = *(const LAS bf16x8*)(Tg + pi_idx(t, l15) * 64 + 32 * p + 8 * g);
#pragma unroll
            for (int pd = 0; pd < 2; ++pd) {
                bf16x8 ka[2][2];
#pragma unroll
                for (int hh = 0; hh < 2; ++hh)
#pragma unroll
                    for (int p = 0; p < 2; ++p) ka[hh][p] = *(const bf16x8*)(ktb + pi_idx(2 * pd + hh, l15) * 64 + 32 * p + 8 * g);
#pragma unroll
                for (int nc = 0; nc < 4; ++nc) { f32x4_t a0 = {0.f, 0.f, 0.f, 0.f}, a1 = {0.f, 0.f, 0.f, 0.f};
                    a0 = __builtin_amdgcn_mfma_f32_16x16x32_bf16(ka[0][0], ta[nc][0], a0, 0, 0, 0); a0 = __builtin_amdgcn_mfma_f32_16x16x32_bf16(ka[0][1], ta[nc][1], a0, 0, 0, 0);
                    a1 = __builtin_amdgcn_mfma_f32_16x16x32_bf16(ka[1][0], ta[nc][0], a1, 0, 0, 0); a1 = __builtin_amdgcn_mfma_f32_16x16x32_bf16(ka[1][1], ta[nc][1], a1, 0, 0, 0);
                    v4u w; w.x = pk2(a0[0], a0[1]); w.y = pk2(a0[2], a0[3]); w.z = pk2(a1[0], a1[1]); w.w = pk2(a1[2], a1[3]);
                    FW[(((size_t)u * 4 + nc) * 2 + pd) * 64 + lane] = w; }
            }
        }
        asm volatile("s_waitcnt lgkmcnt(0)" ::: "memory");
    }
}

__device__ __forceinline__ float dn_gcum(const float* G, int dir, size_t m0, int h, int lane) {
    float gr = G[((size_t)dir * MT + m0 + lane) * 8 + h];
    if (dir) gr = __shfl(gr, 63 - lane);
#pragma unroll
    for (int o = 1; o < 64; o <<= 1) { const float n = __shfl_up(gr, o); if (lane >= o) gr += n; }
    if (dir) gr = __shfl(gr, 63 - lane);
    return gr;
}
__device__ __forceinline__ bf16x8 pack8(const f32x4_t& a, const f32x4_t& b) { v4u w; w.x = pk2(a[0], a[1]); w.y = pk2(a[2], a[3]); w.z = pk2(b[0], b[1]); w.w = pk2(b[2], b[3]); return __builtin_bit_cast(bf16x8, w); }
constexpr int DN2_SLOT = 25600, DN2_NSLOT = 4;
__device__ __forceinline__ void dn2_issue(const v4u* FW, const uint2* FU, const bf16* kt, const float* GCB, int b, int h, int dir, int st, int lw, int lane, unsigned lds_slot) {
    const int l15 = lane & 15, g = lane >> 4;
    const int cc = dir == 0 ? st : (st < 4 ? 3 - st : NCH + 3 - st);
    const size_t u = ((size_t)((b * 8 + h) * 2 + dir)) * NCH + cc; const int ck = chunk_ck(b, cc);
    const unsigned char* fw = (const unsigned char*)(FW + u * 8 * 64); const unsigned char* fu = (const unsigned char*)(FU + u * 4 * 4 * 64);
    const unsigned char* ktb = (const unsigned char*)(kt + ((size_t)ck * 8 + h) * 4096); const unsigned char* gb = (const unsigned char*)(GCB + u * 192);
#pragma unroll
    for (int k = 0; k < 2; ++k) { const int j = 2 * lw + k;
        attn64::glds16(fw + j * 1024 + lane * 16, (unsigned)__builtin_amdgcn_readfirstlane(lds_slot + j * 1024));
        attn64::glds16(ktb + pi_idx(j >> 1, l15) * 128 + (j & 1) * 64 + g * 16, (unsigned)__builtin_amdgcn_readfirstlane(lds_slot + 8192 + j * 1024));
        attn64::glds16(fu + j * 1024 + lane * 16, (unsigned)__builtin_amdgcn_readfirstlane(lds_slot + 16384 + j * 1024)); }
    attn64::glds16(gb + 512 + (lane % 10) * 16, (unsigned)__builtin_amdgcn_readfirstlane(lds_slot + 24576));
}
__device__ __forceinline__ void p6_dn2_fast(Ctx& C, bool dry = false) {
    const int lane = C.lane, g = lane >> 4;
    const v4u* FW = WSP(v4u, WS_W); uint2* FU = WSP(uint2, WS_U); const bf16* kt = WSP(bf16, WS_KT); const float* GCB = WSP(float, WS_GCB);
    v4u* SS = WSP(v4u, WS_XN);
    const unsigned lds0 = (unsigned)(uintptr_t)C.lds;
    for (int ch = blockIdx.x; ch < NB * 8 * 2; ch += C.G) {
        const int dir = ch & 1, h = (ch >> 1) & 7, b = ch >> 4;
        __syncthreads();
        if (C.wave >= 4) {
            const int lw = C.wave - 4;
            dn2_issue(FW, FU, kt, GCB, b, h, dir, 0, lw, lane, lds0 + 0 * DN2_SLOT); dn2_issue(FW, FU, kt, GCB, b, h, dir, 1, lw, lane, lds0 + 1 * DN2_SLOT); dn2_issue(FW, FU, kt, GCB, b, h, dir, 2, lw, lane, lds0 + 2 * DN2_SLOT);
            for (int st = 0; st < NCH; ++st) {
                if (st + 2 < NCH) asm volatile("s_waitcnt vmcnt(14)" ::: "memory"); else if (st + 1 < NCH) asm volatile("s_waitcnt vmcnt(7)" ::: "memory"); else asm volatile("s_waitcnt vmcnt(0)" ::: "memory");
                __builtin_amdgcn_s_barrier();
                if (st + 3 < NCH) dn2_issue(FW, FU, kt, GCB, b, h, dir, st + 3, lw, lane, lds0 + ((st + 3) & 3) * DN2_SLOT);
            }
        } else {
            const int dvq = C.wave;
            f32x4_t S[4];
#pragma unroll
            for (int t = 0; t < 4; ++t) S[t] = (f32x4_t){0.f, 0.f, 0.f, 0.f};
            bf16x8 Sf[2]; Sf[0] = (bf16x8){0, 0, 0, 0, 0, 0, 0, 0}; Sf[1] = Sf[0];
            for (int st = 0; st < NCH; ++st) {
                asm volatile("s_waitcnt lgkmcnt(0)" ::: "memory");
                __builtin_amdgcn_s_barrier();
                asm volatile("" ::: "memory");
                const LAS unsigned char* sl = C.lds + (st & 3) * DN2_SLOT;
                const int cc = dir == 0 ? st : (st < 4 ? 3 - st : NCH + 3 - st);
                const size_t u = ((size_t)((b * 8 + h) * 2 + dir)) * NCH + cc;
                if (!dry) { SS[((u * 4 + dvq) * 2 + 0) * 64 + lane] = __builtin_bit_cast(v4u, Sf[0]); SS[((u * 4 + dvq) * 2 + 1) * 64 + lane] = __builtin_bit_cast(v4u, Sf[1]); }
                const float gl = *(const LAS float*)(sl + 24576); const float egl = __expf(gl);
                const v4u ef0 = *(const LAS v4u*)(sl + 24576 + 16 + g * 32), ef1 = *(const LAS v4u*)(sl + 24576 + 32 + g * 32);
                f32x4_t vn[4];
#pragma unroll
                for (int t = 0; t < 4; ++t) { typedef unsigned u32x2v __attribute__((ext_vector_type(2))); const u32x2v uu = *(const LAS u32x2v*)(sl + 16384 + dvq * 2048 + t * 512 + lane * 8);
                    const bf16x8 a0 = *(const LAS bf16x8*)(sl + (t * 2 + 0) * 1024 + lane * 16), a1 = *(const LAS bf16x8*)(sl + (t * 2 + 1) * 1024 + lane * 16);
                    vn[t] = (f32x4_t){bflo(uu.x), bfhi(uu.x), bflo(uu.y), bfhi(uu.y)};
                    vn[t] = __builtin_amdgcn_mfma_f32_16x16x32_bf16(a0, Sf[0], vn[t], 0, 0, 0);
                    vn[t] = __builtin_amdgcn_mfma_f32_16x16x32_bf16(a1, Sf[1], vn[t], 0, 0, 0); }
                if (!dry) { v4u* VN = (v4u*)(FU + ((u * 4 + dvq) * 4) * 64);
                    VN[0 * 64 + lane] = __builtin_bit_cast(v4u, pack8(vn[0], vn[1])); VN[1 * 64 + lane] = __builtin_bit_cast(v4u, pack8(vn[2], vn[3])); }
#pragma unroll
                for (int t = 0; t < 4; ++t) { const v4u& e = (t < 2) ? ef0 : ef1; const unsigned w0 = e[(t & 1) * 2], w1 = e[(t & 1) * 2 + 1];
                    vn[t][0] *= bflo(w0); vn[t][1] *= bfhi(w0); vn[t][2] *= bflo(w1); vn[t][3] *= bfhi(w1); }
                const bf16x8 vs0 = pack8(vn[0], vn[1]), vs1 = pack8(vn[2], vn[3]);
#pragma unroll
                for (int t = 0; t < 4; ++t) { const bf16x8 k0 = *(const LAS bf16x8*)(sl + 8192 + (t * 2 + 0) * 1024 + lane * 16), k1 = *(const LAS bf16x8*)(sl + 8192 + (t * 2 + 1) * 1024 + lane * 16);
                    S[t] = S[t] * egl;
                    S[t] = __builtin_amdgcn_mfma_f32_16x16x32_bf16(k0, vs0, S[t], 0, 0, 0);
                    S[t] = __builtin_amdgcn_mfma_f32_16x16x32_bf16(k1, vs1, S[t], 0, 0, 0); }
                Sf[0] = pack8(S[0], S[1]); Sf[1] = pack8(S[2], S[3]);
            }
            if (dry) { *(LAS v4u*)(C.lds + 110000 + (C.wave * 64 + lane) * 16) = __builtin_bit_cast(v4u, Sf[0]); }
        }
    }
    __syncthreads();
}
__device__ __forceinline__ void p7_dn3_fast(Ctx& C, int l) {
    const int lane = C.lane, l15 = lane & 15, g = lane >> 4;
    const bf16* qdn = WSP(bf16, WS_QDN); const bf16* kdn = WSP(bf16, WS_KDN);
    const v4u* VNb = WSP(v4u, WS_U); const v4u* SS = WSP(v4u, WS_XN); const bf16* zb = WSP(bf16, WS_ZB); bf16* mix = WSP(bf16, WS_MIX);
    LAS unsigned char* wl = C.lds + C.wave * 16384; const unsigned wl_addr = (unsigned)(uintptr_t)wl;
    const int cc0 = (l == 0) ? 0 : 4; const int ncc = NCH - cc0;
    gu32* qh = C.ctl + CW_Q + 64 * (2 * l + 1);
    for (int un = wq_next(qh, lane); un < NB * 8 * ncc; un = wq_next(qh, lane)) {
        const int cc = cc0 + un % ncc, h = (un / ncc) & 7, b = un / (8 * ncc);
        const int ck = chunk_ck(b, cc); const size_t m0 = (size_t)ck * 64;
        const size_t u0 = ((size_t)((b * 8 + h) * 2 + 0)) * NCH + cc;
        asm volatile("s_waitcnt lgkmcnt(0)" ::: "memory");
#pragma unroll
        for (int f = 0; f < 8; ++f) { attn64::glds16(SS + (u0 * 8 + f) * 64 + lane, (unsigned)__builtin_amdgcn_readfirstlane(wl_addr + f * 1024)); attn64::glds16(VNb + (u0 * 8 + f) * 64 + lane, (unsigned)__builtin_amdgcn_readfirstlane(wl_addr + 8192 + f * 1024)); }
        bf16x8 kf[4][2], qf[4][2];
#pragma unroll
        for (int t = 0; t < 4; ++t)
#pragma unroll
            for (int p = 0; p < 2; ++p) { kf[t][p] = *(const bf16x8*)(kdn + (m0 + pi_idx(t, l15)) * 512 + h * 64 + 32 * p + 8 * g); qf[t][p] = *(const bf16x8*)(qdn + (m0 + pi_idx(t, l15)) * 512 + h * 64 + 32 * p + 8 * g); }
        const float* gcb0 = WSP(float, WS_GCB) + u0 * 192; const float* gcb1 = gcb0 + (size_t)NCH * 192;
        f32x4_t o[4][4];
#pragma unroll
        for (int ni = 0; ni < 4; ++ni)
#pragma unroll
            for (int ne = 0; ne < 4; ++ne) o[ni][ne] = (f32x4_t){0.f, 0.f, 0.f, 0.f};
#pragma unroll
        for (int dir = 0; dir < 2; ++dir) {
            const float* gcbd = dir ? gcb1 : gcb0;
            f32x4_t rowg[4]; float gi[4];
#pragma unroll
            for (int t = 0; t < 4; ++t) { rowg[t] = *(const f32x4_t*)(gcbd + 64 + g * 16 + t * 4); gi[t] = gcbd[pi_idx(t, l15)]; }
            if (dir == 1) { const size_t u1 = u0 + NCH;
                asm volatile("s_waitcnt lgkmcnt(0)" ::: "memory");
#pragma unroll
                for (int f = 0; f < 8; ++f) { attn64::glds16(SS + (u1 * 8 + f) * 64 + lane, (unsigned)__builtin_amdgcn_readfirstlane(wl_addr + f * 1024)); attn64::glds16(VNb + (u1 * 8 + f) * 64 + lane, (unsigned)__builtin_amdgcn_readfirstlane(wl_addr + 8192 + f * 1024)); } }
            asm volatile("s_waitcnt vmcnt(0)" ::: "memory");
#pragma unroll
            for (int ni = 0; ni < 4; ++ni) {
                const int si = pi_idx(ni, l15);
                f32x4_t pt[4];
#pragma unroll
                for (int tj = 0; tj < 4; ++tj) { f32x4_t a = {0.f, 0.f, 0.f, 0.f};
                    a = __builtin_amdgcn_mfma_f32_16x16x32_bf16(kf[tj][0], qf[ni][0], a, 0, 0, 0);
                    a = __builtin_amdgcn_mfma_f32_16x16x32_bf16(kf[tj][1], qf[ni][1], a, 0, 0, 0);
#pragma unroll
                    for (int r = 0; r < 4; ++r) { const int sj = pi_idx(tj, 4 * g + r); const bool keep = dir ? (si <= sj) : (si >= sj);
                        a[r] = keep ? a[r] * __expf(gi[ni] - rowg[tj][r]) : 0.f; }
                    pt[tj] = a; }
                const bf16x8 pa0 = pack8(pt[0], pt[1]), pa1 = pack8(pt[2], pt[3]);
                float erow[4];
#pragma unroll
                for (int r = 0; r < 4; ++r) erow[r] = __expf(rowg[ni][r]);
#pragma unroll
                for (int ne = 0; ne < 4; ++ne) {
                    const bf16x8 s0 = *(const LAS bf16x8*)(wl + (ne * 2 + 0) * 1024 + lane * 16), s1 = *(const LAS bf16x8*)(wl + (ne * 2 + 1) * 1024 + lane * 16);
                    const bf16x8 v0 = *(const LAS bf16x8*)(wl + 8192 + (ne * 2 + 0) * 1024 + lane * 16), v1 = *(const LAS bf16x8*)(wl + 8192 + (ne * 2 + 1) * 1024 + lane * 16);
                    f32x4_t qs = {0.f, 0.f, 0.f, 0.f};
                    qs = __builtin_amdgcn_mfma_f32_16x16x32_bf16(qf[ni][0], s0, qs, 0, 0, 0);
                    qs = __builtin_amdgcn_mfma_f32_16x16x32_bf16(qf[ni][1], s1, qs, 0, 0, 0);
#pragma unroll
                    for (int r = 0; r < 4; ++r) o[ni][ne][r] += qs[r] * erow[r];
                    o[ni][ne] = __builtin_amdgcn_mfma_f32_16x16x32_bf16(pa0, v0, o[ni][ne], 0, 0, 0);
                    o[ni][ne] = __builtin_amdgcn_mfma_f32_16x16x32_bf16(pa1, v1, o[ni][ne], 0, 0, 0);
                    if (ne & 1) __builtin_amdgcn_sched_barrier(0); }
            }
        }
        asm volatile("s_waitcnt lgkmcnt(0)" ::: "memory");
        {   LAS bf16* ot = (LAS bf16*)wl;
#pragma unroll
            for (int ni = 0; ni < 4; ++ni)
#pragma unroll
                for (int ne = 0; ne < 4; ++ne) { const unsigned w0 = pk2(o[ni][ne][0], o[ni][ne][1]), w1 = pk2(o[ni][ne][2], o[ni][ne][3]); const int e = 16 * ne + l15;
                    ot[pi_idx(ni, 4 * g + 0) * 64 + e] = (bf16)(w0 & 0xffffu); ot[pi_idx(ni, 4 * g + 1) * 64 + e] = (bf16)(w0 >> 16);
                    ot[pi_idx(ni, 4 * g + 2) * 64 + e] = (bf16)(w1 & 0xffffu); ot[pi_idx(ni, 4 * g + 3) * 64 + e] = (bf16)(w1 >> 16); }
            asm volatile("s_waitcnt lgkmcnt(0)" ::: "memory");
            const size_t row = m0 + lane; float ov[64]; float ss = 0.f;
#pragma unroll
            for (int c = 0; c < 8; ++c) { const v4u w = *(const LAS v4u*)(wl + lane * 128 + c * 16);
                ov[c * 8 + 0] = bflo(w.x); ov[c * 8 + 1] = bfhi(w.x); ov[c * 8 + 2] = bflo(w.y); ov[c * 8 + 3] = bfhi(w.y); ov[c * 8 + 4] = bflo(w.z); ov[c * 8 + 5] = bfhi(w.z); ov[c * 8 + 6] = bflo(w.w); ov[c * 8 + 7] = bfhi(w.w); }
#pragma unroll
            for (int i = 0; i < 64; ++i) ss += ov[i] * ov[i];
            const float rs = 1.0f / sqrtf(ss * (1.f / 64.f) + EPS);
#pragma unroll
            for (int c = 0; c < 8; ++c) { float z[8]; load8(zb + row * 512 + h * 64 + c * 8, z); float r8[8];
#pragma unroll
                for (int i = 0; i < 8; ++i) r8[i] = ov[c * 8 + i] * rs * C.in[12][l * 64 + c * 8 + i] * silu_f(z[i]);
                store8(mix + row * 1024 + h * 64 + c * 8, r8); }
        }
    }
    asm volatile("s_waitcnt lgkmcnt(0)" ::: "memory");
}
__device__ __forceinline__ void p4_attn_fast(Ctx& C, char* ldsg, int l, bool dry = false) {
    const int bx = blockIdx.x; const int vcu = (C.G % 8 == 0) ? (bx % 8) * (C.G / 8) + bx / 8 : bx;
    attn64::bf16* mix = (attn64::bf16*)WSP(bf16, WS_MIX); attn64::bf16* omix = mix; const unsigned char* q8 = WSP(unsigned char, WS_XN); const unsigned char* k8 = WSP(unsigned char, WS_KALL); const unsigned char* v8 = WSP(unsigned char, WS_VALL);     const attn64::bf16* kall = (const attn64::bf16*)WSP(bf16, WS_KALL); const attn64::bf16* vall = (const attn64::bf16*)WSP(bf16, WS_VALL);
    float mq = fabsf(C.in[13][l * 64 + C.lane]), mk = fabsf(C.in[14][l * 64 + C.lane]);
#pragma unroll
    for (int o = 1; o < 64; o <<= 1) { mq = fmaxf(mq, __shfl_xor(mq, o)); mk = fmaxf(mk, __shfl_xor(mk, o)); }
    const float mref = 64.0f * QSCALE * mq * mk * 1.02f;
    const int nun = NB * 8 * (T / 256) + (l == 0 ? NB * 8 : 0);
    for (int L = vcu; L < nun; L += C.G) {
        int qrow, krow, nt, h;
        if (L < 1024) { const int within = L & 255, bh = within >> 3, qb = (within & 7) + 8 * (L >> 8); const int b = bh >> 3; h = bh & 7; qrow = b * T + qb * 256; krow = b * TK; nt = TK / 64; }
        else { const int b = (L - 1024) >> 3; h = L & 7; qrow = ML + b * LC; krow = b * TK + T; nt = LC / 64; }
        const int kvh = h >> 2;
        attn64::attn_unit8(q8 + (size_t)qrow * 512 + h * 64, omix + (size_t)qrow * 1024 + 512 + h * 64, k8 + (size_t)krow * 128 + kvh * 64, v8 + ((size_t)((krow / TK) * 2 + kvh) * (TK / 64) + (krow % TK) / 64) * 4096, nt, ldsg, mref);
    }
    __syncthreads();
}
__device__ __forceinline__ void tile64(Ctx& C, const bf16* X, int lda, const bf16* Wt, int ldb, int K, float (&r)[8]) {
    typedef pg8::bf16x8 frag_t; typedef pg8::f32x4 c4_t;
    const int lane = C.lane, r16 = lane & 15, g = lane >> 4, w = C.wave;
    const int npair = K >> 6, pbase = npair >> 3, prem = npair & 7;
    const int np = pbase + (w < prem ? 1 : 0), pstart = w * pbase + (w < prem ? w : prem);
    const bf16* xp = X + (size_t)r16 * lda + pstart * 64 + 16 * g;
    const bf16* wp = Wt + (size_t)r16 * ldb + pstart * 64 + 16 * g;
    c4_t acc[4][4];
#pragma unroll
    for (int a = 0; a < 4; ++a)
#pragma unroll
        for (int b = 0; b < 4; ++b) acc[a][b] = (c4_t){0.f, 0.f, 0.f, 0.f};
    frag_t xa[8], wa[8], xb[8], wb[8];
#define T64_LD(xf, wf, p) do { _Pragma("unroll") for (int t_ = 0; t_ < 4; ++t_) { const bf16* xq_ = xp + (size_t)(16 * t_) * lda + 64 * (p); const bf16* wq_ = wp + (size_t)(16 * t_) * ldb + 64 * (p); \
        xf[2 * t_] = *(const GAS frag_t*)(xq_); xf[2 * t_ + 1] = *(const GAS frag_t*)(xq_ + 8); wf[2 * t_] = *(const GAS frag_t*)(wq_); wf[2 * t_ + 1] = *(const GAS frag_t*)(wq_ + 8); } } while (0)
#define T64_MM(xf, wf) do { _Pragma("unroll") for (int h_ = 0; h_ < 2; ++h_) _Pragma("unroll") for (int nt_ = 0; nt_ < 4; ++nt_) _Pragma("unroll") for (int mt_ = 0; mt_ < 4; ++mt_) \
        acc[nt_][mt_] = __builtin_amdgcn_mfma_f32_16x16x32_bf16(wf[2 * nt_ + h_], xf[2 * mt_ + h_], acc[nt_][mt_], 0, 0, 0); } while (0)
#define T64_SB __builtin_amdgcn_sched_barrier(0)
    T64_LD(xa, wa, 0); if (1 < np) T64_LD(xb, wb, 1); T64_SB;
    for (int p = 0; p < np; p += 2) {
        T64_MM(xa, wa); T64_SB;
        if (p + 2 < np) T64_LD(xa, wa, p + 2); T64_SB;
        if (p + 1 < np) T64_MM(xb, wb); T64_SB;
        if (p + 3 < np) T64_LD(xb, wb, p + 3); T64_SB;
    }
#undef T64_SB
#undef T64_LD
#undef T64_MM
    LAS unsigned char* P = C.lds + w * 16384;
#pragma unroll
    for (int nt = 0; nt < 4; ++nt)
#pragma unroll
        for (int mt = 0; mt < 4; ++mt) { const int m = 16 * mt + r16, nb = (16 * nt + 4 * g) * 4; *(LAS c4_t*)(P + m * 256 + (nb ^ (r16 << 4))) = acc[nt][mt]; }
    __syncthreads();
    const int m = 8 * w + (lane >> 3), cb = (lane & 7) * 32, sw = (m & 15) << 4;
#pragma unroll
    for (int i = 0; i < 8; ++i) r[i] = 0.f;
#pragma unroll
    for (int q = 0; q < 8; ++q) { const LAS unsigned char* Q = C.lds + q * 16384 + m * 256; const c4_t a = *(const LAS c4_t*)(Q + (cb ^ sw)), b = *(const LAS c4_t*)(Q + ((cb + 16) ^ sw));
        r[0] += a[0]; r[1] += a[1]; r[2] += a[2]; r[3] += a[3]; r[4] += b[0]; r[5] += b[1]; r[6] += b[2]; r[7] += b[3]; }
    __syncthreads();
}
template <bool XF32> __device__ __forceinline__ void ctx_res_tiles(Ctx& C, const bf16* X, int lda, const bf16* Wt, int K, const void* xin, bf16* out, const float* gate) {
    for (int tI = blockIdx.x; tI < 256; tI += C.G) {
        const int xcd = tI & 7, idx = tI >> 3, ti = 8 * (xcd & 1) + (idx & 7), tj = 4 * (xcd >> 1) + (idx >> 3);
        float r[8]; tile64(C, X + (size_t)(64 * ti) * lda, lda, Wt + (size_t)(64 * tj) * K, K, K, r);
        const size_t off = (size_t)(64 * ti + 8 * C.wave + (C.lane >> 3)) * D + 64 * tj + 8 * (C.lane & 7);
        float x[8];
        if (XF32) { const f32x4 a = *(const GAS f32x4*)((const float*)xin + off), b = *(const GAS f32x4*)((const float*)xin + off + 4); x[0] = a.x; x[1] = a.y; x[2] = a.z; x[3] = a.w; x[4] = b.x; x[5] = b.y; x[6] = b.z; x[7] = b.w; }
        else load8((const bf16*)xin + off, x);
        const f32x4 ga = *(const GAS f32x4*)(gate + 64 * tj + 8 * (C.lane & 7)), gb = *(const GAS f32x4*)(gate + 64 * tj + 8 * (C.lane & 7) + 4);
        const float o[8] = {x[0] + ga.x * r[0], x[1] + ga.y * r[1], x[2] + ga.z * r[2], x[3] + ga.w * r[3], x[4] + gb.x * r[4], x[5] + gb.y * r[5], x[6] + gb.z * r[6], x[7] + gb.w * r[7]};
        store8(out + off, o);
    }
}
__device__ __forceinline__ void moe_down_tiles(Ctx& C, const int (&ps)[9], int p0, int p1) {
    const bf16* hm = WSP(bf16, WS_HM); const bf16* md = WSP(bf16, WS_MD); bf16* ys = WSP(bf16, WS_XS);
    const int nt = (p1 - p0) * 64;
    for (int tI = blockIdx.x; tI < nt; tI += C.G) {
        const int p = p0 + (tI >> 6), mi = (tI >> 4) & 3, nj = tI & 15; int e = 0;
#pragma unroll
        for (int k = 1; k < 8; ++k) e += (p >= ps[k]) ? 1 : 0;
        float r[8]; tile64(C, hm + (size_t)((p - p0) * 256 + 64 * mi) * EF, EF, md + (size_t)e * D * EF + (size_t)(64 * nj) * EF, EF, EF, r);
        store8(ys + (size_t)(p * 256 + 64 * mi + 8 * C.wave + (C.lane >> 3)) * D + 64 * nj + 8 * (C.lane & 7), r);
    }
}
#define STAMP() do {} while (0)
#define RELOAD() do { int t_ = threadIdx.x; asm volatile("" : "+v"(t_)); C.tid = t_; C.lane = t_ & 63; C.wave = __builtin_amdgcn_readfirstlane(t_ >> 6); C.gw = blockIdx.x * NWAVES + C.wave; } while (0)
#define GRID_BAR() do { XcdBarrier b2_ = bar; asm volatile("" : "+s"(b2_.x), "+s"(b2_.bar)); xcd_barrier(b2_); RELOAD(); STAMP(); } while (0)
template <int l> __device__ __forceinline__ void layer_fn(Ctx& C, const XcdBarrier& bar, unsigned char* lds) {
        bf16* const xb1 = (bf16*)C.out;
        const void* xl = (l == 0) ? (const void*)C.in[0] : (const void*)xb1; const void* xc = (l == 0) ? (const void*)C.in[2] : (const void*)WSP(bf16, WS_XC);
        norm_mod<false, l != 0>(C, xl, xc, MT, l, 1, 0, WSP(bf16, WS_XN));
        GRID_BAR();
        {   pg8::Gemm g{WSP(bf16, WS_XN), WSP(bf16, WS_WIN) + (size_t)l * NINP * D, MT, NINP, D}; pg8::StaticOrder S; S.init(MT, NINP, C.G, (int)blockIdx.x);
            pg8::EpiIn E{WSP(bf16, WS_DNRAW), WSP(bf16, WS_ZB), WSP(bf16, WS_QRAW), WSP(bf16, WS_KVRAW), WSP(float, WS_AB)};
            pg8::gemm_phase<pg8::EpiIn, pg8::StaticOrder, true, true>(C.lds, g, S, E); }
        GRID_BAR();
        p3_prep(C, l);
        RELOAD();
        p3b_dnconv(C, l);
        GRID_BAR();
        p4_attn_fast(C, (char*)lds, l);
        STAMP();
        RELOAD();
        p5_dn1_fast(C, l);
        GRID_BAR();
        p6_dn2_fast(C);
        GRID_BAR();
        p7_dn3_fast(C, l);
        GRID_BAR();
        {   const int Mo = ML;
            pg8::Gemm g{WSP(bf16, WS_MIX), WSP(bf16, WS_WOUT) + (size_t)l * D * D, Mo, D, D}; pg8::StaticOrder S; S.init(Mo, D, C.G, (int)blockIdx.x);
            pg8::EpiRes<l == 0> E{xl, (l == 0) ? xb1 : WSP(bf16, WS_XB2), xc, WSP(bf16, WS_XC), mods_ptr(C, l, 0, 2), 6 * 1024};
            pg8::gemm_phase<pg8::EpiRes<l == 0>, pg8::StaticOrder, true, true>(C.lds, g, S, E); }
        if (l == 0) { RELOAD(); ctx_res_tiles<true>(C, WSP(bf16, WS_MIX) + (size_t)ML * D, D, WSP(bf16, WS_WOUT), D, C.in[2], WSP(bf16, WS_XC), mods_ptr(C, 0, 4, 2)); }
        GRID_BAR();
        if (l == 0) {
            norm_mod<false, true>(C, xb1, WSP(bf16, WS_XC), MT, l, 4, 3, WSP(bf16, WS_XN));
            GRID_BAR();
            {   pg8::Gemm g{WSP(bf16, WS_XN), WSP(bf16, WS_WGU), MT, 2 * FF, D}; pg8::StaticOrder S; S.init(MT, 2 * FF, C.G, (int)blockIdx.x);
                pg8::EpiSwiGLU E{WSP(bf16, WS_H), FF, 22, 0};
                pg8::gemm_phase<pg8::EpiSwiGLU, pg8::StaticOrder, true, true>(C.lds, g, S, E); }
            GRID_BAR();
            {   pg8::Gemm g{WSP(bf16, WS_H), WSP(bf16, WS_WD), ML, D, FF}; pg8::StaticOrder S; S.init(ML, D, C.G, (int)blockIdx.x);
                pg8::EpiRes<false> E{xb1, xb1, WSP(bf16, WS_XC), WSP(bf16, WS_XC), mods_ptr(C, l, 0, 5), 6 * 1024};
                pg8::gemm_phase<pg8::EpiRes<false>, pg8::StaticOrder, true, true>(C.lds, g, S, E); }
            RELOAD(); ctx_res_tiles<false>(C, WSP(bf16, WS_H) + (size_t)ML * FF, FF, WSP(bf16, WS_WD), FF, WSP(bf16, WS_XC), WSP(bf16, WS_XC), mods_ptr(C, 0, 4, 5));
            GRID_BAR();
        } else {
            norm_mod<true, true>(C, WSP(bf16, WS_XB2), WSP(bf16, WS_XC), ML, l, 4, 3, WSP(bf16, WS_HM));
            RELOAD();
            moe_weights(C);
            GRID_BAR();
            moe_scatter(C, WSP(bf16, WS_HM));
            GRID_BAR();
            int ps[9], cnt[8]; moe_panel_starts(C, ps, cnt);
            const int per = SS_PANELS;
            for (int ss = 0; ss < NSS; ++ss) {
                const int p0 = ss * per, p1 = (p0 + per < ps[8]) ? p0 + per : ps[8];
                if (p0 < p1) {
                    pg8::MoeOrder S;
#pragma unroll
                    for (int k = 0; k < 9; ++k) S.ps[k] = ps[k];
                    S.p0 = p0; S.p1 = p1; S.nloc = 28; S.G = C.G; S.c = (int)blockIdx.x; S.a_off = 0;
                    pg8::Gemm g{WSP(bf16, WS_XS), WSP(bf16, WS_MGU), 0, 0, D};
                    pg8::EpiSwiGLU E{WSP(bf16, WS_HM), EF, 28, p0};
                    pg8::gemm_phase<pg8::EpiSwiGLU, pg8::MoeOrder, true, true>(C.lds, g, S, E);
                }
                GRID_BAR();
                if (p0 < p1 && p1 - p0 <= 12) { moe_down_tiles(C, ps, p0, p1); }
                else if (p0 < p1) {
                    pg8::MoeOrder S;
#pragma unroll
                    for (int k = 0; k < 9; ++k) S.ps[k] = ps[k];
                    S.p0 = p0; S.p1 = p1; S.nloc = 4; S.G = C.G; S.c = (int)blockIdx.x; S.a_off = -p0;
                    pg8::Gemm g{WSP(bf16, WS_HM), WSP(bf16, WS_MD), 0, 0, EF};
                    pg8::EpiBfPlain E{WSP(bf16, WS_XS) + (size_t)p0 * 256 * D, D, 4};
                    pg8::gemm_phase<pg8::EpiBfPlain, pg8::MoeOrder, true, true>(C.lds, g, S, E);
                }
                GRID_BAR();
            }
            moe_final(C, l);
        }
    }
struct Args { const float* in[25]; float* out; unsigned char* ws; };
__global__ void __launch_bounds__(NWAVES * 64, 2) mk_fwd(Args args) {
    extern __shared__ __attribute__((aligned(16))) unsigned char lds[];
    Ctx C;
    C.lds = (LAS unsigned char*)lds; C.tid = threadIdx.x; C.lane = C.tid & 63; C.wave = __builtin_amdgcn_readfirstlane(C.tid >> 6);
    C.G = gridDim.x; C.gw = blockIdx.x * NWAVES + C.wave; C.NGW = C.G * NWAVES;
    C.in = (const float* const __attribute__((address_space(4)))*)__builtin_amdgcn_kernarg_segment_ptr();
    C.out = args.out; C.ws = args.ws; C.ctl = (gu32*)args.ws;
    volatile LAS unsigned* MISC = (volatile LAS unsigned*)(C.lds + MISC_OFF);
    for (int u = C.tid; u < (LDS_BYTES - LDSCTL_OFF) / 4; u += NWAVES * 64) ((LAS unsigned*)(C.lds + LDSCTL_OFF))[u] = 0u;
    __syncthreads();
    XcdBarrier bar = xcd_barrier_post((unsigned*)(C.ctl + CW_BAR), MISC + 8);
    p0_weights(C); __syncthreads(); RELOAD(); p0_mods(C);
    GRID_BAR();
    layer_fn<0>(C, bar, lds);
    layer_fn<1>(C, bar, lds);
}

extern "C" void kernel_launch(void* const* d_in, const int* in_sizes, int n_in, void* d_out, int out_size, void* d_ws, size_t ws_size, hipStream_t stream) {
    static int grid = 0;
    if (grid == 0) {
        int dev = 0, cus = 0;
        if (n_in != 25 || out_size != ML * D || ws_size < (size_t)560 * MiB) { fprintf(stderr, "kernel_launch: unexpected problem (n_in %d out %d ws %zu)\n", n_in, out_size, ws_size); grid = -1; return; }
        if (hipGetDevice(&dev) != hipSuccess || hipDeviceGetAttribute(&cus, hipDeviceAttributeMultiprocessorCount, dev) != hipSuccess) { grid = -1; return; }
        if (hipFuncSetAttribute((const void*)mk_fwd, hipFuncAttributeMaxDynamicSharedMemorySize, LDS_BYTES) != hipSuccess) { grid = -1; return; }
        (void)hipGetLastError();
        grid = cus;
    }
    if (grid < 0) return;
    (void)hipMemsetAsync((char*)d_ws, 0, CTL_ZERO_BYTES, stream);
    Args a{};
    for (int i = 0; i < 25; ++i) a.in[i] = (const float*)d_in[i];
    a.out = (float*)d_out; a.ws = (unsigned char*)d_ws;
    hipLaunchKernelGGL(mk_fwd, dim3(grid), dim3(NWAVES * 64), LDS_BYTES, stream, a);
}
```

```cpp
#include <hip/hip_runtime.h>
#include <hip/hip_bf16.h>
#include <cstdio>
#include <cstdint>
#include <cmath>
namespace pg8 {
#define PG8_LAS __attribute__((address_space(3)))
typedef unsigned short bf16_t;
typedef short bf16x8 __attribute__((ext_vector_type(8)));
typedef float f32x4 __attribute__((ext_vector_type(4)));
typedef unsigned u32x4 __attribute__((ext_vector_type(4)));
constexpr int BM = 256, BK = 64, HALF = 128, HTB = HALF * BK * 2  , STAGE_BYTES = 8 * HTB, NXCD = 8, WGM = 8;

__host__ __device__ __forceinline__ int lds_byte(int r, int c) { const int st = (r >> 4) * 2 + (c >> 5), rr = r & 15, cc = c & 31, ob = rr * 64 + cc * 2; return st * 1024 + (ob ^ (((ob >> 9) & 1) << 5)); }
__host__ __device__ __forceinline__ void stage_rc(int b, int& R, int& C) { const int st = b / 1024, sb = b % 1024, swz = sb ^ (((sb >> 9) & 1) << 5); R = (st >> 1) * 16 + swz / 64; C = (st & 1) * 32 + (swz % 64) / 2; }
__host__ __device__ __forceinline__ int perm32(int rho) { const int n = rho >> 4, i = rho & 15; return 8 * (i >> 2) + 4 * n + (i & 3); }

struct Unit { int pm, pn; };
struct Gemm { const bf16_t* A; const bf16_t* Bt; int M, N, K; };

struct StaticOrder {
    int nM, nN, nwg, G, c;
    __host__ __device__ void init(int M, int N, int G_, int c_) { nM = M / BM; nN = N / BM; nwg = nM * nN; G = G_; c = c_; }
    __host__ __device__ bool next(int i, Unit& u) const {
        const long L = (long)i * G + c; if (L >= nwg) return false;
        int wgid = (int)L; { const int q = nwg / NXCD, r = nwg % NXCD, xcd = wgid % NXCD, off = wgid / NXCD; wgid = (xcd < r ? xcd * (q + 1) : r * (q + 1) + (xcd - r) * q) + off; }
        const int nig = WGM * nN, gid = wgid / nig, fm = gid * WGM, gsz = (nM - fm) < WGM ? (nM - fm) : WGM;
        u.pm = fm + ((wgid % nig) % gsz); u.pn = (wgid % nig) / gsz; return true;
    }
    __device__ __forceinline__ void a_ready(const Unit&) const {}
    __device__ __forceinline__ void done(const Unit&) const {}
};

__device__ __forceinline__ unsigned cvt_pk_bf16(float lo, float hi) { unsigned r; asm volatile("v_cvt_pk_bf16_f32 %0, %1, %2" : "=v"(r) : "v"(lo), "v"(hi)); return r; }
typedef float f32x2 __attribute__((ext_vector_type(2)));
__device__ __forceinline__ f32x2 gelu_pk(f32x2 v) {
    const f32x2 av = __builtin_elementwise_abs(v), d = av * 0.2316418882f + 1.0f;
    f32x2 t; t.x = __builtin_amdgcn_rcpf(d.x); t.y = __builtin_amdgcn_rcpf(d.y);
    f32x2 q = t * 0.5307027145f + (-0.7265760135f); q = q * t + 0.7107068705f; q = q * t + (-0.142248368f); q = q * t + 0.127414796f; q = q * t;
    const f32x2 s = (v * v) * (-0.72134752044f);
    f32x2 e; e.x = __builtin_amdgcn_exp2f(s.x); e.y = __builtin_amdgcn_exp2f(s.y);
    const f32x2 m = v * (q * e), r = v - m;
    f32x2 o; o.x = v.x < 0.f ? m.x : r.x; o.y = v.y < 0.f ? m.y : r.y; return o;
}

template <int ACT  > struct EpiBf16 {
    static constexpr bool PERM = true, AFTER_DRAIN = false; static_assert(ACT == 0 || ACT == 1, "EpiBf16: ACT is 0 (none) or 1 (gelu_pk)");
    bf16_t* O; int ldc; const float* bias; int split_cols; size_t split_stride; float scale0;
    __device__ __forceinline__ void operator()(const f32x4 (&acc)[2][2][4][2], const Unit& u, int wr, int wc, int fr, int fq) const {
        const int row0 = u.pm * BM + wr * 64 + fr; int colt = u.pn * BM; bf16_t* base = O;
        float sc = 1.f; if (split_cols) { const int t = colt / split_cols; base += (size_t)t * split_stride; colt -= t * split_cols; if (t == 0) sc = scale0; }
        const int col0 = colt + wc * 32 + 8 * fq, bcol0 = u.pn * BM + wc * 32 + 8 * fq;
        f32x4 bv[2][2];
#pragma unroll
        for (int bj = 0; bj < 2; ++bj)
#pragma unroll
            for (int n = 0; n < 2; ++n) bv[bj][n] = bias ? *(const f32x4*)(bias + bcol0 + bj * HALF + 4 * n) : (f32x4){0.f, 0.f, 0.f, 0.f};
#pragma unroll
        for (int ai = 0; ai < 2; ++ai)
#pragma unroll
            for (int m = 0; m < 4; ++m) { bf16_t* rowp = base + (size_t)(row0 + ai * HALF + m * 16) * ldc + col0;
#pragma unroll
                for (int bj = 0; bj < 2; ++bj) { f32x4 v0 = acc[ai][bj][m][0] + bv[bj][0], v1 = acc[ai][bj][m][1] + bv[bj][1];
                    if (ACT == 1) { f32x2 a = gelu_pk((f32x2){v0[0], v0[1]}), b = gelu_pk((f32x2){v0[2], v0[3]}), c = gelu_pk((f32x2){v1[0], v1[1]}), d = gelu_pk((f32x2){v1[2], v1[3]});
                        v0 = (f32x4){a.x, a.y, b.x, b.y}; v1 = (f32x4){c.x, c.y, d.x, d.y}; }
                    v0 = v0 * sc; v1 = v1 * sc; u32x4 w; w.x = cvt_pk_bf16(v0[0], v0[1]); w.y = cvt_pk_bf16(v0[2], v0[3]); w.z = cvt_pk_bf16(v1[0], v1[1]); w.w = cvt_pk_bf16(v1[2], v1[3]);
                    *(u32x4*)(rowp + bj * HALF) = w; } }
    }
};

template <class Epi, class Sched, bool ALIGN_EPI = false, bool SP2 = false>
__device__ __forceinline__ void gemm_phase(PG8_LAS unsigned char* lds, const Gemm g, const Sched& S, const Epi& E) {
    int tid_ = threadIdx.x; asm volatile("" : "+v"(tid_));
    const int tid = tid_, wid = __builtin_amdgcn_readfirstlane(tid >> 6), lane = tid & 63, wr = wid >> 2, wc = wid & 3, fr = lane & 15, fq = lane >> 4;
    const int K = g.K, nt = K / BK;
    unsigned voffA[2], voffB[2];
#pragma unroll
    for (int i = 0; i < 2; ++i) { int R, C; stage_rc(tid * 16 + i * 8192, R, C); const int Rb = Epi::PERM ? ((R & ~31) + perm32(R & 31)) : R;
        voffA[i] = (unsigned)(R * K + C) * 2u; voffB[i] = (unsigned)(Rb * K + C) * 2u; }
    const size_t kstep = (size_t)(BK * 2);
    const size_t hstep = (size_t)HALF * K * 2;
    const size_t tstep = 2 * hstep;
    const unsigned ldsw = (unsigned)wid * 1024u;
    const int aoff = lds_byte(wr * 64 + fr, fq * 8), boff = lds_byte(wc * 32 + fr, fq * 8);
#define PG8_SA(b, h) (((b) * 2 + (h)) * HTB)
#define PG8_SB(b, h) ((4 + (b) * 2 + (h)) * HTB)
#define PG8_STAGE(bufoff, gbase, voff) do { _Pragma("unroll") for (int _i = 0; _i < 2; ++_i) \
        __builtin_amdgcn_global_load_lds((const unsigned*)((const char*)(gbase) + (voff)[_i]), (PG8_LAS unsigned*)(lds + (bufoff) + ldsw + _i * 8192), 16, 0, 0); } while (0)
#define PG8_LDA(dst, b, h) do { _Pragma("unroll") for (int m = 0; m < 4; ++m) _Pragma("unroll") for (int k = 0; k < 2; ++k) dst[m][k] = *(const PG8_LAS bf16x8*)(lds + PG8_SA(b, h) + aoff + m * 2048 + k * 1024); } while (0)
#define PG8_LDB(dst, b, h) do { _Pragma("unroll") for (int n = 0; n < 2; ++n) _Pragma("unroll") for (int k = 0; k < 2; ++k) dst[n][k] = *(const PG8_LAS bf16x8*)(lds + PG8_SB(b, h) + boff + n * 2048 + k * 1024); } while (0)
#define PG8_MMA(ai, bj, At, Bt) do { __builtin_amdgcn_s_setprio(1); _Pragma("unroll") for (int m = 0; m < 4; ++m) _Pragma("unroll") for (int n = 0; n < 2; ++n) _Pragma("unroll") for (int k = 0; k < 2; ++k) \
        acc[ai][bj][m][n] = __builtin_amdgcn_mfma_f32_16x16x32_bf16(Bt[n][k], At[m][k], acc[ai][bj][m][n], 0, 0, 0); __builtin_amdgcn_s_setprio(0); } while (0)
#define PG8_WAIT_V(n) asm volatile("s_waitcnt vmcnt(" #n ")" ::: "memory")
#define PG8_WAIT_L(n) asm volatile("s_waitcnt lgkmcnt(" #n ")" ::: "memory")
#define PG8_BAR __builtin_amdgcn_s_barrier()
#define PG8_SCHED __builtin_amdgcn_sched_barrier(0)
    Unit cur, nxt; int ui = 0;
    if (!S.next(0, cur)) return;
    f32x4 acc[2][2][4][2];
#pragma unroll
    for (int a = 0; a < 2; ++a)
#pragma unroll
        for (int b = 0; b < 2; ++b)
#pragma unroll
            for (int m = 0; m < 4; ++m)
#pragma unroll
                for (int n = 0; n < 2; ++n) acc[a][b][m][n] = (f32x4){0.f, 0.f, 0.f, 0.f};
    bf16x8 At[4][2], B0[2][2], B1[2][2];
    const char* cA = (const char*)g.A + (size_t)cur.pm * tstep; const char* cB = (const char*)g.Bt + (size_t)cur.pn * tstep;
    S.a_ready(cur);
    if constexpr (SP2) {
        PG8_STAGE(PG8_SB(0, 0), cB, voffB); PG8_STAGE(PG8_SB(0, 1), cB + hstep, voffB); PG8_STAGE(PG8_SA(0, 0), cA, voffA); PG8_STAGE(PG8_SA(0, 1), cA + hstep, voffA);
        if (wr == 1) PG8_BAR;
        PG8_WAIT_V(2); PG8_BAR;
        PG8_STAGE(PG8_SB(1, 0), cB + kstep, voffB); PG8_STAGE(PG8_SA(1, 0), cA + kstep, voffA); PG8_STAGE(PG8_SB(1, 1), cB + hstep + kstep, voffB);
        PG8_WAIT_V(6); PG8_BAR;
    } else {
        PG8_STAGE(PG8_SB(0, 0), cB, voffB); PG8_STAGE(PG8_SA(0, 0), cA, voffA); PG8_STAGE(PG8_SB(0, 1), cB + hstep, voffB); PG8_STAGE(PG8_SA(0, 1), cA + hstep, voffA);
        if (wr == 1) PG8_BAR;
        PG8_WAIT_V(4); PG8_BAR;
        PG8_STAGE(PG8_SB(1, 0), cB + kstep, voffB); PG8_STAGE(PG8_SA(1, 0), cA + kstep, voffA); PG8_STAGE(PG8_SB(1, 1), cB + hstep + kstep, voffB);
        PG8_WAIT_V(6); PG8_BAR;
    }
    for (;;) {
        const bool has_next = S.next(ui + 1, nxt);
        const char* nA = has_next ? (const char*)g.A + (size_t)nxt.pm * tstep : cA; const char* nB = has_next ? (const char*)g.Bt + (size_t)nxt.pn * tstep : cB;
        for (int t = 0; t < nt; t += 2) {
            const bool last = (t == nt - 2);
            const char* a1 = cA + (size_t)(t + 1) * kstep;
            const char* a2 = last ? nA : cA + (size_t)(t + 2) * kstep; const char* b2 = last ? nB : cB + (size_t)(t + 2) * kstep;
            const char* a3 = a2 + kstep; const char* b3 = b2 + kstep;
            if (last && has_next) S.a_ready(nxt);
            if constexpr (SP2) {
            PG8_LDB(B0, 0, 0); PG8_LDB(B1, 0, 1); PG8_SCHED; PG8_LDA(At, 0, 0); PG8_STAGE(PG8_SA(1, 1), a1 + hstep, voffA);
            PG8_WAIT_V(8); PG8_WAIT_L(0); PG8_BAR; PG8_MMA(0, 0, At, B0); PG8_MMA(0, 1, At, B1); PG8_BAR; PG8_SCHED;
            PG8_LDA(At, 0, 1); PG8_STAGE(PG8_SB(0, 0), b2, voffB); PG8_STAGE(PG8_SB(0, 1), b2 + hstep, voffB); PG8_STAGE(PG8_SA(0, 0), a2, voffA);
            PG8_WAIT_V(8); PG8_WAIT_L(0); PG8_BAR; PG8_MMA(1, 0, At, B0); PG8_MMA(1, 1, At, B1); PG8_BAR; PG8_SCHED;
            PG8_LDB(B0, 1, 0); PG8_LDB(B1, 1, 1); PG8_SCHED; PG8_LDA(At, 1, 0); PG8_STAGE(PG8_SA(0, 1), a2 + hstep, voffA);
            PG8_WAIT_V(8); PG8_WAIT_L(0); PG8_BAR; PG8_MMA(0, 0, At, B0); PG8_MMA(0, 1, At, B1); PG8_BAR; PG8_SCHED;
            PG8_LDA(At, 1, 1); PG8_STAGE(PG8_SB(1, 0), b3, voffB); PG8_STAGE(PG8_SB(1, 1), b3 + hstep, voffB); PG8_STAGE(PG8_SA(1, 0), a3, voffA);
            PG8_WAIT_V(8); PG8_WAIT_L(0); PG8_BAR; PG8_MMA(1, 0, At, B0); PG8_MMA(1, 1, At, B1); PG8_BAR; PG8_SCHED;
            } else {
            PG8_LDB(B0, 0, 0); PG8_SCHED; PG8_LDA(At, 0, 0); PG8_STAGE(PG8_SA(1, 1), a1 + hstep, voffA);
            PG8_WAIT_L(8); PG8_BAR; PG8_WAIT_L(0); PG8_MMA(0, 0, At, B0); PG8_BAR; PG8_SCHED;
            PG8_LDB(B1, 0, 1); PG8_STAGE(PG8_SB(0, 0), b2, voffB);
            PG8_BAR; PG8_WAIT_L(0); PG8_MMA(0, 1, At, B1); PG8_BAR;
            PG8_LDA(At, 0, 1); PG8_STAGE(PG8_SA(0, 0), a2, voffA);
            PG8_BAR; PG8_WAIT_L(0); PG8_MMA(1, 0, At, B0); PG8_BAR; PG8_SCHED;
            PG8_STAGE(PG8_SB(0, 1), b2 + hstep, voffB);
            PG8_WAIT_V(6); PG8_BAR; PG8_MMA(1, 1, At, B1); PG8_BAR;
            PG8_LDB(B0, 1, 0); PG8_SCHED; PG8_LDA(At, 1, 0); PG8_STAGE(PG8_SA(0, 1), a2 + hstep, voffA);
            PG8_WAIT_L(8); PG8_BAR; PG8_WAIT_L(0); PG8_MMA(0, 0, At, B0); PG8_BAR; PG8_SCHED;
            PG8_LDB(B1, 1, 1); PG8_STAGE(PG8_SB(1, 0), b3, voffB);
            PG8_BAR; PG8_WAIT_L(0); PG8_MMA(0, 1, At, B1); PG8_BAR;
            PG8_LDA(At, 1, 1); PG8_STAGE(PG8_SA(1, 0), a3, voffA);
            PG8_BAR; PG8_WAIT_L(0); PG8_MMA(1, 0, At, B0); PG8_BAR; PG8_SCHED;
            PG8_STAGE(PG8_SB(1, 1), b3 + hstep, voffB);
            PG8_WAIT_V(6); PG8_BAR; PG8_MMA(1, 1, At, B1); PG8_BAR;
            }
        }
        if constexpr (ALIGN_EPI) { if (wr == 0) PG8_BAR; }
        if constexpr (!Epi::AFTER_DRAIN) { E(acc, cur, wr, wc, fr, fq); S.done(cur); }
        if (!has_next) break;
#pragma unroll
        for (int a = 0; a < 2; ++a)
#pragma unroll
            for (int b = 0; b < 2; ++b)
#pragma unroll
                for (int m = 0; m < 4; ++m)
#pragma unroll
                    for (int n = 0; n < 2; ++n) acc[a][b][m][n] = (f32x4){0.f, 0.f, 0.f, 0.f};
        cur = nxt; cA = nA; cB = nB; ++ui;
        if constexpr (ALIGN_EPI) { if (wr == 1) PG8_BAR; }
    }
    PG8_WAIT_V(0);
    if constexpr (!ALIGN_EPI) { if (wr == 0) PG8_BAR; }
    PG8_BAR;
    if constexpr (Epi::AFTER_DRAIN) { E.fused(acc, cur, wr, wc, fr, fq, lds, wid, lane); S.done(cur); }
#undef PG8_SA
#undef PG8_SB
#undef PG8_STAGE
#undef PG8_LDA
#undef PG8_LDB
#undef PG8_MMA
#undef PG8_WAIT_V
#undef PG8_WAIT_L
#undef PG8_BAR
#undef PG8_SCHED
}
}
namespace attn64 {
using bf16=__hip_bfloat16;
using bf16x8=__attribute__((ext_vector_type(8)))short;
using s16x4=__attribute__((ext_vector_type(4)))short;
using f32x16=__attribute__((ext_vector_type(16)))float;
using u32x4=__attribute__((ext_vector_type(4)))unsigned;
constexpr int D=64,QP=1024,KP=128;
constexpr int NW=8,QBLK=32,QB=QBLK*NW,KVBLK=64;
__device__ __forceinline__ int crow(int r,int hi){return (r&3)+8*(r>>2)+4*hi;}
#define SBAR() __builtin_amdgcn_sched_barrier(0)
constexpr int NSLOT=3, SLOTB=8192;
constexpr int LDS_K=0, LDS_V=NSLOT*SLOTB, LDS_WS=2*NSLOT*SLOTB, LDS_OST=LDS_WS+NW*64*4, LDS_BYTES=LDS_OST+NW*4096;
constexpr float C2=0.125f*1.4426950408889634f;
__device__ __forceinline__ void glds16(const void*gsrc,unsigned lds_dst){unsigned keep;
  asm volatile("s_mov_b32 %0, m0\n\ts_mov_b32 m0, %2\n\ts_nop 0\n\tglobal_load_lds_dwordx4 %1, off\n\ts_mov_b32 m0, %0":"=&s"(keep):"v"(gsrc),"s"(lds_dst):"memory");}
__device__ __forceinline__ float max3f(float a,float b,float c){float r;asm("v_max3_f32 %0, %1, %2, %3":"=v"(r):"v"(a),"v"(b),"v"(c));return r;}
__device__ __forceinline__ float max2f(float a,float b){float r;asm("v_max_f32_e32 %0, %1, %2":"=v"(r):"v"(a),"v"(b));return r;}
__device__ __forceinline__ float fadd_s(float a,float b){float r;asm("v_add_f32_e32 %0, %1, %2":"=v"(r):"v"(a),"v"(b));return r;}
__device__ __forceinline__ float fsub_s(float a,float b){float r;asm("v_sub_f32_e32 %0, %1, %2":"=v"(r):"v"(a),"v"(b));return r;}
typedef float f32x2_t __attribute__((ext_vector_type(2))); typedef __bf16 bf16x2_t __attribute__((ext_vector_type(2)));
__device__ __forceinline__ unsigned cvtpk_s(float lo,float hi){f32x2_t v={lo,hi};bf16x2_t b=__builtin_convertvector(v,bf16x2_t);return __builtin_bit_cast(unsigned,b);}
#define WAIT_BAR(N) asm volatile("s_waitcnt vmcnt(" #N ") lgkmcnt(0)\n\ts_barrier":::"memory")

__device__ __forceinline__ void qkt(f32x16&p0,f32x16&p1,const char*Kslot,const bf16x8*qr,const f32x16&negm,int r32,int hi){
  const char*kb=Kslot+hi*1024+r32*16;
  #pragma unroll
  for(int d0=0;d0<4;++d0){
    const bf16x8 b0=*reinterpret_cast<const bf16x8*>(kb+d0*2048);
    const bf16x8 b1=*reinterpret_cast<const bf16x8*>(kb+d0*2048+512);
    if(d0==0){p0=__builtin_amdgcn_mfma_f32_32x32x16_bf16(b0,qr[0],negm,0,0,0);p1=__builtin_amdgcn_mfma_f32_32x32x16_bf16(b1,qr[0],negm,0,0,0);}
    else{p0=__builtin_amdgcn_mfma_f32_32x32x16_bf16(b0,qr[d0],p0,0,0,0);p1=__builtin_amdgcn_mfma_f32_32x32x16_bf16(b1,qr[d0],p1,0,0,0);}}
}
typedef __attribute__((address_space(3))) const char* lds_cptr;
typedef short v4i16_t __attribute__((ext_vector_type(4)));
__device__ __forceinline__ void kload8(bf16x8*kf,lds_cptr kp){
  kf[0]=*(const __attribute__((address_space(3))) bf16x8*)(kp);      kf[1]=*(const __attribute__((address_space(3))) bf16x8*)(kp+512);
  kf[2]=*(const __attribute__((address_space(3))) bf16x8*)(kp+2048); kf[3]=*(const __attribute__((address_space(3))) bf16x8*)(kp+2560);
  kf[4]=*(const __attribute__((address_space(3))) bf16x8*)(kp+4096); kf[5]=*(const __attribute__((address_space(3))) bf16x8*)(kp+4608);
  kf[6]=*(const __attribute__((address_space(3))) bf16x8*)(kp+6144); kf[7]=*(const __attribute__((address_space(3))) bf16x8*)(kp+6656);
}
__device__ __forceinline__ void kload2(bf16x8*kf,lds_cptr kp,int j){ kf[2*j]=*(const __attribute__((address_space(3))) bf16x8*)(kp+j*2048); kf[2*j+1]=*(const __attribute__((address_space(3))) bf16x8*)(kp+j*2048+512); }
__device__ __forceinline__ s16x4 vtr(lds_cptr p){ return __builtin_bit_cast(s16x4,__builtin_amdgcn_ds_read_tr16_b64_v4i16((__attribute__((address_space(3))) v4i16_t*)p)); }
__device__ __forceinline__ float rowmax(const f32x16&p0,const f32x16&p1){
  float a=max3f(p0[0],p0[1],p1[0]),b=max3f(p0[2],p0[3],p1[1]);a=max3f(a,p1[2],p1[3]);
  #pragma unroll
  for(int r=4;r<16;r+=4){a=max3f(a,p0[r],p0[r+1]);b=max3f(b,p0[r+2],p0[r+3]);a=max3f(a,p1[r],p1[r+1]);b=max3f(b,p1[r+2],p1[r+3]);}
  const float m=max2f(a,b);
  auto rr=__builtin_amdgcn_permlane32_swap(__float_as_uint(m),__float_as_uint(m),false,false);
  return max2f(__uint_as_float(rr[0]),__uint_as_float(rr[1]));
}
__device__ __forceinline__ void pv(f32x16*o,int vb,bf16x8 pa0,bf16x8 pa1,bf16x8 pa2,bf16x8 pa3){
  #pragma unroll
  for(int d0=0;d0<2;++d0){s16x4 lo[4],hi[4];
    #pragma unroll
    for(int ks=0;ks<4;++ks){
      asm volatile("ds_read_b64_tr_b16 %0,%1 offset:%c2":"=&v"(lo[ks]):"v"(vb),"i"(d0*4096+ks*1024):"memory");
      asm volatile("ds_read_b64_tr_b16 %0,%1 offset:%c2":"=&v"(hi[ks]):"v"(vb),"i"(d0*4096+ks*1024+512):"memory");}
    asm volatile("s_waitcnt lgkmcnt(0)":::"memory");SBAR();
    #define PK(k) (bf16x8){lo[k][0],lo[k][1],lo[k][2],lo[k][3],hi[k][0],hi[k][1],hi[k][2],hi[k][3]}
    o[d0]=__builtin_amdgcn_mfma_f32_32x32x16_bf16(pa0,PK(0),o[d0],0,0,0);
    o[d0]=__builtin_amdgcn_mfma_f32_32x32x16_bf16(pa1,PK(1),o[d0],0,0,0);
    o[d0]=__builtin_amdgcn_mfma_f32_32x32x16_bf16(pa2,PK(2),o[d0],0,0,0);
    o[d0]=__builtin_amdgcn_mfma_f32_32x32x16_bf16(pa3,PK(3),o[d0],0,0,0);
    #undef PK
  }
}

#ifndef ATTN_STORE16
#define ATTN_STORE16(p,v) (*(u32x4*)(p)=(v))
#endif
template<int THRL> __device__ __forceinline__ void attn_unit(const bf16*Q0,bf16*O0,const bf16*__restrict__ Kh,const bf16*__restrict__ Vh,const int NT,char*shm,const float mref){
  int tid_=threadIdx.x; asm volatile("":"+v"(tid_)); const int tid=tid_,lane=tid&63,r32=lane&31,hi=lane>>5; const int wid=__builtin_amdgcn_readfirstlane(tid>>6);
  const bf16*Qw=Q0+(long)(wid*QBLK)*QP;
  const unsigned lds0=(unsigned)(uintptr_t)shm;
  float*wsf=(float*)(shm+LDS_WS)+wid*64;
  const bf16*ksrc=Kh+(long)lane*KP+wid*8;
  const bf16*vsrc=Vh+(long)(16*(wid&3)+(lane>>2))*KP+(wid>>2)*32+(lane&3)*8;
  const unsigned kdst=lds0+LDS_K+wid*1024, vdst=lds0+LDS_V+wid*1024;
  #define DMA_K(t,slot) glds16(ksrc+(long)(t)*KVBLK*KP,(unsigned)__builtin_amdgcn_readfirstlane(kdst+(slot)))
  #define DMA_V(t,slot) glds16(vsrc+(long)(t)*KVBLK*KP,(unsigned)__builtin_amdgcn_readfirstlane(vdst+(slot)))
  const int vb0=(int)(lds0+LDS_V)+((lane>>4)&1)*32+(lane&3)*8+(4*hi+((lane&15)>>2))*64;
  const char*Kbase=shm+LDS_K; bf16x8 kf[8];
  const lds_cptr shm3=(lds_cptr)shm; const lds_cptr kp0=shm3+LDS_K+hi*1024+r32*16; const lds_cptr vp0=shm3+LDS_V+((lane>>4)&1)*32+(lane&3)*8+(4*hi+((lane&15)>>2))*64;
  DMA_K(0,0);DMA_V(0,0);DMA_K(1,SLOTB);
  bf16x8 qr[4];
  #pragma unroll
  for(int d0=0;d0<4;++d0)qr[d0]=*reinterpret_cast<const bf16x8*>(&Qw[(long)r32*QP+d0*16+hi*8]);
  float l_reg=0.f;f32x16 o[2];o[0]=f32x16{};o[1]=f32x16{};f32x16 negm;
  _Pragma("unroll") for(int r=0;r<16;++r)negm[r]=-mref;
  asm volatile("":"+v"(negm));
  #define CMASK(P0,P1,t) do{}while(0)
  #define START(P0,P1) do{ _Pragma("unroll") for(int r=0;r<16;++r)P0[r]=__builtin_amdgcn_exp2f(P0[r]); }while(0)
  #define RESC() do{}while(0)
  f32x16 pA0,pA1,pB0,pB1;
  int sl_prev=0,sl_cur=0,sl_next=SLOTB;
  #define ROT() do{sl_prev=sl_cur;sl_cur=sl_next;sl_next=(sl_next==(NSLOT-1)*SLOTB)?0:sl_next+SLOTB;}while(0)
  DMA_K(2,2*SLOTB);
  WAIT_BAR(3);
  qkt(pA0,pA1,Kbase,qr,negm,r32,hi);asm volatile("s_nop 15\n\ts_nop 7":"+v"(pA0),"+v"(pA1));CMASK(pA0,pA1,0);
  START(pA0,pA1);
  _Pragma("unroll") for(int r=0;r<16;++r)pA1[r]=__builtin_amdgcn_exp2f(pA1[r]);
  WAIT_BAR(0);
  DMA_K(3,0);DMA_V(1,SLOTB);
  ROT();
  kload8(kf,kp0+sl_cur);
  WAIT_BAR(2);
  s16x4 vlo[8],vhi[8]; u32x4 pw0,pw1,pw2,pw3;
  #define PKW(P,B) cvtpk_s(P[B],P[B+1])
  #define PAF(k) __builtin_bit_cast(bf16x8,pw##k)
  #define VFR(i) (bf16x8){vlo[i][0],vlo[i][1],vlo[i][2],vlo[i][3],vhi[i][0],vhi[i][1],vhi[i][2],vhi[i][3]}
  #define PIN(x) asm volatile("":"+v"(x))
  #define MX3(a,b,c) __builtin_fmaxf(__builtin_fmaxf((a),(b)),(c))
  #define GAPA(MF,A0,A1,A2,A3,W0,W1,PW) do{ MF; sacc+=A0; sacc+=A1; sacc+=A2; sacc+=A3; PIN(sacc); W0; W1; PIN(PW); SBAR(); }while(0)
  #define EX(v) __builtin_amdgcn_exp2f(v)
  #define GAPB(MF,X,B) do{ MF; X[B]=EX(X[B]); X[B+1]=EX(X[B+1]); X[B+2]=EX(X[B+2]); X[B+3]=EX(X[B+3]); PIN(X); SBAR(); }while(0)
  #define VRD(i) do{ vlo[i]=vtr(vp_+(((i)>>2)*4096+((i)&3)*1024)); vhi[i]=vtr(vp_+(((i)>>2)*4096+((i)&3)*1024+512)); }while(0)
  #define KRD(G,j) do{ if(G){ kload2(kf,kp0+sl_next,j); SBAR(); } }while(0)
  #define STEP(C0,C1,P0,P1,t,GK,GV,GL) do{ SBAR(); \
    const lds_cptr vp_=vp0+sl_prev; \
    VRD(0); SBAR(); float sacc=(P0[0]+P0[1]); \
    GAPA(C0=__builtin_amdgcn_mfma_f32_32x32x16_bf16(kf[0],qr[0],negm,0,0,0), P0[2],P0[3],P0[4],P0[5],     pw0[0]=PKW(P0,0), pw0[1]=PKW(P0,2), pw0); \
    VRD(4); SBAR(); GAPA(C1=__builtin_amdgcn_mfma_f32_32x32x16_bf16(kf[1],qr[0],negm,0,0,0), P0[6],P0[7],P0[8],P0[9],     pw0[2]=PKW(P0,4), pw0[3]=PKW(P0,6), pw0); \
    VRD(1); SBAR(); GAPA(C0=__builtin_amdgcn_mfma_f32_32x32x16_bf16(kf[2],qr[1],C0,0,0,0),   P0[10],P0[11],P0[12],P0[13], pw1[0]=PKW(P0,8), pw1[1]=PKW(P0,10), pw1); \
    VRD(5); SBAR(); GAPA(C1=__builtin_amdgcn_mfma_f32_32x32x16_bf16(kf[3],qr[1],C1,0,0,0),   P0[14],P0[15],P1[0],P1[1],   pw1[2]=PKW(P0,12),pw1[3]=PKW(P0,14), pw1); \
    VRD(2); SBAR(); GAPA(C0=__builtin_amdgcn_mfma_f32_32x32x16_bf16(kf[4],qr[2],C0,0,0,0),   P1[2],P1[3],P1[4],P1[5],     pw2[0]=PKW(P1,0), pw2[1]=PKW(P1,2), pw2); \
    VRD(6); SBAR(); GAPA(C1=__builtin_amdgcn_mfma_f32_32x32x16_bf16(kf[5],qr[2],C1,0,0,0),   P1[6],P1[7],P1[8],P1[9],     pw2[2]=PKW(P1,4), pw2[3]=PKW(P1,6), pw2); \
    VRD(3); SBAR(); GAPA(C0=__builtin_amdgcn_mfma_f32_32x32x16_bf16(kf[6],qr[3],C0,0,0,0),   P1[10],P1[11],P1[12],P1[13], pw3[0]=PKW(P1,8), pw3[1]=PKW(P1,10), pw3); \
    VRD(7); SBAR(); GAPA(C1=__builtin_amdgcn_mfma_f32_32x32x16_bf16(kf[7],qr[3],C1,0,0,0),   P1[14],P1[15],0.f,0.f,       pw3[2]=PKW(P1,12),pw3[3]=PKW(P1,14), pw3); \
    l_reg+=sacc; \
    if(GK){DMA_K((t)+3,sl_cur);} if(GV){DMA_V((t)+1,sl_next);} \
    CMASK(C0,C1,t); \
    SBAR(); \
    GAPB(o[0]=__builtin_amdgcn_mfma_f32_32x32x16_bf16(PAF(0),VFR(0),o[0],0,0,0), C0,0); \
    GAPB(o[1]=__builtin_amdgcn_mfma_f32_32x32x16_bf16(PAF(0),VFR(4),o[1],0,0,0), C0,4); \
    KRD(GL,0); GAPB(o[0]=__builtin_amdgcn_mfma_f32_32x32x16_bf16(PAF(1),VFR(1),o[0],0,0,0), C0,8); \
    KRD(GL,1); GAPB(o[1]=__builtin_amdgcn_mfma_f32_32x32x16_bf16(PAF(1),VFR(5),o[1],0,0,0), C0,12); \
    KRD(GL,2); GAPB(o[0]=__builtin_amdgcn_mfma_f32_32x32x16_bf16(PAF(2),VFR(2),o[0],0,0,0), C1,0); \
    KRD(GL,3); GAPB(o[1]=__builtin_amdgcn_mfma_f32_32x32x16_bf16(PAF(2),VFR(6),o[1],0,0,0), C1,4); \
    GAPB(o[0]=__builtin_amdgcn_mfma_f32_32x32x16_bf16(PAF(3),VFR(3),o[0],0,0,0), C1,8); \
    GAPB(o[1]=__builtin_amdgcn_mfma_f32_32x32x16_bf16(PAF(3),VFR(7),o[1],0,0,0), C1,12); \
    }while(0)
  int t=1;
  for(;t+5<NT;t+=2){
    STEP(pB0,pB1,pA0,pA1,t,true,true,true);     WAIT_BAR(2); RESC(); ROT();
    STEP(pA0,pA1,pB0,pB1,t+1,true,true,true);   WAIT_BAR(2); RESC(); ROT();
  }
  #define ENDW(tt) do{ if((tt)+3<NT){WAIT_BAR(2);} else if((tt)+2<NT){WAIT_BAR(1);} else {WAIT_BAR(0);} }while(0)
  for(;t+1<NT;t+=2){
    STEP(pB0,pB1,pA0,pA1,t,(t+3<NT),(t+1<NT),(t+1<NT));       ENDW(t);   RESC(); ROT();
    STEP(pA0,pA1,pB0,pB1,t+1,(t+4<NT),(t+2<NT),(t+2<NT));     ENDW(t+1); RESC(); ROT();
  }
  STEP(pB0,pB1,pA0,pA1,NT-1,false,false,false); RESC();
  { float sacc=pB0[0]+pB0[1]; _Pragma("unroll") for(int r=2;r<16;++r)sacc+=pB0[r]; _Pragma("unroll") for(int r=0;r<16;++r)sacc+=pB1[r]; l_reg+=sacc;
    pw0=(u32x4){PKW(pB0,0),PKW(pB0,2),PKW(pB0,4),PKW(pB0,6)};pw1=(u32x4){PKW(pB0,8),PKW(pB0,10),PKW(pB0,12),PKW(pB0,14)};pw2=(u32x4){PKW(pB1,0),PKW(pB1,2),PKW(pB1,4),PKW(pB1,6)};pw3=(u32x4){PKW(pB1,8),PKW(pB1,10),PKW(pB1,12),PKW(pB1,14)};
    SBAR(); pv(o,vb0+sl_cur,PAF(0),PAF(1),PAF(2),PAF(3)); }
  #undef PKW
  #undef PAF
  #undef VFR
  #undef PIN
  #undef MX3
  #undef GAPA
  #undef GAPB
  #undef EX
  #undef VRD
  #undef KRD
  #undef STEP
  #undef ENDW
  {auto rr=__builtin_amdgcn_permlane32_swap(__float_as_uint(l_reg),__float_as_uint(l_reg),false,false);l_reg=__uint_as_float(rr[0])+__uint_as_float(rr[1]);}
  if(hi==0)wsf[32+r32]=l_reg;asm volatile("s_waitcnt lgkmcnt(0)":::"memory");
  float rli[16];
  #pragma unroll
  for(int r=0;r<16;++r)rli[r]=__builtin_amdgcn_rcpf(wsf[32+crow(r,hi)]);
  bf16*Ow=O0+(long)(wid*QBLK)*QP;
  { bf16*stg=(bf16*)(shm+LDS_OST)+wid*2048;
    #pragma unroll
    for(int r=0;r<16;++r){const int orow=crow(r,hi);
      #pragma unroll
      for(int d0=0;d0<2;++d0)stg[orow*64+d0*32+r32]=__float2bfloat16(o[d0][r]*rli[r]);}
    asm volatile("s_waitcnt lgkmcnt(0)":::"memory");
    #pragma unroll
    for(int i=0;i<4;++i){const int row=i*8+(lane>>3),ch=lane&7; const u32x4 v=*(const u32x4*)(stg+row*64+ch*8); ATTN_STORE16(Ow+(long)row*QP+ch*8,v);} }
  asm volatile("s_waitcnt lgkmcnt(0)\n\ts_barrier":::"memory");
  #undef DMA_K
  #undef DMA_V
  #undef CMASK
  #undef START
  #undef RESC
  #undef ROT
}

typedef int i32x8 __attribute__((ext_vector_type(8)));
__device__ __forceinline__ void attn_unit8(const unsigned char*Q8,bf16*O0,const unsigned char*K8,const unsigned char*V8,const int NT,char*shm,const float mref){
  int tid_=threadIdx.x; asm volatile("":"+v"(tid_)); const int tid=tid_,lane=tid&63,r32=lane&31,hi=lane>>5; const int wid=__builtin_amdgcn_readfirstlane(tid>>6);
  const unsigned lds0=(unsigned)(uintptr_t)shm; const lds_cptr shm3=(lds_cptr)shm;
  constexpr int SL=8192, OST=32768, LWS=65536;
  const unsigned char*dsrc=(wid<4)?(K8+(long)lane*128+wid*16):(V8+(long)lane*64+(wid-4)*16); const long dstep=(wid<4)?(long)64*128:(long)4096;
  const unsigned ddst=lds0+((wid<4)?wid*1024:4096+(wid-4)*1024);
  #define DMA8(t) glds16(dsrc+(long)(t)*dstep,(unsigned)__builtin_amdgcn_readfirstlane(ddst+((t)&3)*SL))
  DMA8(0); if(1<NT)DMA8(1); if(2<NT)DMA8(2);
  const unsigned char*qp=Q8+(long)(wid*32+r32)*512+32*hi; const u32x4 q0=*(const u32x4*)qp,q1=*(const u32x4*)(qp+16);
  const i32x8 qf={(int)q0[0],(int)q0[1],(int)q0[2],(int)q0[3],(int)q1[0],(int)q1[1],(int)q1[2],(int)q1[3]};
  f32x16 o0=f32x16{},o1=f32x16{},ol=f32x16{},zero16;
  i32x8 ones; _Pragma("unroll") for(int j=0;j<8;++j)ones[j]=0x38383838;
  asm volatile("":"+v"(ones));
  _Pragma("unroll") for(int r=0;r<16;++r)zero16[r]=15.0f-mref;
  asm volatile("":"+v"(zero16));
  typedef __attribute__((address_space(3))) const u32x4* l4p;
  #define KFR(t,K0,K1) do{ const lds_cptr ks_=shm3+((t)&3)*SL+(2*hi)*1024+r32*16; const u32x4 ka=*(l4p)(ks_),kb=*(l4p)(ks_+1024),kc=*(l4p)(ks_+512),kd=*(l4p)(ks_+1024+512); \
      K0=(i32x8){(int)ka[0],(int)ka[1],(int)ka[2],(int)ka[3],(int)kb[0],(int)kb[1],(int)kb[2],(int)kb[3]}; K1=(i32x8){(int)kc[0],(int)kc[1],(int)kc[2],(int)kc[3],(int)kd[0],(int)kd[1],(int)kd[2],(int)kd[3]}; }while(0)
  asm volatile("s_waitcnt vmcnt(0)":::"memory");
  asm volatile("s_barrier":::"memory");
  f32x16 pa0,pa1,pb0,pb1;
  { i32x8 kf0,kf1; KFR(0,kf0,kf1);
    pa0=__builtin_amdgcn_mfma_scale_f32_32x32x64_f8f6f4(kf0,qf,zero16,0,0,0,0,0,0); pa1=__builtin_amdgcn_mfma_scale_f32_32x32x64_f8f6f4(kf1,qf,zero16,0,0,0,0,0,0); }
  #define FENCE() __builtin_amdgcn_sched_barrier(0)
  #define VFR8(t,V0,V1) do{ const lds_cptr vs_=shm3+((t)&3)*SL+4096+(2*hi)*1024+r32*16; const u32x4 va_=*(l4p)(vs_),vb_=*(l4p)(vs_+1024),vc_=*(l4p)(vs_+512),vd_=*(l4p)(vs_+1024+512); \
      V0=(i32x8){(int)va_[0],(int)va_[1],(int)va_[2],(int)va_[3],(int)vb_[0],(int)vb_[1],(int)vb_[2],(int)vb_[3]}; V1=(i32x8){(int)vc_[0],(int)vc_[1],(int)vc_[2],(int)vc_[3],(int)vd_[0],(int)vd_[1],(int)vd_[2],(int)vd_[3]}; }while(0)
  #define TOP8(t,FULL) do{ if((FULL)||(t)+2<NT)asm volatile("s_waitcnt vmcnt(1) lgkmcnt(0)\n\ts_barrier":::"memory"); else asm volatile("s_waitcnt vmcnt(0) lgkmcnt(0)\n\ts_barrier":::"memory"); if((FULL)||(t)+3<NT)DMA8((t)+3); }while(0)
  #define EXPR(C,LO,HI) do{ _Pragma("unroll") for(int r=LO;r<HI;++r)C[r]=__builtin_amdgcn_exp2f(C[r]); }while(0)
  #define CVT4(PW,J,C,B) do{ int w_=0; w_=__builtin_amdgcn_cvt_pk_bf8_f32(C[B],C[B+1],w_,false); w_=__builtin_amdgcn_cvt_pk_bf8_f32(C[B+2],C[B+3],w_,true); PW[J]=w_; }while(0)
  #define MF8(A,B,C,CB) __builtin_amdgcn_mfma_scale_f32_32x32x64_f8f6f4(A,B,C,CB,0,0,0,0,0)
  #define STEPC(C0,C1,N0,N1,PS,V0S,V1S,PN,V0N,V1N,t,FULL) do{ TOP8(t,FULL); \
    i32x8 kf0_,kf1_; const bool nx_=(FULL)||(t)+1<NT; \
    o0=MF8(PS,V0S,o0,1); if(nx_){ KFR((t)+1,kf0_,kf1_); } EXPR(C0,0,7); FENCE(); \
    o1=MF8(PS,V1S,o1,1); EXPR(C0,7,14); FENCE(); \
    ol=MF8(PS,ones,ol,1); EXPR(C0,14,16); EXPR(C1,0,5); FENCE(); \
    if(nx_){ N0=MF8(kf0_,qf,zero16,0); } EXPR(C1,5,12); CVT4(PN,0,C0,0); CVT4(PN,1,C0,4); FENCE(); \
    if(nx_){ N1=MF8(kf1_,qf,zero16,0); } EXPR(C1,12,16); CVT4(PN,2,C0,8); CVT4(PN,3,C0,12); VFR8(t,V0N,V1N); CVT4(PN,4,C1,0); CVT4(PN,5,C1,4); CVT4(PN,6,C1,8); CVT4(PN,7,C1,12); FENCE(); }while(0)
  i32x8 pwA,pwB,vA0,vA1,vB0,vB1; _Pragma("unroll") for(int j=0;j<8;++j){pwA[j]=0;vA0[j]=0;vA1[j]=0;}
  int t=0;
  for(;t+4<NT;t+=2){ STEPC(pa0,pa1,pb0,pb1,pwA,vA0,vA1,pwB,vB0,vB1,t,true); STEPC(pb0,pb1,pa0,pa1,pwB,vB0,vB1,pwA,vA0,vA1,t+1,true); }
  for(;t<NT;t+=2){ STEPC(pa0,pa1,pb0,pb1,pwA,vA0,vA1,pwB,vB0,vB1,t,false); STEPC(pb0,pb1,pa0,pa1,pwB,vB0,vB1,pwA,vA0,vA1,t+1,false); }
  o0=MF8(pwA,vA0,o0,1); o1=MF8(pwA,vA1,o1,1); ol=MF8(pwA,ones,ol,1);
  { bf16*Ow=O0+(long)(wid*32)*QP; bf16*stg=(bf16*)(shm+OST)+wid*2048;
    _Pragma("unroll") for(int r=0;r<16;++r){const int orow=crow(r,hi); const float rl=__builtin_amdgcn_rcpf(ol[r]); stg[orow*64+r32]=__float2bfloat16(o0[r]*rl); stg[orow*64+32+r32]=__float2bfloat16(o1[r]*rl);}
    asm volatile("s_waitcnt lgkmcnt(0)":::"memory");
    _Pragma("unroll") for(int i=0;i<4;++i){const int row=i*8+(lane>>3),ch=lane&7; const u32x4 v=*(const u32x4*)(stg+row*64+ch*8); *(u32x4*)(Ow+(long)row*QP+ch*8)=v;} }
  #undef STEPC
  #undef MF8
  #undef CVT4
  #undef EXPR
  #undef TOP8
  #undef VFR8
  #undef FENCE
  #undef KFR
  #undef DMA8
  asm volatile("s_waitcnt lgkmcnt(0)\n\ts_barrier":::"memory");
}
constexpr int ATTN_LDS_BYTES=LDS_BYTES;
#undef SBAR
#undef WAIT_BAR
}
#define GAS __attribute__((address_space(1)))
#define LAS __attribute__((address_space(3)))
typedef unsigned short bf16;
typedef unsigned v4u __attribute__((ext_vector_type(4)));
typedef float f32x4 __attribute__((ext_vector_type(4)));
typedef short bf16x8 __attribute__((ext_vector_type(8)));
typedef GAS unsigned gu32;
typedef GAS unsigned long long gu64;
#define RLX_AGENT __ATOMIC_RELAXED, __HIP_MEMORY_SCOPE_AGENT
#define LDS_WAIT() asm volatile("s_waitcnt lgkmcnt(0)" ::: "memory")
#define VM_WAIT() asm volatile("s_waitcnt vmcnt(0)" ::: "memory")
__device__ __forceinline__ unsigned long long rt() { return __builtin_amdgcn_s_memrealtime(); }
__device__ __forceinline__ unsigned f2bf(float f) { unsigned u = __builtin_bit_cast(unsigned, f); return (u + 0x7fffu + ((u >> 16) & 1u)) >> 16; }
typedef float pk_f32x2_t __attribute__((ext_vector_type(2))); typedef __bf16 pk_bf16x2_t __attribute__((ext_vector_type(2)));
__device__ __forceinline__ unsigned pk2(float lo, float hi) { pk_f32x2_t v = {lo, hi}; pk_bf16x2_t b = __builtin_convertvector(v, pk_bf16x2_t); return __builtin_bit_cast(unsigned, b); }
#define XB_TMO      128
#define XB_XCNT(j)  (256  + 64 * (j))
#define XB_XSUB(j)  (1280 + 64 * (j))
#define XB_XGEN(j)  (2304 + 64 * (j))
#define XB_TOP      3328
#define XB_TOPGEN   3392
#define XCD_BAR_WORDS 3456
#define XB_SPIN_CAP (1u << 18)

__device__ __forceinline__ unsigned xb_ld(unsigned* p)              { return __hip_atomic_load(p, __ATOMIC_RELAXED, __HIP_MEMORY_SCOPE_AGENT); }
__device__ __forceinline__ unsigned xb_add(unsigned* p, unsigned v) { return __hip_atomic_fetch_add(p, v, __ATOMIC_RELAXED, __HIP_MEMORY_SCOPE_AGENT); }
__device__ __forceinline__ unsigned xb_xcc_id() { return (unsigned)__builtin_amdgcn_s_getreg((3 << 11) | 20) & 0xFu; }
#define XB_SPIN(cond, bar) do { unsigned _sp = 0; while (cond) { __builtin_amdgcn_s_sleep(1); \
    if ((++_sp & 255u) == 0u) { if (xb_ld(&(bar)[XB_TMO])) break; if (_sp > XB_SPIN_CAP) { atomicAdd(&(bar)[XB_TMO], 1u); break; } } } } while (0)

struct XcdBarrier {
    unsigned* bar; unsigned x;
    volatile LAS unsigned* st;
};

__device__ __forceinline__ XcdBarrier xcd_barrier_post(unsigned* bar, volatile LAS unsigned* st) {
    XcdBarrier b; b.bar = bar; b.x = xb_xcc_id(); b.st = st;
    if (threadIdx.x == 0) (void)xb_add(&bar[XB_XCNT(b.x)], 1u);
    return b;
}
__device__ __forceinline__ void xcd_barrier_complete(unsigned* bar, unsigned x, unsigned& nloc, unsigned& nx) {
    const unsigned G = gridDim.x * gridDim.y * gridDim.z;
    unsigned sum, cnt, mine, sp = 0u;
    for (;;) {
        sum = 0u; cnt = 0u; mine = 0u;
#pragma unroll
        for (unsigned j = 0; j < 16; ++j) { const unsigned c = xb_ld(&bar[XB_XCNT(j)]); sum += c; cnt += (c > 0u) ? 1u : 0u; mine = (j == x) ? c : mine; }
        if (sum == G) break;
        __builtin_amdgcn_s_sleep(1);
        if ((++sp & 255u) == 0u) { if (xb_ld(&bar[XB_TMO])) break; if (sp > XB_SPIN_CAP) { atomicAdd(&bar[XB_TMO], 1u); break; } }
    }
    nloc = mine > 0u ? mine : 1u; nx = cnt > 0u ? cnt : 1u;
}

__device__ __forceinline__ void xcd_barrier(const XcdBarrier& b) {
    asm volatile("s_waitcnt vmcnt(0)" ::: "memory");
    __syncthreads();
    if (threadIdx.x == 0) {
        unsigned* bar = b.bar;
        __builtin_amdgcn_s_waitcnt(0);
        unsigned nloc = b.st[0], nx = b.st[1];
        if (nloc == 0u) { xcd_barrier_complete(bar, b.x, nloc, nx); b.st[0] = nloc; b.st[1] = nx; }
        const unsigned old = xb_add(&bar[XB_XSUB(b.x)], 1u);
        const unsigned gen = old / nloc;
        if (old + 1u == (gen + 1u) * nloc) {
            __builtin_amdgcn_fence(__ATOMIC_RELEASE, "agent");
            asm volatile("s_waitcnt vmcnt(0)" ::: "memory");
            const unsigned og = xb_add(&bar[XB_TOP], 1u);
            const unsigned tg = og / nx;
            if (og + 1u == (tg + 1u) * nx) xb_add(&bar[XB_TOPGEN], 1u);
            else XB_SPIN(xb_ld(&bar[XB_TOPGEN]) == tg, bar);
            __builtin_amdgcn_fence(__ATOMIC_ACQUIRE, "agent");
            xb_add(&bar[XB_XGEN(b.x)], 1u);
            asm volatile("s_waitcnt vmcnt(0)" ::: "memory");
        } else {
            XB_SPIN(xb_ld(&bar[XB_XGEN(b.x)]) == gen, bar);
            __builtin_amdgcn_fence(__ATOMIC_ACQUIRE, "agent");
            asm volatile("s_waitcnt vmcnt(0)" ::: "memory");
        }
    }
    __syncthreads();
}
constexpr int NB = 4, T = 8192, LC = 256, D = 1024, NLAYER = 2;
constexpr int ML = NB * T, MC = NB * LC, MT = ML + MC;
constexpr int NIN = 2848, NINP = 3072;
constexpr int FF = 2816, EF = 3584, NE = 8;
constexpr int TK = T + LC;
constexpr int NCH = TK / 64;
constexpr float EPS = 1e-6f;
constexpr float QSCALE = 0.125f * 1.4426950408889634f;

constexpr int NWAVES = 8;
constexpr int LDS_BYTES = 147456;
constexpr int RING_BYTES = 131072, LDSCTL_OFF = RING_BYTES, MISC_OFF = LDSCTL_OFF + 320;

constexpr size_t MiB = 1u << 20;
constexpr size_t CTL_ZERO_BYTES = 1 * MiB;
constexpr int CW_BAR = 4096;
constexpr int CW_CNT = 16384;
constexpr int CW_Q = 17408;
constexpr size_t WS_MODS = 1 * MiB;
constexpr size_t WS_ROUTE = 1 * MiB + 512 * 1024;
constexpr size_t WS_RW = WS_ROUTE + (size_t)ML * 16;
constexpr size_t WS_POS = WS_RW + (size_t)ML * 8;
constexpr size_t WS_XC = 3 * MiB;
constexpr size_t WS_ROPE = 7 * MiB;
constexpr size_t WS_WIN = 9 * MiB;
constexpr size_t WS_WOUT = 21 * MiB;
constexpr size_t WS_WGU = 25 * MiB;
constexpr size_t WS_WD = 36 * MiB;
constexpr size_t WS_G = 42 * MiB;
constexpr size_t WS_BETA = WS_G + (size_t)2 * MT * 8 * 4;
constexpr size_t WS_AB = 47 * MiB;
constexpr size_t WS_KALL = 52 * MiB;
constexpr size_t WS_VALL = 61 * MiB;
constexpr size_t WS_DYN = 70 * MiB;
constexpr size_t WS_XN = WS_DYN;
constexpr size_t WS_OF = WS_XN, WS_OB = WS_XN + 33 * MiB;
constexpr size_t WS_DNRAW = WS_XN + 66 * MiB;
constexpr size_t WS_QRAW = WS_DNRAW + 99 * MiB;
constexpr size_t WS_KVRAW = WS_QRAW + 33 * MiB;
constexpr size_t WS_U = WS_DNRAW, WS_W = WS_DNRAW + 66 * MiB;
constexpr size_t WS_ZB = WS_KVRAW + 17 * MiB;
constexpr size_t WS_QDN = WS_ZB + 33 * MiB;
constexpr size_t WS_KDN = WS_QDN + 33 * MiB;
constexpr size_t WS_KT = WS_KDN + 33 * MiB;
constexpr size_t WS_VT = WS_KT + 33 * MiB;
constexpr size_t WS_MIX = WS_VT + 33 * MiB;
constexpr size_t WS_MIX_END = WS_MIX + 66 * MiB;
constexpr size_t WS_GCB = WS_MIX_END + 1 * MiB;
constexpr size_t WS_H = WS_DNRAW;
constexpr size_t WS_XB2 = WS_DYN;
constexpr size_t WS_MGU = WS_DYN + 64 * MiB;
constexpr size_t WS_MD = WS_MGU + 112 * MiB;
constexpr size_t WS_XS = WS_MD + 56 * MiB;
constexpr int SS_PANELS = 64, NSS = 5;
constexpr size_t WS_HM = WS_XS + 132 * MiB;
constexpr size_t WS_END = WS_HM + 112 * MiB;
static_assert(WS_END <= 560 * MiB, "ws map (MoE)");
static_assert(WS_W + 66 * MiB <= WS_ZB && WS_H + (size_t)MT * FF * 2 <= WS_MIX && WS_MIX_END <= 560 * MiB && WS_POS + (size_t)ML * 8 <= WS_XC, "ws map");

typedef unsigned short bf16;
__device__ __forceinline__ float bf2f(unsigned short h) { return __uint_as_float(((unsigned)h) << 16); }
__device__ __forceinline__ float bflo(unsigned w) { return __uint_as_float(w << 16); }
__device__ __forceinline__ float bfhi(unsigned w) { return __uint_as_float(w & 0xffff0000u); }
__device__ __forceinline__ float wave_sum(float v) {
#pragma unroll
    for (int o = 1; o < 64; o <<= 1) v += __shfl_xor(v, o);
    return v;
}
__device__ __forceinline__ float silu_f(float x) { return x * __builtin_amdgcn_rcpf(1.0f + __expf(-x)); }
namespace pg8 {
struct EpiIn {
    static constexpr bool PERM = true, AFTER_DRAIN = false;
    bf16_t* dnraw; bf16_t* zb; bf16_t* qraw; bf16_t* kvraw; float* ab;
    __device__ __forceinline__ void operator()(const f32x4 (&acc)[2][2][4][2], const Unit& u, int wr, int wc, int fr, int fq) const {
        const int row0 = u.pm * BM + wr * 64 + fr; const int pn = u.pn;
        if (pn < 11) {
            bf16_t* base; int ldc, coff;
            if (pn < 6) { base = dnraw; ldc = 1536; coff = pn * 256; } else if (pn < 8) { base = zb; ldc = 512; coff = (pn - 6) * 256; }
            else if (pn < 10) { base = qraw; ldc = 512; coff = (pn - 8) * 256; } else { base = kvraw; ldc = 256; coff = 0; }
            const int col0 = coff + wc * 32 + 8 * fq;
#pragma unroll
            for (int ai = 0; ai < 2; ++ai)
#pragma unroll
                for (int m = 0; m < 4; ++m) { bf16_t* rowp = base + (size_t)(row0 + ai * HALF + m * 16) * ldc + col0;
#pragma unroll
                    for (int bj = 0; bj < 2; ++bj) { const f32x4 v0 = acc[ai][bj][m][0], v1 = acc[ai][bj][m][1];
                        u32x4 w; w.x = cvt_pk_bf16(v0[0], v0[1]); w.y = cvt_pk_bf16(v0[2], v0[3]); w.z = cvt_pk_bf16(v1[0], v1[1]); w.w = cvt_pk_bf16(v1[2], v1[3]);
                        *(u32x4*)(rowp + bj * HALF) = w; } }
        } else if (wc == 0) {
#pragma unroll
            for (int ai = 0; ai < 2; ++ai)
#pragma unroll
                for (int m = 0; m < 4; ++m) { float* rowp = ab + (size_t)(row0 + ai * HALF + m * 16) * 32 + 8 * fq;
                    *(f32x4*)(rowp) = acc[ai][0][m][0]; *(f32x4*)(rowp + 4) = acc[ai][0][m][1]; }
        }
    }
};
template <bool XF32> struct EpiRes {
    static constexpr bool PERM = true, AFTER_DRAIN = false;
    const void* xin_l; bf16_t* out_l; const void* xin_c; bf16_t* out_c; const float* gate; int gstride;
    __device__ __forceinline__ void operator()(const f32x4 (&acc)[2][2][4][2], const Unit& u, int wr, int wc, int fr, int fq) const {
        const int pm = u.pm; const bool isc = pm >= 128; const int bidx = isc ? 4 : (pm >> 5);
        const void* xin = isc ? xin_c : xin_l; bf16_t* out = isc ? out_c : out_l; const int prow = isc ? pm - 128 : pm;
        const int row0 = prow * BM + wr * 64 + fr; const int col0 = u.pn * BM + wc * 32 + 8 * fq; const float* gp = gate + (size_t)bidx * gstride + col0;
        f32x4 gv[2][2];
#pragma unroll
        for (int bj = 0; bj < 2; ++bj)
#pragma unroll
            for (int n = 0; n < 2; ++n) gv[bj][n] = *(const f32x4*)(gp + bj * HALF + 4 * n);
#pragma unroll
        for (int ai = 0; ai < 2; ++ai)
#pragma unroll
            for (int m = 0; m < 4; ++m) { const size_t off = (size_t)(row0 + ai * HALF + m * 16) * 1024 + col0;
#pragma unroll
                for (int bj = 0; bj < 2; ++bj) { f32x4 x0, x1;
                    if (XF32) { x0 = *(const f32x4*)((const float*)xin + off + bj * HALF); x1 = *(const f32x4*)((const float*)xin + off + bj * HALF + 4); }
                    else { const u32x4 w = *(const u32x4*)((const bf16_t*)xin + off + bj * HALF);
                        x0 = (f32x4){__uint_as_float(w.x << 16), __uint_as_float(w.x & 0xffff0000u), __uint_as_float(w.y << 16), __uint_as_float(w.y & 0xffff0000u)};
                        x1 = (f32x4){__uint_as_float(w.z << 16), __uint_as_float(w.z & 0xffff0000u), __uint_as_float(w.w << 16), __uint_as_float(w.w & 0xffff0000u)}; }
                    const f32x4 v0 = x0 + gv[bj][0] * acc[ai][bj][m][0], v1 = x1 + gv[bj][1] * acc[ai][bj][m][1];
                    u32x4 o; o.x = cvt_pk_bf16(v0[0], v0[1]); o.y = cvt_pk_bf16(v0[2], v0[3]); o.z = cvt_pk_bf16(v1[0], v1[1]); o.w = cvt_pk_bf16(v1[2], v1[3]);
                    *(u32x4*)(out + off + bj * HALF) = o; } }
    }
};
struct EpiSwiGLU {
    static constexpr bool PERM = true, AFTER_DRAIN = false;
    bf16_t* H; int ldh; int nloc; int pm0;
    __device__ __forceinline__ void operator()(const f32x4 (&acc)[2][2][4][2], const Unit& u, int wr, int wc, int fr, int fq) const {
        const int row0 = (u.pm - pm0) * BM + wr * 64 + fr; const int col0 = (u.pn % nloc) * 128 + wc * 32 + 8 * fq;
#pragma unroll
        for (int ai = 0; ai < 2; ++ai)
#pragma unroll
            for (int m = 0; m < 4; ++m) { bf16_t* rowp = H + (size_t)(row0 + ai * HALF + m * 16) * ldh + col0;
                float r[8];
#pragma unroll
                for (int n = 0; n < 2; ++n)
#pragma unroll
                    for (int j = 0; j < 4; ++j) { const float g = acc[ai][0][m][n][j], up = acc[ai][1][m][n][j]; r[n * 4 + j] = g * __builtin_amdgcn_rcpf(1.0f + __expf(-g)) * up; }
                u32x4 w; w.x = cvt_pk_bf16(r[0], r[1]); w.y = cvt_pk_bf16(r[2], r[3]); w.z = cvt_pk_bf16(r[4], r[5]); w.w = cvt_pk_bf16(r[6], r[7]);
                *(u32x4*)(rowp) = w; }
    }
};
struct EpiBfPlain {
    static constexpr bool PERM = true, AFTER_DRAIN = false;
    bf16_t* O; int ldc; int nloc;
    __device__ __forceinline__ void operator()(const f32x4 (&acc)[2][2][4][2], const Unit& u, int wr, int wc, int fr, int fq) const {
        const int row0 = u.pm * BM + wr * 64 + fr; const int col0 = (u.pn % nloc) * BM + wc * 32 + 8 * fq;
#pragma unroll
        for (int ai = 0; ai < 2; ++ai)
#pragma unroll
            for (int m = 0; m < 4; ++m) { bf16_t* rowp = O + (size_t)(row0 + ai * HALF + m * 16) * ldc + col0;
#pragma unroll
                for (int bj = 0; bj < 2; ++bj) { const f32x4 v0 = acc[ai][bj][m][0], v1 = acc[ai][bj][m][1];
                    u32x4 w; w.x = cvt_pk_bf16(v0[0], v0[1]); w.y = cvt_pk_bf16(v0[2], v0[3]); w.z = cvt_pk_bf16(v1[0], v1[1]); w.w = cvt_pk_bf16(v1[2], v1[3]);
                    *(u32x4*)(rowp + bj * HALF) = w; } }
    }
};
struct MoeOrder {
    int ps[9]; int p0, p1, nloc, G, c; int a_off;
    __device__ __forceinline__ bool next(int i, Unit& u) const {
        const int L = i * G + c; const int np = p1 - p0; if (L >= np * nloc) return false;
        const int p = p0 + L / nloc, pl = L % nloc; int e = 0;
#pragma unroll
        for (int k = 1; k < 8; ++k) e += (p >= ps[k]) ? 1 : 0;
        u.pm = p + a_off; u.pn = e * nloc + pl; return true;
    }
    __device__ __forceinline__ void a_ready(const Unit&) const {}
    __device__ __forceinline__ void done(const Unit&) const {}
};
}
struct Ctx {
    LAS unsigned char* lds; gu32* ctl; int tid, lane, wave, G, gw, NGW;
    const float* const __attribute__((address_space(4)))* in; float* out; unsigned char* ws;
};
#define WSP(T, off) ((T*)(C.ws + (off)))

template <class MapF>
__device__ __forceinline__ void transpose_item(const float* W, int K, int N, bf16* WT, MapF map, LAS float* scr, int item, int lane) {
    const int nblk = N / 32, kb = item / nblk, nb = item % nblk, k0 = 64 * kb, n0 = 32 * nb;
#pragma unroll 8
    for (int i = 0; i < 32; ++i) { const int kk = 2 * i + (lane >> 5); scr[kk * 33 + (lane & 31)] = W[(size_t)(k0 + kk) * N + n0 + (lane & 31)]; }
    LDS_WAIT(); asm volatile("" ::: "memory");
    const int c = lane & 7; const int r0 = map(n0);
#pragma unroll
    for (int j = 0; j < 4; ++j) { const int n = (lane >> 3) + 8 * j; const LAS float* s = scr + (8 * c) * 33 + n;
        v4u o; o.x = pk2(s[0 * 33], s[1 * 33]); o.y = pk2(s[2 * 33], s[3 * 33]); o.z = pk2(s[4 * 33], s[5 * 33]); o.w = pk2(s[6 * 33], s[7 * 33]);
        *(GAS v4u*)(WT + (size_t)(r0 + n) * K + k0 + 8 * c) = o; }
    LDS_WAIT(); asm volatile("" ::: "memory");
}
struct MapId { __device__ __forceinline__ int operator()(int n0) const { return n0; } };
struct MapWin { __device__ __forceinline__ int operator()(int n0) const { return n0 < 2048 ? n0 : (n0 < 2080 ? n0 + 768 : n0 - 32); } };
struct MapGU { int up; __device__ __forceinline__ int operator()(int n0) const { return (n0 >> 7) * 256 + (n0 & 127) + up * 128; } };

__device__ __forceinline__ void p0_weights(Ctx& C) {
    LAS float* scr = (LAS float*)(C.lds + C.wave * 16384);
    constexpr int I_IN = (D / 64) * (NIN / 32), I_OUT = (D / 64) * (D / 32), I_G = (D / 64) * (FF / 32), I_D = (FF / 64) * (D / 32);
    constexpr int NITEMS = 2 * I_IN + 2 * I_OUT + 2 * I_G + I_D;
    for (int it = C.gw; it < NITEMS; it += C.NGW) {
        int r = it;
        if (r < 2 * I_IN) { const int l = r / I_IN; transpose_item(C.in[8] + (size_t)l * D * NIN, D, NIN, WSP(bf16, WS_WIN) + (size_t)l * NINP * D, MapWin(), scr, r % I_IN, C.lane); continue; } r -= 2 * I_IN;
        if (r < 2 * I_OUT) { const int l = r / I_OUT; transpose_item(C.in[15] + (size_t)l * D * D, D, D, WSP(bf16, WS_WOUT) + (size_t)l * D * D, MapId(), scr, r % I_OUT, C.lane); continue; } r -= 2 * I_OUT;
        if (r < I_G) { transpose_item(C.in[16], D, FF, WSP(bf16, WS_WGU), MapGU{0}, scr, r, C.lane); continue; } r -= I_G;
        if (r < I_G) { transpose_item(C.in[17], D, FF, WSP(bf16, WS_WGU), MapGU{1}, scr, r, C.lane); continue; } r -= I_G;
        transpose_item(C.in[18], FF, D, WSP(bf16, WS_WD), MapId(), scr, r, C.lane);
    }
    for (int i = C.gw * 64 + C.lane; i < 2 * 28672; i += C.NGW * 64) { const int l = i / 28672, j = i % 28672;
        *(GAS v4u*)(WSP(bf16, WS_WIN) + (size_t)l * NINP * D + (size_t)NIN * D + (size_t)j * 8) = (v4u){0u, 0u, 0u, 0u}; }
    for (int i = C.gw * 64 + C.lane; i < T * 32; i += C.NGW * 64) { const int t = i >> 5, a = i & 31;
        const float pos = (float)((a < 16) ? (t >> 6) : (t & 63)); const float fr = powf(10000.0f, -(float)(a & 15) / 16.0f);
        float sn, cs; sincosf(pos * fr, &sn, &cs);
        WSP(float, WS_ROPE)[i] = cs; WSP(float, WS_ROPE)[T * 32 + i] = sn; }
}
__device__ __forceinline__ void p0_mods(Ctx& C) {
    LAS float* sc = (LAS float*)C.lds;
    LAS float* part = (LAS float*)(C.lds + 32768);
    const int nblk = 2 * 6144 / 64;
    bool staged = false;
    for (int cb = blockIdx.x; cb < nblk; cb += C.G) {
        if (!staged) { for (int i = C.tid; i < 5 * 1024; i += 512) { const float v = (i < 4096) ? C.in[1][i] : C.in[3][i - 4096]; sc[i] = silu_f(v); } staged = true; }
        __syncthreads();
        const int l = cb / 96, j = (cb % 96) * 64 + C.lane;
        const float* wm = C.in[4] + (size_t)l * D * 6144 + j;
        float a0 = 0.f, a1 = 0.f, a2 = 0.f, a3 = 0.f, a4 = 0.f;
        const int kb = C.wave * 128;
#pragma unroll 8
        for (int k = 0; k < 128; ++k) { const float w = wm[(size_t)(kb + k) * 6144];
            a0 += sc[kb + k] * w; a1 += sc[1024 + kb + k] * w; a2 += sc[2048 + kb + k] * w; a3 += sc[3072 + kb + k] * w; a4 += sc[4096 + kb + k] * w; }
        part[(C.wave * 5 + 0) * 64 + C.lane] = a0; part[(C.wave * 5 + 1) * 64 + C.lane] = a1; part[(C.wave * 5 + 2) * 64 + C.lane] = a2;
        part[(C.wave * 5 + 3) * 64 + C.lane] = a3; part[(C.wave * 5 + 4) * 64 + C.lane] = a4;
        __syncthreads();
        if (C.tid < 320) { const int i = C.tid / 64, ln = C.tid % 64; const int jj = (cb % 96) * 64 + ln;
            float s = 0.f;
#pragma unroll
            for (int w = 0; w < 8; ++w) s += part[(w * 5 + i) * 64 + ln];
            s += C.in[5][l * 6144 + jj];
            const int chunk = jj >> 10, col = jj & 1023;
            if (chunk == 1) s = C.in[6][l * 1024 + col] * (1.0f + s);
            if (chunk == 4) s = C.in[7][l * 1024 + col] * (1.0f + s);
            WSP(float, WS_MODS)[((size_t)(l * 5 + i) * 6 + chunk) * 1024 + col] = s; }
        __syncthreads();
    }
}
__device__ __forceinline__ const float* mods_ptr(Ctx& C, int l, int i, int chunk) { return WSP(float, WS_MODS) + ((size_t)(l * 5 + i) * 6 + chunk) * 1024; }

typedef unsigned u32x2n __attribute__((ext_vector_type(2)));
template <bool ROUTE, bool XBF  >
__device__ __forceinline__ void norm_mod(Ctx& C, const void* xl, const void* xc, int nrows, int l, int chA, int chS, bf16* dst) {
    float rw[ROUTE ? 16 : 1][8];
    if (ROUTE) {
#pragma unroll
        for (int j = 0; j < 4; ++j)
#pragma unroll
            for (int q = 0; q < 4; ++q) { const f32x4 a = *(const f32x4*)(C.in[19] + (size_t)(4 * C.lane + 256 * j + q) * 8), b = *(const f32x4*)(C.in[19] + (size_t)(4 * C.lane + 256 * j + q) * 8 + 4);
                rw[j * 4 + q][0] = a.x; rw[j * 4 + q][1] = a.y; rw[j * 4 + q][2] = a.z; rw[j * 4 + q][3] = a.w; rw[j * 4 + q][4] = b.x; rw[j * 4 + q][5] = b.y; rw[j * 4 + q][6] = b.z; rw[j * 4 + q][7] = b.w; }
    }
    for (int m = C.gw; m < nrows; m += C.NGW) {
        const bool isc = m >= ML; const int bidx = isc ? 4 : (m >> 13);
        const size_t xoff = isc ? (size_t)(m - ML) * D : (size_t)m * D; const void* xbase = isc ? xc : xl;
        const GAS f32x4* Ap = (const GAS f32x4*)mods_ptr(C, l, bidx, chA) + C.lane; const GAS f32x4* Sp = (const GAS f32x4*)mods_ptr(C, l, bidx, chS) + C.lane;
        f32x4 v[4]; float s2 = 0.f;
#pragma unroll
        for (int j = 0; j < 4; ++j) {
            if (XBF) { const u32x2n w = *(const GAS u32x2n*)((const bf16*)xbase + xoff + 4 * C.lane + 256 * j); v[j] = (f32x4){bflo(w.x), bfhi(w.x), bflo(w.y), bfhi(w.y)}; }
            else v[j] = ((const GAS f32x4*)((const float*)xbase + xoff) + C.lane)[64 * j];
            s2 += (v[j].x * v[j].x + v[j].y * v[j].y) + (v[j].z * v[j].z + v[j].w * v[j].w); }
        const float rstd = 1.0f / sqrtf(wave_sum(s2) * (1.f / D) + EPS);
#pragma unroll
        for (int j = 0; j < 4; ++j) v[j] = v[j] * rstd * Ap[64 * j] + Sp[64 * j];
        GAS unsigned long long* o8 = (GAS unsigned long long*)(dst + (size_t)m * D) + C.lane;
#pragma unroll
        for (int j = 0; j < 4; ++j) o8[64 * j] = (unsigned long long)pk2(v[j].x, v[j].y) | ((unsigned long long)pk2(v[j].z, v[j].w) << 32);
        if (ROUTE) {
            float lg[8];
#pragma unroll
            for (int e = 0; e < 8; ++e) { float s = 0.f;
#pragma unroll
                for (int j = 0; j < 4; ++j) s += (v[j].x * rw[j * 4 + 0][e] + v[j].y * rw[j * 4 + 1][e]) + (v[j].z * rw[j * 4 + 2][e] + v[j].w * rw[j * 4 + 3][e]);
                lg[e] = wave_sum(s) + C.in[20][e]; }
            if (C.lane == 0) {
                int e0 = 0; float v0 = lg[0];
#pragma unroll
                for (int e = 1; e < 8; ++e) if (lg[e] > v0) { v0 = lg[e]; e0 = e; }
                int e1 = -1; float v1 = -INFINITY;
#pragma unroll
                for (int e = 0; e < 8; ++e) if (e != e0 && lg[e] > v1) { v1 = lg[e]; e1 = e; }
                const float w0 = 1.0f / (1.0f + expf(v1 - v0)), w1 = 1.0f - w0;
                const int s0 = (int)__hip_atomic_fetch_add(C.ctl + CW_CNT + 64 * e0, 1u, RLX_AGENT), s1 = (int)__hip_atomic_fetch_add(C.ctl + CW_CNT + 64 * e1, 1u, RLX_AGENT);
                WSP(int, WS_ROUTE)[m * 4 + 0] = e0; WSP(int, WS_ROUTE)[m * 4 + 1] = s0; WSP(int, WS_ROUTE)[m * 4 + 2] = e1; WSP(int, WS_ROUTE)[m * 4 + 3] = s1;
                WSP(float, WS_RW)[m * 2 + 0] = w0; WSP(float, WS_RW)[m * 2 + 1] = w1;
            }
        }
    }
}
__device__ __forceinline__ void load8(const bf16* p, float (&f)[8]) { const v4u w = *(const GAS v4u*)p; f[0] = bflo(w.x); f[1] = bfhi(w.x); f[2] = bflo(w.y); f[3] = bfhi(w.y); f[4] = bflo(w.z); f[5] = bfhi(w.z); f[6] = bflo(w.w); f[7] = bfhi(w.w); }
__device__ __forceinline__ void store8(bf16* p, const float (&f)[8]) { v4u w; w.x = pk2(f[0], f[1]); w.y = pk2(f[2], f[3]); w.z = pk2(f[4], f[5]); w.w = pk2(f[6], f[7]); *(GAS v4u*)p = w; }
__device__ __forceinline__ float sum8(float v) { v += __shfl_xor(v, 1); v += __shfl_xor(v, 2); v += __shfl_xor(v, 4); return v; }

__device__ __forceinline__ unsigned cvt4_fp8(float a, float b, float c, float d) { int w = 0; w = __builtin_amdgcn_cvt_pk_fp8_f32(a, b, w, false); w = __builtin_amdgcn_cvt_pk_fp8_f32(c, d, w, true); return (unsigned)w; }
constexpr float SQS = 0.42466090014400953f;
__device__ __forceinline__ void p3_prep(Ctx& C, int l) {
    const int lane = C.lane;
    const bf16* qraw = WSP(bf16, WS_QRAW); const bf16* kvraw = WSP(bf16, WS_KVRAW); const float* ab = WSP(float, WS_AB);
    unsigned char* q8 = WSP(unsigned char, WS_XN); unsigned char* k8 = WSP(unsigned char, WS_KALL); unsigned char* v8 = WSP(unsigned char, WS_VALL);
    const float* ropec = WSP(float, WS_ROPE); const float* ropes = ropec + T * 32;
    const int jj = (lane & 7) * 8;
    float qw[8], kw[8];
#pragma unroll
    for (int i = 0; i < 8; ++i) { qw[i] = C.in[13][l * 64 + jj + i]; kw[i] = C.in[14][l * 64 + jj + i]; }
    const int gd = (lane >> 3) & 1, gh = lane & 7;
    const float neg_a = -expf(C.in[10][l * 16 + gd * 8 + gh]), dtb = C.in[11][l * 16 + gd * 8 + gh];
    for (int m = C.gw; m < MT; m += C.NGW) {
        const bool isc = m >= ML; const int b = isc ? (m - ML) >> 8 : m >> 13; const int t = isc ? (m - ML) & 255 : m & 8191;
        {
            float f[8]; load8(qraw + (size_t)m * 512 + lane * 8, f);
            float ss = 0.f;
#pragma unroll
            for (int i = 0; i < 8; ++i) ss += f[i] * f[i];
            const float r = 1.0f / sqrtf(sum8(ss) * (1.f / 64.f) + EPS);
#pragma unroll
            for (int i = 0; i < 8; ++i) f[i] = f[i] * r * qw[i];
            if (!isc) {
                float o[8];
#pragma unroll
                for (int i = 0; i < 8; ++i) o[i] = __shfl_xor(f[i], 4);
                const int a0 = jj & 31; const bool first = jj < 32;
#pragma unroll
                for (int i = 0; i < 8; ++i) { const float cs = ropec[t * 32 + a0 + i], sn = ropes[t * 32 + a0 + i]; f[i] = first ? (f[i] * cs - o[i] * sn) : (f[i] * cs + o[i] * sn); }
            }
#pragma unroll
            for (int i = 0; i < 8; ++i) f[i] *= SQS;
            *(GAS u32x2n*)(q8 + (size_t)m * 512 + lane * 8) = (u32x2n){cvt4_fp8(f[0], f[1], f[2], f[3]), cvt4_fp8(f[4], f[5], f[6], f[7])};
        }
        {
            const size_t krow = (size_t)b * TK + (isc ? T + t : t);
            if (lane < 32) {
                float f[8]; load8(kvraw + (size_t)m * 256 + lane * 8, f);
                if (lane < 16) {
                    float ss = 0.f;
#pragma unroll
                    for (int i = 0; i < 8; ++i) ss += f[i] * f[i];
                    const float r = 1.0f / sqrtf(sum8(ss) * (1.f / 64.f) + EPS);
#pragma unroll
                    for (int i = 0; i < 8; ++i) f[i] = f[i] * r * kw[i];
                    float o[8];
#pragma unroll
                    for (int i = 0; i < 8; ++i) o[i] = __shfl_xor(f[i], 4);
                    if (!isc) { const int a0 = jj & 31; const bool first = jj < 32;
#pragma unroll
                        for (int i = 0; i < 8; ++i) { const float cs = ropec[t * 32 + a0 + i], sn = ropes[t * 32 + a0 + i]; f[i] = first ? (f[i] * cs - o[i] * sn) : (f[i] * cs + o[i] * sn); } }
#pragma unroll
                    for (int i = 0; i < 8; ++i) f[i] *= SQS;
                    *(GAS u32x2n*)(k8 + krow * 128 + lane * 8) = (u32x2n){cvt4_fp8(f[0], f[1], f[2], f[3]), cvt4_fp8(f[4], f[5], f[6], f[7])};
                } else {
                    const int pos = isc ? T + t : t, kk = pos & 63, vh = (lane - 16) >> 3, n0 = ((lane - 16) & 7) * 8;
                    unsigned char* vt = v8 + ((size_t)((b * 2 + vh) * (TK / 64) + (pos >> 6))) * 4096 + 32 * ((kk >> 2) & 1) + ((kk >> 5) << 4) + (((kk >> 3) & 3) << 2) + (kk & 3);
                    const unsigned w0 = cvt4_fp8(f[0], f[1], f[2], f[3]), w1 = cvt4_fp8(f[4], f[5], f[6], f[7]);
#pragma unroll
                    for (int i = 0; i < 4; ++i) { vt[(size_t)(n0 + i) * 64] = (unsigned char)(w0 >> (8 * i)); vt[(size_t)(n0 + 4 + i) * 64] = (unsigned char)(w1 >> (8 * i)); }
                }
            }
        }
        if (lane < 16) {
            const float a = ab[(size_t)m * 32 + lane], bb = ab[(size_t)m * 32 + 16 + lane];
            const float xx = a + dtb; const float sp = xx > 20.f ? xx : log1pf(expf(xx));
            WSP(float, WS_G)[((size_t)gd * MT + m) * 8 + gh] = neg_a * sp;
            WSP(float, WS_BETA)[((size_t)gd * MT + m) * 8 + gh] = 1.0f / (1.0f + expf(-bb));
        }
    }
}

__device__ __forceinline__ float silu_fast(float x) { return x * __builtin_amdgcn_rcpf(1.0f + __expf(-x)); }
__device__ __forceinline__ void p3b_dnconv(Ctx& C, int l) {
    const bf16* dnraw = WSP(bf16, WS_DNRAW); bf16* qdn = WSP(bf16, WS_QDN); bf16* kdn = WSP(bf16, WS_KDN); bf16* kt = WSP(bf16, WS_KT); bf16* vt = WSP(bf16, WS_VT);
    const float* cwl = C.in[9] + (size_t)l * 5 * 1536;
    LAS unsigned char* wl = C.lds + C.wave * 16384;
    if (C.gw < 85 * 24) {
        const int hs = C.gw % 24, sg = hs >> 3, h = hs & 7; const int ch0 = sg * 512 + h * 64;
        float wv[5];
#pragma unroll
        for (int tp = 0; tp < 5; ++tp) wv[tp] = cwl[tp * 1536 + ch0 + C.lane];
        const int lr = C.lane >> 3, lc = C.lane & 7;
        v4u stg[9];
#define DNC_REQ(ckk) do { const int t0_ = ((ckk) < 512) ? (((ckk) & 127) * 64) : ((((ckk) - 512) & 3) * 64); const int tlen_ = ((ckk) < 512) ? T : LC; \
            _Pragma("unroll") for (int i = 0; i < 9; ++i) { const int r_ = i * 8 + lr; const int tt_ = t0_ - 2 + r_; const bool ok_ = r_ < 68 && tt_ >= 0 && tt_ < tlen_; \
                stg[i] = ok_ ? *(const GAS v4u*)(dnraw + ((size_t)(ckk) * 64 - 2 + r_) * 1536 + ch0 + lc * 8) : (v4u){0u, 0u, 0u, 0u}; } } while (0)
        int ck = C.gw / 24;
        if (ck < 528) DNC_REQ(ck);
        for (; ck < 528; ck += 85) {
            asm volatile("s_waitcnt lgkmcnt(0)" ::: "memory");
#pragma unroll
            for (int i = 0; i < 9; ++i) { const int r = i * 8 + lr; if (r < 68) *(LAS v4u*)(wl + r * 144 + lc * 16) = stg[i]; }
            asm volatile("s_waitcnt lgkmcnt(0)" ::: "memory");
            if (ck + 85 < 528) DNC_REQ(ck + 85);
            const int m = ck * 64 + C.lane;
            float y[64];
#pragma unroll
            for (int i = 0; i < 64; ++i) y[i] = 0.f;
#pragma unroll
            for (int tp = 0; tp < 5; ++tp) {
#pragma unroll
                for (int cg = 0; cg < 8; ++cg) { const v4u w = *(const LAS v4u*)(wl + (C.lane + tp) * 144 + cg * 16);
                    const float f[8] = {bflo(w.x), bfhi(w.x), bflo(w.y), bfhi(w.y), bflo(w.z), bfhi(w.z), bflo(w.w), bfhi(w.w)};
#pragma unroll
                    for (int i = 0; i < 8; ++i) y[cg * 8 + i] += f[i] * __builtin_bit_cast(float, __builtin_amdgcn_readlane(__builtin_bit_cast(int, wv[tp]), cg * 8 + i)); } }
            float ss = 0.f;
#pragma unroll
            for (int i = 0; i < 64; ++i) { y[i] = silu_fast(y[i]); ss += y[i] * y[i]; }
            if (sg < 2) { const float r = (1.0f / sqrtf(ss + EPS)) * (sg == 0 ? 0.125f : 1.0f);
#pragma unroll
                for (int i = 0; i < 64; ++i) y[i] *= r; }
            if (sg < 2) { bf16* dst = (sg == 0 ? qdn : kdn) + (size_t)m * 512 + h * 64;
#pragma unroll
                for (int cg = 0; cg < 8; ++cg) { float f[8];
#pragma unroll
                    for (int i = 0; i < 8; ++i) f[i] = y[cg * 8 + i];
                    store8(dst + cg * 8, f); } }
            if (sg >= 1) { bf16* dst = (sg == 1 ? kt : vt) + ((size_t)ck * 8 + h) * 4096 + C.lane;
#pragma unroll
                for (int i = 0; i < 64; i += 2) { const unsigned w = pk2(y[i], y[i + 1]); dst[i * 64] = (bf16)(w & 0xffffu); dst[(i + 1) * 64] = (bf16)(w >> 16); } }
        }
#undef DNC_REQ
    }
    asm volatile("s_waitcnt lgkmcnt(0)" ::: "memory");
}

__device__ __forceinline__ int chunk_ck(int b, int cc) { return cc < 4 ? 512 + b * 4 + cc : b * 128 + (cc - 4); }
__device__ __forceinline__ int chunk_row(int b, int cc, int dir, int i) { const int ii = dir ? 63 - i : i; return cc < 4 ? ML + b * LC + cc * 64 + ii : b * T + (cc - 4) * 64 + ii; }
struct MapGUE { int off; __device__ __forceinline__ int operator()(int n0) const { return off + (n0 >> 7) * 256 + (n0 & 127); } };
__device__ __forceinline__ void moe_weights(Ctx& C) {
    LAS float* scr = (LAS float*)(C.lds + C.wave * 16384);
    constexpr int I_G = (D / 64) * (EF / 32), I_D = (EF / 64) * (D / 32);
    constexpr int NITEMS = NE * (2 * I_G + I_D);
    for (int it = C.gw; it < NITEMS; it += C.NGW) {
        const int e = it / (2 * I_G + I_D); int r = it % (2 * I_G + I_D);
        if (r < I_G) { transpose_item(C.in[21] + (size_t)e * D * EF, D, EF, WSP(bf16, WS_MGU), MapGUE{e * 7168}, scr, r, C.lane); continue; } r -= I_G;
        if (r < I_G) { transpose_item(C.in[22] + (size_t)e * D * EF, D, EF, WSP(bf16, WS_MGU), MapGUE{e * 7168 + 128}, scr, r, C.lane); continue; } r -= I_G;
        transpose_item(C.in[23] + (size_t)e * EF * D, EF, D, WSP(bf16, WS_MD) + (size_t)e * D * EF, MapId(), scr, r, C.lane);
    }
}
__device__ __forceinline__ void moe_panel_starts(Ctx& C, int (&ps)[9], int (&cnt)[8]) {
    int acc = 0;
#pragma unroll
    for (int e = 0; e < 8; ++e) { cnt[e] = (int)__hip_atomic_load(C.ctl + CW_CNT + 64 * e, RLX_AGENT); ps[e] = acc; acc += (cnt[e] + 255) >> 8; }
    ps[8] = acc;
}
__device__ __forceinline__ void moe_scatter(Ctx& C, const bf16* xn2) {
    int ps[9], cnt[8]; moe_panel_starts(C, ps, cnt);
    bf16* xs = WSP(bf16, WS_XS); const int* route = WSP(int, WS_ROUTE); int* pos = WSP(int, WS_POS);
    for (int m = C.gw; m < ML; m += C.NGW) {
        const int e0 = route[m * 4 + 0], s0 = route[m * 4 + 1], e1 = route[m * 4 + 2], s1 = route[m * 4 + 3];
        int p0 = 0, p1 = 0;
#pragma unroll
        for (int e = 0; e < 8; ++e) { p0 = (e == e0) ? ps[e] : p0; p1 = (e == e1) ? ps[e] : p1; }
        const int r0 = p0 * 256 + s0, r1 = p1 * 256 + s1;
        const GAS v4u* src = (const GAS v4u*)(xn2 + (size_t)m * D) + C.lane; GAS v4u* d0 = (GAS v4u*)(xs + (size_t)r0 * D) + C.lane; GAS v4u* d1 = (GAS v4u*)(xs + (size_t)r1 * D) + C.lane;
        const v4u a = src[0], b = src[64]; d0[0] = a; d0[64] = b; d1[0] = a; d1[64] = b;

        if (C.lane == 0) { pos[m * 2 + 0] = r0; pos[m * 2 + 1] = r1; }
    }
#pragma unroll
    for (int e = 0; e < 8; ++e) { const int nb = ps[e + 1] * 256 - (ps[e] * 256 + cnt[e]); const int rb = ps[e] * 256 + cnt[e];
        for (int r = C.gw; r < nb; r += C.NGW) { GAS v4u* d = (GAS v4u*)(xs + (size_t)(rb + r) * D) + C.lane; d[0] = (v4u){0u, 0u, 0u, 0u}; d[64] = (v4u){0u, 0u, 0u, 0u}; } }
}
__device__ __forceinline__ void moe_final(Ctx& C, int l) {
    const bf16* ys = WSP(bf16, WS_XS); const int* route = WSP(int, WS_POS); const float* rwt = WSP(float, WS_RW);
    for (int m = C.gw; m < ML; m += C.NGW) {
        const int r0 = route[m * 2 + 0], r1 = route[m * 2 + 1]; const float w0 = rwt[m * 2], w1 = rwt[m * 2 + 1];
        const int bidx = m >> 13; const float* g2 = mods_ptr(C, l, bidx, 5);
        float x[16]; float ss = 0.f;
#pragma unroll
        for (int j = 0; j < 2; ++j) { const int c0 = j * 512 + C.lane * 8; float a[8], bb[8]; load8(ys + (size_t)r0 * D + c0, a); load8(ys + (size_t)r1 * D + c0, bb);
            float xv[8]; load8(WSP(bf16, WS_XB2) + (size_t)m * D + c0, xv);
            const f32x4 ga = *(const GAS f32x4*)(g2 + c0), gb = *(const GAS f32x4*)(g2 + c0 + 4);
            const float gv[8] = {ga.x, ga.y, ga.z, ga.w, gb.x, gb.y, gb.z, gb.w};
#pragma unroll
            for (int i = 0; i < 8; ++i) { const float v = xv[i] + gv[i] * (w0 * a[i] + w1 * bb[i]); x[j * 8 + i] = v; ss += v * v; } }
        const float rstd = 1.0f / sqrtf(wave_sum(ss) * (1.f / D) + EPS);
#pragma unroll
        for (int j = 0; j < 2; ++j) { const int c0 = j * 512 + C.lane * 8;
            const f32x4 fa = *(const GAS f32x4*)(C.in[24] + c0), fb = *(const GAS f32x4*)(C.in[24] + c0 + 4);
            f32x4 oa = {x[j * 8 + 0] * rstd * fa.x, x[j * 8 + 1] * rstd * fa.y, x[j * 8 + 2] * rstd * fa.z, x[j * 8 + 3] * rstd * fa.w};
            f32x4 ob = {x[j * 8 + 4] * rstd * fb.x, x[j * 8 + 5] * rstd * fb.y, x[j * 8 + 6] * rstd * fb.z, x[j * 8 + 7] * rstd * fb.w};
            *(GAS f32x4*)(C.out + (size_t)m * D + c0) = oa; *(GAS f32x4*)(C.out + (size_t)m * D + c0 + 4) = ob; }
    }
}
typedef float f32x4_t __attribute__((ext_vector_type(4)));
__device__ __forceinline__ int pi_idx(int t, int m) { return 32 * (t >> 1) + 8 * (m >> 2) + 4 * (t & 1) + (m & 3); }
constexpr size_t DN_UNITS = (size_t)NB * 8 * 2 * NCH;
__device__ __forceinline__ int wq_next(gu32* head, int lane) { unsigned v = 0; if (lane == 0) v = __hip_atomic_fetch_add(head, 1u, RLX_AGENT); return (int)__builtin_amdgcn_readfirstlane(v); }
__device__ __forceinline__ void p5_dn1_fast(Ctx& C, int l) {
    const int lane = C.lane, l15 = lane & 15, g = lane >> 4;
    LAS unsigned char* wl = C.lds + C.wave * 16384;
    LAS float* Aimg = (LAS float*)wl;
    const bf16* kdn = WSP(bf16, WS_KDN); const bf16* kt = WSP(bf16, WS_KT); const bf16* vt = WSP(bf16, WS_VT);
    const float* G = WSP(float, WS_G); const float* BT = WSP(float, WS_BETA);
    uint2* FU = WSP(uint2, WS_U); v4u* FW = WSP(v4u, WS_W);
    gu32* qh = C.ctl + CW_Q + 64 * (2 * l);
    for (int u = wq_next(qh, lane); u < (int)DN_UNITS; u = wq_next(qh, lane)) {
        const int cc = u % NCH, dir = (u / NCH) & 1, h = (u / (2 * NCH)) & 7, b = u / (16 * NCH);
        const int ck = chunk_ck(b, cc); const size_t m0 = (size_t)ck * 64;
        float gr = G[((size_t)dir * MT + m0 + lane) * 8 + h]; const float be = BT[((size_t)dir * MT + m0 + lane) * 8 + h];
        if (dir) gr = __shfl(gr, 63 - lane);
#pragma unroll
        for (int o = 1; o < 64; o <<= 1) { const float n = __shfl_up(gr, o); if (lane >= o) gr += n; }
        if (dir) gr = __shfl(gr, 63 - lane);
        const float gcv = gr;
        { float* gcb = WSP(float, WS_GCB) + (size_t)u * 192; gcb[lane] = gcv; gcb[64 + lane] = __shfl(gcv, pi_idx((lane >> 2) & 3, 4 * (lane >> 4) + (lane & 3))); const float gl_ = __shfl(gcv, dir ? 0 : 63); if (lane == 0) gcb[128] = gl_;
          ((bf16*)(gcb + 132))[lane] = (bf16)(pk2(__expf(gl_ - __shfl(gcv, pi_idx((lane >> 2) & 3, 4 * (lane >> 4) + (lane & 3)))), 0.f) & 0xffffu); }
        bf16x8 kf[4][2];
#pragma unroll
        for (int t = 0; t < 4; ++t)
#pragma unroll
            for (int s = 0; s < 2; ++s) kf[t][s] = *(const bf16x8*)(kdn + (m0 + 16 * t + l15) * 512 + h * 64 + 32 * s + 8 * g);
        float gcol[4];
#pragma unroll
        for (int tj = 0; tj < 4; ++tj) gcol[tj] = __shfl(gcv, 16 * tj + l15);
#pragma unroll
        for (int ti = 0; ti < 4; ++ti) {
            float grow[4], brow[4];
#pragma unroll
            for (int r = 0; r < 4; ++r) { grow[r] = __shfl(gcv, 16 * ti + 4 * g + r); brow[r] = __shfl(be, 16 * ti + 4 * g + r); }
#pragma unroll
            for (int tj = 0; tj < 4; ++tj) {
                f32x4_t acc = {0.f, 0.f, 0.f, 0.f};
                acc = __builtin_amdgcn_mfma_f32_16x16x32_bf16(kf[ti][0], kf[tj][0], acc, 0, 0, 0);
                acc = __builtin_amdgcn_mfma_f32_16x16x32_bf16(kf[ti][1], kf[tj][1], acc, 0, 0, 0);
#pragma unroll
                for (int r = 0; r < 4; ++r) { const int si = 16 * ti + 4 * g + r, sj = 16 * tj + l15; const int ci = dir ? 63 - si : si, cj = dir ? 63 - sj : sj;
                    if (ci > cj) Aimg[cj * 64 + ci] = brow[r] * acc[r] * __expf(grow[r] - gcol[tj]); }
            }
        }
        asm volatile("s_waitcnt lgkmcnt(0)" ::: "memory");
        float tcol[64];
#pragma unroll
        for (int i = 0; i < 64; ++i) tcol[i] = (i == lane) ? 1.f : 0.f;
#pragma unroll
        for (int jb = 0; jb < 16; ++jb) {
            f32x4_t d[4];
#pragma unroll
            for (int c = 0; c < 4; ++c) d[c] = *(const LAS f32x4_t*)(Aimg + (4 * jb + c) * 64 + 4 * jb);
            const float t0 = tcol[4 * jb];
            const float t1 = tcol[4 * jb + 1] - d[0][1] * t0;
            const float t2 = tcol[4 * jb + 2] - d[0][2] * t0 - d[1][2] * t1;
            const float t3 = tcol[4 * jb + 3] - d[0][3] * t0 - d[1][3] * t1 - d[2][3] * t2;
            tcol[4 * jb + 1] = t1; tcol[4 * jb + 2] = t2; tcol[4 * jb + 3] = t3;
#pragma unroll
            for (int i4 = jb + 1; i4 < 16; ++i4) {
                const f32x4_t a0 = *(const LAS f32x4_t*)(Aimg + (4 * jb + 0) * 64 + 4 * i4), a1 = *(const LAS f32x4_t*)(Aimg + (4 * jb + 1) * 64 + 4 * i4);
                const f32x4_t a2 = *(const LAS f32x4_t*)(Aimg + (4 * jb + 2) * 64 + 4 * i4), a3 = *(const LAS f32x4_t*)(Aimg + (4 * jb + 3) * 64 + 4 * i4);
#pragma unroll
                for (int k = 0; k < 4; ++k) { float x = tcol[4 * i4 + k];
                    asm("v_fma_f32 %0, -%1, %2, %0" : "+v"(x) : "v"(a0[k]), "v"(t0)); asm("v_fma_f32 %0, -%1, %2, %0" : "+v"(x) : "v"(a1[k]), "v"(t1));
                    asm("v_fma_f32 %0, -%1, %2, %0" : "+v"(x) : "v"(a2[k]), "v"(t2)); asm("v_fma_f32 %0, -%1, %2, %0" : "+v"(x) : "v"(a3[k]), "v"(t3)); tcol[4 * i4 + k] = x; }
                if (((i4 - jb) & 3) == 0) __builtin_amdgcn_sched_barrier(0); }
            __builtin_amdgcn_sched_barrier(0); }
        asm volatile("s_waitcnt lgkmcnt(0)" ::: "memory");
        {   const int kap = dir ? 63 - lane : lane; const float bk = __shfl(be, kap), egk = __expf(__shfl(gcv, kap));
            LAS bf16* Tb = (LAS bf16*)wl; LAS bf16* Tg = Tb + 4096;
#pragma unroll
            for (int i = 0; i < 64; ++i) { const int rho = dir ? 63 - i : i; const float v = tcol[i] * bk; const unsigned w = pk2(v, -v * egk); Tb[rho * 64 + kap] = (bf16)(w & 0xffffu); Tg[rho * 64 + kap] = (bf16)(w >> 16); } }
        asm volatile("s_waitcnt lgkmcnt(0)" ::: "memory");
        {   const LAS bf16* Tb = (const LAS bf16*)wl; const LAS bf16* Tg = Tb + 4096;
            const bf16* vtb = vt + ((size_t)ck * 8 + h) * 4096; const bf16* ktb = kt + ((size_t)ck * 8 + h) * 4096;
            bf16x8 ta[4][2];
#pragma unroll
            for (int t = 0; t < 4; ++t)
#pragma unroll
                for (int p = 0; p < 2; ++p) ta[t][p] = *(const LAS bf16x8*)(Tb + pi_idx(t, l15) * 64 + 32 * p + 8 * g);
#pragma unroll
            for (int ne = 0; ne < 4; ++ne) {
                const bf16x8 vb0 = *(const bf16x8*)(vtb + (16 * ne + l15) * 64 + 8 * g), vb1 = *(const bf16x8*)(vtb + (16 * ne + l15) * 64 + 32 + 8 * g);
#pragma unroll
                for (int t = 0; t < 4; ++t) { f32x4_t acc = {0.f, 0.f, 0.f, 0.f};
                    acc = __builtin_amdgcn_mfma_f32_16x16x32_bf16(ta[t][0], vb0, acc, 0, 0, 0);
                    acc = __builtin_amdgcn_mfma_f32_16x16x32_bf16(ta[t][1], vb1, acc, 0, 0, 0);
                    uint2 w; w.x = pk2(acc[0], acc[1]); w.y = pk2(acc[2], acc[3]);
                    FU[(((size_t)u * 4 + ne) * 4 + t) * 64 + lane] = w; }
            }
#pragma unroll
            for (int t = 0; t < 4; ++t)
#pragma unroll
                for (int p = 0; p < 2; ++p) ta[t][p] = *(const LAS bf16x8*)(Tg + pi_idx(t, l15) * 64 + 32 * p + 8 * g);
#pragma unroll
            for (int pd = 0; pd < 2; ++pd) {
                bf16x8 ka[2][2];
#pragma unroll
                for (int hh = 0; hh < 2; ++hh)
#pragma unroll
                    for (int p = 0; p < 2; ++p) ka[hh][p] = *(const bf16x8*)(ktb + pi_idx(2 * pd + hh, l15) * 64 + 32 * p + 8 * g);
#pragma unroll
                for (int nc = 0; nc < 4; ++nc) { f32x4_t a0 = {0.f, 0.f, 0.f, 0.f}, a1 = {0.f, 0.f, 0.f, 0.f};
                    a0 = __builtin_amdgcn_mfma_f32_16x16x32_bf16(ka[0][0], ta[nc][0], a0, 0, 0, 0); a0 = __builtin_amdgcn_mfma_f32_16x16x32_bf16(ka[0][1], ta[nc][1], a0, 0, 0, 0);
                    a1 = __builtin_amdgcn_mfma_f32_16x16x32_bf16(ka[1][0], ta[nc][0], a1, 0, 0, 0); a1 = __builtin_amdgcn_mfma_f32_16x16x32_bf16(ka[1][1], ta[nc][1], a1, 0, 0, 0);
                    v4u w; w.x = pk2(a0[0], a0[1]); w.y = pk2(a0[2], a0[3]); w.z = pk2(a1[0], a1[1]); w.w = pk2(a1[2], a1[3]);
                    FW[(((size_t)u * 4 + nc) * 2 + pd) * 64 + lane] = w; }
            }
        }
        asm volatile("s_waitcnt lgkmcnt(0)" ::: "memory");
    }
}

__device__ __forceinline__ float dn_gcum(const float* G, int dir, size_t m0, int h, int lane) {
    float gr = G[((size_t)dir * MT + m0 + lane) * 8 + h];
    if (dir) gr = __shfl(gr, 63 - lane);
#pragma unroll
    for (int o = 1; o < 64; o <<= 1) { const float n = __shfl_up(gr, o); if (lane >= o) gr += n; }
    if (dir) gr = __shfl(gr, 63 - lane);
    return gr;
}
__device__ __forceinline__ bf16x8 pack8(const f32x4_t& a, const f32x4_t& b) { v4u w; w.x = pk2(a[0], a[1]); w.y = pk2(a[2], a[3]); w.z = pk2(b[0], b[1]); w.w = pk2(b[2], b[3]); return __builtin_bit_cast(bf16x8, w); }
constexpr int DN2_SLOT = 25600, DN2_NSLOT = 4;
__device__ __forceinline__ void dn2_issue(const v4u* FW, const uint2* FU, const bf16* kt, const float* GCB, int b, int h, int dir, int st, int lw, int lane, unsigned lds_slot) {
    const int l15 = lane & 15, g = lane >> 4;
    const int cc = dir == 0 ? st : (st < 4 ? 3 - st : NCH + 3 - st);
    const size_t u = ((size_t)((b * 8 + h) * 2 + dir)) * NCH + cc; const int ck = chunk_ck(b, cc);
    const unsigned char* fw = (const unsigned char*)(FW + u * 8 * 64); const unsigned char* fu = (const unsigned char*)(FU + u * 4 * 4 * 64);
    const unsigned char* ktb = (const unsigned char*)(kt + ((size_t)ck * 8 + h) * 4096); const unsigned char* gb = (const unsigned char*)(GCB + u * 192);
#pragma unroll
    for (int k = 0; k < 2; ++k) { const int j = 2 * lw + k;
        attn64::glds16(fw + j * 1024 + lane * 16, (unsigned)__builtin_amdgcn_readfirstlane(lds_slot + j * 1024));
        attn64::glds16(ktb + pi_idx(j >> 1, l15) * 128 + (j & 1) * 64 + g * 16, (unsigned)__builtin_amdgcn_readfirstlane(lds_slot + 8192 + j * 1024));
        attn64::glds16(fu + j * 1024 + lane * 16, (unsigned)__builtin_amdgcn_readfirstlane(lds_slot + 16384 + j * 1024)); }
    attn64::glds16(gb + 512 + (lane % 10) * 16, (unsigned)__builtin_amdgcn_readfirstlane(lds_slot + 24576));
}
__device__ __forceinline__ void p6_dn2_fast(Ctx& C, bool dry = false) {
    const int lane = C.lane, g = lane >> 4;
    const v4u* FW = WSP(v4u, WS_W); uint2* FU = WSP(uint2, WS_U); const bf16* kt = WSP(bf16, WS_KT); const float* GCB = WSP(float, WS_GCB);
    v4u* SS = WSP(v4u, WS_XN);
    const unsigned lds0 = (unsigned)(uintptr_t)C.lds;
    for (int ch = blockIdx.x; ch < NB * 8 * 2; ch += C.G) {
        const int dir = ch & 1, h = (ch >> 1) & 7, b = ch >> 4;
        __syncthreads();
        if (C.wave >= 4) {
            const int lw = C.wave - 4;
            dn2_issue(FW, FU, kt, GCB, b, h, dir, 0, lw, lane, lds0 + 0 * DN2_SLOT); dn2_issue(FW, FU, kt, GCB, b, h, dir, 1, lw, lane, lds0 + 1 * DN2_SLOT); dn2_issue(FW, FU, kt, GCB, b, h, dir, 2, lw, lane, lds0 + 2 * DN2_SLOT);
            for (int st = 0; st < NCH; ++st) {
                if (st + 2 < NCH) asm volatile("s_waitcnt vmcnt(14)" ::: "memory"); else if (st + 1 < NCH) asm volatile("s_waitcnt vmcnt(7)" ::: "memory"); else asm volatile("s_waitcnt vmcnt(0)" ::: "memory");
                __builtin_amdgcn_s_barrier();
                if (st + 3 < NCH) dn2_issue(FW, FU, kt, GCB, b, h, dir, st + 3, lw, lane, lds0 + ((st + 3) & 3) * DN2_SLOT);
            }
        } else {
            const int dvq = C.wave;
            f32x4_t S[4];
#pragma unroll
            for (int t = 0; t < 4; ++t) S[t] = (f32x4_t){0.f, 0.f, 0.f, 0.f};
            bf16x8 Sf[2]; Sf[0] = (bf16x8){0, 0, 0, 0, 0, 0, 0, 0}; Sf[1] = Sf[0];
            for (int st = 0; st < NCH; ++st) {
                asm volatile("s_waitcnt lgkmcnt(0)" ::: "memory");
                __builtin_amdgcn_s_barrier();
                asm volatile("" ::: "memory");
                const LAS unsigned char* sl = C.lds + (st & 3) * DN2_SLOT;
                const int cc = dir == 0 ? st : (st < 4 ? 3 - st : NCH + 3 - st);
                const size_t u = ((size_t)((b * 8 + h) * 2 + dir)) * NCH + cc;
                if (!dry) { SS[((u * 4 + dvq) * 2 + 0) * 64 + lane] = __builtin_bit_cast(v4u, Sf[0]); SS[((u * 4 + dvq) * 2 + 1) * 64 + lane] = __builtin_bit_cast(v4u, Sf[1]); }
                const float gl = *(const LAS float*)(sl + 24576); const float egl = __expf(gl);
                const v4u ef0 = *(const LAS v4u*)(sl + 24576 + 16 + g * 32), ef1 = *(const LAS v4u*)(sl + 24576 + 32 + g * 32);
                f32x4_t vn[4];
#pragma unroll
                for (int t = 0; t < 4; ++t) { typedef unsigned u32x2v __attribute__((ext_vector_type(2))); const u32x2v uu = *(const LAS u32x2v*)(sl + 16384 + dvq * 2048 + t * 512 + lane * 8);
                    const bf16x8 a0 = *(const LAS bf16x8*)(sl + (t * 2 + 0) * 1024 + lane * 16), a1 = *(const LAS bf16x8*)(sl + (t * 2 + 1) * 1024 + lane * 16);
                    vn[t] = (f32x4_t){bflo(uu.x), bfhi(uu.x), bflo(uu.y), bfhi(uu.y)};
                    vn[t] = __builtin_amdgcn_mfma_f32_16x16x32_bf16(a0, Sf[0], vn[t], 0, 0, 0);
                    vn[t] = __builtin_amdgcn_mfma_f32_16x16x32_bf16(a1, Sf[1], vn[t], 0, 0, 0); }
                if (!dry) { v4u* VN = (v4u*)(FU + ((u * 4 + dvq) * 4) * 64);
                    VN[0 * 64 + lane] = __builtin_bit_cast(v4u, pack8(vn[0], vn[1])); VN[1 * 64 + lane] = __builtin_bit_cast(v4u, pack8(vn[2], vn[3])); }
#pragma unroll
                for (int t = 0; t < 4; ++t) { const v4u& e = (t < 2) ? ef0 : ef1; const unsigned w0 = e[(t & 1) * 2], w1 = e[(t & 1) * 2 + 1];
                    vn[t][0] *= bflo(w0); vn[t][1] *= bfhi(w0); vn[t][2] *= bflo(w1); vn[t][3] *= bfhi(w1); }
                const bf16x8 vs0 = pack8(vn[0], vn[1]), vs1 = pack8(vn[2], vn[3]);
#pragma unroll
                for (int t = 0; t < 4; ++t) { const bf16x8 k0 = *(const LAS bf16x8*)(sl + 8192 + (t * 2 + 0) * 1024 + lane * 16), k1 = *(const LAS bf16x8*)(sl + 8192 + (t * 2 + 1) * 1024 + lane * 16);
                    S[t] = S[t] * egl;
                    S[t] = __builtin_amdgcn_mfma_f32_16x16x32_bf16(k0, vs0, S[t], 0, 0, 0);
                    S[t] = __builtin_amdgcn_mfma_f32_16x16x32_bf16(k1, vs1, S[t], 0, 0, 0); }
                Sf[0] = pack8(S[0], S[1]); Sf[1] = pack8(S[2], S[3]);
            }
            if (dry) { *(LAS v4u*)(C.lds + 110000 + (C.wave * 64 + lane) * 16) = __builtin_bit_cast(v4u, Sf[0]); }
        }
    }
    __syncthreads();
}
__device__ __forceinline__ void p7_dn3_fast(Ctx& C, int l) {
    const int lane = C.lane, l15 = lane & 15, g = lane >> 4;
    const bf16* qdn = WSP(bf16, WS_QDN); const bf16* kdn = WSP(bf16, WS_KDN);
    const v4u* VNb = WSP(v4u, WS_U); const v4u* SS = WSP(v4u, WS_XN); const bf16* zb = WSP(bf16, WS_ZB); bf16* mix = WSP(bf16, WS_MIX);
    LAS unsigned char* wl = C.lds + C.wave * 16384; const unsigned wl_addr = (unsigned)(uintptr_t)wl;
    const int cc0 = (l == 0) ? 0 : 4; const int ncc = NCH - cc0;
    gu32* qh = C.ctl + CW_Q + 64 * (2 * l + 1);
    for (int un = wq_next(qh, lane); un < NB * 8 * ncc; un = wq_next(qh, lane)) {
        const int cc = cc0 + un % ncc, h = (un / ncc) & 7, b = un / (8 * ncc);
        const int ck = chunk_ck(b, cc); const size_t m0 = (size_t)ck * 64;
        const size_t u0 = ((size_t)((b * 8 + h) * 2 + 0)) * NCH + cc;
        asm volatile("s_waitcnt lgkmcnt(0)" ::: "memory");
#pragma unroll
        for (int f = 0; f < 8; ++f) { attn64::glds16(SS + (u0 * 8 + f) * 64 + lane, (unsigned)__builtin_amdgcn_readfirstlane(wl_addr + f * 1024)); attn64::glds16(VNb + (u0 * 8 + f) * 64 + lane, (unsigned)__builtin_amdgcn_readfirstlane(wl_addr + 8192 + f * 1024)); }
        bf16x8 kf[4][2], qf[4][2];
#pragma unroll
        for (int t = 0; t < 4; ++t)
#pragma unroll
            for (int p = 0; p < 2; ++p) { kf[t][p] = *(const bf16x8*)(kdn + (m0 + pi_idx(t, l15)) * 512 + h * 64 + 32 * p + 8 * g); qf[t][p] = *(const bf16x8*)(qdn + (m0 + pi_idx(t, l15)) * 512 + h * 64 + 32 * p + 8 * g); }
        const float* gcb0 = WSP(float, WS_GCB) + u0 * 192; const float* gcb1 = gcb0 + (size_t)NCH * 192;
        f32x4_t o[4][4];
#pragma unroll
        for (int ni = 0; ni < 4; ++ni)
#pragma unroll
            for (int ne = 0; ne < 4; ++ne) o[ni][ne] = (f32x4_t){0.f, 0.f, 0.f, 0.f};
#pragma unroll
        for (int dir = 0; dir < 2; ++dir) {
            const float* gcbd = dir ? gcb1 : gcb0;
            f32x4_t rowg[4]; float gi[4];
#pragma unroll
            for (int t = 0; t < 4; ++t) { rowg[t] = *(const f32x4_t*)(gcbd + 64 + g * 16 + t * 4); gi[t] = gcbd[pi_idx(t, l15)]; }
            if (dir == 1) { const size_t u1 = u0 + NCH;
                asm volatile("s_waitcnt lgkmcnt(0)" ::: "memory");
#pragma unroll
                for (int f = 0; f < 8; ++f) { attn64::glds16(SS + (u1 * 8 + f) * 64 + lane, (unsigned)__builtin_amdgcn_readfirstlane(wl_addr + f * 1024)); attn64::glds16(VNb + (u1 * 8 + f) * 64 + lane, (unsigned)__builtin_amdgcn_readfirstlane(wl_addr + 8192 + f * 1024)); } }
            asm volatile("s_waitcnt vmcnt(0)" ::: "memory");
#pragma unroll
            for (int ni = 0; ni < 4; ++ni) {
                const int si = pi_idx(ni, l15);
                f32x4_t pt[4];
#pragma unroll
                for (int tj = 0; tj < 4; ++tj) { f32x4_t a = {0.f, 0.f, 0.f, 0.f};
                    a = __builtin_amdgcn_mfma_f32_16x16x32_bf16(kf[tj][0], qf[ni][0], a, 0, 0, 0);
                    a = __builtin_amdgcn_mfma_f32_16x16x32_bf16(kf[tj][1], qf[ni][1], a, 0, 0, 0);
#pragma unroll
                    for (int r = 0; r < 4; ++r) { const int sj = pi_idx(tj, 4 * g + r); const bool keep = dir ? (si <= sj) : (si >= sj);
                        a[r] = keep ? a[r] * __expf(gi[ni] - rowg[tj][r]) : 0.f; }
                    pt[tj] = a; }
                const bf16x8 pa0 = pack8(pt[0], pt[1]), pa1 = pack8(pt[2], pt[3]);
                float erow[4];
#pragma unroll
                for (int r = 0; r < 4; ++r) erow[r] = __expf(rowg[ni][r]);
#pragma unroll
                for (int ne = 0; ne < 4; ++ne) {
                    const bf16x8 s0 = *(const LAS bf16x8*)(wl + (ne * 2 + 0) * 1024 + lane * 16), s1 = *(const LAS bf16x8*)(wl + (ne * 2 + 1) * 1024 + lane * 16);
                    const bf16x8 v0 = *(const LAS bf16x8*)(wl + 8192 + (ne * 2 + 0) * 1024 + lane * 16), v1 = *(const LAS bf16x8*)(wl + 8192 + (ne * 2 + 1) * 1024 + lane * 16);
                    f32x4_t qs = {0.f, 0.f, 0.f, 0.f};
                    qs = __builtin_amdgcn_mfma_f32_16x16x32_bf16(qf[ni][0], s0, qs, 0, 0, 0);
                    qs = __builtin_amdgcn_mfma_f32_16x16x32_bf16(qf[ni][1], s1, qs, 0, 0, 0);
#pragma unroll
                    for (int r = 0; r < 4; ++r) o[ni][ne][r] += qs[r] * erow[r];
                    o[ni][ne] = __builtin_amdgcn_mfma_f32_16x16x32_bf16(pa0, v0, o[ni][ne], 0, 0, 0);
                    o[ni][ne] = __builtin_amdgcn_mfma_f32_16x16x32_bf16(pa1, v1, o[ni][ne], 0, 0, 0);
                    if (ne & 1) __builtin_amdgcn_sched_barrier(0); }
            }
        }
        asm volatile("s_waitcnt lgkmcnt(0)" ::: "memory");
        {   LAS bf16* ot = (LAS bf16*)wl;
#pragma unroll
            for (int ni = 0; ni < 4; ++ni)
#pragma unroll
                for (int ne = 0; ne < 4; ++ne) { const unsigned w0 = pk2(o[ni][ne][0], o[ni][ne][1]), w1 = pk2(o[ni][ne][2], o[ni][ne][3]); const int e = 16 * ne + l15;
                    ot[pi_idx(ni, 4 * g + 0) * 64 + e] = (bf16)(w0 & 0xffffu); ot[pi_idx(ni, 4 * g + 1) * 64 + e] = (bf16)(w0 >> 16);
                    ot[pi_idx(ni, 4 * g + 2) * 64 + e] = (bf16)(w1 & 0xffffu); ot[pi_idx(ni, 4 * g + 3) * 64 + e] = (bf16)(w1 >> 16); }
            asm volatile("s_waitcnt lgkmcnt(0)" ::: "memory");
            const size_t row = m0 + lane; float ov[64]; float ss = 0.f;
#pragma unroll
            for (int c = 0; c < 8; ++c) { const v4u w = *(const LAS v4u*)(wl + lane * 128 + c * 16);
                ov[c * 8 + 0] = bflo(w.x); ov[c * 8 + 1] = bfhi(w.x); ov[c * 8 + 2] = bflo(w.y); ov[c * 8 + 3] = bfhi(w.y); ov[c * 8 + 4] = bflo(w.z); ov[c * 8 + 5] = bfhi(w.z); ov[c * 8 + 6] = bflo(w.w); ov[c * 8 + 7] = bfhi(w.w); }
#pragma unroll
            for (int i = 0; i < 64; ++i) ss += ov[i] * ov[i];
            const float rs = 1.0f / sqrtf(ss * (1.f / 64.f) + EPS);
#pragma unroll
            for (int c = 0; c < 8; ++c) { float z[8]; load8(zb + row * 512 + h * 64 + c * 8, z); float r8[8];
#pragma unroll
                for (int i = 0; i < 8; ++i) r8[i] = ov[c * 8 + i] * rs * C.in[12][l * 64 + c * 8 + i] * silu_f(z[i]);
                store8(mix + row * 1024 + h * 64 + c * 8, r8); }
        }
    }
    asm volatile("s_waitcnt lgkmcnt(0)" ::: "memory");
}
__device__ __forceinline__ void p4_attn_fast(Ctx& C, char* ldsg, int l, bool dry = false) {
    const int bx = blockIdx.x; const int vcu = (C.G % 8 == 0) ? (bx % 8) * (C.G / 8) + bx / 8 : bx;
    attn64::bf16* mix = (attn64::bf16*)WSP(bf16, WS_MIX); attn64::bf16* omix = mix; const unsigned char* q8 = WSP(unsigned char, WS_XN); const unsigned char* k8 = WSP(unsigned char, WS_KALL); const unsigned char* v8 = WSP(unsigned char, WS_VALL);     const attn64::bf16* kall = (const attn64::bf16*)WSP(bf16, WS_KALL); const attn64::bf16* vall = (const attn64::bf16*)WSP(bf16, WS_VALL);
    float mq = fabsf(C.in[13][l * 64 + C.lane]), mk = fabsf(C.in[14][l * 64 + C.lane]);
#pragma unroll
    for (int o = 1; o < 64; o <<= 1) { mq = fmaxf(mq, __shfl_xor(mq, o)); mk = fmaxf(mk, __shfl_xor(mk, o)); }
    const float mref = 64.0f * QSCALE * mq * mk * 1.02f;
    const int nun = NB * 8 * (T / 256) + (l == 0 ? NB * 8 : 0);
    for (int L = vcu; L < nun; L += C.G) {
        int qrow, krow, nt, h;
        if (L < 1024) { const int within = L & 255, bh = within >> 3, qb = (within & 7) + 8 * (L >> 8); const int b = bh >> 3; h = bh & 7; qrow = b * T + qb * 256; krow = b * TK; nt = TK / 64; }
        else { const int b = (L - 1024) >> 3; h = L & 7; qrow = ML + b * LC; krow = b * TK + T; nt = LC / 64; }
        const int kvh = h >> 2;
        attn64::attn_unit8(q8 + (size_t)qrow * 512 + h * 64, omix + (size_t)qrow * 1024 + 512 + h * 64, k8 + (size_t)krow * 128 + kvh * 64, v8 + ((size_t)((krow / TK) * 2 + kvh) * (TK / 64) + (krow % TK) / 64) * 4096, nt, ldsg, mref);
    }
    __syncthreads();
}
__device__ __forceinline__ void tile64(Ctx& C, const bf16* X, int lda, const bf16* Wt, int ldb, int K, float (&r)[8]) {
    typedef pg8::bf16x8 frag_t; typedef pg8::f32x4 c4_t;
    const int lane = C.lane, r16 = lane & 15, g = lane >> 4, w = C.wave;
    const int npair = K >> 6, pbase = npair >> 3, prem = npair & 7;
    const int np = pbase + (w < prem ? 1 : 0), pstart = w * pbase + (w < prem ? w : prem);
    const bf16* xp = X + (size_t)r16 * lda + pstart * 64 + 16 * g;
    const bf16* wp = Wt + (size_t)r16 * ldb + pstart * 64 + 16 * g;
    c4_t acc[4][4];
#pragma unroll
    for (int a = 0; a < 4; ++a)
#pragma unroll
        for (int b = 0; b < 4; ++b) acc[a][b] = (c4_t){0.f, 0.f, 0.f, 0.f};
    frag_t xa[8], wa[8], xb[8], wb[8];
#define T64_LD(xf, wf, p) do { _Pragma("unroll") for (int t_ = 0; t_ < 4; ++t_) { const bf16* xq_ = xp + (size_t)(16 * t_) * lda + 64 * (p); const bf16* wq_ = wp + (size_t)(16 * t_) * ldb + 64 * (p); \
        xf[2 * t_] = *(const GAS frag_t*)(xq_); xf[2 * t_ + 1] = *(const GAS frag_t*)(xq_ + 8); wf[2 * t_] = *(const GAS frag_t*)(wq_); wf[2 * t_ + 1] = *(const GAS frag_t*)(wq_ + 8); } } while (0)
#define T64_MM(xf, wf) do { _Pragma("unroll") for (int h_ = 0; h_ < 2; ++h_) _Pragma("unroll") for (int nt_ = 0; nt_ < 4; ++nt_) _Pragma("unroll") for (int mt_ = 0; mt_ < 4; ++mt_) \
        acc[nt_][mt_] = __builtin_amdgcn_mfma_f32_16x16x32_bf16(wf[2 * nt_ + h_], xf[2 * mt_ + h_], acc[nt_][mt_], 0, 0, 0); } while (0)
#define T64_SB __builtin_amdgcn_sched_barrier(0)
    T64_LD(xa, wa, 0); if (1 < np) T64_LD(xb, wb, 1); T64_SB;
    for (int p = 0; p < np; p += 2) {
        T64_MM(xa, wa); T64_SB;
        if (p + 2 < np) T64_LD(xa, wa, p + 2); T64_SB;
        if (p + 1 < np) T64_MM(xb, wb); T64_SB;
        if (p + 3 < np) T64_LD(xb, wb, p + 3); T64_SB;
    }
#undef T64_SB
#undef T64_LD
#undef T64_MM
    LAS unsigned char* P = C.lds + w * 16384;
#pragma unroll
    for (int nt = 0; nt < 4; ++nt)
#pragma unroll
        for (int mt = 0; mt < 4; ++mt) { const int m = 16 * mt + r16, nb = (16 * nt + 4 * g) * 4; *(LAS c4_t*)(P + m * 256 + (nb ^ (r16 << 4))) = acc[nt][mt]; }
    __syncthreads();
    const int m = 8 * w + (lane >> 3), cb = (lane & 7) * 32, sw = (m & 15) << 4;
#pragma unroll
    for (int i = 0; i < 8; ++i) r[i] = 0.f;
#pragma unroll
    for (int q = 0; q < 8; ++q) { const LAS unsigned char* Q = C.lds + q * 16384 + m * 256; const c4_t a = *(const LAS c4_t*)(Q + (cb ^ sw)), b = *(const LAS c4_t*)(Q + ((cb + 16) ^ sw));
        r[0] += a[0]; r[1] += a[1]; r[2] += a[2]; r[3] += a[3]; r[4] += b[0]; r[5] += b[1]; r[6] += b[2]; r[7] += b[3]; }
    __syncthreads();
}
template <bool XF32> __device__ __forceinline__ void ctx_res_tiles(Ctx& C, const bf16* X, int lda, const bf16* Wt, int K, const void* xin, bf16* out, const float* gate) {
    for (int tI = blockIdx.x; tI < 256; tI += C.G) {
        const int xcd = tI & 7, idx = tI >> 3, ti = 8 * (xcd & 1) + (idx & 7), tj = 4 * (xcd >> 1) + (idx >> 3);
        float r[8]; tile64(C, X + (size_t)(64 * ti) * lda, lda, Wt + (size_t)(64 * tj) * K, K, K, r);
        const size_t off = (size_t)(64 * ti + 8 * C.wave + (C.lane >> 3)) * D + 64 * tj + 8 * (C.lane & 7);
        float x[8];
        if (XF32) { const f32x4 a = *(const GAS f32x4*)((const float*)xin + off), b = *(const GAS f32x4*)((const float*)xin + off + 4); x[0] = a.x; x[1] = a.y; x[2] = a.z; x[3] = a.w; x[4] = b.x; x[5] = b.y; x[6] = b.z; x[7] = b.w; }
        else load8((const bf16*)xin + off, x);
        const f32x4 ga = *(const GAS f32x4*)(gate + 64 * tj + 8 * (C.lane & 7)), gb = *(const GAS f32x4*)(gate + 64 * tj + 8 * (C.lane & 7) + 4);
        const float o[8] = {x[0] + ga.x * r[0], x[1] + ga.y * r[1], x[2] + ga.z * r[2], x[3] + ga.w * r[3], x[4] + gb.x * r[4], x[5] + gb.y * r[5], x[6] + gb.z * r[6], x[7] + gb.w * r[7]};
        store8(out + off, o);
    }
}
__device__ __forceinline__ void moe_down_tiles(Ctx& C, const int (&ps)[9], int p0, int p1) {
    const bf16* hm = WSP(bf16, WS_HM); const bf16* md = WSP(bf16, WS_MD); bf16* ys = WSP(bf16, WS_XS);
    const int nt = (p1 - p0) * 64;
    for (int tI = blockIdx.x; tI < nt; tI += C.G) {
        const int p = p0 + (tI >> 6), mi = (tI >> 4) & 3, nj = tI & 15; int e = 0;
#pragma unroll
        for (int k = 1; k < 8; ++k) e += (p >= ps[k]) ? 1 : 0;
        float r[8]; tile64(C, hm + (size_t)((p - p0) * 256 + 64 * mi) * EF, EF, md + (size_t)e * D * EF + (size_t)(64 * nj) * EF, EF, EF, r);
        store8(ys + (size_t)(p * 256 + 64 * mi + 8 * C.wave + (C.lane >> 3)) * D + 64 * nj + 8 * (C.lane & 7), r);
    }
}
#define STAMP() do {} while (0)
#define RELOAD() do { int t_ = threadIdx.x; asm volatile("" : "+v"(t_)); C.tid = t_; C.lane = t_ & 63; C.wave = __builtin_amdgcn_readfirstlane(t_ >> 6); C.gw = blockIdx.x * NWAVES + C.wave; } while (0)
#define GRID_BAR() do { XcdBarrier b2_ = bar; asm volatile("" : "+s"(b2_.x), "+s"(b2_.bar)); xcd_barrier(b2_); RELOAD(); STAMP(); } while (0)
template <int l> __device__ __forceinline__ void layer_fn(Ctx& C, const XcdBarrier& bar, unsigned char* lds) {
        bf16* const xb1 = (bf16*)C.out;
        const void* xl = (l == 0) ? (const void*)C.in[0] : (const void*)xb1; const void* xc = (l == 0) ? (const void*)C.in[2] : (const void*)WSP(bf16, WS_XC);
        norm_mod<false, l != 0>(C, xl, xc, MT, l, 1, 0, WSP(bf16, WS_XN));
        GRID_BAR();
        {   pg8::Gemm g{WSP(bf16, WS_XN), WSP(bf16, WS_WIN) + (size_t)l * NINP * D, MT, NINP, D}; pg8::StaticOrder S; S.init(MT, NINP, C.G, (int)blockIdx.x);
            pg8::EpiIn E{WSP(bf16, WS_DNRAW), WSP(bf16, WS_ZB), WSP(bf16, WS_QRAW), WSP(bf16, WS_KVRAW), WSP(float, WS_AB)};
            pg8::gemm_phase<pg8::EpiIn, pg8::StaticOrder, true, true>(C.lds, g, S, E); }
        GRID_BAR();
        p3_prep(C, l);
        RELOAD();
        p3b_dnconv(C, l);
        GRID_BAR();
        p4_attn_fast(C, (char*)lds, l);
        STAMP();
        RELOAD();
        p5_dn1_fast(C, l);
        GRID_BAR();
        p6_dn2_fast(C);
        GRID_BAR();
        p7_dn3_fast(C, l);
        GRID_BAR();
        {   const int Mo = ML;
            pg8::Gemm g{WSP(bf16, WS_MIX), WSP(bf16, WS_WOUT) + (size_t)l * D * D, Mo, D, D}; pg8::StaticOrder S; S.init(Mo, D, C.G, (int)blockIdx.x);
            pg8::EpiRes<l == 0> E{xl, (l == 0) ? xb1 : WSP(bf16, WS_XB2), xc, WSP(bf16, WS_XC), mods_ptr(C, l, 0, 2), 6 * 1024};
            pg8::gemm_phase<pg8::EpiRes<l == 0>, pg8::StaticOrder, true, true>(C.lds, g, S, E); }
        if (l == 0) { RELOAD(); ctx_res_tiles<true>(C, WSP(bf16, WS_MIX) + (size_t)ML * D, D, WSP(bf16, WS_WOUT), D, C.in[2], WSP(bf16, WS_XC), mods_ptr(C, 0, 4, 2)); }
        GRID_BAR();
        if (l == 0) {
            norm_mod<false, true>(C, xb1, WSP(bf16, WS_XC), MT, l, 4, 3, WSP(bf16, WS_XN));
            GRID_BAR();
            {   pg8::Gemm g{WSP(bf16, WS_XN), WSP(bf16, WS_WGU), MT, 2 * FF, D}; pg8::StaticOrder S; S.init(MT, 2 * FF, C.G, (int)blockIdx.x);
                pg8::EpiSwiGLU E{WSP(bf16, WS_H), FF, 22, 0};
                pg8::gemm_phase<pg8::EpiSwiGLU, pg8::StaticOrder, true, true>(C.lds, g, S, E); }
            GRID_BAR();
            {   pg8::Gemm g{WSP(bf16, WS_H), WSP(bf16, WS_WD), ML, D, FF}; pg8::StaticOrder S; S.init(ML, D, C.G, (int)blockIdx.x);
                pg8::EpiRes<false> E{xb1, xb1, WSP(bf16, WS_XC), WSP(bf16, WS_XC), mods_ptr(C, l, 0, 5), 6 * 1024};
                pg8::gemm_phase<pg8::EpiRes<false>, pg8::StaticOrder, true, true>(C.lds, g, S, E); }
            RELOAD(); ctx_res_tiles<false>(C, WSP(bf16, WS_H) + (size_t)ML * FF, FF, WSP(bf16, WS_WD), FF, WSP(bf16, WS_XC), WSP(bf16, WS_XC), mods_ptr(C, 0, 4, 5));
            GRID_BAR();
        } else {
            norm_mod<true, true>(C, WSP(bf16, WS_XB2), WSP(bf16, WS_XC), ML, l, 4, 3, WSP(bf16, WS_HM));
            RELOAD();
            moe_weights(C);
            GRID_BAR();
            moe_scatter(C, WSP(bf16, WS_HM));
            GRID_BAR();
            int ps[9], cnt[8]; moe_panel_starts(C, ps, cnt);
            const int per = SS_PANELS;
            for (int ss = 0; ss < NSS; ++ss) {
                const int p0 = ss * per, p1 = (p0 + per < ps[8]) ? p0 + per : ps[8];
                if (p0 < p1) {
                    pg8::MoeOrder S;
#pragma unroll
                    for (int k = 0; k < 9; ++k) S.ps[k] = ps[k];
                    S.p0 = p0; S.p1 = p1; S.nloc = 28; S.G = C.G; S.c = (int)blockIdx.x; S.a_off = 0;
                    pg8::Gemm g{WSP(bf16, WS_XS), WSP(bf16, WS_MGU), 0, 0, D};
                    pg8::EpiSwiGLU E{WSP(bf16, WS_HM), EF, 28, p0};
                    pg8::gemm_phase<pg8::EpiSwiGLU, pg8::MoeOrder, true, true>(C.lds, g, S, E);
                }
                GRID_BAR();
                if (p0 < p1 && p1 - p0 <= 12) { moe_down_tiles(C, ps, p0, p1); }
                else if (p0 < p1) {
                    pg8::MoeOrder S;
#pragma unroll
                    for (int k = 0; k < 9; ++k) S.ps[k] = ps[k];
                    S.p0 = p0; S.p1 = p1; S.nloc = 4; S.G = C.G; S.c = (int)blockIdx.x; S.a_off = -p0;
                    pg8::Gemm g{WSP(bf16, WS_HM), WSP(bf16, WS_MD), 0, 0, EF};
                    pg8::EpiBfPlain E{WSP(bf16, WS_XS) + (size_t)p0 * 256 * D, D, 4};
                    pg8::gemm_phase<pg8::EpiBfPlain, pg8::MoeOrder, true, true>(C.lds, g, S, E);
                }
                GRID_BAR();
            }
            moe_final(C, l);
        }
    }
struct Args { const float* in[25]; float* out; unsigned char* ws; };
__global__ void __launch_bounds__(NWAVES * 64, 2) mk_fwd(Args args) {
    extern __shared__ __attribute__((aligned(16))) unsigned char lds[];
    Ctx C;
    C.lds = (LAS unsigned char*)lds; C.tid = threadIdx.x; C.lane = C.tid & 63; C.wave = __builtin_amdgcn_readfirstlane(C.tid >> 6);
    C.G = gridDim.x; C.gw = blockIdx.x * NWAVES + C.wave; C.NGW = C.G * NWAVES;
    C.in = (const float* const __attribute__((address_space(4)))*)__builtin_amdgcn_kernarg_segment_ptr();
    C.out = args.out; C.ws = args.ws; C.ctl = (gu32*)args.ws;
    volatile LAS unsigned* MISC = (volatile LAS unsigned*)(C.lds + MISC_OFF);
    for (int u = C.tid; u < (LDS_BYTES - LDSCTL_OFF) / 4; u += NWAVES * 64) ((LAS unsigned*)(C.lds + LDSCTL_OFF))[u] = 0u;
    __syncthreads();
    XcdBarrier bar = xcd_barrier_post((unsigned*)(C.ctl + CW_BAR), MISC + 8);
    p0_weights(C); __syncthreads(); RELOAD(); p0_mods(C);
    GRID_BAR();
    layer_fn<0>(C, bar, lds);
    layer_fn<1>(C, bar, lds);
}

extern "C" void kernel_launch(void* const* d_in, const int* in_sizes, int n_in, void* d_out, int out_size, void* d_ws, size_t ws_size, hipStream_t stream) {
    static int grid = 0;
    if (grid == 0) {
        int dev = 0, cus = 0;
        if (n_in != 25 || out_size != ML * D || ws_size < (size_t)560 * MiB) { fprintf(stderr, "kernel_launch: unexpected problem (n_in %d out %d ws %zu)\n", n_in, out_size, ws_size); grid = -1; return; }
        if (hipGetDevice(&dev) != hipSuccess || hipDeviceGetAttribute(&cus, hipDeviceAttributeMultiprocessorCount, dev) != hipSuccess) { grid = -1; return; }
        if (hipFuncSetAttribute((const void*)mk_fwd, hipFuncAttributeMaxDynamicSharedMemorySize, LDS_BYTES) != hipSuccess) { grid = -1; return; }
        (void)hipGetLastError();
        grid = cus;
    }
    if (grid < 0) return;
    (void)hipMemsetAsync((char*)d_ws, 0, CTL_ZERO_BYTES, stream);
    Args a{};
    for (int i = 0; i < 25; ++i) a.in[i] = (const float*)d_in[i];
    a.out = (float*)d_out; a.ws = (unsigned char*)d_ws;
    hipLaunchKernelGGL(mk_fwd, dim3(grid), dim3(NWAVES * 64), LDS_BYTES, stream, a);
}
```

```cpp
#include <hip/hip_runtime.h>
#include <hip/hip_bf16.h>
#include <cstdio>
#include <cstdint>
#include <cmath>
namespace pg8 {
#define PG8_LAS __attribute__((address_space(3)))
typedef unsigned short bf16_t;
typedef short bf16x8 __attribute__((ext_vector_type(8)));
typedef float f32x4 __attribute__((ext_vector_type(4)));
typedef unsigned u32x4 __attribute__((ext_vector_type(4)));
constexpr int BM = 256, BK = 64, HALF = 128, HTB = HALF * BK * 2  , STAGE_BYTES = 8 * HTB, NXCD = 8, WGM = 8;

__host__ __device__ __forceinline__ int lds_byte(int r, int c) { const int st = (r >> 4) * 2 + (c >> 5), rr = r & 15, cc = c & 31, ob = rr * 64 + cc * 2; return st * 1024 + (ob ^ (((ob >> 9) & 1) << 5)); }
__host__ __device__ __forceinline__ void stage_rc(int b, int& R, int& C) { const int st = b / 1024, sb = b % 1024, swz = sb ^ (((sb >> 9) & 1) << 5); R = (st >> 1) * 16 + swz / 64; C = (st & 1) * 32 + (swz % 64) / 2; }
__host__ __device__ __forceinline__ int perm32(int rho) { const int n = rho >> 4, i = rho & 15; return 8 * (i >> 2) + 4 * n + (i & 3); }

struct Unit { int pm, pn; };
struct Gemm { const bf16_t* A; const bf16_t* Bt; int M, N, K; };

struct StaticOrder {
    int nM, nN, nwg, G, c;
    __host__ __device__ void init(int M, int N, int G_, int c_) { nM = M / BM; nN = N / BM; nwg = nM * nN; G = G_; c = c_; }
    __host__ __device__ bool next(int i, Unit& u) const {
        const long L = (long)i * G + c; if (L >= nwg) return false;
        int wgid = (int)L; { const int q = nwg / NXCD, r = nwg % NXCD, xcd = wgid % NXCD, off = wgid / NXCD; wgid = (xcd < r ? xcd * (q + 1) : r * (q + 1) + (xcd - r) * q) + off; }
        const int nig = WGM * nN, gid = wgid / nig, fm = gid * WGM, gsz = (nM - fm) < WGM ? (nM - fm) : WGM;
        u.pm = fm + ((wgid % nig) % gsz); u.pn = (wgid % nig) / gsz; return true;
    }
    __device__ __forceinline__ void a_ready(const Unit&) const {}
    __device__ __forceinline__ void done(const Unit&) const {}
};

__device__ __forceinline__ unsigned cvt_pk_bf16(float lo, float hi) { unsigned r; asm volatile("v_cvt_pk_bf16_f32 %0, %1, %2" : "=v"(r) : "v"(lo), "v"(hi)); return r; }
typedef float f32x2 __attribute__((ext_vector_type(2)));
__device__ __forceinline__ f32x2 gelu_pk(f32x2 v) {
    const f32x2 av = __builtin_elementwise_abs(v), d = av * 0.2316418882f + 1.0f;
    f32x2 t; t.x = __builtin_amdgcn_rcpf(d.x); t.y = __builtin_amdgcn_rcpf(d.y);
    f32x2 q = t * 0.5307027145f + (-0.7265760135f); q = q * t + 0.7107068705f; q = q * t + (-0.142248368f); q = q * t + 0.127414796f; q = q * t;
    const f32x2 s = (v * v) * (-0.72134752044f);
    f32x2 e; e.x = __builtin_amdgcn_exp2f(s.x); e.y = __builtin_amdgcn_exp2f(s.y);
    const f32x2 m = v * (q * e), r = v - m;
    f32x2 o; o.x = v.x < 0.f ? m.x : r.x; o.y = v.y < 0.f ? m.y : r.y; return o;
}

template <int ACT  > struct EpiBf16 {
    static constexpr bool PERM = true, AFTER_DRAIN = false; static_assert(ACT == 0 || ACT == 1, "EpiBf16: ACT is 0 (none) or 1 (gelu_pk)");
    bf16_t* O; int ldc; const float* bias; int split_cols; size_t split_stride; float scale0;
    __device__ __forceinline__ void operator()(const f32x4 (&acc)[2][2][4][2], const Unit& u, int wr, int wc, int fr, int fq) const {
        const int row0 = u.pm * BM + wr * 64 + fr; int colt = u.pn * BM; bf16_t* base = O;
        float sc = 1.f; if (split_cols) { const int t = colt / split_cols; base += (size_t)t * split_stride; colt -= t * split_cols; if (t == 0) sc = scale0; }
        const int col0 = colt + wc * 32 + 8 * fq, bcol0 = u.pn * BM + wc * 32 + 8 * fq;
        f32x4 bv[2][2];
#pragma unroll
        for (int bj = 0; bj < 2; ++bj)
#pragma unroll
            for (int n = 0; n < 2; ++n) bv[bj][n] = bias ? *(const f32x4*)(bias + bcol0 + bj * HALF + 4 * n) : (f32x4){0.f, 0.f, 0.f, 0.f};
#pragma unroll
        for (int ai = 0; ai < 2; ++ai)
#pragma unroll
            for (int m = 0; m < 4; ++m) { bf16_t* rowp = base + (size_t)(row0 + ai * HALF + m * 16) * ldc + col0;
#pragma unroll
                for (int bj = 0; bj < 2; ++bj) { f32x4 v0 = acc[ai][bj][m][0] + bv[bj][0], v1 = acc[ai][bj][m][1] + bv[bj][1];
                    if (ACT == 1) { f32x2 a = gelu_pk((f32x2){v0[0], v0[1]}), b = gelu_pk((f32x2){v0[2], v0[3]}), c = gelu_pk((f32x2){v1[0], v1[1]}), d = gelu_pk((f32x2){v1[2], v1[3]});
                        v0 = (f32x4){a.x, a.y, b.x, b.y}; v1 = (f32x4){c.x, c.y, d.x, d.y}; }
                    v0 = v0 * sc; v1 = v1 * sc; u32x4 w; w.x = cvt_pk_bf16(v0[0], v0[1]); w.y = cvt_pk_bf16(v0[2], v0[3]); w.z = cvt_pk_bf16(v1[0], v1[1]); w.w = cvt_pk_bf16(v1[2], v1[3]);
                    *(u32x4*)(rowp + bj * HALF) = w; } }
    }
};

template <class Epi, class Sched, bool ALIGN_EPI = false, bool SP2 = false>
__device__ __forceinline__ void gemm_phase(PG8_LAS unsigned char* lds, const Gemm g, const Sched& S, const Epi& E) {
    int tid_ = threadIdx.x; asm volatile("" : "+v"(tid_));
    const int tid = tid_, wid = __builtin_amdgcn_readfirstlane(tid >> 6), lane = tid & 63, wr = wid >> 2, wc = wid & 3, fr = lane & 15, fq = lane >> 4;
    const int K = g.K, nt = K / BK;
    unsigned voffA[2], voffB[2];
#pragma unroll
    for (int i = 0; i < 2; ++i) { int R, C; stage_rc(tid * 16 + i * 8192, R, C); const int Rb = Epi::PERM ? ((R & ~31) + perm32(R & 31)) : R;
        voffA[i] = (unsigned)(R * K + C) * 2u; voffB[i] = (unsigned)(Rb * K + C) * 2u; }
    const size_t kstep = (size_t)(BK * 2);
    const size_t hstep = (size_t)HALF * K * 2;
    const size_t tstep = 2 * hstep;
    const unsigned ldsw = (unsigned)wid * 1024u;
    const int aoff = lds_byte(wr * 64 + fr, fq * 8), boff = lds_byte(wc * 32 + fr, fq * 8);
#define PG8_SA(b, h) (((b) * 2 + (h)) * HTB)
#define PG8_SB(b, h) ((4 + (b) * 2 + (h)) * HTB)
#define PG8_STAGE(bufoff, gbase, voff) do { _Pragma("unroll") for (int _i = 0; _i < 2; ++_i) \
        __builtin_amdgcn_global_load_lds((const unsigned*)((const char*)(gbase) + (voff)[_i]), (PG8_LAS unsigned*)(lds + (bufoff) + ldsw + _i * 8192), 16, 0, 0); } while (0)
#define PG8_LDA(dst, b, h) do { _Pragma("unroll") for (int m = 0; m < 4; ++m) _Pragma("unroll") for (int k = 0; k < 2; ++k) dst[m][k] = *(const PG8_LAS bf16x8*)(lds + PG8_SA(b, h) + aoff + m * 2048 + k * 1024); } while (0)
#define PG8_LDB(dst, b, h) do { _Pragma("unroll") for (int n = 0; n < 2; ++n) _Pragma("unroll") for (int k = 0; k < 2; ++k) dst[n][k] = *(const PG8_LAS bf16x8*)(lds + PG8_SB(b, h) + boff + n * 2048 + k * 1024); } while (0)
#define PG8_MMA(ai, bj, At, Bt) do { __builtin_amdgcn_s_setprio(1); _Pragma("unroll") for (int m = 0; m < 4; ++m) _Pragma("unroll") for (int n = 0; n < 2; ++n) _Pragma("unroll") for (int k = 0; k < 2; ++k) \
        acc[ai][bj][m][n] = __builtin_amdgcn_mfma_f32_16x16x32_bf16(Bt[n][k], At[m][k], acc[ai][bj][m][n], 0, 0, 0); __builtin_amdgcn_s_setprio(0); } while (0)
#define PG8_WAIT_V(n) asm volatile("s_waitcnt vmcnt(" #n ")" ::: "memory")
#define PG8_WAIT_L(n) asm volatile("s_waitcnt lgkmcnt(" #n ")" ::: "memory")
#define PG8_BAR __builtin_amdgcn_s_barrier()
#define PG8_SCHED __builtin_amdgcn_sched_barrier(0)
    Unit cur, nxt; int ui = 0;
    if (!S.next(0, cur)) return;
    f32x4 acc[2][2][4][2];
#pragma unroll
    for (int a = 0; a < 2; ++a)
#pragma unroll
        for (int b = 0; b < 2; ++b)
#pragma unroll
            for (int m = 0; m < 4; ++m)
#pragma unroll
                for (int n = 0; n < 2; ++n) acc[a][b][m][n] = (f32x4){0.f, 0.f, 0.f, 0.f};
    bf16x8 At[4][2], B0[2][2], B1[2][2];
    const char* cA = (const char*)g.A + (size_t)cur.pm * tstep; const char* cB = (const char*)g.Bt + (size_t)cur.pn * tstep;
    S.a_ready(cur);
    if constexpr (SP2) {
        PG8_STAGE(PG8_SB(0, 0), cB, voffB); PG8_STAGE(PG8_SB(0, 1), cB + hstep, voffB); PG8_STAGE(PG8_SA(0, 0), cA, voffA); PG8_STAGE(PG8_SA(0, 1), cA + hstep, voffA);
        if (wr == 1) PG8_BAR;
        PG8_WAIT_V(2); PG8_BAR;
        PG8_STAGE(PG8_SB(1, 0), cB + kstep, voffB); PG8_STAGE(PG8_SA(1, 0), cA + kstep, voffA); PG8_STAGE(PG8_SB(1, 1), cB + hstep + kstep, voffB);
        PG8_WAIT_V(6); PG8_BAR;
    } else {
        PG8_STAGE(PG8_SB(0, 0), cB, voffB); PG8_STAGE(PG8_SA(0, 0), cA, voffA); PG8_STAGE(PG8_SB(0, 1), cB + hstep, voffB); PG8_STAGE(PG8_SA(0, 1), cA + hstep, voffA);
        if (wr == 1) PG8_BAR;
        PG8_WAIT_V(4); PG8_BAR;
        PG8_STAGE(PG8_SB(1, 0), cB + kstep, voffB); PG8_STAGE(PG8_SA(1, 0), cA + kstep, voffA); PG8_STAGE(PG8_SB(1, 1), cB + hstep + kstep, voffB);
        PG8_WAIT_V(6); PG8_BAR;
    }
    for (;;) {
        const bool has_next = S.next(ui + 1, nxt);
        const char* nA = has_next ? (const char*)g.A + (size_t)nxt.pm * tstep : cA; const char* nB = has_next ? (const char*)g.Bt + (size_t)nxt.pn * tstep : cB;
        for (int t = 0; t < nt; t += 2) {
            const bool last = (t == nt - 2);
            const char* a1 = cA + (size_t)(t + 1) * kstep;
            const char* a2 = last ? nA : cA + (size_t)(t + 2) * kstep; const char* b2 = last ? nB : cB + (size_t)(t + 2) * kstep;
            const char* a3 = a2 + kstep; const char* b3 = b2 + kstep;
            if (last && has_next) S.a_ready(nxt);
            if constexpr (SP2) {
            PG8_LDB(B0, 0, 0); PG8_LDB(B1, 0, 1); PG8_SCHED; PG8_LDA(At, 0, 0); PG8_STAGE(PG8_SA(1, 1), a1 + hstep, voffA);
            PG8_WAIT_V(8); PG8_WAIT_L(0); PG8_BAR; PG8_MMA(0, 0, At, B0); PG8_MMA(0, 1, At, B1); PG8_BAR; PG8_SCHED;
            PG8_LDA(At, 0, 1); PG8_STAGE(PG8_SB(0, 0), b2, voffB); PG8_STAGE(PG8_SB(0, 1), b2 + hstep, voffB); PG8_STAGE(PG8_SA(0, 0), a2, voffA);
            PG8_WAIT_V(8); PG8_WAIT_L(0); PG8_BAR; PG8_MMA(1, 0, At, B0); PG8_MMA(1, 1, At, B1); PG8_BAR; PG8_SCHED;
            PG8_LDB(B0, 1, 0); PG8_LDB(B1, 1, 1); PG8_SCHED; PG8_LDA(At, 1, 0); PG8_STAGE(PG8_SA(0, 1), a2 + hstep, voffA);
            PG8_WAIT_V(8); PG8_WAIT_L(0); PG8_BAR; PG8_MMA(0, 0, At, B0); PG8_MMA(0, 1, At, B1); PG8_BAR; PG8_SCHED;
            PG8_LDA(At, 1, 1); PG8_STAGE(PG8_SB(1, 0), b3, voffB); PG8_STAGE(PG8_SB(1, 1), b3 + hstep, voffB); PG8_STAGE(PG8_SA(1, 0), a3, voffA);
            PG8_WAIT_V(8); PG8_WAIT_L(0); PG8_BAR; PG8_MMA(1, 0, At, B0); PG8_MMA(1, 1, At, B1); PG8_BAR; PG8_SCHED;
            } else {
            PG8_LDB(B0, 0, 0); PG8_SCHED; PG8_LDA(At, 0, 0); PG8_STAGE(PG8_SA(1, 1), a1 + hstep, voffA);
            PG8_WAIT_L(8); PG8_BAR; PG8_WAIT_L(0); PG8_MMA(0, 0, At, B0); PG8_BAR; PG8_SCHED;
            PG8_LDB(B1, 0, 1); PG8_STAGE(PG8_SB(0, 0), b2, voffB);
            PG8_BAR; PG8_WAIT_L(0); PG8_MMA(0, 1, At, B1); PG8_BAR;
            PG8_LDA(At, 0, 1); PG8_STAGE(PG8_SA(0, 0), a2, voffA);
            PG8_BAR; PG8_WAIT_L(0); PG8_MMA(1, 0, At, B0); PG8_BAR; PG8_SCHED;
            PG8_STAGE(PG8_SB(0, 1), b2 + hstep, voffB);
            PG8_WAIT_V(6); PG8_BAR; PG8_MMA(1, 1, At, B1); PG8_BAR;
            PG8_LDB(B0, 1, 0); PG8_SCHED; PG8_LDA(At, 1, 0); PG8_STAGE(PG8_SA(0, 1), a2 + hstep, voffA);
            PG8_WAIT_L(8); PG8_BAR; PG8_WAIT_L(0); PG8_MMA(0, 0, At, B0); PG8_BAR; PG8_SCHED;
            PG8_LDB(B1, 1, 1); PG8_STAGE(PG8_SB(1, 0), b3, voffB);
            PG8_BAR; PG8_WAIT_L(0); PG8_MMA(0, 1, At, B1); PG8_BAR;
            PG8_LDA(At, 1, 1); PG8_STAGE(PG8_SA(1, 0), a3, voffA);
            PG8_BAR; PG8_WAIT_L(0); PG8_MMA(1, 0, At, B0); PG8_BAR; PG8_SCHED;
            PG8_STAGE(PG8_SB(1, 1), b3 + hstep, voffB);
            PG8_WAIT_V(6); PG8_BAR; PG8_MMA(1, 1, At, B1); PG8_BAR;
            }
        }
        if constexpr (ALIGN_EPI) { if (wr == 0) PG8_BAR; }
        if constexpr (!Epi::AFTER_DRAIN) { E(acc, cur, wr, wc, fr, fq); S.done(cur); }
        if (!has_next) break;
#pragma unroll
        for (int a = 0; a < 2; ++a)
#pragma unroll
            for (int b = 0; b < 2; ++b)
#pragma unroll
                for (int m = 0; m < 4; ++m)
#pragma unroll
                    for (int n = 0; n < 2; ++n) acc[a][b][m][n] = (f32x4){0.f, 0.f, 0.f, 0.f};
        cur = nxt; cA = nA; cB = nB; ++ui;
        if constexpr (ALIGN_EPI) { if (wr == 1) PG8_BAR; }
    }
    PG8_WAIT_V(0);
    if constexpr (!ALIGN_EPI) { if (wr == 0) PG8_BAR; }
    PG8_BAR;
    if constexpr (Epi::AFTER_DRAIN) { E.fused(acc, cur, wr, wc, fr, fq, lds, wid, lane); S.done(cur); }
#undef PG8_SA
#undef PG8_SB
#undef PG8_STAGE
#undef PG8_LDA
#undef PG8_LDB
#undef PG8_MMA
#undef PG8_WAIT_V
#undef PG8_WAIT_L
#undef PG8_BAR
#undef PG8_SCHED
}
}
namespace attn64 {
using bf16=__hip_bfloat16;
using bf16x8=__attribute__((ext_vector_type(8)))short;
using s16x4=__attribute__((ext_vector_type(4)))short;
using f32x16=__attribute__((ext_vector_type(16)))float;
using u32x4=__attribute__((ext_vector_type(4)))unsigned;
constexpr int D=64,QP=1024,KP=128;
constexpr int NW=8,QBLK=32,QB=QBLK*NW,KVBLK=64;
__device__ __forceinline__ int crow(int r,int hi){return (r&3)+8*(r>>2)+4*hi;}
#define SBAR() __builtin_amdgcn_sched_barrier(0)
constexpr int NSLOT=3, SLOTB=8192;
constexpr int LDS_K=0, LDS_V=NSLOT*SLOTB, LDS_WS=2*NSLOT*SLOTB, LDS_OST=LDS_WS+NW*64*4, LDS_BYTES=LDS_OST+NW*4096;
constexpr float C2=0.125f*1.4426950408889634f;
__device__ __forceinline__ void glds16(const void*gsrc,unsigned lds_dst){unsigned keep;
  asm volatile("s_mov_b32 %0, m0\n\ts_mov_b32 m0, %2\n\ts_nop 0\n\tglobal_load_lds_dwordx4 %1, off\n\ts_mov_b32 m0, %0":"=&s"(keep):"v"(gsrc),"s"(lds_dst):"memory");}
__device__ __forceinline__ float max3f(float a,float b,float c){float r;asm("v_max3_f32 %0, %1, %2, %3":"=v"(r):"v"(a),"v"(b),"v"(c));return r;}
__device__ __forceinline__ float max2f(float a,float b){float r;asm("v_max_f32_e32 %0, %1, %2":"=v"(r):"v"(a),"v"(b));return r;}
__device__ __forceinline__ float fadd_s(float a,float b){float r;asm("v_add_f32_e32 %0, %1, %2":"=v"(r):"v"(a),"v"(b));return r;}
__device__ __forceinline__ float fsub_s(float a,float b){float r;asm("v_sub_f32_e32 %0, %1, %2":"=v"(r):"v"(a),"v"(b));return r;}
typedef float f32x2_t __attribute__((ext_vector_type(2))); typedef __bf16 bf16x2_t __attribute__((ext_vector_type(2)));
__device__ __forceinline__ unsigned cvtpk_s(float lo,float hi){f32x2_t v={lo,hi};bf16x2_t b=__builtin_convertvector(v,bf16x2_t);return __builtin_bit_cast(unsigned,b);}
#define WAIT_BAR(N) asm volatile("s_waitcnt vmcnt(" #N ") lgkmcnt(0)\n\ts_barrier":::"memory")

__device__ __forceinline__ void qkt(f32x16&p0,f32x16&p1,const char*Kslot,const bf16x8*qr,const f32x16&negm,int r32,int hi){
  const char*kb=Kslot+hi*1024+r32*16;
  #pragma unroll
  for(int d0=0;d0<4;++d0){
    const bf16x8 b0=*reinterpret_cast<const bf16x8*>(kb+d0*2048);
    const bf16x8 b1=*reinterpret_cast<const bf16x8*>(kb+d0*2048+512);
    if(d0==0){p0=__builtin_amdgcn_mfma_f32_32x32x16_bf16(b0,qr[0],negm,0,0,0);p1=__builtin_amdgcn_mfma_f32_32x32x16_bf16(b1,qr[0],negm,0,0,0);}
    else{p0=__builtin_amdgcn_mfma_f32_32x32x16_bf16(b0,qr[d0],p0,0,0,0);p1=__builtin_amdgcn_mfma_f32_32x32x16_bf16(b1,qr[d0],p1,0,0,0);}}
}
typedef __attribute__((address_space(3))) const char* lds_cptr;
typedef short v4i16_t __attribute__((ext_vector_type(4)));
__device__ __forceinline__ void kload8(bf16x8*kf,lds_cptr kp){
  kf[0]=*(const __attribute__((address_space(3))) bf16x8*)(kp);      kf[1]=*(const __attribute__((address_space(3))) bf16x8*)(kp+512);
  kf[2]=*(const __attribute__((address_space(3))) bf16x8*)(kp+2048); kf[3]=*(const __attribute__((address_space(3))) bf16x8*)(kp+2560);
  kf[4]=*(const __attribute__((address_space(3))) bf16x8*)(kp+4096); kf[5]=*(const __attribute__((address_space(3))) bf16x8*)(kp+4608);
  kf[6]=*(const __attribute__((address_space(3))) bf16x8*)(kp+6144); kf[7]=*(const __attribute__((address_space(3))) bf16x8*)(kp+6656);
}
__device__ __forceinline__ void kload2(bf16x8*kf,lds_cptr kp,int j){ kf[2*j]=*(const __attribute__((address_space(3))) bf16x8*)(kp+j*2048); kf[2*j+1]=*(const __attribute__((address_space(3))) bf16x8*)(kp+j*2048+512); }
__device__ __forceinline__ s16x4 vtr(lds_cptr p){ return __builtin_bit_cast(s16x4,__builtin_amdgcn_ds_read_tr16_b64_v4i16((__attribute__((address_space(3))) v4i16_t*)p)); }
__device__ __forceinline__ float rowmax(const f32x16&p0,const f32x16&p1){
  float a=max3f(p0[0],p0[1],p1[0]),b=max3f(p0[2],p0[3],p1[1]);a=max3f(a,p1[2],p1[3]);
  #pragma unroll
  for(int r=4;r<16;r+=4){a=max3f(a,p0[r],p0[r+1]);b=max3f(b,p0[r+2],p0[r+3]);a=max3f(a,p1[r],p1[r+1]);b=max3f(b,p1[r+2],p1[r+3]);}
  const float m=max2f(a,b);
  auto rr=__builtin_amdgcn_permlane32_swap(__float_as_uint(m),__float_as_uint(m),false,false);
  return max2f(__uint_as_float(rr[0]),__uint_as_float(rr[1]));
}
__device__ __forceinline__ void pv(f32x16*o,int vb,bf16x8 pa0,bf16x8 pa1,bf16x8 pa2,bf16x8 pa3){
  #pragma unroll
  for(int d0=0;d0<2;++d0){s16x4 lo[4],hi[4];
    #pragma unroll
    for(int ks=0;ks<4;++ks){
      asm volatile("ds_read_b64_tr_b16 %0,%1 offset:%c2":"=&v"(lo[ks]):"v"(vb),"i"(d0*4096+ks*1024):"memory");
      asm volatile("ds_read_b64_tr_b16 %0,%1 offset:%c2":"=&v"(hi[ks]):"v"(vb),"i"(d0*4096+ks*1024+512):"memory");}
    asm volatile("s_waitcnt lgkmcnt(0)":::"memory");SBAR();
    #define PK(k) (bf16x8){lo[k][0],lo[k][1],lo[k][2],lo[k][3],hi[k][0],hi[k][1],hi[k][2],hi[k][3]}
    o[d0]=__builtin_amdgcn_mfma_f32_32x32x16_bf16(pa0,PK(0),o[d0],0,0,0);
    o[d0]=__builtin_amdgcn_mfma_f32_32x32x16_bf16(pa1,PK(1),o[d0],0,0,0);
    o[d0]=__builtin_amdgcn_mfma_f32_32x32x16_bf16(pa2,PK(2),o[d0],0,0,0);
    o[d0]=__builtin_amdgcn_mfma_f32_32x32x16_bf16(pa3,PK(3),o[d0],0,0,0);
    #undef PK
  }
}

#ifndef ATTN_STORE16
#define ATTN_STORE16(p,v) (*(u32x4*)(p)=(v))
#endif
template<int THRL> __device__ __forceinline__ void attn_unit(const bf16*Q0,bf16*O0,const bf16*__restrict__ Kh,const bf16*__restrict__ Vh,const int NT,char*shm,const float mref){
  int tid_=threadIdx.x; asm volatile("":"+v"(tid_)); const int tid=tid_,lane=tid&63,r32=lane&31,hi=lane>>5; const int wid=__builtin_amdgcn_readfirstlane(tid>>6);
  const bf16*Qw=Q0+(long)(wid*QBLK)*QP;
  const unsigned lds0=(unsigned)(uintptr_t)shm;
  float*wsf=(float*)(shm+LDS_WS)+wid*64;
  const bf16*ksrc=Kh+(long)lane*KP+wid*8;
  const bf16*vsrc=Vh+(long)(16*(wid&3)+(lane>>2))*KP+(wid>>2)*32+(lane&3)*8;
  const unsigned kdst=lds0+LDS_K+wid*1024, vdst=lds0+LDS_V+wid*1024;
  #define DMA_K(t,slot) glds16(ksrc+(long)(t)*KVBLK*KP,(unsigned)__builtin_amdgcn_readfirstlane(kdst+(slot)))
  #define DMA_V(t,slot) glds16(vsrc+(long)(t)*KVBLK*KP,(unsigned)__builtin_amdgcn_readfirstlane(vdst+(slot)))
  const int vb0=(int)(lds0+LDS_V)+((lane>>4)&1)*32+(lane&3)*8+(4*hi+((lane&15)>>2))*64;
  const char*Kbase=shm+LDS_K; bf16x8 kf[8];
  const lds_cptr shm3=(lds_cptr)shm; const lds_cptr kp0=shm3+LDS_K+hi*1024+r32*16; const lds_cptr vp0=shm3+LDS_V+((lane>>4)&1)*32+(lane&3)*8+(4*hi+((lane&15)>>2))*64;
  DMA_K(0,0);DMA_V(0,0);DMA_K(1,SLOTB);
  bf16x8 qr[4];
  #pragma unroll
  for(int d0=0;d0<4;++d0)qr[d0]=*reinterpret_cast<const bf16x8*>(&Qw[(long)r32*QP+d0*16+hi*8]);
  float l_reg=0.f;f32x16 o[2];o[0]=f32x16{};o[1]=f32x16{};f32x16 negm;
  _Pragma("unroll") for(int r=0;r<16;++r)negm[r]=-mref;
  asm volatile("":"+v"(negm));
  #define CMASK(P0,P1,t) do{}while(0)
  #define START(P0,P1) do{ _Pragma("unroll") for(int r=0;r<16;++r)P0[r]=__builtin_amdgcn_exp2f(P0[r]); }while(0)
  #define RESC() do{}while(0)
  f32x16 pA0,pA1,pB0,pB1;
  int sl_prev=0,sl_cur=0,sl_next=SLOTB;
  #define ROT() do{sl_prev=sl_cur;sl_cur=sl_next;sl_next=(sl_next==(NSLOT-1)*SLOTB)?0:sl_next+SLOTB;}while(0)
  DMA_K(2,2*SLOTB);
  WAIT_BAR(3);
  qkt(pA0,pA1,Kbase,qr,negm,r32,hi);asm volatile("s_nop 15\n\ts_nop 7":"+v"(pA0),"+v"(pA1));CMASK(pA0,pA1,0);
  START(pA0,pA1);
  _Pragma("unroll") for(int r=0;r<16;++r)pA1[r]=__builtin_amdgcn_exp2f(pA1[r]);
  WAIT_BAR(0);
  DMA_K(3,0);DMA_V(1,SLOTB);
  ROT();
  kload8(kf,kp0+sl_cur);
  WAIT_BAR(2);
  s16x4 vlo[8],vhi[8]; u32x4 pw0,pw1,pw2,pw3;
  #define PKW(P,B) cvtpk_s(P[B],P[B+1])
  #define PAF(k) __builtin_bit_cast(bf16x8,pw##k)
  #define VFR(i) (bf16x8){vlo[i][0],vlo[i][1],vlo[i][2],vlo[i][3],vhi[i][0],vhi[i][1],vhi[i][2],vhi[i][3]}
  #define PIN(x) asm volatile("":"+v"(x))
  #define MX3(a,b,c) __builtin_fmaxf(__builtin_fmaxf((a),(b)),(c))
  #define GAPA(MF,A0,A1,A2,A3,W0,W1,PW) do{ MF; sacc+=A0; sacc+=A1; sacc+=A2; sacc+=A3; PIN(sacc); W0; W1; PIN(PW); SBAR(); }while(0)
  #define EX(v) __builtin_amdgcn_exp2f(v)
  #define GAPB(MF,X,B) do{ MF; X[B]=EX(X[B]); X[B+1]=EX(X[B+1]); X[B+2]=EX(X[B+2]); X[B+3]=EX(X[B+3]); PIN(X); SBAR(); }while(0)
  #define VRD(i) do{ vlo[i]=vtr(vp_+(((i)>>2)*4096+((i)&3)*1024)); vhi[i]=vtr(vp_+(((i)>>2)*4096+((i)&3)*1024+512)); }while(0)
  #define KRD(G,j) do{ if(G){ kload2(kf,kp0+sl_next,j); SBAR(); } }while(0)
  #define STEP(C0,C1,P0,P1,t,GK,GV,GL) do{ SBAR(); \
    const lds_cptr vp_=vp0+sl_prev; \
    VRD(0); SBAR(); float sacc=(P0[0]+P0[1]); \
    GAPA(C0=__builtin_amdgcn_mfma_f32_32x32x16_bf16(kf[0],qr[0],negm,0,0,0), P0[2],P0[3],P0[4],P0[5],     pw0[0]=PKW(P0,0), pw0[1]=PKW(P0,2), pw0); \
    VRD(4); SBAR(); GAPA(C1=__builtin_amdgcn_mfma_f32_32x32x16_bf16(kf[1],qr[0],negm,0,0,0), P0[6],P0[7],P0[8],P0[9],     pw0[2]=PKW(P0,4), pw0[3]=PKW(P0,6), pw0); \
    VRD(1); SBAR(); GAPA(C0=__builtin_amdgcn_mfma_f32_32x32x16_bf16(kf[2],qr[1],C0,0,0,0),   P0[10],P0[11],P0[12],P0[13], pw1[0]=PKW(P0,8), pw1[1]=PKW(P0,10), pw1); \
    VRD(5); SBAR(); GAPA(C1=__builtin_amdgcn_mfma_f32_32x32x16_bf16(kf[3],qr[1],C1,0,0,0),   P0[14],P0[15],P1[0],P1[1],   pw1[2]=PKW(P0,12),pw1[3]=PKW(P0,14), pw1); \
    VRD(2); SBAR(); GAPA(C0=__builtin_amdgcn_mfma_f32_32x32x16_bf16(kf[4],qr[2],C0,0,0,0),   P1[2],P1[3],P1[4],P1[5],     pw2[0]=PKW(P1,0), pw2[1]=PKW(P1,2), pw2); \
    VRD(6); SBAR(); GAPA(C1=__builtin_amdgcn_mfma_f32_32x32x16_bf16(kf[5],qr[2],C1,0,0,0),   P1[6],P1[7],P1[8],P1[9],     pw2[2]=PKW(P1,4), pw2[3]=PKW(P1,6), pw2); \
    VRD(3); SBAR(); GAPA(C0=__builtin_amdgcn_mfma_f32_32x32x16_bf16(kf[6],qr[3],C0,0,0,0),   P1[10],P1[11],P1[12],P1[13], pw3[0]=PKW(P1,8), pw3[1]=PKW(P1,10), pw3); \
    VRD(7); SBAR(); GAPA(C1=__builtin_amdgcn_mfma_f32_32x32x16_bf16(kf[7],qr[3],C1,0,0,0),   P1[14],P1[15],0.f,0.f,       pw3[2]=PKW(P1,12),pw3[3]=PKW(P1,14), pw3); \
    l_reg+=sacc; \
    if(GK){DMA_K((t)+3,sl_cur);} if(GV){DMA_V((t)+1,sl_next);} \
    CMASK(C0,C1,t); \
    SBAR(); \
    GAPB(o[0]=__builtin_amdgcn_mfma_f32_32x32x16_bf16(PAF(0),VFR(0),o[0],0,0,0), C0,0); \
    GAPB(o[1]=__builtin_amdgcn_mfma_f32_32x32x16_bf16(PAF(0),VFR(4),o[1],0,0,0), C0,4); \
    KRD(GL,0); GAPB(o[0]=__builtin_amdgcn_mfma_f32_32x32x16_bf16(PAF(1),VFR(1),o[0],0,0,0), C0,8); \
    KRD(GL,1); GAPB(o[1]=__builtin_amdgcn_mfma_f32_32x32x16_bf16(PAF(1),VFR(5),o[1],0,0,0), C0,12); \
    KRD(GL,2); GAPB(o[0]=__builtin_amdgcn_mfma_f32_32x32x16_bf16(PAF(2),VFR(2),o[0],0,0,0), C1,0); \
    KRD(GL,3); GAPB(o[1]=__builtin_amdgcn_mfma_f32_32x32x16_bf16(PAF(2),VFR(6),o[1],0,0,0), C1,4); \
    GAPB(o[0]=__builtin_amdgcn_mfma_f32_32x32x16_bf16(PAF(3),VFR(3),o[0],0,0,0), C1,8); \
    GAPB(o[1]=__builtin_amdgcn_mfma_f32_32x32x16_bf16(PAF(3),VFR(7),o[1],0,0,0), C1,12); \
    }while(0)
  int t=1;
  for(;t+5<NT;t+=2){
    STEP(pB0,pB1,pA0,pA1,t,true,true,true);     WAIT_BAR(2); RESC(); ROT();
    STEP(pA0,pA1,pB0,pB1,t+1,true,true,true);   WAIT_BAR(2); RESC(); ROT();
  }
  #define ENDW(tt) do{ if((tt)+3<NT){WAIT_BAR(2);} else if((tt)+2<NT){WAIT_BAR(1);} else {WAIT_BAR(0);} }while(0)
  for(;t+1<NT;t+=2){
    STEP(pB0,pB1,pA0,pA1,t,(t+3<NT),(t+1<NT),(t+1<NT));       ENDW(t);   RESC(); ROT();
    STEP(pA0,pA1,pB0,pB1,t+1,(t+4<NT),(t+2<NT),(t+2<NT));     ENDW(t+1); RESC(); ROT();
  }
  STEP(pB0,pB1,pA0,pA1,NT-1,false,false,false); RESC();
  { float sacc=pB0[0]+pB0[1]; _Pragma("unroll") for(int r=2;r<16;++r)sacc+=pB0[r]; _Pragma("unroll") for(int r=0;r<16;++r)sacc+=pB1[r]; l_reg+=sacc;
    pw0=(u32x4){PKW(pB0,0),PKW(pB0,2),PKW(pB0,4),PKW(pB0,6)};pw1=(u32x4){PKW(pB0,8),PKW(pB0,10),PKW(pB0,12),PKW(pB0,14)};pw2=(u32x4){PKW(pB1,0),PKW(pB1,2),PKW(pB1,4),PKW(pB1,6)};pw3=(u32x4){PKW(pB1,8),PKW(pB1,10),PKW(pB1,12),PKW(pB1,14)};
    SBAR(); pv(o,vb0+sl_cur,PAF(0),PAF(1),PAF(2),PAF(3)); }
  #undef PKW
  #undef PAF
  #undef VFR
  #undef PIN
  #undef MX3
  #undef GAPA
  #undef GAPB
  #undef EX
  #undef VRD
  #undef KRD
  #undef STEP
  #undef ENDW
  {auto rr=__builtin_amdgcn_permlane32_swap(__float_as_uint(l_reg),__float_as_uint(l_reg),false,false);l_reg=__uint_as_float(rr[0])+__uint_as_float(rr[1]);}
  if(hi==0)wsf[32+r32]=l_reg;asm volatile("s_waitcnt lgkmcnt(0)":::"memory");
  float rli[16];
  #pragma unroll
  for(int r=0;r<16;++r)rli[r]=__builtin_amdgcn_rcpf(wsf[32+crow(r,hi)]);
  bf16*Ow=O0+(long)(wid*QBLK)*QP;
  { bf16*stg=(bf16*)(shm+LDS_OST)+wid*2048;
    #pragma unroll
    for(int r=0;r<16;++r){const int orow=crow(r,hi);
      #pragma unroll
      for(int d0=0;d0<2;++d0)stg[orow*64+d0*32+r32]=__float2bfloat16(o[d0][r]*rli[r]);}
    asm volatile("s_waitcnt lgkmcnt(0)":::"memory");
    #pragma unroll
    for(int i=0;i<4;++i){const int row=i*8+(lane>>3),ch=lane&7; const u32x4 v=*(const u32x4*)(stg+row*64+ch*8); ATTN_STORE16(Ow+(long)row*QP+ch*8,v);} }
  asm volatile("s_waitcnt lgkmcnt(0)\n\ts_barrier":::"memory");
  #undef DMA_K
  #undef DMA_V
  #undef CMASK
  #undef START
  #undef RESC
  #undef ROT
}

typedef int i32x8 __attribute__((ext_vector_type(8)));
__device__ __forceinline__ void attn_unit8(const unsigned char*Q8,bf16*O0,const unsigned char*K8,const unsigned char*V8,const int NT,char*shm,const float mref){
  int tid_=threadIdx.x; asm volatile("":"+v"(tid_)); const int tid=tid_,lane=tid&63,r32=lane&31,hi=lane>>5; const int wid=__builtin_amdgcn_readfirstlane(tid>>6);
  const unsigned lds0=(unsigned)(uintptr_t)shm; const lds_cptr shm3=(lds_cptr)shm;
  constexpr int SL=8192, OST=32768, LWS=65536;
  const unsigned char*dsrc=(wid<4)?(K8+(long)lane*128+wid*16):(V8+(long)lane*64+(wid-4)*16); const long dstep=(wid<4)?(long)64*128:(long)4096;
  const unsigned ddst=lds0+((wid<4)?wid*1024:4096+(wid-4)*1024);
  #define DMA8(t) glds16(dsrc+(long)(t)*dstep,(unsigned)__builtin_amdgcn_readfirstlane(ddst+((t)&3)*SL))
  DMA8(0); if(1<NT)DMA8(1); if(2<NT)DMA8(2);
  const unsigned char*qp=Q8+(long)(wid*32+r32)*512+32*hi; const u32x4 q0=*(const u32x4*)qp,q1=*(const u32x4*)(qp+16);
  const i32x8 qf={(int)q0[0],(int)q0[1],(int)q0[2],(int)q0[3],(int)q1[0],(int)q1[1],(int)q1[2],(int)q1[3]};
  f32x16 o0=f32x16{},o1=f32x16{},ol=f32x16{},zero16;
  i32x8 ones; _Pragma("unroll") for(int j=0;j<8;++j)ones[j]=0x38383838;
  asm volatile("":"+v"(ones));
  _Pragma("unroll") for(int r=0;r<16;++r)zero16[r]=15.0f-mref;
  asm volatile("":"+v"(zero16));
  typedef __attribute__((address_space(3))) const u32x4* l4p;
  #define KFR(t,K0,K1) do{ const lds_cptr ks_=shm3+((t)&3)*SL+(2*hi)*1024+r32*16; const u32x4 ka=*(l4p)(ks_),kb=*(l4p)(ks_+1024),kc=*(l4p)(ks_+512),kd=*(l4p)(ks_+1024+512); \
      K0=(i32x8){(int)ka[0],(int)ka[1],(int)ka[2],(int)ka[3],(int)kb[0],(int)kb[1],(int)kb[2],(int)kb[3]}; K1=(i32x8){(int)kc[0],(int)kc[1],(int)kc[2],(int)kc[3],(int)kd[0],(int)kd[1],(int)kd[2],(int)kd[3]}; }while(0)
  asm volatile("s_waitcnt vmcnt(0)":::"memory");
  asm volatile("s_barrier":::"memory");
  f32x16 pa0,pa1,pb0,pb1;
  { i32x8 kf0,kf1; KFR(0,kf0,kf1);
    pa0=__builtin_amdgcn_mfma_scale_f32_32x32x64_f8f6f4(kf0,qf,zero16,0,0,0,0,0,0); pa1=__builtin_amdgcn_mfma_scale_f32_32x32x64_f8f6f4(kf1,qf,zero16,0,0,0,0,0,0); }
  #define FENCE() __builtin_amdgcn_sched_barrier(0)
  #define VFR8(t,V0,V1) do{ const lds_cptr vs_=shm3+((t)&3)*SL+4096+(2*hi)*1024+r32*16; const u32x4 va_=*(l4p)(vs_),vb_=*(l4p)(vs_+1024),vc_=*(l4p)(vs_+512),vd_=*(l4p)(vs_+1024+512); \
      V0=(i32x8){(int)va_[0],(int)va_[1],(int)va_[2],(int)va_[3],(int)vb_[0],(int)vb_[1],(int)vb_[2],(int)vb_[3]}; V1=(i32x8){(int)vc_[0],(int)vc_[1],(int)vc_[2],(int)vc_[3],(int)vd_[0],(int)vd_[1],(int)vd_[2],(int)vd_[3]}; }while(0)
  #define TOP8(t,FULL) do{ if((FULL)||(t)+2<NT)asm volatile("s_waitcnt vmcnt(1) lgkmcnt(0)\n\ts_barrier":::"memory"); else asm volatile("s_waitcnt vmcnt(0) lgkmcnt(0)\n\ts_barrier":::"memory"); if((FULL)||(t)+3<NT)DMA8((t)+3); }while(0)
  #define EXPR(C,LO,HI) do{ _Pragma("unroll") for(int r=LO;r<HI;++r)C[r]=__builtin_amdgcn_exp2f(C[r]); }while(0)
  #define CVT4(PW,J,C,B) do{ const unsigned h0_=__builtin_bit_cast(unsigned,__builtin_amdgcn_cvt_pkrtz(C[B],C[B+1])), h1_=__builtin_bit_cast(unsigned,__builtin_amdgcn_cvt_pkrtz(C[B+2],C[B+3])); PW[J]=(int)__builtin_amdgcn_perm(h1_,h0_,0x07050301u); }while(0)
  #define MF8(A,B,C,CB) __builtin_amdgcn_mfma_scale_f32_32x32x64_f8f6f4(A,B,C,CB,0,0,0,0,0)
  #define STEPC(C0,C1,N0,N1,PS,V0S,V1S,PN,V0N,V1N,t,FULL) do{ TOP8(t,FULL); \
    i32x8 kf0_,kf1_; const bool nx_=(FULL)||(t)+1<NT; \
    o0=MF8(PS,V0S,o0,1); if(nx_){ KFR((t)+1,kf0_,kf1_); } EXPR(C0,0,7); FENCE(); \
    o1=MF8(PS,V1S,o1,1); EXPR(C0,7,14); FENCE(); \
    ol=MF8(PS,ones,ol,1); EXPR(C0,14,16); EXPR(C1,0,5); FENCE(); \
    if(nx_){ N0=MF8(kf0_,qf,zero16,0); } EXPR(C1,5,12); CVT4(PN,0,C0,0); CVT4(PN,1,C0,4); FENCE(); \
    if(nx_){ N1=MF8(kf1_,qf,zero16,0); } EXPR(C1,12,16); CVT4(PN,2,C0,8); CVT4(PN,3,C0,12); VFR8(t,V0N,V1N); CVT4(PN,4,C1,0); CVT4(PN,5,C1,4); CVT4(PN,6,C1,8); CVT4(PN,7,C1,12); FENCE(); }while(0)
  i32x8 pwA,pwB,vA0,vA1,vB0,vB1; _Pragma("unroll") for(int j=0;j<8;++j){pwA[j]=0;vA0[j]=0;vA1[j]=0;}
  int t=0;
  for(;t+4<NT;t+=2){ STEPC(pa0,pa1,pb0,pb1,pwA,vA0,vA1,pwB,vB0,vB1,t,true); STEPC(pb0,pb1,pa0,pa1,pwB,vB0,vB1,pwA,vA0,vA1,t+1,true); }
  for(;t<NT;t+=2){ STEPC(pa0,pa1,pb0,pb1,pwA,vA0,vA1,pwB,vB0,vB1,t,false); STEPC(pb0,pb1,pa0,pa1,pwB,vB0,vB1,pwA,vA0,vA1,t+1,false); }
  o0=MF8(pwA,vA0,o0,1); o1=MF8(pwA,vA1,o1,1); ol=MF8(pwA,ones,ol,1);
  { bf16*Ow=O0+(long)(wid*32)*QP; bf16*stg=(bf16*)(shm+OST)+wid*2048;
    _Pragma("unroll") for(int r=0;r<16;++r){const int orow=crow(r,hi); const float rl=__builtin_amdgcn_rcpf(ol[r]); stg[orow*64+r32]=__float2bfloat16(o0[r]*rl); stg[orow*64+32+r32]=__float2bfloat16(o1[r]*rl);}
    asm volatile("s_waitcnt lgkmcnt(0)":::"memory");
    _Pragma("unroll") for(int i=0;i<4;++i){const int row=i*8+(lane>>3),ch=lane&7; const u32x4 v=*(const u32x4*)(stg+row*64+ch*8); *(u32x4*)(Ow+(long)row*QP+ch*8)=v;} }
  #undef STEPC
  #undef MF8
  #undef CVT4
  #undef EXPR
  #undef TOP8
  #undef VFR8
  #undef FENCE
  #undef KFR
  #undef DMA8
  asm volatile("s_waitcnt lgkmcnt(0)\n\ts_barrier":::"memory");
}
constexpr int ATTN_LDS_BYTES=LDS_BYTES;
#undef SBAR
#undef WAIT_BAR
}
#define GAS __attribute__((address_space(1)))
#define LAS __attribute__((address_space(3)))
typedef unsigned short bf16;
typedef unsigned v4u __attribute__((ext_vector_type(4)));
typedef float f32x4 __attribute__((ext_vector_type(4)));
typedef short bf16x8 __attribute__((ext_vector_type(8)));
typedef GAS unsigned gu32;
typedef GAS unsigned long long gu64;
#define RLX_AGENT __ATOMIC_RELAXED, __HIP_MEMORY_SCOPE_AGENT
#define LDS_WAIT() asm volatile("s_waitcnt lgkmcnt(0)" ::: "memory")
#define VM_WAIT() asm volatile("s_waitcnt vmcnt(0)" ::: "memory")
__device__ __forceinline__ unsigned long long rt() { return __builtin_amdgcn_s_memrealtime(); }
__device__ __forceinline__ unsigned f2bf(float f) { unsigned u = __builtin_bit_cast(unsigned, f); return (u + 0x7fffu + ((u >> 16) & 1u)) >> 16; }
typedef float pk_f32x2_t __attribute__((ext_vector_type(2))); typedef __bf16 pk_bf16x2_t __attribute__((ext_vector_type(2)));
__device__ __forceinline__ unsigned pk2(float lo, float hi) { pk_f32x2_t v = {lo, hi}; pk_bf16x2_t b = __builtin_convertvector(v, pk_bf16x2_t); return __builtin_bit_cast(unsigned, b); }
#define XB_TMO      128
#define XB_XCNT(j)  (256  + 64 * (j))
#define XB_XSUB(j)  (1280 + 64 * (j))
#define XB_XGEN(j)  (2304 + 64 * (j))
#define XB_TOP      3328
#define XB_TOPGEN   3392
#define XCD_BAR_WORDS 3456
#define XB_SPIN_CAP (1u << 18)

__device__ __forceinline__ unsigned xb_ld(unsigned* p)              { return __hip_atomic_load(p, __ATOMIC_RELAXED, __HIP_MEMORY_SCOPE_AGENT); }
__device__ __forceinline__ unsigned xb_add(unsigned* p, unsigned v) { return __hip_atomic_fetch_add(p, v, __ATOMIC_RELAXED, __HIP_MEMORY_SCOPE_AGENT); }
__device__ __forceinline__ unsigned xb_xcc_id() { return (unsigned)__builtin_amdgcn_s_getreg((3 << 11) | 20) & 0xFu; }
#define XB_SPIN(cond, bar) do { unsigned _sp = 0; while (cond) { __builtin_amdgcn_s_sleep(1); \
    if ((++_sp & 255u) == 0u) { if (xb_ld(&(bar)[XB_TMO])) break; if (_sp > XB_SPIN_CAP) { atomicAdd(&(bar)[XB_TMO], 1u); break; } } } } while (0)

struct XcdBarrier {
    unsigned* bar; unsigned x;
    volatile LAS unsigned* st;
};

__device__ __forceinline__ XcdBarrier xcd_barrier_post(unsigned* bar, volatile LAS unsigned* st) {
    XcdBarrier b; b.bar = bar; b.x = xb_xcc_id(); b.st = st;
    if (threadIdx.x == 0) (void)xb_add(&bar[XB_XCNT(b.x)], 1u);
    return b;
}
__device__ __forceinline__ void xcd_barrier_complete(unsigned* bar, unsigned x, unsigned& nloc, unsigned& nx) {
    const unsigned G = gridDim.x * gridDim.y * gridDim.z;
    unsigned sum, cnt, mine, sp = 0u;
    for (;;) {
        sum = 0u; cnt = 0u; mine = 0u;
#pragma unroll
        for (unsigned j = 0; j < 16; ++j) { const unsigned c = xb_ld(&bar[XB_XCNT(j)]); sum += c; cnt += (c > 0u) ? 1u : 0u; mine = (j == x) ? c : mine; }
        if (sum == G) break;
        __builtin_amdgcn_s_sleep(1);
        if ((++sp & 255u) == 0u) { if (xb_ld(&bar[XB_TMO])) break; if (sp > XB_SPIN_CAP) { atomicAdd(&bar[XB_TMO], 1u); break; } }
    }
    nloc = mine > 0u ? mine : 1u; nx = cnt > 0u ? cnt : 1u;
}

__device__ __forceinline__ void xcd_barrier(const XcdBarrier& b) {
    asm volatile("s_waitcnt vmcnt(0)" ::: "memory");
    __syncthreads();
    if (threadIdx.x == 0) {
        unsigned* bar = b.bar;
        __builtin_amdgcn_s_waitcnt(0);
        unsigned nloc = b.st[0], nx = b.st[1];
        if (nloc == 0u) { xcd_barrier_complete(bar, b.x, nloc, nx); b.st[0] = nloc; b.st[1] = nx; }
        const unsigned old = xb_add(&bar[XB_XSUB(b.x)], 1u);
        const unsigned gen = old / nloc;
        if (old + 1u == (gen + 1u) * nloc) {
            __builtin_amdgcn_fence(__ATOMIC_RELEASE, "agent");
            asm volatile("s_waitcnt vmcnt(0)" ::: "memory");
            const unsigned og = xb_add(&bar[XB_TOP], 1u);
            const unsigned tg = og / nx;
            if (og + 1u == (tg + 1u) * nx) xb_add(&bar[XB_TOPGEN], 1u);
            else XB_SPIN(xb_ld(&bar[XB_TOPGEN]) == tg, bar);
            __builtin_amdgcn_fence(__ATOMIC_ACQUIRE, "agent");
            xb_add(&bar[XB_XGEN(b.x)], 1u);
            asm volatile("s_waitcnt vmcnt(0)" ::: "memory");
        } else {
            XB_SPIN(xb_ld(&bar[XB_XGEN(b.x)]) == gen, bar);
            __builtin_amdgcn_fence(__ATOMIC_ACQUIRE, "agent");
            asm volatile("s_waitcnt vmcnt(0)" ::: "memory");
        }
    }
    __syncthreads();
}
constexpr int NB = 4, T = 8192, LC = 256, D = 1024, NLAYER = 2;
constexpr int ML = NB * T, MC = NB * LC, MT = ML + MC;
constexpr int NIN = 2848, NINP = 3072;
constexpr int FF = 2816, EF = 3584, NE = 8;
constexpr int TK = T + LC;
constexpr int NCH = TK / 64;
constexpr float EPS = 1e-6f;
constexpr float QSCALE = 0.125f * 1.4426950408889634f;

constexpr int NWAVES = 8;
constexpr int LDS_BYTES = 147456;
constexpr int RING_BYTES = 131072, LDSCTL_OFF = RING_BYTES, MISC_OFF = LDSCTL_OFF + 320;

constexpr size_t MiB = 1u << 20;
constexpr size_t CTL_ZERO_BYTES = 1 * MiB;
constexpr int CW_BAR = 4096;
constexpr int CW_CNT = 16384;
constexpr int CW_Q = 17408;
constexpr size_t WS_MODS = 1 * MiB;
constexpr size_t WS_ROUTE = 1 * MiB + 512 * 1024;
constexpr size_t WS_RW = WS_ROUTE + (size_t)ML * 16;
constexpr size_t WS_POS = WS_RW + (size_t)ML * 8;
constexpr size_t WS_XC = 3 * MiB;
constexpr size_t WS_ROPE = 7 * MiB;
constexpr size_t WS_WIN = 9 * MiB;
constexpr size_t WS_WOUT = 21 * MiB;
constexpr size_t WS_WGU = 25 * MiB;
constexpr size_t WS_WD = 36 * MiB;
constexpr size_t WS_G = 42 * MiB;
constexpr size_t WS_BETA = WS_G + (size_t)2 * MT * 8 * 4;
constexpr size_t WS_AB = 47 * MiB;
constexpr size_t WS_KALL = 52 * MiB;
constexpr size_t WS_VALL = 61 * MiB;
constexpr size_t WS_DYN = 70 * MiB;
constexpr size_t WS_XN = WS_DYN;
constexpr size_t WS_OF = WS_XN, WS_OB = WS_XN + 33 * MiB;
constexpr size_t WS_DNRAW = WS_XN + 66 * MiB;
constexpr size_t WS_QRAW = WS_DNRAW + 99 * MiB;
constexpr size_t WS_KVRAW = WS_QRAW + 33 * MiB;
constexpr size_t WS_U = WS_DNRAW, WS_W = WS_DNRAW + 66 * MiB;
constexpr size_t WS_ZB = WS_KVRAW + 17 * MiB;
constexpr size_t WS_QDN = WS_ZB + 33 * MiB;
constexpr size_t WS_KDN = WS_QDN + 33 * MiB;
constexpr size_t WS_KT = WS_KDN + 33 * MiB;
constexpr size_t WS_VT = WS_KT + 33 * MiB;
constexpr size_t WS_MIX = WS_VT + 33 * MiB;
constexpr size_t WS_MIX_END = WS_MIX + 66 * MiB;
constexpr size_t WS_GCB = WS_MIX_END + 1 * MiB;
constexpr size_t WS_H = WS_DNRAW;
constexpr size_t WS_XB2 = WS_DYN;
constexpr size_t WS_MGU = WS_DYN + 64 * MiB;
constexpr size_t WS_MD = WS_MGU + 112 * MiB;
constexpr size_t WS_XS = WS_MD + 56 * MiB;
constexpr int SS_PANELS = 64, NSS = 5;
constexpr size_t WS_HM = WS_XS + 132 * MiB;
constexpr size_t WS_END = WS_HM + 112 * MiB;
static_assert(WS_END <= 560 * MiB, "ws map (MoE)");
static_assert(WS_W + 66 * MiB <= WS_ZB && WS_H + (size_t)MT * FF * 2 <= WS_MIX && WS_MIX_END <= 560 * MiB && WS_POS + (size_t)ML * 8 <= WS_XC, "ws map");

typedef unsigned short bf16;
__device__ __forceinline__ float bf2f(unsigned short h) { return __uint_as_float(((unsigned)h) << 16); }
__device__ __forceinline__ float bflo(unsigned w) { return __uint_as_float(w << 16); }
__device__ __forceinline__ float bfhi(unsigned w) { return __uint_as_float(w & 0xffff0000u); }
__device__ __forceinline__ float wave_sum(float v) {
#pragma unroll
    for (int o = 1; o < 64; o <<= 1) v += __shfl_xor(v, o);
    return v;
}
__device__ __forceinline__ float silu_f(float x) { return x * __builtin_amdgcn_rcpf(1.0f + __expf(-x)); }
namespace pg8 {
struct EpiIn {
    static constexpr bool PERM = true, AFTER_DRAIN = false;
    bf16_t* dnraw; bf16_t* zb; bf16_t* qraw; bf16_t* kvraw; float* ab;
    __device__ __forceinline__ void operator()(const f32x4 (&acc)[2][2][4][2], const Unit& u, int wr, int wc, int fr, int fq) const {
        const int row0 = u.pm * BM + wr * 64 + fr; const int pn = u.pn;
        if (pn < 11) {
            bf16_t* base; int ldc, coff;
            if (pn < 6) { base = dnraw; ldc = 1536; coff = pn * 256; } else if (pn < 8) { base = zb; ldc = 512; coff = (pn - 6) * 256; }
            else if (pn < 10) { base = qraw; ldc = 512; coff = (pn - 8) * 256; } else { base = kvraw; ldc = 256; coff = 0; }
            const int col0 = coff + wc * 32 + 8 * fq;
#pragma unroll
            for (int ai = 0; ai < 2; ++ai)
#pragma unroll
                for (int m = 0; m < 4; ++m) { bf16_t* rowp = base + (size_t)(row0 + ai * HALF + m * 16) * ldc + col0;
#pragma unroll
                    for (int bj = 0; bj < 2; ++bj) { const f32x4 v0 = acc[ai][bj][m][0], v1 = acc[ai][bj][m][1];
                        u32x4 w; w.x = cvt_pk_bf16(v0[0], v0[1]); w.y = cvt_pk_bf16(v0[2], v0[3]); w.z = cvt_pk_bf16(v1[0], v1[1]); w.w = cvt_pk_bf16(v1[2], v1[3]);
                        *(u32x4*)(rowp + bj * HALF) = w; } }
        } else if (wc == 0) {
#pragma unroll
            for (int ai = 0; ai < 2; ++ai)
#pragma unroll
                for (int m = 0; m < 4; ++m) { float* rowp = ab + (size_t)(row0 + ai * HALF + m * 16) * 32 + 8 * fq;
                    *(f32x4*)(rowp) = acc[ai][0][m][0]; *(f32x4*)(rowp + 4) = acc[ai][0][m][1]; }
        }
    }
};
template <bool XF32> struct EpiRes {
    static constexpr bool PERM = true, AFTER_DRAIN = false;
    const void* xin_l; bf16_t* out_l; const void* xin_c; bf16_t* out_c; const float* gate; int gstride;
    __device__ __forceinline__ void operator()(const f32x4 (&acc)[2][2][4][2], const Unit& u, int wr, int wc, int fr, int fq) const {
        const int pm = u.pm; const bool isc = pm >= 128; const int bidx = isc ? 4 : (pm >> 5);
        const void* xin = isc ? xin_c : xin_l; bf16_t* out = isc ? out_c : out_l; const int prow = isc ? pm - 128 : pm;
        const int row0 = prow * BM + wr * 64 + fr; const int col0 = u.pn * BM + wc * 32 + 8 * fq; const float* gp = gate + (size_t)bidx * gstride + col0;
        f32x4 gv[2][2];
#pragma unroll
        for (int bj = 0; bj < 2; ++bj)
#pragma unroll
            for (int n = 0; n < 2; ++n) gv[bj][n] = *(const f32x4*)(gp + bj * HALF + 4 * n);
#pragma unroll
        for (int ai = 0; ai < 2; ++ai)
#pragma unroll
            for (int m = 0; m < 4; ++m) { const size_t off = (size_t)(row0 + ai * HALF + m * 16) * 1024 + col0;
#pragma unroll
                for (int bj = 0; bj < 2; ++bj) { f32x4 x0, x1;
                    if (XF32) { x0 = *(const f32x4*)((const float*)xin + off + bj * HALF); x1 = *(const f32x4*)((const float*)xin + off + bj * HALF + 4); }
                    else { const u32x4 w = *(const u32x4*)((const bf16_t*)xin + off + bj * HALF);
                        x0 = (f32x4){__uint_as_float(w.x << 16), __uint_as_float(w.x & 0xffff0000u), __uint_as_float(w.y << 16), __uint_as_float(w.y & 0xffff0000u)};
                        x1 = (f32x4){__uint_as_float(w.z << 16), __uint_as_float(w.z & 0xffff0000u), __uint_as_float(w.w << 16), __uint_as_float(w.w & 0xffff0000u)}; }
                    const f32x4 v0 = x0 + gv[bj][0] * acc[ai][bj][m][0], v1 = x1 + gv[bj][1] * acc[ai][bj][m][1];
                    u32x4 o; o.x = cvt_pk_bf16(v0[0], v0[1]); o.y = cvt_pk_bf16(v0[2], v0[3]); o.z = cvt_pk_bf16(v1[0], v1[1]); o.w = cvt_pk_bf16(v1[2], v1[3]);
                    *(u32x4*)(out + off + bj * HALF) = o; } }
    }
};
struct EpiSwiGLU {
    static constexpr bool PERM = true, AFTER_DRAIN = false;
    bf16_t* H; int ldh; int nloc; int pm0;
    __device__ __forceinline__ void operator()(const f32x4 (&acc)[2][2][4][2], const Unit& u, int wr, int wc, int fr, int fq) const {
        const int row0 = (u.pm - pm0) * BM + wr * 64 + fr; const int col0 = (u.pn % nloc) * 128 + wc * 32 + 8 * fq;
#pragma unroll
        for (int ai = 0; ai < 2; ++ai)
#pragma unroll
            for (int m = 0; m < 4; ++m) { bf16_t* rowp = H + (size_t)(row0 + ai * HALF + m * 16) * ldh + col0;
                float r[8];
#pragma unroll
                for (int n = 0; n < 2; ++n)
#pragma unroll
                    for (int j = 0; j < 4; ++j) { const float g = acc[ai][0][m][n][j], up = acc[ai][1][m][n][j]; r[n * 4 + j] = g * __builtin_amdgcn_rcpf(1.0f + __expf(-g)) * up; }
                u32x4 w; w.x = cvt_pk_bf16(r[0], r[1]); w.y = cvt_pk_bf16(r[2], r[3]); w.z = cvt_pk_bf16(r[4], r[5]); w.w = cvt_pk_bf16(r[6], r[7]);
                *(u32x4*)(rowp) = w; }
    }
};
struct EpiBfPlain {
    static constexpr bool PERM = true, AFTER_DRAIN = false;
    bf16_t* O; int ldc; int nloc;
    __device__ __forceinline__ void operator()(const f32x4 (&acc)[2][2][4][2], const Unit& u, int wr, int wc, int fr, int fq) const {
        const int row0 = u.pm * BM + wr * 64 + fr; const int col0 = (u.pn % nloc) * BM + wc * 32 + 8 * fq;
#pragma unroll
        for (int ai = 0; ai < 2; ++ai)
#pragma unroll
            for (int m = 0; m < 4; ++m) { bf16_t* rowp = O + (size_t)(row0 + ai * HALF + m * 16) * ldc + col0;
#pragma unroll
                for (int bj = 0; bj < 2; ++bj) { const f32x4 v0 = acc[ai][bj][m][0], v1 = acc[ai][bj][m][1];
                    u32x4 w; w.x = cvt_pk_bf16(v0[0], v0[1]); w.y = cvt_pk_bf16(v0[2], v0[3]); w.z = cvt_pk_bf16(v1[0], v1[1]); w.w = cvt_pk_bf16(v1[2], v1[3]);
                    *(u32x4*)(rowp + bj * HALF) = w; } }
    }
};
struct MoeOrder {
    int ps[9]; int p0, p1, nloc, G, c; int a_off;
    __device__ __forceinline__ bool next(int i, Unit& u) const {
        const int L = i * G + c; const int np = p1 - p0; if (L >= np * nloc) return false;
        const int p = p0 + L / nloc, pl = L % nloc; int e = 0;
#pragma unroll
        for (int k = 1; k < 8; ++k) e += (p >= ps[k]) ? 1 : 0;
        u.pm = p + a_off; u.pn = e * nloc + pl; return true;
    }
    __device__ __forceinline__ void a_ready(const Unit&) const {}
    __device__ __forceinline__ void done(const Unit&) const {}
};
}
struct Ctx {
    LAS unsigned char* lds; gu32* ctl; int tid, lane, wave, G, gw, NGW;
    const float* const __attribute__((address_space(4)))* in; float* out; unsigned char* ws;
};
#define WSP(T, off) ((T*)(C.ws + (off)))

template <class MapF>
__device__ __forceinline__ void transpose_item(const float* W, int K, int N, bf16* WT, MapF map, LAS float* scr, int item, int lane) {
    const int nblk = N / 32, kb = item / nblk, nb = item % nblk, k0 = 64 * kb, n0 = 32 * nb;
#pragma unroll 8
    for (int i = 0; i < 32; ++i) { const int kk = 2 * i + (lane >> 5); scr[kk * 33 + (lane & 31)] = W[(size_t)(k0 + kk) * N + n0 + (lane & 31)]; }
    LDS_WAIT(); asm volatile("" ::: "memory");
    const int c = lane & 7; const int r0 = map(n0);
#pragma unroll
    for (int j = 0; j < 4; ++j) { const int n = (lane >> 3) + 8 * j; const LAS float* s = scr + (8 * c) * 33 + n;
        v4u o; o.x = pk2(s[0 * 33], s[1 * 33]); o.y = pk2(s[2 * 33], s[3 * 33]); o.z = pk2(s[4 * 33], s[5 * 33]); o.w = pk2(s[6 * 33], s[7 * 33]);
        *(GAS v4u*)(WT + (size_t)(r0 + n) * K + k0 + 8 * c) = o; }
    LDS_WAIT(); asm volatile("" ::: "memory");
}
struct MapId { __device__ __forceinline__ int operator()(int n0) const { return n0; } };
struct MapWin { __device__ __forceinline__ int operator()(int n0) const { return n0 < 2048 ? n0 : (n0 < 2080 ? n0 + 768 : n0 - 32); } };
struct MapGU { int up; __device__ __forceinline__ int operator()(int n0) const { return (n0 >> 7) * 256 + (n0 & 127) + up * 128; } };

__device__ __forceinline__ void p0_weights(Ctx& C) {
    LAS float* scr = (LAS float*)(C.lds + C.wave * 16384);
    constexpr int I_IN = (D / 64) * (NIN / 32), I_OUT = (D / 64) * (D / 32), I_G = (D / 64) * (FF / 32), I_D = (FF / 64) * (D / 32);
    constexpr int NITEMS = 2 * I_IN + 2 * I_OUT + 2 * I_G + I_D;
    for (int it = C.gw; it < NITEMS; it += C.NGW) {
        int r = it;
        if (r < 2 * I_IN) { const int l = r / I_IN; transpose_item(C.in[8] + (size_t)l * D * NIN, D, NIN, WSP(bf16, WS_WIN) + (size_t)l * NINP * D, MapWin(), scr, r % I_IN, C.lane); continue; } r -= 2 * I_IN;
        if (r < 2 * I_OUT) { const int l = r / I_OUT; transpose_item(C.in[15] + (size_t)l * D * D, D, D, WSP(bf16, WS_WOUT) + (size_t)l * D * D, MapId(), scr, r % I_OUT, C.lane); continue; } r -= 2 * I_OUT;
        if (r < I_G) { transpose_item(C.in[16], D, FF, WSP(bf16, WS_WGU), MapGU{0}, scr, r, C.lane); continue; } r -= I_G;
        if (r < I_G) { transpose_item(C.in[17], D, FF, WSP(bf16, WS_WGU), MapGU{1}, scr, r, C.lane); continue; } r -= I_G;
        transpose_item(C.in[18], FF, D, WSP(bf16, WS_WD), MapId(), scr, r, C.lane);
    }
    for (int i = C.gw * 64 + C.lane; i < 2 * 28672; i += C.NGW * 64) { const int l = i / 28672, j = i % 28672;
        *(GAS v4u*)(WSP(bf16, WS_WIN) + (size_t)l * NINP * D + (size_t)NIN * D + (size_t)j * 8) = (v4u){0u, 0u, 0u, 0u}; }
    for (int i = C.gw * 64 + C.lane; i < T * 32; i += C.NGW * 64) { const int t = i >> 5, a = i & 31;
        const float pos = (float)((a < 16) ? (t >> 6) : (t & 63)); const float fr = powf(10000.0f, -(float)(a & 15) / 16.0f);
        float sn, cs; sincosf(pos * fr, &sn, &cs);
        WSP(float, WS_ROPE)[i] = cs; WSP(float, WS_ROPE)[T * 32 + i] = sn; }
}
__device__ __forceinline__ void p0_mods(Ctx& C) {
    LAS float* sc = (LAS float*)C.lds;
    LAS float* part = (LAS float*)(C.lds + 32768);
    const int nblk = 2 * 6144 / 64;
    bool staged = false;
    for (int cb = blockIdx.x; cb < nblk; cb += C.G) {
        if (!staged) { for (int i = C.tid; i < 5 * 1024; i += 512) { const float v = (i < 4096) ? C.in[1][i] : C.in[3][i - 4096]; sc[i] = silu_f(v); } staged = true; }
        __syncthreads();
        const int l = cb / 96, j = (cb % 96) * 64 + C.lane;
        const float* wm = C.in[4] + (size_t)l * D * 6144 + j;
        float a0 = 0.f, a1 = 0.f, a2 = 0.f, a3 = 0.f, a4 = 0.f;
        const int kb = C.wave * 128;
#pragma unroll 8
        for (int k = 0; k < 128; ++k) { const float w = wm[(size_t)(kb + k) * 6144];
            a0 += sc[kb + k] * w; a1 += sc[1024 + kb + k] * w; a2 += sc[2048 + kb + k] * w; a3 += sc[3072 + kb + k] * w; a4 += sc[4096 + kb + k] * w; }
        part[(C.wave * 5 + 0) * 64 + C.lane] = a0; part[(C.wave * 5 + 1) * 64 + C.lane] = a1; part[(C.wave * 5 + 2) * 64 + C.lane] = a2;
        part[(C.wave * 5 + 3) * 64 + C.lane] = a3; part[(C.wave * 5 + 4) * 64 + C.lane] = a4;
        __syncthreads();
        if (C.tid < 320) { const int i = C.tid / 64, ln = C.tid % 64; const int jj = (cb % 96) * 64 + ln;
            float s = 0.f;
#pragma unroll
            for (int w = 0; w < 8; ++w) s += part[(w * 5 + i) * 64 + ln];
            s += C.in[5][l * 6144 + jj];
            const int chunk = jj >> 10, col = jj & 1023;
            if (chunk == 1) s = C.in[6][l * 1024 + col] * (1.0f + s);
            if (chunk == 4) s = C.in[7][l * 1024 + col] * (1.0f + s);
            WSP(float, WS_MODS)[((size_t)(l * 5 + i) * 6 + chunk) * 1024 + col] = s; }
        __syncthreads();
    }
}
__device__ __forceinline__ const float* mods_ptr(Ctx& C, int l, int i, int chunk) { return WSP(float, WS_MODS) + ((size_t)(l * 5 + i) * 6 + chunk) * 1024; }

typedef unsigned u32x2n __attribute__((ext_vector_type(2)));
template <bool ROUTE, bool XBF  >
__device__ __forceinline__ void norm_mod(Ctx& C, const void* xl, const void* xc, int nrows, int l, int chA, int chS, bf16* dst) {
    float rw[ROUTE ? 16 : 1][8];
    if (ROUTE) {
#pragma unroll
        for (int j = 0; j < 4; ++j)
#pragma unroll
            for (int q = 0; q < 4; ++q) { const f32x4 a = *(const f32x4*)(C.in[19] + (size_t)(4 * C.lane + 256 * j + q) * 8), b = *(const f32x4*)(C.in[19] + (size_t)(4 * C.lane + 256 * j + q) * 8 + 4);
                rw[j * 4 + q][0] = a.x; rw[j * 4 + q][1] = a.y; rw[j * 4 + q][2] = a.z; rw[j * 4 + q][3] = a.w; rw[j * 4 + q][4] = b.x; rw[j * 4 + q][5] = b.y; rw[j * 4 + q][6] = b.z; rw[j * 4 + q][7] = b.w; }
    }
    for (int m = C.gw; m < nrows; m += C.NGW) {
        const bool isc = m >= ML; const int bidx = isc ? 4 : (m >> 13);
        const size_t xoff = isc ? (size_t)(m - ML) * D : (size_t)m * D; const void* xbase = isc ? xc : xl;
        const GAS f32x4* Ap = (const GAS f32x4*)mods_ptr(C, l, bidx, chA) + C.lane; const GAS f32x4* Sp = (const GAS f32x4*)mods_ptr(C, l, bidx, chS) + C.lane;
        f32x4 v[4]; float s2 = 0.f;
#pragma unroll
        for (int j = 0; j < 4; ++j) {
            if (XBF) { const u32x2n w = *(const GAS u32x2n*)((const bf16*)xbase + xoff + 4 * C.lane + 256 * j); v[j] = (f32x4){bflo(w.x), bfhi(w.x), bflo(w.y), bfhi(w.y)}; }
            else v[j] = ((const GAS f32x4*)((const float*)xbase + xoff) + C.lane)[64 * j];
            s2 += (v[j].x * v[j].x + v[j].y * v[j].y) + (v[j].z * v[j].z + v[j].w * v[j].w); }
        const float rstd = 1.0f / sqrtf(wave_sum(s2) * (1.f / D) + EPS);
#pragma unroll
        for (int j = 0; j < 4; ++j) v[j] = v[j] * rstd * Ap[64 * j] + Sp[64 * j];
        GAS unsigned long long* o8 = (GAS unsigned long long*)(dst + (size_t)m * D) + C.lane;
#pragma unroll
        for (int j = 0; j < 4; ++j) o8[64 * j] = (unsigned long long)pk2(v[j].x, v[j].y) | ((unsigned long long)pk2(v[j].z, v[j].w) << 32);
        if (ROUTE) {
            float lg[8];
#pragma unroll
            for (int e = 0; e < 8; ++e) { float s = 0.f;
#pragma unroll
                for (int j = 0; j < 4; ++j) s += (v[j].x * rw[j * 4 + 0][e] + v[j].y * rw[j * 4 + 1][e]) + (v[j].z * rw[j * 4 + 2][e] + v[j].w * rw[j * 4 + 3][e]);
                lg[e] = wave_sum(s) + C.in[20][e]; }
            if (C.lane == 0) {
                int e0 = 0; float v0 = lg[0];
#pragma unroll
                for (int e = 1; e < 8; ++e) if (lg[e] > v0) { v0 = lg[e]; e0 = e; }
                int e1 = -1; float v1 = -INFINITY;
#pragma unroll
                for (int e = 0; e < 8; ++e) if (e != e0 && lg[e] > v1) { v1 = lg[e]; e1 = e; }
                const float w0 = 1.0f / (1.0f + expf(v1 - v0)), w1 = 1.0f - w0;
                const int s0 = (int)__hip_atomic_fetch_add(C.ctl + CW_CNT + 64 * e0, 1u, RLX_AGENT), s1 = (int)__hip_atomic_fetch_add(C.ctl + CW_CNT + 64 * e1, 1u, RLX_AGENT);
                WSP(int, WS_ROUTE)[m * 4 + 0] = e0; WSP(int, WS_ROUTE)[m * 4 + 1] = s0; WSP(int, WS_ROUTE)[m * 4 + 2] = e1; WSP(int, WS_ROUTE)[m * 4 + 3] = s1;
                WSP(float, WS_RW)[m * 2 + 0] = w0; WSP(float, WS_RW)[m * 2 + 1] = w1;
            }
        }
    }
}
__device__ __forceinline__ void load8(const bf16* p, float (&f)[8]) { const v4u w = *(const GAS v4u*)p; f[0] = bflo(w.x); f[1] = bfhi(w.x); f[2] = bflo(w.y); f[3] = bfhi(w.y); f[4] = bflo(w.z); f[5] = bfhi(w.z); f[6] = bflo(w.w); f[7] = bfhi(w.w); }
__device__ __forceinline__ void store8(bf16* p, const float (&f)[8]) { v4u w; w.x = pk2(f[0], f[1]); w.y = pk2(f[2], f[3]); w.z = pk2(f[4], f[5]); w.w = pk2(f[6], f[7]); *(GAS v4u*)p = w; }
__device__ __forceinline__ float sum8(float v) { v += __shfl_xor(v, 1); v += __shfl_xor(v, 2); v += __shfl_xor(v, 4); return v; }

__device__ __forceinline__ unsigned cvt4_fp8(float a, float b, float c, float d) { int w = 0; w = __builtin_amdgcn_cvt_pk_fp8_f32(a, b, w, false); w = __builtin_amdgcn_cvt_pk_fp8_f32(c, d, w, true); return (unsigned)w; }
constexpr float SQS = 0.42466090014400953f;
__device__ __forceinline__ void p3_prep(Ctx& C, int l) {
    const int lane = C.lane;
    const bf16* qraw = WSP(bf16, WS_QRAW); const bf16* kvraw = WSP(bf16, WS_KVRAW); const float* ab = WSP(float, WS_AB);
    unsigned char* q8 = WSP(unsigned char, WS_XN); unsigned char* k8 = WSP(unsigned char, WS_KALL); unsigned char* v8 = WSP(unsigned char, WS_VALL);
    const float* ropec = WSP(float, WS_ROPE); const float* ropes = ropec + T * 32;
    const int jj = (lane & 7) * 8;
    float qw[8], kw[8];
#pragma unroll
    for (int i = 0; i < 8; ++i) { qw[i] = C.in[13][l * 64 + jj + i]; kw[i] = C.in[14][l * 64 + jj + i]; }
    const int gd = (lane >> 3) & 1, gh = lane & 7;
    const float neg_a = -expf(C.in[10][l * 16 + gd * 8 + gh]), dtb = C.in[11][l * 16 + gd * 8 + gh];
    for (int m = C.gw; m < MT; m += C.NGW) {
        const bool isc = m >= ML; const int b = isc ? (m - ML) >> 8 : m >> 13; const int t = isc ? (m - ML) & 255 : m & 8191;
        {
            float f[8]; load8(qraw + (size_t)m * 512 + lane * 8, f);
            float ss = 0.f;
#pragma unroll
            for (int i = 0; i < 8; ++i) ss += f[i] * f[i];
            const float r = 1.0f / sqrtf(sum8(ss) * (1.f / 64.f) + EPS);
#pragma unroll
            for (int i = 0; i < 8; ++i) f[i] = f[i] * r * qw[i];
            if (!isc) {
                float o[8];
#pragma unroll
                for (int i = 0; i < 8; ++i) o[i] = __shfl_xor(f[i], 4);
                const int a0 = jj & 31; const bool first = jj < 32;
#pragma unroll
                for (int i = 0; i < 8; ++i) { const float cs = ropec[t * 32 + a0 + i], sn = ropes[t * 32 + a0 + i]; f[i] = first ? (f[i] * cs - o[i] * sn) : (f[i] * cs + o[i] * sn); }
            }
#pragma unroll
            for (int i = 0; i < 8; ++i) f[i] *= SQS;
            *(GAS u32x2n*)(q8 + (size_t)m * 512 + lane * 8) = (u32x2n){cvt4_fp8(f[0], f[1], f[2], f[3]), cvt4_fp8(f[4], f[5], f[6], f[7])};
        }
        {
            const size_t krow = (size_t)b * TK + (isc ? T + t : t);
            if (lane < 32) {
                float f[8]; load8(kvraw + (size_t)m * 256 + lane * 8, f);
                if (lane < 16) {
                    float ss = 0.f;
#pragma unroll
                    for (int i = 0; i < 8; ++i) ss += f[i] * f[i];
                    const float r = 1.0f / sqrtf(sum8(ss) * (1.f / 64.f) + EPS);
#pragma unroll
                    for (int i = 0; i < 8; ++i) f[i] = f[i] * r * kw[i];
                    float o[8];
#pragma unroll
                    for (int i = 0; i < 8; ++i) o[i] = __shfl_xor(f[i], 4);
                    if (!isc) { const int a0 = jj & 31; const bool first = jj < 32;
#pragma unroll
                        for (int i = 0; i < 8; ++i) { const float cs = ropec[t * 32 + a0 + i], sn = ropes[t * 32 + a0 + i]; f[i] = first ? (f[i] * cs - o[i] * sn) : (f[i] * cs + o[i] * sn); } }
#pragma unroll
                    for (int i = 0; i < 8; ++i) f[i] *= SQS;
                    *(GAS u32x2n*)(k8 + krow * 128 + lane * 8) = (u32x2n){cvt4_fp8(f[0], f[1], f[2], f[3]), cvt4_fp8(f[4], f[5], f[6], f[7])};
                } else {
                    const int pos = isc ? T + t : t, kk = pos & 63, vh = (lane - 16) >> 3, n0 = ((lane - 16) & 7) * 8;
                    unsigned char* vt = v8 + ((size_t)((b * 2 + vh) * (TK / 64) + (pos >> 6))) * 4096 + 32 * ((kk >> 2) & 1) + ((kk >> 5) << 4) + (((kk >> 3) & 3) << 2) + (kk & 3);
                    const unsigned w0 = cvt4_fp8(f[0], f[1], f[2], f[3]), w1 = cvt4_fp8(f[4], f[5], f[6], f[7]);
#pragma unroll
                    for (int i = 0; i < 4; ++i) { vt[(size_t)(n0 + i) * 64] = (unsigned char)(w0 >> (8 * i)); vt[(size_t)(n0 + 4 + i) * 64] = (unsigned char)(w1 >> (8 * i)); }
                }
            }
        }
        if (lane < 16) {
            const float a = ab[(size_t)m * 32 + lane], bb = ab[(size_t)m * 32 + 16 + lane];
            const float xx = a + dtb; const float sp = xx > 20.f ? xx : log1pf(expf(xx));
            WSP(float, WS_G)[((size_t)gd * MT + m) * 8 + gh] = neg_a * sp;
            WSP(float, WS_BETA)[((size_t)gd * MT + m) * 8 + gh] = 1.0f / (1.0f + expf(-bb));
        }
    }
}

__device__ __forceinline__ float silu_fast(float x) { return x * __builtin_amdgcn_rcpf(1.0f + __expf(-x)); }
__device__ __forceinline__ void p3b_dnconv(Ctx& C, int l) {
    const bf16* dnraw = WSP(bf16, WS_DNRAW); bf16* qdn = WSP(bf16, WS_QDN); bf16* kdn = WSP(bf16, WS_KDN); bf16* kt = WSP(bf16, WS_KT); bf16* vt = WSP(bf16, WS_VT);
    const float* cwl = C.in[9] + (size_t)l * 5 * 1536;
    LAS unsigned char* wl = C.lds + C.wave * 16384;
    if (C.gw < 85 * 24) {
        const int hs = C.gw % 24, sg = hs >> 3, h = hs & 7; const int ch0 = sg * 512 + h * 64;
        float wv[5];
#pragma unroll
        for (int tp = 0; tp < 5; ++tp) wv[tp] = cwl[tp * 1536 + ch0 + C.lane];
        const int lr = C.lane >> 3, lc = C.lane & 7;
        v4u stg[9];
#define DNC_REQ(ckk) do { const int t0_ = ((ckk) < 512) ? (((ckk) & 127) * 64) : ((((ckk) - 512) & 3) * 64); const int tlen_ = ((ckk) < 512) ? T : LC; \
            _Pragma("unroll") for (int i = 0; i < 9; ++i) { const int r_ = i * 8 + lr; const int tt_ = t0_ - 2 + r_; const bool ok_ = r_ < 68 && tt_ >= 0 && tt_ < tlen_; \
                stg[i] = ok_ ? *(const GAS v4u*)(dnraw + ((size_t)(ckk) * 64 - 2 + r_) * 1536 + ch0 + lc * 8) : (v4u){0u, 0u, 0u, 0u}; } } while (0)
        int ck = C.gw / 24;
        if (ck < 528) DNC_REQ(ck);
        for (; ck < 528; ck += 85) {
            asm volatile("s_waitcnt lgkmcnt(0)" ::: "memory");
#pragma unroll
            for (int i = 0; i < 9; ++i) { const int r = i * 8 + lr; if (r < 68) *(LAS v4u*)(wl + r * 144 + lc * 16) = stg[i]; }
            asm volatile("s_waitcnt lgkmcnt(0)" ::: "memory");
            if (ck + 85 < 528) DNC_REQ(ck + 85);
            const int m = ck * 64 + C.lane;
            float y[64];
#pragma unroll
            for (int i = 0; i < 64; ++i) y[i] = 0.f;
#pragma unroll
            for (int tp = 0; tp < 5; ++tp) {
#pragma unroll
                for (int cg = 0; cg < 8; ++cg) { const v4u w = *(const LAS v4u*)(wl + (C.lane + tp) * 144 + cg * 16);
                    const float f[8] = {bflo(w.x), bfhi(w.x), bflo(w.y), bfhi(w.y), bflo(w.z), bfhi(w.z), bflo(w.w), bfhi(w.w)};
#pragma unroll
                    for (int i = 0; i < 8; ++i) y[cg * 8 + i] += f[i] * __builtin_bit_cast(float, __builtin_amdgcn_readlane(__builtin_bit_cast(int, wv[tp]), cg * 8 + i)); } }
            float ss = 0.f;
#pragma unroll
            for (int i = 0; i < 64; ++i) { y[i] = silu_fast(y[i]); ss += y[i] * y[i]; }
            if (sg < 2) { const float r = (1.0f / sqrtf(ss + EPS)) * (sg == 0 ? 0.125f : 1.0f);
#pragma unroll
                for (int i = 0; i < 64; ++i) y[i] *= r; }
            if (sg < 2) { bf16* dst = (sg == 0 ? qdn : kdn) + (size_t)m * 512 + h * 64;
#pragma unroll
                for (int cg = 0; cg < 8; ++cg) { float f[8];
#pragma unroll
                    for (int i = 0; i < 8; ++i) f[i] = y[cg * 8 + i];
                    store8(dst + cg * 8, f); } }
            if (sg >= 1) { bf16* dst = (sg == 1 ? kt : vt) + ((size_t)ck * 8 + h) * 4096 + C.lane;
#pragma unroll
                for (int i = 0; i < 64; i += 2) { const unsigned w = pk2(y[i], y[i + 1]); dst[i * 64] = (bf16)(w & 0xffffu); dst[(i + 1) * 64] = (bf16)(w >> 16); } }
        }
#undef DNC_REQ
    }
    asm volatile("s_waitcnt lgkmcnt(0)" ::: "memory");
}

__device__ __forceinline__ int chunk_ck(int b, int cc) { return cc < 4 ? 512 + b * 4 + cc : b * 128 + (cc - 4); }
__device__ __forceinline__ int chunk_row(int b, int cc, int dir, int i) { const int ii = dir ? 63 - i : i; return cc < 4 ? ML + b * LC + cc * 64 + ii : b * T + (cc - 4) * 64 + ii; }
struct MapGUE { int off; __device__ __forceinline__ int operator()(int n0) const { return off + (n0 >> 7) * 256 + (n0 & 127); } };
__device__ __forceinline__ void moe_weights(Ctx& C) {
    LAS float* scr = (LAS float*)(C.lds + C.wave * 16384);
    constexpr int I_G = (D / 64) * (EF / 32), I_D = (EF / 64) * (D / 32);
    constexpr int NITEMS = NE * (2 * I_G + I_D);
    for (int it = C.gw; it < NITEMS; it += C.NGW) {
        const int e = it / (2 * I_G + I_D); int r = it % (2 * I_G + I_D);
        if (r < I_G) { transpose_item(C.in[21] + (size_t)e * D * EF, D, EF, WSP(bf16, WS_MGU), MapGUE{e * 7168}, scr, r, C.lane); continue; } r -= I_G;
        if (r < I_G) { transpose_item(C.in[22] + (size_t)e * D * EF, D, EF, WSP(bf16, WS_MGU), MapGUE{e * 7168 + 128}, scr, r, C.lane); continue; } r -= I_G;
        transpose_item(C.in[23] + (size_t)e * EF * D, EF, D, WSP(bf16, WS_MD) + (size_t)e * D * EF, MapId(), scr, r, C.lane);
    }
}
__device__ __forceinline__ void moe_panel_starts(Ctx& C, int (&ps)[9], int (&cnt)[8]) {
    int acc = 0;
#pragma unroll
    for (int e = 0; e < 8; ++e) { cnt[e] = (int)__hip_atomic_load(C.ctl + CW_CNT + 64 * e, RLX_AGENT); ps[e] = acc; acc += (cnt[e] + 255) >> 8; }
    ps[8] = acc;
}
__device__ __forceinline__ void moe_scatter(Ctx& C, const bf16* xn2) {
    int ps[9], cnt[8]; moe_panel_starts(C, ps, cnt);
    bf16* xs = WSP(bf16, WS_XS); const int* route = WSP(int, WS_ROUTE); int* pos = WSP(int, WS_POS);
    for (int m = C.gw; m < ML; m += C.NGW) {
        const int e0 = route[m * 4 + 0], s0 = route[m * 4 + 1], e1 = route[m * 4 + 2], s1 = route[m * 4 + 3];
        int p0 = 0, p1 = 0;
#pragma unroll
        for (int e = 0; e < 8; ++e) { p0 = (e == e0) ? ps[e] : p0; p1 = (e == e1) ? ps[e] : p1; }
        const int r0 = p0 * 256 + s0, r1 = p1 * 256 + s1;
        const GAS v4u* src = (const GAS v4u*)(xn2 + (size_t)m * D) + C.lane; GAS v4u* d0 = (GAS v4u*)(xs + (size_t)r0 * D) + C.lane; GAS v4u* d1 = (GAS v4u*)(xs + (size_t)r1 * D) + C.lane;
        const v4u a = src[0], b = src[64]; d0[0] = a; d0[64] = b; d1[0] = a; d1[64] = b;

        if (C.lane == 0) { pos[m * 2 + 0] = r0; pos[m * 2 + 1] = r1; }
    }
#pragma unroll
    for (int e = 0; e < 8; ++e) { const int nb = ps[e + 1] * 256 - (ps[e] * 256 + cnt[e]); const int rb = ps[e] * 256 + cnt[e];
        for (int r = C.gw; r < nb; r += C.NGW) { GAS v4u* d = (GAS v4u*)(xs + (size_t)(rb + r) * D) + C.lane; d[0] = (v4u){0u, 0u, 0u, 0u}; d[64] = (v4u){0u, 0u, 0u, 0u}; } }
}
__device__ __forceinline__ void moe_final(Ctx& C, int l) {
    const bf16* ys = WSP(bf16, WS_XS); const int* route = WSP(int, WS_POS); const float* rwt = WSP(float, WS_RW);
    for (int m = C.gw; m < ML; m += C.NGW) {
        const int r0 = route[m * 2 + 0], r1 = route[m * 2 + 1]; const float w0 = rwt[m * 2], w1 = rwt[m * 2 + 1];
        const int bidx = m >> 13; const float* g2 = mods_ptr(C, l, bidx, 5);
        float x[16]; float ss = 0.f;
#pragma unroll
        for (int j = 0; j < 2; ++j) { const int c0 = j * 512 + C.lane * 8; float a[8], bb[8]; load8(ys + (size_t)r0 * D + c0, a); load8(ys + (size_t)r1 * D + c0, bb);
            float xv[8]; load8(WSP(bf16, WS_XB2) + (size_t)m * D + c0, xv);
            const f32x4 ga = *(const GAS f32x4*)(g2 + c0), gb = *(const GAS f32x4*)(g2 + c0 + 4);
            const float gv[8] = {ga.x, ga.y, ga.z, ga.w, gb.x, gb.y, gb.z, gb.w};
#pragma unroll
            for (int i = 0; i < 8; ++i) { const float v = xv[i] + gv[i] * (w0 * a[i] + w1 * bb[i]); x[j * 8 + i] = v; ss += v * v; } }
        const float rstd = 1.0f / sqrtf(wave_sum(ss) * (1.f / D) + EPS);
#pragma unroll
        for (int j = 0; j < 2; ++j) { const int c0 = j * 512 + C.lane * 8;
            const f32x4 fa = *(const GAS f32x4*)(C.in[24] + c0), fb = *(const GAS f32x4*)(C.in[24] + c0 + 4);
            f32x4 oa = {x[j * 8 + 0] * rstd * fa.x, x[j * 8 + 1] * rstd * fa.y, x[j * 8 + 2] * rstd * fa.z, x[j * 8 + 3] * rstd * fa.w};
            f32x4 ob = {x[j * 8 + 4] * rstd * fb.x, x[j * 8 + 5] * rstd * fb.y, x[j * 8 + 6] * rstd * fb.z, x[j * 8 + 7] * rstd * fb.w};
            *(GAS f32x4*)(C.out + (size_t)m * D + c0) = oa; *(GAS f32x4*)(C.out + (size_t)m * D + c0 + 4) = ob; }
    }
}
typedef float f32x4_t __attribute__((ext_vector_type(4)));
__device__ __forceinline__ int pi_idx(int t, int m) { return 32 * (t >> 1) + 8 * (m >> 2) + 4 * (t & 1) + (m & 3); }
constexpr size_t DN_UNITS = (size_t)NB * 8 * 2 * NCH;
__device__ __forceinline__ int wq_next(gu32* head, int lane) { unsigned v = 0; if (lane == 0) v = __hip_atomic_fetch_add(head, 1u, RLX_AGENT); return (int)__builtin_amdgcn_readfirstlane(v); }
__device__ __forceinline__ void p5_dn1_fast(Ctx& C, int l) {
    const int lane = C.lane, l15 = lane & 15, g = lane >> 4;
    LAS unsigned char* wl = C.lds + C.wave * 16384;
    LAS float* Aimg = (LAS float*)wl;
    const bf16* kdn = WSP(bf16, WS_KDN); const bf16* kt = WSP(bf16, WS_KT); const bf16* vt = WSP(bf16, WS_VT);
    const float* G = WSP(float, WS_G); const float* BT = WSP(float, WS_BETA);
    uint2* FU = WSP(uint2, WS_U); v4u* FW = WSP(v4u, WS_W);
    gu32* qh = C.ctl + CW_Q + 64 * (2 * l);
    for (int u = wq_next(qh, lane); u < (int)DN_UNITS; u = wq_next(qh, lane)) {
        const int cc = u % NCH, dir = (u / NCH) & 1, h = (u / (2 * NCH)) & 7, b = u / (16 * NCH);
        const int ck = chunk_ck(b, cc); const size_t m0 = (size_t)ck * 64;
        float gr = G[((size_t)dir * MT + m0 + lane) * 8 + h]; const float be = BT[((size_t)dir * MT + m0 + lane) * 8 + h];
        if (dir) gr = __shfl(gr, 63 - lane);
#pragma unroll
        for (int o = 1; o < 64; o <<= 1) { const float n = __shfl_up(gr, o); if (lane >= o) gr += n; }
        if (dir) gr = __shfl(gr, 63 - lane);
        const float gcv = gr;
        { float* gcb = WSP(float, WS_GCB) + (size_t)u * 192; gcb[lane] = gcv; gcb[64 + lane] = __shfl(gcv, pi_idx((lane >> 2) & 3, 4 * (lane >> 4) + (lane & 3))); const float gl_ = __shfl(gcv, dir ? 0 : 63); if (lane == 0) gcb[128] = gl_;
          ((bf16*)(gcb + 132))[lane] = (bf16)(pk2(__expf(gl_ - __shfl(gcv, pi_idx((lane >> 2) & 3, 4 * (lane >> 4) + (lane & 3)))), 0.f) & 0xffffu); }
        bf16x8 kf[4][2];
#pragma unroll
        for (int t = 0; t < 4; ++t)
#pragma unroll
            for (int s = 0; s < 2; ++s) kf[t][s] = *(const bf16x8*)(kdn + (m0 + 16 * t + l15) * 512 + h * 64 + 32 * s + 8 * g);
        float gcol[4];
#pragma unroll
        for (int tj = 0; tj < 4; ++tj) gcol[tj] = __shfl(gcv, 16 * tj + l15);
#pragma unroll
        for (int ti = 0; ti < 4; ++ti) {
            float grow[4], brow[4];
#pragma unroll
            for (int r = 0; r < 4; ++r) { grow[r] = __shfl(gcv, 16 * ti + 4 * g + r); brow[r] = __shfl(be, 16 * ti + 4 * g + r); }
#pragma unroll
            for (int tj = 0; tj < 4; ++tj) {
                f32x4_t acc = {0.f, 0.f, 0.f, 0.f};
                acc = __builtin_amdgcn_mfma_f32_16x16x32_bf16(kf[ti][0], kf[tj][0], acc, 0, 0, 0);
                acc = __builtin_amdgcn_mfma_f32_16x16x32_bf16(kf[ti][1], kf[tj][1], acc, 0, 0, 0);
#pragma unroll
                for (int r = 0; r < 4; ++r) { const int si = 16 * ti + 4 * g + r, sj = 16 * tj + l15; const int ci = dir ? 63 - si : si, cj = dir ? 63 - sj : sj;
                    if (ci > cj) Aimg[cj * 64 + ci] = brow[r] * acc[r] * __expf(grow[r] - gcol[tj]); }
            }
        }
        asm volatile("s_waitcnt lgkmcnt(0)" ::: "memory");
        float tcol[64];
#pragma unroll
        for (int i = 0; i < 64; ++i) tcol[i] = (i == lane) ? 1.f : 0.f;
#pragma unroll
        for (int jb = 0; jb < 16; ++jb) {
            f32x4_t d[4];
#pragma unroll
            for (int c = 0; c < 4; ++c) d[c] = *(const LAS f32x4_t*)(Aimg + (4 * jb + c) * 64 + 4 * jb);
            const float t0 = tcol[4 * jb];
            const float t1 = tcol[4 * jb + 1] - d[0][1] * t0;
            const float t2 = tcol[4 * jb + 2] - d[0][2] * t0 - d[1][2] * t1;
            const float t3 = tcol[4 * jb + 3] - d[0][3] * t0 - d[1][3] * t1 - d[2][3] * t2;
            tcol[4 * jb + 1] = t1; tcol[4 * jb + 2] = t2; tcol[4 * jb + 3] = t3;
#pragma unroll
            for (int i4 = jb + 1; i4 < 16; ++i4) {
                const f32x4_t a0 = *(const LAS f32x4_t*)(Aimg + (4 * jb + 0) * 64 + 4 * i4), a1 = *(const LAS f32x4_t*)(Aimg + (4 * jb + 1) * 64 + 4 * i4);
                const f32x4_t a2 = *(const LAS f32x4_t*)(Aimg + (4 * jb + 2) * 64 + 4 * i4), a3 = *(const LAS f32x4_t*)(Aimg + (4 * jb + 3) * 64 + 4 * i4);
#pragma unroll
                for (int k = 0; k < 4; ++k) { float x = tcol[4 * i4 + k];
                    asm("v_fma_f32 %0, -%1, %2, %0" : "+v"(x) : "v"(a0[k]), "v"(t0)); asm("v_fma_f32 %0, -%1, %2, %0" : "+v"(x) : "v"(a1[k]), "v"(t1));
                    asm("v_fma_f32 %0, -%1, %2, %0" : "+v"(x) : "v"(a2[k]), "v"(t2)); asm("v_fma_f32 %0, -%1, %2, %0" : "+v"(x) : "v"(a3[k]), "v"(t3)); tcol[4 * i4 + k] = x; }
                if (((i4 - jb) & 3) == 0) __builtin_amdgcn_sched_barrier(0); }
            __builtin_amdgcn_sched_barrier(0); }
        asm volatile("s_waitcnt lgkmcnt(0)" ::: "memory");
        {   const int kap = dir ? 63 - lane : lane; const float bk = __shfl(be, kap), egk = __expf(__shfl(gcv, kap));
            LAS bf16* Tb = (LAS bf16*)wl; LAS bf16* Tg = Tb + 4096;
#pragma unroll
            for (int i = 0; i < 64; ++i) { const int rho = dir ? 63 - i : i; const float v = tcol[i] * bk; const unsigned w = pk2(v, -v * egk); Tb[rho * 64 + kap] = (bf16)(w & 0xffffu); Tg[rho * 64 + kap] = (bf16)(w >> 16); } }
        asm volatile("s_waitcnt lgkmcnt(0)" ::: "memory");
        {   const LAS bf16* Tb = (const LAS bf16*)wl; const LAS bf16* Tg = Tb + 4096;
            const bf16* vtb = vt + ((size_t)ck * 8 + h) * 4096; const bf16* ktb = kt + ((size_t)ck * 8 + h) * 4096;
            bf16x8 ta[4][2];
#pragma unroll
            for (int t = 0; t < 4; ++t)
#pragma unroll
                for (int p = 0; p < 2; ++p) ta[t][p] = *(const LAS bf16x8*)(Tb + pi_idx(t, l15) * 64 + 32 * p + 8 * g);
#pragma unroll
            for (int ne = 0; ne < 4; ++ne) {
                const bf16x8 vb0 = *(const bf16x8*)(vtb + (16 * ne + l15) * 64 + 8 * g), vb1 = *(const bf16x8*)(vtb + (16 * ne + l15) * 64 + 32 + 8 * g);
#pragma unroll
                for (int t = 0; t < 4; ++t) { f32x4_t acc = {0.f, 0.f, 0.f, 0.f};
                    acc = __builtin_amdgcn_mfma_f32_16x16x32_bf16(ta[t][0], vb0, acc, 0, 0, 0);
                    acc = __builtin_amdgcn_mfma_f32_16x16x32_bf16(ta[t][1], vb1, acc, 0, 0, 0);
                    uint2 w; w.x = pk2(acc[0], acc[1]); w.y = pk2(acc[2], acc[3]);
                    FU[(((size_t)u * 4 + ne) * 4 + t) * 64 + lane] = w; }
            }
#pragma unroll
            for (int t = 0; t < 4; ++t)
#pragma unroll
                for (int p = 0; p < 2; ++p) ta[t][p] = *(const LAS bf16x8*)(Tg + pi_idx(t, l15) * 64 + 32 * p + 8 * g);
#pragma unroll
            for (int pd = 0; pd < 2; ++pd) {
                bf16x8 ka[2][2];
#pragma unroll
                for (int hh = 0; hh < 2; ++hh)
#pragma unroll
                    for (int p = 0; p < 2; ++p) ka[hh][p] = *(const bf16x8*)(ktb + pi_idx(2 * pd + hh, l15) * 64 + 32 * p + 8 * g);
#pragma unroll
                for (int nc = 0; nc < 4; ++nc) { f32x4_t a0 = {0.f, 0.f, 0.f, 0.f}, a1 = {0.f, 0.f, 0.f, 0.f};
                    a0 = __builtin_amdgcn_mfma_f32_16x16x32_bf16(ka[0][0], ta[nc][0], a0, 0, 0, 0); a0 = __builtin_amdgcn_mfma_f32_16x16x32_bf16(ka[0][1], ta[nc][1], a0, 0, 0, 0);
                    a1 = __builtin_amdgcn_mfma_f32_16x16x32_bf16(ka[1][0], ta[nc][0], a1, 0, 0, 0); a1 = __builtin_amdgcn_mfma_f32_16x16x32_bf16(ka[1][1], ta[nc][1], a1, 0, 0, 0);
                    v4u w; w.x = pk2(a0[0], a0[1]); w.y = pk2(a0[2], a0[3]); w.z = pk2(a1[0], a1[1]); w.w = pk2(a1[2], a1[3]);
                    FW[(((size_t)u * 4 + nc) * 2 + pd) * 64 + lane] = w; }
            }
        }
        asm volatile("s_waitcnt lgkmcnt(0)" ::: "memory");
    }
}

__device__ __forceinline__ float dn_gcum(const float* G, int dir, size_t m0, int h, int lane) {
    float gr = G[((size_t)dir * MT + m0 + lane) * 8 + h];
    if (dir) gr = __shfl(gr, 63 - lane);
#pragma unroll
    for (int o = 1; o < 64; o <<= 1) { const float n = __shfl_up(gr, o); if (lane >= o) gr += n; }
    if (dir) gr = __shfl(gr, 63 - lane);
    return gr;
}
__device__ __forceinline__ bf16x8 pack8(const f32x4_t& a, const f32x4_t& b) { v4u w; w.x = pk2(a[0], a[1]); w.y = pk2(a[2], a[3]); w.z = pk2(b[0], b[1]); w.w = pk2(b[2], b[3]); return __builtin_bit_cast(bf16x8, w); }
constexpr int DN2_SLOT = 25600, DN2_NSLOT = 4;
__device__ __forceinline__ void dn2_issue(const v4u* FW, const uint2* FU, const bf16* kt, const float* GCB, int b, int h, int dir, int st, int lw, int lane, unsigned lds_slot) {
    const int l15 = lane & 15, g = lane >> 4;
    const int cc = dir == 0 ? st : (st < 4 ? 3 - st : NCH + 3 - st);
    const size_t u = ((size_t)((b * 8 + h) * 2 + dir)) * NCH + cc; const int ck = chunk_ck(b, cc);
    const unsigned char* fw = (const unsigned char*)(FW + u * 8 * 64); const unsigned char* fu = (const unsigned char*)(FU + u * 4 * 4 * 64);
    const unsigned char* ktb = (const unsigned char*)(kt + ((size_t)ck * 8 + h) * 4096); const unsigned char* gb = (const unsigned char*)(GCB + u * 192);
#pragma unroll
    for (int k = 0; k < 2; ++k) { const int j = 2 * lw + k;
        attn64::glds16(fw + j * 1024 + lane * 16, (unsigned)__builtin_amdgcn_readfirstlane(lds_slot + j * 1024));
        attn64::glds16(ktb + pi_idx(j >> 1, l15) * 128 + (j & 1) * 64 + g * 16, (unsigned)__builtin_amdgcn_readfirstlane(lds_slot + 8192 + j * 1024));
        attn64::glds16(fu + j * 1024 + lane * 16, (unsigned)__builtin_amdgcn_readfirstlane(lds_slot + 16384 + j * 1024)); }
    attn64::glds16(gb + 512 + (lane % 10) * 16, (unsigned)__builtin_amdgcn_readfirstlane(lds_slot + 24576));
}
__device__ __forceinline__ void p6_dn2_fast(Ctx& C, bool dry = false) {
    const int lane = C.lane, g = lane >> 4;
    const v4u* FW = WSP(v4u, WS_W); uint2* FU = WSP(uint2, WS_U); const bf16* kt = WSP(bf16, WS_KT); const float* GCB = WSP(float, WS_GCB);
    v4u* SS = WSP(v4u, WS_XN);
    const unsigned lds0 = (unsigned)(uintptr_t)C.lds;
    for (int ch = blockIdx.x; ch < NB * 8 * 2; ch += C.G) {
        const int dir = ch & 1, h = (ch >> 1) & 7, b = ch >> 4;
        __syncthreads();
        if (C.wave >= 4) {
            const int lw = C.wave - 4;
            dn2_issue(FW, FU, kt, GCB, b, h, dir, 0, lw, lane, lds0 + 0 * DN2_SLOT); dn2_issue(FW, FU, kt, GCB, b, h, dir, 1, lw, lane, lds0 + 1 * DN2_SLOT); dn2_issue(FW, FU, kt, GCB, b, h, dir, 2, lw, lane, lds0 + 2 * DN2_SLOT);
            for (int st = 0; st < NCH; ++st) {
                if (st + 2 < NCH) asm volatile("s_waitcnt vmcnt(14)" ::: "memory"); else if (st + 1 < NCH) asm volatile("s_waitcnt vmcnt(7)" ::: "memory"); else asm volatile("s_waitcnt vmcnt(0)" ::: "memory");
                __builtin_amdgcn_s_barrier();
                if (st + 3 < NCH) dn2_issue(FW, FU, kt, GCB, b, h, dir, st + 3, lw, lane, lds0 + ((st + 3) & 3) * DN2_SLOT);
            }
        } else {
            const int dvq = C.wave;
            f32x4_t S[4];
#pragma unroll
            for (int t = 0; t < 4; ++t) S[t] = (f32x4_t){0.f, 0.f, 0.f, 0.f};
            bf16x8 Sf[2]; Sf[0] = (bf16x8){0, 0, 0, 0, 0, 0, 0, 0}; Sf[1] = Sf[0];
            for (int st = 0; st < NCH; ++st) {
                asm volatile("s_waitcnt lgkmcnt(0)" ::: "memory");
                __builtin_amdgcn_s_barrier();
                asm volatile("" ::: "memory");
                const LAS unsigned char* sl = C.lds + (st & 3) * DN2_SLOT;
                const int cc = dir == 0 ? st : (st < 4 ? 3 - st : NCH + 3 - st);
                const size_t u = ((size_t)((b * 8 + h) * 2 + dir)) * NCH + cc;
                if (!dry) { SS[((u * 4 + dvq) * 2 + 0) * 64 + lane] = __builtin_bit_cast(v4u, Sf[0]); SS[((u * 4 + dvq) * 2 + 1) * 64 + lane] = __builtin_bit_cast(v4u, Sf[1]); }
                const float gl = *(const LAS float*)(sl + 24576); const float egl = __expf(gl);
                const v4u ef0 = *(const LAS v4u*)(sl + 24576 + 16 + g * 32), ef1 = *(const LAS v4u*)(sl + 24576 + 32 + g * 32);
                f32x4_t vn[4];
#pragma unroll
                for (int t = 0; t < 4; ++t) { typedef unsigned u32x2v __attribute__((ext_vector_type(2))); const u32x2v uu = *(const LAS u32x2v*)(sl + 16384 + dvq * 2048 + t * 512 + lane * 8);
                    const bf16x8 a0 = *(const LAS bf16x8*)(sl + (t * 2 + 0) * 1024 + lane * 16), a1 = *(const LAS bf16x8*)(sl + (t * 2 + 1) * 1024 + lane * 16);
                    vn[t] = (f32x4_t){bflo(uu.x), bfhi(uu.x), bflo(uu.y), bfhi(uu.y)};
                    vn[t] = __builtin_amdgcn_mfma_f32_16x16x32_bf16(a0, Sf[0], vn[t], 0, 0, 0);
                    vn[t] = __builtin_amdgcn_mfma_f32_16x16x32_bf16(a1, Sf[1], vn[t], 0, 0, 0); }
                if (!dry) { v4u* VN = (v4u*)(FU + ((u * 4 + dvq) * 4) * 64);
                    VN[0 * 64 + lane] = __builtin_bit_cast(v4u, pack8(vn[0], vn[1])); VN[1 * 64 + lane] = __builtin_bit_cast(v4u, pack8(vn[2], vn[3])); }
#pragma unroll
                for (int t = 0; t < 4; ++t) { const v4u& e = (t < 2) ? ef0 : ef1; const unsigned w0 = e[(t & 1) * 2], w1 = e[(t & 1) * 2 + 1];
                    vn[t][0] *= bflo(w0); vn[t][1] *= bfhi(w0); vn[t][2] *= bflo(w1); vn[t][3] *= bfhi(w1); }
                const bf16x8 vs0 = pack8(vn[0], vn[1]), vs1 = pack8(vn[2], vn[3]);
#pragma unroll
                for (int t = 0; t < 4; ++t) { const bf16x8 k0 = *(const LAS bf16x8*)(sl + 8192 + (t * 2 + 0) * 1024 + lane * 16), k1 = *(const LAS bf16x8*)(sl + 8192 + (t * 2 + 1) * 1024 + lane * 16);
                    S[t] = S[t] * egl;
                    S[t] = __builtin_amdgcn_mfma_f32_16x16x32_bf16(k0, vs0, S[t], 0, 0, 0);
                    S[t] = __builtin_amdgcn_mfma_f32_16x16x32_bf16(k1, vs1, S[t], 0, 0, 0); }
                Sf[0] = pack8(S[0], S[1]); Sf[1] = pack8(S[2], S[3]);
            }
            if (dry) { *(LAS v4u*)(C.lds + 110000 + (C.wave * 64 + lane) * 16) = __builtin_bit_cast(v4u, Sf[0]); }
        }
    }
    __syncthreads();
}
__device__ __forceinline__ void p7_dn3_fast(Ctx& C, int l) {
    const int lane = C.lane, l15 = lane & 15, g = lane >> 4;
    const bf16* qdn = WSP(bf16, WS_QDN); const bf16* kdn = WSP(bf16, WS_KDN);
    const v4u* VNb = WSP(v4u, WS_U); const v4u* SS = WSP(v4u, WS_XN); const bf16* zb = WSP(bf16, WS_ZB); bf16* mix = WSP(bf16, WS_MIX);
    LAS unsigned char* wl = C.lds + C.wave * 16384; const unsigned wl_addr = (unsigned)(uintptr_t)wl;
    const int cc0 = (l == 0) ? 0 : 4; const int ncc = NCH - cc0;
    gu32* qh = C.ctl + CW_Q + 64 * (2 * l + 1);
    for (int un = wq_next(qh, lane); un < NB * 8 * ncc; un = wq_next(qh, lane)) {
        const int cc = cc0 + un % ncc, h = (un / ncc) & 7, b = un / (8 * ncc);
        const int ck = chunk_ck(b, cc); const size_t m0 = (size_t)ck * 64;
        const size_t u0 = ((size_t)((b * 8 + h) * 2 + 0)) * NCH + cc;
        asm volatile("s_waitcnt lgkmcnt(0)" ::: "memory");
#pragma unroll
        for (int f = 0; f < 8; ++f) { attn64::glds16(SS + (u0 * 8 + f) * 64 + lane, (unsigned)__builtin_amdgcn_readfirstlane(wl_addr + f * 1024)); attn64::glds16(VNb + (u0 * 8 + f) * 64 + lane, (unsigned)__builtin_amdgcn_readfirstlane(wl_addr + 8192 + f * 1024)); }
        bf16x8 kf[4][2], qf[4][2];
#pragma unroll
        for (int t = 0; t < 4; ++t)
#pragma unroll
            for (int p = 0; p < 2; ++p) { kf[t][p] = *(const bf16x8*)(kdn + (m0 + pi_idx(t, l15)) * 512 + h * 64 + 32 * p + 8 * g); qf[t][p] = *(const bf16x8*)(qdn + (m0 + pi_idx(t, l15)) * 512 + h * 64 + 32 * p + 8 * g); }
        const float* gcb0 = WSP(float, WS_GCB) + u0 * 192; const float* gcb1 = gcb0 + (size_t)NCH * 192;
        f32x4_t o[4][4];
#pragma unroll
        for (int ni = 0; ni < 4; ++ni)
#pragma unroll
            for (int ne = 0; ne < 4; ++ne) o[ni][ne] = (f32x4_t){0.f, 0.f, 0.f, 0.f};
#pragma unroll
        for (int dir = 0; dir < 2; ++dir) {
            const float* gcbd = dir ? gcb1 : gcb0;
            f32x4_t rowg[4]; float gi[4];
#pragma unroll
            for (int t = 0; t < 4; ++t) { rowg[t] = *(const f32x4_t*)(gcbd + 64 + g * 16 + t * 4); gi[t] = gcbd[pi_idx(t, l15)]; }
            if (dir == 1) { const size_t u1 = u0 + NCH;
                asm volatile("s_waitcnt lgkmcnt(0)" ::: "memory");
#pragma unroll
                for (int f = 0; f < 8; ++f) { attn64::glds16(SS + (u1 * 8 + f) * 64 + lane, (unsigned)__builtin_amdgcn_readfirstlane(wl_addr + f * 1024)); attn64::glds16(VNb + (u1 * 8 + f) * 64 + lane, (unsigned)__builtin_amdgcn_readfirstlane(wl_addr + 8192 + f * 1024)); } }
            asm volatile("s_waitcnt vmcnt(0)" ::: "memory");
#pragma unroll
            for (int ni = 0; ni < 4; ++ni) {
                const int si = pi_idx(ni, l15);
                f32x4_t pt[4];
#pragma unroll
                for (int tj = 0; tj < 4; ++tj) { f32x4_t a = {0.f, 0.f, 0.f, 0.f};
                    a = __builtin_amdgcn_mfma_f32_16x16x32_bf16(kf[tj][0], qf[ni][0], a, 0, 0, 0);
                    a = __builtin_amdgcn_mfma_f32_16x16x32_bf16(kf[tj][1], qf[ni][1], a, 0, 0, 0);
#pragma unroll
                    for (int r = 0; r < 4; ++r) { const int sj = pi_idx(tj, 4 * g + r); const bool keep = dir ? (si <= sj) : (si >= sj);
                        a[r] = keep ? a[r] * __expf(gi[ni] - rowg[tj][r]) : 0.f; }
                    pt[tj] = a; }
                const bf16x8 pa0 = pack8(pt[0], pt[1]), pa1 = pack8(pt[2], pt[3]);
                float erow[4];
#pragma unroll
                for (int r = 0; r < 4; ++r) erow[r] = __expf(rowg[ni][r]);
#pragma unroll
                for (int ne = 0; ne < 4; ++ne) {
                    const bf16x8 s0 = *(const LAS bf16x8*)(wl + (ne * 2 + 0) * 1024 + lane * 16), s1 = *(const LAS bf16x8*)(wl + (ne * 2 + 1) * 1024 + lane * 16);
                    const bf16x8 v0 = *(const LAS bf16x8*)(wl + 8192 + (ne * 2 + 0) * 1024 + lane * 16), v1 = *(const LAS bf16x8*)(wl + 8192 + (ne * 2 + 1) * 1024 + lane * 16);
                    f32x4_t qs = {0.f, 0.f, 0.f, 0.f};
                    qs = __builtin_amdgcn_mfma_f32_16x16x32_bf16(qf[ni][0], s0, qs, 0, 0, 0);
                    qs = __builtin_amdgcn_mfma_f32_16x16x32_bf16(qf[ni][1], s1, qs, 0, 0, 0);
#pragma unroll
                    for (int r = 0; r < 4; ++r) o[ni][ne][r] += qs[r] * erow[r];
                    o[ni][ne] = __builtin_amdgcn_mfma_f32_16x16x32_bf16(pa0, v0, o[ni][ne], 0, 0, 0);
                    o[ni][ne] = __builtin_amdgcn_mfma_f32_16x16x32_bf16(pa1, v1, o[ni][ne], 0, 0, 0);
                    if (ne & 1) __builtin_amdgcn_sched_barrier(0); }
            }
        }
        asm volatile("s_waitcnt lgkmcnt(0)" ::: "memory");
        {   LAS bf16* ot = (LAS bf16*)wl;
#pragma unroll
            for (int ni = 0; ni < 4; ++ni)
#pragma unroll
                for (int ne = 0; ne < 4; ++ne) { const unsigned w0 = pk2(o[ni][ne][0], o[ni][ne][1]), w1 = pk2(o[ni][ne][2], o[ni][ne][3]); const int e = 16 * ne + l15;
                    ot[pi_idx(ni, 4 * g + 0) * 64 + e] = (bf16)(w0 & 0xffffu); ot[pi_idx(ni, 4 * g + 1) * 64 + e] = (bf16)(w0 >> 16);
                    ot[pi_idx(ni, 4 * g + 2) * 64 + e] = (bf16)(w1 & 0xffffu); ot[pi_idx(ni, 4 * g + 3) * 64 + e] = (bf16)(w1 >> 16); }
            asm volatile("s_waitcnt lgkmcnt(0)" ::: "memory");
            const size_t row = m0 + lane; float ov[64]; float ss = 0.f;
#pragma unroll
            for (int c = 0; c < 8; ++c) { const v4u w = *(const LAS v4u*)(wl + lane * 128 + c * 16);
                ov[c * 8 + 0] = bflo(w.x); ov[c * 8 + 1] = bfhi(w.x); ov[c * 8 + 2] = bflo(w.y); ov[c * 8 + 3] = bfhi(w.y); ov[c * 8 + 4] = bflo(w.z); ov[c * 8 + 5] = bfhi(w.z); ov[c * 8 + 6] = bflo(w.w); ov[c * 8 + 7] = bfhi(w.w); }
#pragma unroll
            for (int i = 0; i < 64; ++i) ss += ov[i] * ov[i];
            const float rs = 1.0f / sqrtf(ss * (1.f / 64.f) + EPS);
#pragma unroll
            for (int c = 0; c < 8; ++c) { float z[8]; load8(zb + row * 512 + h * 64 + c * 8, z); float r8[8];
#pragma unroll
                for (int i = 0; i < 8; ++i) r8[i] = ov[c * 8 + i] * rs * C.in[12][l * 64 + c * 8 + i] * silu_f(z[i]);
                store8(mix + row * 1024 + h * 64 + c * 8, r8); }
        }
    }
    asm volatile("s_waitcnt lgkmcnt(0)" ::: "memory");
}
__device__ __forceinline__ void p4_attn_fast(Ctx& C, char* ldsg, int l, bool dry = false) {
    const int bx = blockIdx.x; const int vcu = (C.G % 8 == 0) ? (bx % 8) * (C.G / 8) + bx / 8 : bx;
    attn64::bf16* mix = (attn64::bf16*)WSP(bf16, WS_MIX); attn64::bf16* omix = mix; const unsigned char* q8 = WSP(unsigned char, WS_XN); const unsigned char* k8 = WSP(unsigned char, WS_KALL); const unsigned char* v8 = WSP(unsigned char, WS_VALL);     const attn64::bf16* kall = (const attn64::bf16*)WSP(bf16, WS_KALL); const attn64::bf16* vall = (const attn64::bf16*)WSP(bf16, WS_VALL);
    float mq = fabsf(C.in[13][l * 64 + C.lane]), mk = fabsf(C.in[14][l * 64 + C.lane]);
#pragma unroll
    for (int o = 1; o < 64; o <<= 1) { mq = fmaxf(mq, __shfl_xor(mq, o)); mk = fmaxf(mk, __shfl_xor(mk, o)); }
    const float mref = 64.0f * QSCALE * mq * mk * 1.02f;
    const int nun = NB * 8 * (T / 256) + (l == 0 ? NB * 8 : 0);
    for (int L = vcu; L < nun; L += C.G) {
        int qrow, krow, nt, h;
        if (L < 1024) { const int within = L & 255, bh = within >> 3, qb = (within & 7) + 8 * (L >> 8); const int b = bh >> 3; h = bh & 7; qrow = b * T + qb * 256; krow = b * TK; nt = TK / 64; }
        else { const int b = (L - 1024) >> 3; h = L & 7; qrow = ML + b * LC; krow = b * TK + T; nt = LC / 64; }
        const int kvh = h >> 2;
        attn64::attn_unit8(q8 + (size_t)qrow * 512 + h * 64, omix + (size_t)qrow * 1024 + 512 + h * 64, k8 + (size_t)krow * 128 + kvh * 64, v8 + ((size_t)((krow / TK) * 2 + kvh) * (TK / 64) + (krow % TK) / 64) * 4096, nt, ldsg, mref);
    }
    __syncthreads();
}
__device__ __forceinline__ void tile64(Ctx& C, const bf16* X, int lda, const bf16* Wt, int ldb, int K, float (&r)[8]) {
    typedef pg8::bf16x8 frag_t; typedef pg8::f32x4 c4_t;
    const int lane = C.lane, r16 = lane & 15, g = lane >> 4, w = C.wave;
    const int npair = K >> 6, pbase = npair >> 3, prem = npair & 7;
    const int np = pbase + (w < prem ? 1 : 0), pstart = w * pbase + (w < prem ? w : prem);
    const bf16* xp = X + (size_t)r16 * lda + pstart * 64 + 16 * g;
    const bf16* wp = Wt + (size_t)r16 * ldb + pstart * 64 + 16 * g;
    c4_t acc[4][4];
#pragma unroll
    for (int a = 0; a < 4; ++a)
#pragma unroll
        for (int b = 0; b < 4; ++b) acc[a][b] = (c4_t){0.f, 0.f, 0.f, 0.f};
    frag_t xa[8], wa[8], xb[8], wb[8];
#define T64_LD(xf, wf, p) do { _Pragma("unroll") for (int t_ = 0; t_ < 4; ++t_) { const bf16* xq_ = xp + (size_t)(16 * t_) * lda + 64 * (p); const bf16* wq_ = wp + (size_t)(16 * t_) * ldb + 64 * (p); \
        xf[2 * t_] = *(const GAS frag_t*)(xq_); xf[2 * t_ + 1] = *(const GAS frag_t*)(xq_ + 8); wf[2 * t_] = *(const GAS frag_t*)(wq_); wf[2 * t_ + 1] = *(const GAS frag_t*)(wq_ + 8); } } while (0)
#define T64_MM(xf, wf) do { _Pragma("unroll") for (int h_ = 0; h_ < 2; ++h_) _Pragma("unroll") for (int nt_ = 0; nt_ < 4; ++nt_) _Pragma("unroll") for (int mt_ = 0; mt_ < 4; ++mt_) \
        acc[nt_][mt_] = __builtin_amdgcn_mfma_f32_16x16x32_bf16(wf[2 * nt_ + h_], xf[2 * mt_ + h_], acc[nt_][mt_], 0, 0, 0); } while (0)
#define T64_SB __builtin_amdgcn_sched_barrier(0)
    T64_LD(xa, wa, 0); if (1 < np) T64_LD(xb, wb, 1); T64_SB;
    for (int p = 0; p < np; p += 2) {
        T64_MM(xa, wa); T64_SB;
        if (p + 2 < np) T64_LD(xa, wa, p + 2); T64_SB;
        if (p + 1 < np) T64_MM(xb, wb); T64_SB;
        if (p + 3 < np) T64_LD(xb, wb, p + 3); T64_SB;
    }
#undef T64_SB
#undef T64_LD
#undef T64_MM
    LAS unsigned char* P = C.lds + w * 16384;
#pragma unroll
    for (int nt = 0; nt < 4; ++nt)
#pragma unroll
        for (int mt = 0; mt < 4; ++mt) { const int m = 16 * mt + r16, nb = (16 * nt + 4 * g) * 4; *(LAS c4_t*)(P + m * 256 + (nb ^ (r16 << 4))) = acc[nt][mt]; }
    __syncthreads();
    const int m = 8 * w + (lane >> 3), cb = (lane & 7) * 32, sw = (m & 15) << 4;
#pragma unroll
    for (int i = 0; i < 8; ++i) r[i] = 0.f;
#pragma unroll
    for (int q = 0; q < 8; ++q) { const LAS unsigned char* Q = C.lds + q * 16384 + m * 256; const c4_t a = *(const LAS c4_t*)(Q + (cb ^ sw)), b = *(const LAS c4_t*)(Q + ((cb + 16) ^ sw));
        r[0] += a[0]; r[1] += a[1]; r[2] += a[2]; r[3] += a[3]; r[4] += b[0]; r[5] += b[1]; r[6] += b[2]; r[7] += b[3]; }
    __syncthreads();
}
template <bool XF32> __device__ __forceinline__ void ctx_res_tiles(Ctx& C, const bf16* X, int lda, const bf16* Wt, int K, const void* xin, bf16* out, const float* gate) {
    for (int tI = blockIdx.x; tI < 256; tI += C.G) {
        const int xcd = tI & 7, idx = tI >> 3, ti = 8 * (xcd & 1) + (idx & 7), tj = 4 * (xcd >> 1) + (idx >> 3);
        float r[8]; tile64(C, X + (size_t)(64 * ti) * lda, lda, Wt + (size_t)(64 * tj) * K, K, K, r);
        const size_t off = (size_t)(64 * ti + 8 * C.wave + (C.lane >> 3)) * D + 64 * tj + 8 * (C.lane & 7);
        float x[8];
        if (XF32) { const f32x4 a = *(const GAS f32x4*)((const float*)xin + off), b = *(const GAS f32x4*)((const float*)xin + off + 4); x[0] = a.x; x[1] = a.y; x[2] = a.z; x[3] = a.w; x[4] = b.x; x[5] = b.y; x[6] = b.z; x[7] = b.w; }
        else load8((const bf16*)xin + off, x);
        const f32x4 ga = *(const GAS f32x4*)(gate + 64 * tj + 8 * (C.lane & 7)), gb = *(const GAS f32x4*)(gate + 64 * tj + 8 * (C.lane & 7) + 4);
        const float o[8] = {x[0] + ga.x * r[0], x[1] + ga.y * r[1], x[2] + ga.z * r[2], x[3] + ga.w * r[3], x[4] + gb.x * r[4], x[5] + gb.y * r[5], x[6] + gb.z * r[6], x[7] + gb.w * r[7]};
        store8(out + off, o);
    }
}
__device__ __forceinline__ void moe_down_tiles(Ctx& C, const int (&ps)[9], int p0, int p1) {
    const bf16* hm = WSP(bf16, WS_HM); const bf16* md = WSP(bf16, WS_MD); bf16* ys = WSP(bf16, WS_XS);
    const int nt = (p1 - p0) * 64;
    for (int tI = blockIdx.x; tI < nt; tI += C.G) {
        const int p = p0 + (tI >> 6), mi = (tI >> 4) & 3, nj = tI & 15; int e = 0;
#pragma unroll
        for (int k = 1; k < 8; ++k) e += (p >= ps[k]) ? 1 : 0;
        float r[8]; tile64(C, hm + (size_t)((p - p0) * 256 + 64 * mi) * EF, EF, md + (size_t)e * D * EF + (size_t)(64 * nj) * EF, EF, EF, r);
        store8(ys + (size_t)(p * 256 + 64 * mi + 8 * C.wave + (C.lane >> 3)) * D + 64 * nj + 8 * (C.lane & 7), r);
    }
}
#define STAMP() do {} while (0)
#define RELOAD() do { int t_ = threadIdx.x; asm volatile("" : "+v"(t_)); C.tid = t_; C.lane = t_ & 63; C.wave = __builtin_amdgcn_readfirstlane(t_ >> 6); C.gw = blockIdx.x * NWAVES + C.wave; } while (0)
#define GRID_BAR() do { XcdBarrier b2_ = bar; asm volatile("" : "+s"(b2_.x), "+s"(b2_.bar)); xcd_barrier(b2_); RELOAD(); STAMP(); } while (0)
template <int l> __device__ __forceinline__ void layer_fn(Ctx& C, const XcdBarrier& bar, unsigned char* lds) {
        bf16* const xb1 = (bf16*)C.out;
        const void* xl = (l == 0) ? (const void*)C.in[0] : (const void*)xb1; const void* xc = (l == 0) ? (const void*)C.in[2] : (const void*)WSP(bf16, WS_XC);
        norm_mod<false, l != 0>(C, xl, xc, MT, l, 1, 0, WSP(bf16, WS_XN));
        GRID_BAR();
        {   pg8::Gemm g{WSP(bf16, WS_XN), WSP(bf16, WS_WIN) + (size_t)l * NINP * D, MT, NINP, D}; pg8::StaticOrder S; S.init(MT, NINP, C.G, (int)blockIdx.x);
            pg8::EpiIn E{WSP(bf16, WS_DNRAW), WSP(bf16, WS_ZB), WSP(bf16, WS_QRAW), WSP(bf16, WS_KVRAW), WSP(float, WS_AB)};
            pg8::gemm_phase<pg8::EpiIn, pg8::StaticOrder, true, true>(C.lds, g, S, E); }
        GRID_BAR();
        p3_prep(C, l);
        RELOAD();
        p3b_dnconv(C, l);
        GRID_BAR();
        p4_attn_fast(C, (char*)lds, l);
        STAMP();
        RELOAD();
        p5_dn1_fast(C, l);
        GRID_BAR();
        p6_dn2_fast(C);
        GRID_BAR();
        p7_dn3_fast(C, l);
        GRID_BAR();
        {   const int Mo = ML;
            pg8::Gemm g{WSP(bf16, WS_MIX), WSP(bf16, WS_WOUT) + (size_t)l * D * D, Mo, D, D}; pg8::StaticOrder S; S.init(Mo, D, C.G, (int)blockIdx.x);
            pg8::EpiRes<l == 0> E{xl, (l == 0) ? xb1 : WSP(bf16, WS_XB2), xc, WSP(bf16, WS_XC), mods_ptr(C, l, 0, 2), 6 * 1024};
            pg8::gemm_phase<pg8::EpiRes<l == 0>, pg8::StaticOrder, true, true>(C.lds, g, S, E); }
        if (l == 0) { RELOAD(); ctx_res_tiles<true>(C, WSP(bf16, WS_MIX) + (size_t)ML * D, D, WSP(bf16, WS_WOUT), D, C.in[2], WSP(bf16, WS_XC), mods_ptr(C, 0, 4, 2)); }
        GRID_BAR();
        if (l == 0) {
            norm_mod<false, true>(C, xb1, WSP(bf16, WS_XC), MT, l, 4, 3, WSP(bf16, WS_XN));
            GRID_BAR();
            {   pg8::Gemm g{WSP(bf16, WS_XN), WSP(bf16, WS_WGU), MT, 2 * FF, D}; pg8::StaticOrder S; S.init(MT, 2 * FF, C.G, (int)blockIdx.x);
                pg8::EpiSwiGLU E{WSP(bf16, WS_H), FF, 22, 0};
                pg8::gemm_phase<pg8::EpiSwiGLU, pg8::StaticOrder, true, true>(C.lds, g, S, E); }
            GRID_BAR();
            {   pg8::Gemm g{WSP(bf16, WS_H), WSP(bf16, WS_WD), ML, D, FF}; pg8::StaticOrder S; S.init(ML, D, C.G, (int)blockIdx.x);
                pg8::EpiRes<false> E{xb1, xb1, WSP(bf16, WS_XC), WSP(bf16, WS_XC), mods_ptr(C, l, 0, 5), 6 * 1024};
                pg8::gemm_phase<pg8::EpiRes<false>, pg8::StaticOrder, true, true>(C.lds, g, S, E); }
            RELOAD(); ctx_res_tiles<false>(C, WSP(bf16, WS_H) + (size_t)ML * FF, FF, WSP(bf16, WS_WD), FF, WSP(bf16, WS_XC), WSP(bf16, WS_XC), mods_ptr(C, 0, 4, 5));
            GRID_BAR();
        } else {
            norm_mod<true, true>(C, WSP(bf16, WS_XB2), WSP(bf16, WS_XC), ML, l, 4, 3, WSP(bf16, WS_HM));
            RELOAD();
            moe_weights(C);
            GRID_BAR();
            moe_scatter(C, WSP(bf16, WS_HM));
            GRID_BAR();
            int ps[9], cnt[8]; moe_panel_starts(C, ps, cnt);
            const int per = SS_PANELS;
            for (int ss = 0; ss < NSS; ++ss) {
                const int p0 = ss * per, p1 = (p0 + per < ps[8]) ? p0 + per : ps[8];
                if (p0 < p1) {
                    pg8::MoeOrder S;
#pragma unroll
                    for (int k = 0; k < 9; ++k) S.ps[k] = ps[k];
                    S.p0 = p0; S.p1 = p1; S.nloc = 28; S.G = C.G; S.c = (int)blockIdx.x; S.a_off = 0;
                    pg8::Gemm g{WSP(bf16, WS_XS), WSP(bf16, WS_MGU), 0, 0, D};
                    pg8::EpiSwiGLU E{WSP(bf16, WS_HM), EF, 28, p0};
                    pg8::gemm_phase<pg8::EpiSwiGLU, pg8::MoeOrder, true, true>(C.lds, g, S, E);
                }
                GRID_BAR();
                if (p0 < p1 && p1 - p0 <= 12) { moe_down_tiles(C, ps, p0, p1); }
                else if (p0 < p1) {
                    pg8::MoeOrder S;
#pragma unroll
                    for (int k = 0; k < 9; ++k) S.ps[k] = ps[k];
                    S.p0 = p0; S.p1 = p1; S.nloc = 4; S.G = C.G; S.c = (int)blockIdx.x; S.a_off = -p0;
                    pg8::Gemm g{WSP(bf16, WS_HM), WSP(bf16, WS_MD), 0, 0, EF};
                    pg8::EpiBfPlain E{WSP(bf16, WS_XS) + (size_t)p0 * 256 * D, D, 4};
                    pg8::gemm_phase<pg8::EpiBfPlain, pg8::MoeOrder, true, true>(C.lds, g, S, E);
                }
                GRID_BAR();
            }
            moe_final(C, l);
        }
    }
struct Args { const float* in[25]; float* out; unsigned char* ws; };
__global__ void __launch_bounds__(NWAVES * 64, 2) mk_fwd(Args args) {
    extern __shared__ __attribute__((aligned(16))) unsigned char lds[];
    Ctx C;
    C.lds = (LAS unsigned char*)lds; C.tid = threadIdx.x; C.lane = C.tid & 63; C.wave = __builtin_amdgcn_readfirstlane(C.tid >> 6);
    C.G = gridDim.x; C.gw = blockIdx.x * NWAVES + C.wave; C.NGW = C.G * NWAVES;
    C.in = (const float* const __attribute__((address_space(4)))*)__builtin_amdgcn_kernarg_segment_ptr();
    C.out = args.out; C.ws = args.ws; C.ctl = (gu32*)args.ws;
    volatile LAS unsigned* MISC = (volatile LAS unsigned*)(C.lds + MISC_OFF);
    for (int u = C.tid; u < (LDS_BYTES - LDSCTL_OFF) / 4; u += NWAVES * 64) ((LAS unsigned*)(C.lds + LDSCTL_OFF))[u] = 0u;
    __syncthreads();
    XcdBarrier bar = xcd_barrier_post((unsigned*)(C.ctl + CW_BAR), MISC + 8);
    p0_weights(C); __syncthreads(); RELOAD(); p0_mods(C);
    GRID_BAR();
    layer_fn<0>(C, bar, lds);
    layer_fn<1>(C, bar, lds);
}

extern "C" void kernel_launch(void* const* d_in, const int* in_sizes, int n_in, void* d_out, int out_size, void* d_ws, size_t ws_size, hipStream_t stream) {
    static int grid = 0;
    if (grid == 0) {
        int dev = 0, cus = 0;
        if (n_in != 25 || out_size != ML * D || ws_size < (size_t)560 * MiB) { fprintf(stderr, "kernel_launch: unexpected problem (n_in %d out %d ws %zu)\n", n_in, out_size, ws_size); grid = -1; return; }
        if (hipGetDevice(&dev) != hipSuccess || hipDeviceGetAttribute(&cus, hipDeviceAttributeMultiprocessorCount, dev) != hipSuccess) { grid = -1; return; }
        if (hipFuncSetAttribute((const void*)mk_fwd, hipFuncAttributeMaxDynamicSharedMemorySize, LDS_BYTES) != hipSuccess) { grid = -1; return; }
        (void)hipGetLastError();
        grid = cus;
    }
    if (grid < 0) return;
    (void)hipMemsetAsync((char*)d_ws, 0, CTL_ZERO_BYTES, stream);
    Args a{};
    for (int i = 0; i < 25; ++i) a.in[i] = (const float*)d_in[i];
    a.out = (float*)d_out; a.ws = (unsigned char*)d_ws;
    hipLaunchKernelGGL(mk_fwd, dim3(grid), dim3(NWAVES * 64), LDS_BYTES, stream, a);
}
```
